# Optimizing an MI355X kernel written in HIP

```python
import math
import jax
import jax.numpy as jnp
from jax import lax
import numpy as np

D_MODEL = 1024
BATCH = 2
SEQ = 8192
DEPTH = 2

GRID_W = 64
CTX_LEN = 256
RMS_EPS = 1e-6
N_BRANCH = 3
BRANCH_W = 512
ATT_HEADS = 8
ATT_KV_HEADS = 2
ATT_HEAD_DIM = 64
ATT_GROUP = ATT_HEADS // ATT_KV_HEADS
Q_BLOCK = 128
ROPE_THETA = 10000.0
SSD_HEADS = 8
SSD_HEAD_DIM = 64
SSD_INNER = SSD_HEADS * SSD_HEAD_DIM
SSD_GROUPS = 2
SSD_STATE = 64
SSD_XBC = SSD_INNER + 2 * SSD_GROUPS * SSD_STATE
SSD_CONV = 5
SSD_CHUNK = 128
ML_HEADS = 4
ML_HEAD_DIM = 128
ML_INNER = ML_HEADS * ML_HEAD_DIM
ML_CHUNK = 128
PEER_HEADS = 8
PEER_KEYS = 128
PEER_EXPERTS = PEER_KEYS * PEER_KEYS
PEER_TOPK = 16
PEER_QDIM = 256
PEER_BLOCK = 128
IN_SPLITS = (ATT_HEADS * ATT_HEAD_DIM, ATT_KV_HEADS * ATT_HEAD_DIM, ATT_KV_HEADS * ATT_HEAD_DIM,
             SSD_INNER, SSD_XBC, 2 * SSD_HEADS,
             ML_INNER, ML_INNER, ML_INNER, ML_INNER, 4 * ML_HEADS,
             N_BRANCH * D_MODEL)
IN_COLS = sum(IN_SPLITS)

kernel_name = 'hybrid_gqa_ssd_mlstm_peer_dit'


def rmsnorm(x, g):
    xf = x.astype(jnp.float32)
    y = xf * lax.rsqrt(jnp.mean(xf * xf, axis=-1, keepdims=True) + RMS_EPS)
    return (y * g.astype(jnp.float32)).astype(x.dtype)


def split_cols(p):
    bounds = np.cumsum(IN_SPLITS)[:-1].tolist()
    return jnp.split(p, bounds, axis=-1)


def heads(t, n):
    return t.reshape(t.shape[0], t.shape[1], n, -1)


def axial_rope(rows):
    n_freq = ATT_HEAD_DIM // 4
    inv = ROPE_THETA ** (-jnp.arange(n_freq, dtype=jnp.float32) / n_freq)
    row = jnp.broadcast_to(jnp.arange(rows, dtype=jnp.float32)[:, None], (rows, GRID_W)).reshape(-1)
    col = jnp.broadcast_to(jnp.arange(GRID_W, dtype=jnp.float32)[None, :], (rows, GRID_W)).reshape(-1)
    ang = jnp.concatenate([row[:, None] * inv, col[:, None] * inv], axis=-1)
    return jnp.cos(ang), jnp.sin(ang)


def apply_rope(t, cos, sin):
    half = t.shape[-1] // 2
    tf = t.astype(jnp.float32)
    t1, t2 = tf[..., :half], tf[..., half:]
    c, s = cos[:, None, :], sin[:, None, :]
    return jnp.concatenate([t1 * c - t2 * s, t1 * s + t2 * c], axis=-1).astype(t.dtype)


def latent_attention(q, k, v, kc, vc):
    Bsz, S = q.shape[0], q.shape[1]
    kk = jnp.concatenate([k, kc], axis=1)
    vv = jnp.concatenate([v, vc], axis=1)
    nb = S // Q_BLOCK
    qb = q.reshape(Bsz, nb, Q_BLOCK, ATT_KV_HEADS, ATT_GROUP, ATT_HEAD_DIM).transpose(1, 0, 2, 3, 4, 5)
    scale = ATT_HEAD_DIM ** -0.5

    def block(qblk):
        s = jnp.einsum('bqkgd,bmkd->bkgqm', qblk, kk).astype(jnp.float32) * scale
        p = jax.nn.softmax(s, axis=-1).astype(vv.dtype)
        return jnp.einsum('bkgqm,bmkd->bqkgd', p, vv)

    o = lax.map(block, qb)
    return o.transpose(1, 0, 2, 3, 4, 5).reshape(Bsz, S, ATT_HEADS * ATT_HEAD_DIM)


def context_attention(qc, kc, vc):
    Bsz, L = qc.shape[0], qc.shape[1]
    qg = qc.reshape(Bsz, L, ATT_KV_HEADS, ATT_GROUP, ATT_HEAD_DIM)
    s = jnp.einsum('blkgd,bmkd->bkglm', qg, kc).astype(jnp.float32) * ATT_HEAD_DIM ** -0.5
    p = jax.nn.softmax(s, axis=-1).astype(vc.dtype)
    o = jnp.einsum('bkglm,bmkd->blkgd', p, vc)
    return o.reshape(Bsz, L, ATT_HEADS * ATT_HEAD_DIM)


def dwconv(x, w, b):
    out = lax.conv_general_dilated(x, w[:, None, :], window_strides=(1,), padding='SAME',
                                   dimension_numbers=('NWC', 'WIO', 'NWC'),
                                   feature_group_count=x.shape[-1])
    return out + b


def segsum(a):
    T = a.shape[-1]
    xa = jnp.broadcast_to(a[..., None], a.shape + (T,))
    xa = jnp.where(jnp.tril(jnp.ones((T, T), bool), -1), xa, 0.0)
    cs = jnp.cumsum(xa, axis=-2)
    return jnp.where(jnp.tril(jnp.ones((T, T), bool)), cs, -jnp.inf)


def ssd_scan(x, dt, A, Bm, Cm, init, with_output):
    Bsz, T, H, P = x.shape
    G, N = Bm.shape[2], Bm.shape[3]
    R = H // G
    Q = SSD_CHUNK
    nc = T // Q
    a = dt * A
    xc = (x * dt[..., None]).reshape(Bsz, nc, Q, G, R, P)
    ac = a.reshape(Bsz, nc, Q, G, R).transpose(0, 3, 4, 1, 2)
    Bc = Bm.reshape(Bsz, nc, Q, G, N)
    Cc = Cm.reshape(Bsz, nc, Q, G, N)
    a_cum = jnp.cumsum(ac, axis=-1)
    decay_states = jnp.exp(a_cum[..., -1:] - a_cum)
    states = jnp.einsum('bcqgn,bgrcq,bcqgrp->bcgrpn', Bc, decay_states, xc)
    init_c = init.reshape(Bsz, G, R, P, N)[:, None]
    states = jnp.concatenate([init_c, states.astype(init_c.dtype)], axis=1)
    chunk_decay = jnp.exp(segsum(jnp.pad(a_cum[..., -1], [(0, 0)] * 3 + [(1, 0)])))
    new_states = jnp.einsum('bgrzc,bcgrpn->bzgrpn', chunk_decay, states)
    start_states = new_states[:, :-1]
    final = new_states[:, -1].reshape(Bsz, H, P, N)
    if not with_output:
        return None, final
    Lmat = jnp.exp(segsum(ac))
    y_diag = jnp.einsum('bcqgn,bcsgn,bgrcqs,bcsgrp->bcqgrp', Cc, Bc, Lmat, xc)
    y_off = jnp.einsum('bcqgn,bcgrpn,bgrcq->bcqgrp', Cc, start_states, jnp.exp(a_cum))
    return (y_diag + y_off).reshape(Bsz, T, H, P), final


def ssd_zero_state(Bsz):
    z = jnp.zeros((Bsz, SSD_HEADS, SSD_HEAD_DIM, SSD_STATE), jnp.float32)
    return (z, z)


def ssd_mixer(z, xbc, dt_raw, conv_w, conv_b, dt_bias, a_log, d_skip, norm_g, inits, with_output):
    Bsz, T, _ = xbc.shape
    xbc = jax.nn.silu(dwconv(xbc, conv_w, conv_b))
    xs, Bm, Cm = jnp.split(xbc, [SSD_INNER, SSD_INNER + SSD_GROUPS * SSD_STATE], axis=-1)
    xs = xs.reshape(Bsz, T, SSD_HEADS, SSD_HEAD_DIM)
    Bm = Bm.reshape(Bsz, T, SSD_GROUPS, SSD_STATE)
    Cm = Cm.reshape(Bsz, T, SSD_GROUPS, SSD_STATE)
    dt = jax.nn.softplus(dt_raw.reshape(Bsz, T, 2, SSD_HEADS).astype(jnp.float32) + dt_bias.astype(jnp.float32))
    A = -jnp.exp(a_log.astype(jnp.float32))
    fl = lambda t: jnp.flip(t, axis=1)
    y_f, fin_f = ssd_scan(xs, dt[:, :, 0], A[0], Bm, Cm, inits[0], with_output)
    y_b, fin_b = ssd_scan(fl(xs), fl(dt[:, :, 1]), A[1], fl(Bm), fl(Cm), inits[1], with_output)
    if not with_output:
        return None, (fin_f, fin_b)
    y = y_f + fl(y_b) + xs.astype(jnp.float32) * d_skip.astype(jnp.float32)[:, None]
    y = y.reshape(Bsz, T, SSD_INNER).astype(z.dtype) * jax.nn.silu(z)
    return rmsnorm(y, norm_g), (fin_f, fin_b)


def mlstm_scan(q, k, v, i_pre, logf, init, with_output):
    Bsz, T, H, Dh = q.shape
    Q = ML_CHUNK
    nc = T // Q
    qc = q.reshape(Bsz, nc, Q, H, Dh)
    kc = k.reshape(Bsz, nc, Q, H, Dh)
    vc = v.reshape(Bsz, nc, Q, H, Dh)
    ic = i_pre.reshape(Bsz, nc, Q, H).transpose(0, 3, 1, 2)
    b = jnp.cumsum(logf.reshape(Bsz, nc, Q, H).transpose(0, 3, 1, 2), axis=-1)
    b_last = b[..., -1]
    g = b_last[..., None] - b + ic
    m_loc = jnp.max(g, axis=-1)
    w = jnp.exp(g - m_loc[..., None])
    C_loc = jnp.einsum('bhcs,bcshd,bcshe->bchde', w, vc, kc)
    n_loc = jnp.einsum('bhcs,bcshe->bche', w, kc)

    def step(carry, inp):
        C, n, m = carry
        Cl, nl, ml, bl = inp
        m_new = jnp.maximum(bl + m, ml)
        a_prev = jnp.exp(bl + m - m_new)
        a_loc = jnp.exp(ml - m_new)
        C_new = a_prev[..., None, None] * C + a_loc[..., None, None] * Cl
        n_new = a_prev[..., None] * n + a_loc[..., None] * nl
        return (C_new, n_new, m_new), (C, n, m)

    xs = (C_loc.transpose(1, 0, 2, 3, 4), n_loc.transpose(1, 0, 2, 3),
          m_loc.transpose(2, 0, 1), b_last.transpose(2, 0, 1))
    final, (C0, n0, m0) = lax.scan(step, init, xs)
    if not with_output:
        return None, final
    m0 = m0.transpose(1, 2, 0)
    Dm = b[..., :, None] - b[..., None, :] + ic[..., None, :]
    Dm = jnp.where(jnp.tril(jnp.ones((Q, Q), bool)), Dm, -jnp.inf)
    inter = b + m0[..., None]
    m_t = jnp.maximum(inter, jnp.max(Dm, axis=-1))
    Wts = jnp.exp(Dm - m_t[..., None])
    w_inter = jnp.exp(inter - m_t)
    s = jnp.einsum('bcqhd,bcshd->bhcqs', qc, kc) * Wts
    num = (jnp.einsum('bhcqs,bcshd->bcqhd', s, vc)
           + jnp.einsum('bcqhe,cbhde->bcqhd', qc, C0) * w_inter.transpose(0, 2, 3, 1)[..., None])
    den = jnp.sum(s, axis=-1) + w_inter * jnp.einsum('bcqhe,cbhe->bhcq', qc, n0)
    denom = jnp.maximum(jnp.abs(den), jnp.exp(-m_t)).transpose(0, 2, 3, 1)[..., None]
    return (num / denom).reshape(Bsz, T, H, Dh), final


def mlstm_zero_state(Bsz):
    st = (jnp.zeros((Bsz, ML_HEADS, ML_HEAD_DIM, ML_HEAD_DIM), jnp.float32),
          jnp.zeros((Bsz, ML_HEADS, ML_HEAD_DIM), jnp.float32),
          jnp.zeros((Bsz, ML_HEADS), jnp.float32))
    return (st, st)


def mlstm_mixer(q, k, v, o_pre, if_pre, gate_bias, norm_g, inits, with_output):
    Bsz, T, _ = q.shape
    out_dtype = q.dtype
    qh = heads(q, ML_HEADS).astype(jnp.float32)
    kh = heads(k, ML_HEADS).astype(jnp.float32) * ML_HEAD_DIM ** -0.5
    vh = heads(v, ML_HEADS).astype(jnp.float32)
    gates = if_pre.reshape(Bsz, T, 2, 2, ML_HEADS).astype(jnp.float32) + gate_bias.astype(jnp.float32)
    i_pre = gates[:, :, :, 0]
    logf = jax.nn.log_sigmoid(gates[:, :, :, 1])
    fl = lambda t: jnp.flip(t, axis=1)
    h_f, fin_f = mlstm_scan(qh, kh, vh, i_pre[:, :, 0], logf[:, :, 0], inits[0], with_output)
    h_b, fin_b = mlstm_scan(fl(qh), fl(kh), fl(vh), fl(i_pre[:, :, 1]), fl(logf[:, :, 1]), inits[1], with_output)
    if not with_output:
        return None, (fin_f, fin_b)
    h = rmsnorm(h_f + fl(h_b), norm_g).reshape(Bsz, T, ML_INNER)
    h = h * jax.nn.sigmoid(o_pre.astype(jnp.float32))
    return h.astype(out_dtype), (fin_f, fin_b)


def merge_branches(branches, gate_pre, w_branch, w_out):
    Bsz, T, _ = gate_pre.shape
    stacked = jnp.stack(branches, axis=2)
    proj = jnp.einsum('btrw,rwd->btrd', stacked, w_branch)
    gates = jax.nn.sigmoid(gate_pre.reshape(Bsz, T, N_BRANCH, D_MODEL))
    return jnp.sum(gates * proj, axis=2) @ w_out


def token_mixer(h, hc, w_in, qn, kn, conv_w, conv_b, dt_bias, a_log, d_skip, ssd_norm_g,
                ml_bias, ml_norm_g, w_branch, w_out, cos, sin, ctx_out):
    Bsz = h.shape[0]
    aq, ak, av, sz, sxbc, sdt, mq, mk, mv, mo, mif, gpre = split_cols(h @ w_in)
    caq, cak, cav, csz, csxbc, csdt, cmq, cmk, cmv, cmo, cmif, cgpre = split_cols(hc @ w_in)
    q = apply_rope(rmsnorm(heads(aq, ATT_HEADS), qn), cos, sin)
    k = apply_rope(rmsnorm(heads(ak, ATT_KV_HEADS), kn), cos, sin)
    kc = rmsnorm(heads(cak, ATT_KV_HEADS), kn)
    vc = heads(cav, ATT_KV_HEADS)
    att = latent_attention(q, k, heads(av, ATT_KV_HEADS), kc, vc)
    ssd_c, ssd_fin = ssd_mixer(csz, csxbc, csdt, conv_w, conv_b, dt_bias, a_log, d_skip, ssd_norm_g,
                               ssd_zero_state(Bsz), ctx_out)
    ssd_l, _ = ssd_mixer(sz, sxbc, sdt, conv_w, conv_b, dt_bias, a_log, d_skip, ssd_norm_g, ssd_fin, True)
    ml_c, ml_fin = mlstm_mixer(cmq, cmk, cmv, cmo, cmif, ml_bias, ml_norm_g, mlstm_zero_state(Bsz), ctx_out)
    ml_l, _ = mlstm_mixer(mq, mk, mv, mo, mif, ml_bias, ml_norm_g, ml_fin, True)
    y = merge_branches((att, ssd_l, ml_l), gpre, w_branch, w_out)
    if not ctx_out:
        return y, None
    att_c = context_attention(rmsnorm(heads(caq, ATT_HEADS), qn), kc, vc)
    yc = merge_branches((att_c, ssd_c, ml_c), cgpre, w_branch, w_out)
    return y, yc


def peer(h, w_q, subkeys, u, v):
    n_tok = h.shape[0]
    hb = h.reshape(n_tok // PEER_BLOCK, PEER_BLOCK, D_MODEL)

    def block(xb):
        q = (xb @ w_q).reshape(PEER_BLOCK, PEER_HEADS, 2, PEER_QDIM // 2)
        s = jnp.einsum('thpd,hpkd->thpk', q, subkeys).astype(jnp.float32)
        s1, i1 = lax.top_k(s[:, :, 0], PEER_TOPK)
        s2, i2 = lax.top_k(s[:, :, 1], PEER_TOPK)
        cand = (s1[..., :, None] + s2[..., None, :]).reshape(PEER_BLOCK, PEER_HEADS, PEER_TOPK * PEER_TOPK)
        cidx = (i1[..., :, None] * PEER_KEYS + i2[..., None, :]).reshape(PEER_BLOCK, PEER_HEADS, PEER_TOPK * PEER_TOPK)
        sc, pos = lax.top_k(cand, PEER_TOPK)
        idx = jnp.take_along_axis(cidx, pos, axis=-1)
        g = jax.nn.softmax(sc, axis=-1).astype(xb.dtype)
        act = jax.nn.gelu(jnp.einsum('thkd,td->thk', u[idx], xb))
        return jnp.einsum('thk,thkd->td', g * act, v[idx])

    return lax.map(block, hb).reshape(n_tok, D_MODEL)


def setup_inputs(seed: int = 0) -> dict:
    key = jax.random.key(seed)
    ks = jax.random.split(key, 28)
    f32 = jnp.float32
    L = DEPTH

    def nrm(k, shape, s):
        return jax.random.normal(k, shape, f32) * s

    dt0 = jnp.exp(jax.random.uniform(ks[12], (L, 2, SSD_HEADS), f32, math.log(1e-3), math.log(1e-1)))
    fgate = jnp.broadcast_to(jnp.linspace(3.0, 6.0, ML_HEADS, dtype=f32), (L, 2, ML_HEADS))
    return {
        'x': nrm(ks[0], (BATCH, SEQ, D_MODEL), 1.0),
        'c': nrm(ks[1], (BATCH, D_MODEL), 1.0),
        'ctx': nrm(ks[2], (BATCH, CTX_LEN, D_MODEL), 1.0),
        'c_ctx': nrm(ks[3], (D_MODEL,), 1.0),
        'norm1_g': 1.0 + nrm(ks[4], (L, D_MODEL), 0.02),
        'norm2_g': 1.0 + nrm(ks[5], (L, D_MODEL), 0.02),
        'w_mod': nrm(ks[6], (L, D_MODEL, 6 * D_MODEL), 0.02),
        'b_mod': nrm(ks[7], (L, 6 * D_MODEL), 0.01),
        'w_in': nrm(ks[8], (L, D_MODEL, IN_COLS), D_MODEL ** -0.5),
        'att_qnorm': 1.0 + nrm(ks[9], (L, ATT_HEAD_DIM), 0.02),
        'att_knorm': 1.0 + nrm(ks[10], (L, ATT_HEAD_DIM), 0.02),
        'ssd_conv_w': nrm(ks[11], (L, SSD_CONV, SSD_XBC), SSD_CONV ** -0.5),
        'ssd_conv_b': nrm(ks[13], (L, SSD_XBC), 0.01),
        'ssd_dt_bias': dt0 + jnp.log(-jnp.expm1(-dt0)),
        'ssd_a_log': jnp.log(jax.random.uniform(ks[14], (L, 2, SSD_HEADS), f32, 1.0, 16.0)),
        'ssd_d': 1.0 + nrm(ks[15], (L, SSD_HEADS), 0.1),
        'ssd_norm': 1.0 + nrm(ks[16], (L, SSD_INNER), 0.02),
        'ml_gate_bias': jnp.stack([nrm(ks[17], (L, 2, ML_HEADS), 0.1),
                                   fgate + nrm(ks[18], (L, 2, ML_HEADS), 0.1)], axis=2),
        'ml_norm': 1.0 + nrm(ks[19], (L, ML_HEADS, ML_HEAD_DIM), 0.02),
        'w_branch': nrm(ks[20], (L, N_BRANCH, BRANCH_W, D_MODEL), BRANCH_W ** -0.5),
        'w_out': nrm(ks[21], (L, D_MODEL, D_MODEL), D_MODEL ** -0.5),
        'peer_wq': nrm(ks[22], (L, D_MODEL, PEER_HEADS * PEER_QDIM), D_MODEL ** -0.5),
        'peer_subkeys': nrm(ks[23], (L, PEER_HEADS, 2, PEER_KEYS, PEER_QDIM // 2), (PEER_QDIM // 2) ** -0.5),
        'peer_u': nrm(ks[24], (L, PEER_EXPERTS, D_MODEL), D_MODEL ** -0.5),
        'peer_v': nrm(ks[25], (L, PEER_EXPERTS, D_MODEL), PEER_HEADS ** -0.5),
    }


def reference(x, c, ctx, c_ctx, norm1_g, norm2_g, w_mod, b_mod, w_in, att_qnorm, att_knorm,
              ssd_conv_w, ssd_conv_b, ssd_dt_bias, ssd_a_log, ssd_d, ssd_norm, ml_gate_bias, ml_norm,
              w_branch, w_out, peer_wq, peer_subkeys, peer_u, peer_v):
    Bsz, S, _ = x.shape
    ROWS = S // GRID_W
    cos, sin = axial_rope(ROWS)
    silu_c = jax.nn.silu(c)
    silu_cc = jax.nn.silu(c_ctx)
    xc = ctx
    for l in range(DEPTH):
        last = l == DEPTH - 1
        sh1, sc1, g1, sh2, sc2, g2 = jnp.split((silu_c @ w_mod[l] + b_mod[l])[:, None, :], 6, axis=-1)
        csh1, csc1, cg1, csh2, csc2, cg2 = jnp.split(silu_cc @ w_mod[l] + b_mod[l], 6, axis=-1)
        h = rmsnorm(x, norm1_g[l]) * (1.0 + sc1) + sh1
        hc = rmsnorm(xc, norm1_g[l]) * (1.0 + csc1) + csh1
        y, yc = token_mixer(h, hc, w_in[l], att_qnorm[l], att_knorm[l], ssd_conv_w[l], ssd_conv_b[l],
                            ssd_dt_bias[l], ssd_a_log[l], ssd_d[l], ssd_norm[l], ml_gate_bias[l], ml_norm[l],
                            w_branch[l], w_out[l], cos, sin, not last)
        x = x + g1 * y
        h2 = rmsnorm(x, norm2_g[l]) * (1.0 + sc2) + sh2
        x = x + g2 * peer(h2.reshape(-1, D_MODEL), peer_wq[l], peer_subkeys[l], peer_u[l], peer_v[l]).reshape(x.shape)
        if not last:
            xc = xc + cg1 * yc
            hc2 = rmsnorm(xc, norm2_g[l]) * (1.0 + csc2) + csh2
            xc = xc + cg2 * peer(hc2.reshape(-1, D_MODEL), peer_wq[l], peer_subkeys[l], peer_u[l], peer_v[l]).reshape(xc.shape)
    return x
```

```cpp
#include <hip/hip_runtime.h>
#include <hip/hip_cooperative_groups.h>
#include <stdint.h>
#include <stdio.h>
namespace cg = cooperative_groups;

typedef unsigned short bf16_t;
typedef short bf16x8 __attribute__((ext_vector_type(8)));
typedef float f32x4 __attribute__((ext_vector_type(4)));
typedef unsigned u32x4 __attribute__((ext_vector_type(4)));
typedef unsigned u32x2 __attribute__((ext_vector_type(2)));
typedef float f32x16 __attribute__((ext_vector_type(16)));

constexpr int SEQ = 8192, BATCH = 2, CTXL = 256, DM = 1024;
constexpr int NLAT = BATCH * SEQ;
constexpr int NCTX = BATCH * CTXL;
constexpr int MROWS = NLAT + NCTX;
constexpr int INC = 7200, INCP = 7296;
constexpr int NTHR = 256;

#ifndef DIAG_HP
#define DIAG_HP 0
#endif
#define REP_INIT 1
#define REP_NORM 1
#define REP_SPREP 1
#define REP_SOUT 1
#define REP_UVC 1
#define REP_QK 1
#define REP_KCOMP 1
#define REP_KSTG 1
#define REP_G_IN 1
#define REP_G_GATE 1
#define REP_G_MERGE 1
#define REP_G_OUT 1
#define REP_G_WQ 1
#define REP_STG 1
#define REP_EXP 1
#define REP_MLA 1
#define REP_SSDA 1
#define REP_ATT 1
#define REP_MLC 1
#define REP_SSDC 1
#ifndef ATT_ALPHA
#define ATT_ALPHA 1.f
#endif
#ifndef ATT_NAIVE
#define ATT_NAIVE 0
#endif
#ifndef ATT_TAU
#define ATT_TAU 1.f
#endif
#ifndef PEER_ALPHA
#define PEER_ALPHA 1.f
#endif
#define LDS_BYTES (DIAG_HP ? 140 * 1024 : 78 * 1024)
extern __shared__ __attribute__((aligned(16))) char smem[];

struct Params {
  const float *x, *c, *ctx, *c_ctx, *norm1_g, *norm2_g, *w_mod, *b_mod, *w_in, *att_qnorm, *att_knorm,
      *ssd_conv_w, *ssd_conv_b, *ssd_dt_bias, *ssd_a_log, *ssd_d, *ssd_norm, *ml_gate_bias, *ml_norm,
      *w_branch, *w_out, *peer_wq, *peer_subkeys, *peer_u, *peer_v;
  float* out;
  unsigned* bar;
  float* mod;
  float* xc;
  float* small;
  float* dtb;
  bf16_t *wt_in, *wt_br, *wt_out, *wt_q, *sk;
  bf16_t* h;
  bf16_t* br;
  bf16_t* xbc;
  bf16_t *yf, *yb, *hf, *hb;
  bf16_t* mix;
  bf16_t* proj;
  bf16_t* gp;
  unsigned char* gp8;
  bf16_t* q;
  bf16_t* uv;
  unsigned char* uvq;
  float* uvs;
  int* idx;
  float* gw;
  bf16_t* h2lo;
  bf16_t* wt_q_lo;
  float* qf;
  bf16_t* vt;
  float* ropec;
  float* ropes;
  bf16_t* ssl;
  float* sdec;
  bf16_t* mcl;
  float* mnl;
  float* mml;
  float* mbl;
  float* mmp;
};

__device__ __forceinline__ int tidx() { int t = __builtin_amdgcn_workitem_id_x(); asm volatile("" : "+v"(t)); return t; }
__device__ __forceinline__ int bidx() { int t = __builtin_amdgcn_workgroup_id_x(); asm volatile("" : "+s"(t)); return t; }
__device__ __forceinline__ float bf2f(bf16_t v) { return __uint_as_float(((unsigned)v) << 16); }
__device__ __forceinline__ bf16_t f2bf(float f) {
  unsigned u = __float_as_uint(f);
  u += 0x7fffu + ((u >> 16) & 1u);
  return (bf16_t)(u >> 16);
}
typedef float f32x2 __attribute__((ext_vector_type(2)));
typedef __bf16 bf16x2n __attribute__((ext_vector_type(2)));
__device__ __forceinline__ unsigned pack2(float a, float b) {
  f32x2 v = {a, b};
  bf16x2n r = __builtin_convertvector(v, bf16x2n);
  return *(unsigned*)&r;
}
__device__ __forceinline__ float sigmoidf_(float x) { return 1.f / (1.f + __expf(-x)); }
__device__ __forceinline__ float siluf_(float x) { return x / (1.f + __expf(-x)); }
__device__ __forceinline__ float softplusf_(float x) { return x > 20.f ? x : log1pf(__expf(x)); }
__device__ __forceinline__ float logsigmoidf_(float x) { return x < 0.f ? x - log1pf(__expf(x)) : -log1pf(__expf(-x)); }
__device__ __forceinline__ float gelu_tanh(float x) {
  float u = 0.7978845608028654f * (x + 0.044715f * x * x * x);
  float t = 1.f - 2.f / (1.f + __expf(2.f * u));
  return 0.5f * x * (1.f + t);
}
__device__ __forceinline__ float ub0(unsigned v) { return (float)(v & 0xffu); }
__device__ __forceinline__ float ub1(unsigned v) { return (float)((v >> 8) & 0xffu); }
__device__ __forceinline__ float ub2(unsigned v) { return (float)((v >> 16) & 0xffu); }
__device__ __forceinline__ float ub3(unsigned v) { return (float)(v >> 24); }
__device__ __forceinline__ float* xrow(const Params& p, int row) {
  return row < NLAT ? p.out + (size_t)row * DM : p.xc + (size_t)(row - NLAT) * DM;
}
__device__ __forceinline__ const float* xrow_src(const Params& p, int row, int from_input) {
  if (from_input) return row < NLAT ? p.x + (size_t)row * DM : p.ctx + (size_t)(row - NLAT) * DM;
  return row < NLAT ? p.out + (size_t)row * DM : p.xc + (size_t)(row - NLAT) * DM;
}
__device__ __forceinline__ int modrow(int row) { return row < NLAT ? row / SEQ : 2; }
__device__ __forceinline__ float wave_sum(float v) {
#pragma unroll
  for (int o = 32; o > 0; o >>= 1) v += __shfl_xor(v, o);
  return v;
}
__device__ __forceinline__ float wave_max(float v) {
#pragma unroll
  for (int o = 32; o > 0; o >>= 1) v = fmaxf(v, __shfl_xor(v, o));
  return v;
}

__device__ __forceinline__ int win_colmap(int n) {
  if (n < 2048) return n;
  if (n < 4096) return n + 16;
  if (n < 7168) return n + 32;
  if (n < 7184) return n - 5120;
  if (n < 7200) return n - 3072;
  return -1;
}

__device__ __forceinline__ void transpose_tile(const float* src, int Nsrc, int K, bf16_t* dst, int n0, int k0, int mode, bf16_t* dstlo = nullptr) {
  float* tile = (float*)smem;
  const int tid = tidx();
  {
    const int n4 = (tid & 15) * 4;
    int sc = n0 + n4;
    if (mode == 1) sc = win_colmap(sc);
#pragma unroll
    for (int i = 0; i < 4; ++i) {
      const int kk = (tid >> 4) + 16 * i;
      f32x4 v = sc >= 0 ? *(const f32x4*)(src + (size_t)(k0 + kk) * Nsrc + sc) : (f32x4){0.f, 0.f, 0.f, 0.f};
      tile[kk * 65 + n4] = v[0]; tile[kk * 65 + n4 + 1] = v[1]; tile[kk * 65 + n4 + 2] = v[2]; tile[kk * 65 + n4 + 3] = v[3];
    }
  }
  __syncthreads();
  {
    const int n = tid >> 2, kc = (tid & 3) * 16;
    float t[16];
#pragma unroll
    for (int e = 0; e < 16; ++e) t[e] = tile[(kc + e) * 65 + n];
    u32x4 w0, w1;
#pragma unroll
    for (int e = 0; e < 4; ++e) { w0[e] = pack2(t[2 * e], t[2 * e + 1]); w1[e] = pack2(t[8 + 2 * e], t[8 + 2 * e + 1]); }
    bf16_t* d = dst + (size_t)(n0 + n) * K + k0 + kc;
    *(u32x4*)d = w0; *(u32x4*)(d + 8) = w1;
    if (dstlo) {
      u32x4 l0, l1;
#pragma unroll
      for (int e = 0; e < 4; ++e) {
        l0[e] = pack2(t[2 * e] - __uint_as_float(w0[e] << 16), t[2 * e + 1] - __uint_as_float(w0[e] & 0xffff0000u));
        l1[e] = pack2(t[8 + 2 * e] - __uint_as_float(w1[e] << 16), t[8 + 2 * e + 1] - __uint_as_float(w1[e] & 0xffff0000u));
      }
      bf16_t* dl = dstlo + (size_t)(n0 + n) * K + k0 + kc;
      *(u32x4*)dl = l0; *(u32x4*)(dl + 8) = l1;
    }
  }
  __syncthreads();
}

__device__ __forceinline__ void phase_init(const Params& p) {
  const int tid = tidx(), bid = bidx(), nb = gridDim.x;
  for (int i = bid * NTHR + tid; i < 8192 * 32; i += nb * NTHR) {
    int pos = i >> 5, jj = i & 31;
    float inv = powf(10000.f, -(float)(jj & 15) / 16.f);
    float ang = (float)(jj < 16 ? (pos >> 6) : (pos & 63)) * inv;
    float sn, cs_; sincosf(ang, &sn, &cs_);
    p.ropec[i] = cs_; p.ropes[i] = sn;
  }
  for (size_t i = (size_t)bid * NTHR + tid; i < (size_t)2 * 8 * 2 * 128 * 128; i += (size_t)nb * NTHR) p.sk[i] = f2bf(p.peer_subkeys[i]);
  {
    const int per_layer = 1824 + 384 + 256 + 512;
    for (int job = bid; job < 2 * per_layer; job += nb) {
      int l = job / per_layer, j = job % per_layer;
      if (j < 1824) {
        int nt = j / 16, kt = j % 16;
        transpose_tile(p.w_in + (size_t)l * DM * INC, INC, DM, p.wt_in + (size_t)l * INCP * DM, nt * 64, kt * 64, 1);
      } else if (j < 1824 + 384) {
        j -= 1824; int r = j / 128; j %= 128; int nt = j / 8, kt = j % 8;
        transpose_tile(p.w_branch + ((size_t)l * 3 + r) * 512 * DM, DM, 512, p.wt_br + ((size_t)l * 3 + r) * DM * 512, nt * 64, kt * 64, 0);
      } else if (j < 1824 + 384 + 256) {
        j -= 1824 + 384; int nt = j / 16, kt = j % 16;
        transpose_tile(p.w_out + (size_t)l * DM * DM, DM, DM, p.wt_out + (size_t)l * DM * DM, nt * 64, kt * 64, 0);
      } else {
        j -= 1824 + 384 + 256; int nt = j / 16, kt = j % 16;
        transpose_tile(p.peer_wq + (size_t)l * DM * 2048, 2048, DM, p.wt_q + (size_t)l * 2048 * DM, nt * 64, kt * 64, 0, DIAG_HP ? p.wt_q_lo + (size_t)l * 2048 * DM : nullptr);
      }
    }
  }
  {
    float* sl = (float*)smem;
    float* part = sl + 3 * DM;
    bool loaded = false;
    for (int blk = bid; blk < 192; blk += nb) {
      if (!loaded) {
        __syncthreads();
        for (int i = tid; i < 3 * DM; i += NTHR) {
          float v = i < 2 * DM ? p.c[i] : p.c_ctx[i - 2 * DM];
          sl[i] = siluf_(v);
        }
        loaded = true;
      }
      __syncthreads();
      const int wv = tid >> 6, ln = tid & 63;
      const int gi = blk * 64 + ln;
      const int l = gi / 6144, col = gi % 6144;
      const float* w = p.w_mod + (size_t)l * DM * 6144 + col;
      float a0 = 0.f, a1 = 0.f, a2 = 0.f;
#pragma unroll 8
      for (int k = wv * 256; k < wv * 256 + 256; ++k) {
        float wv_ = w[(size_t)k * 6144];
        a0 += sl[k] * wv_; a1 += sl[DM + k] * wv_; a2 += sl[2 * DM + k] * wv_;
      }
      part[(wv * 3 + 0) * 64 + ln] = a0; part[(wv * 3 + 1) * 64 + ln] = a1; part[(wv * 3 + 2) * 64 + ln] = a2;
      __syncthreads();
      if (tid < 192) {
        const int r = tid >> 6;
        float s = part[(0 * 3 + r) * 64 + ln] + part[(1 * 3 + r) * 64 + ln] + part[(2 * 3 + r) * 64 + ln] + part[(3 * 3 + r) * 64 + ln];
        p.mod[(l * 3 + r) * 6144 + col] = s + p.b_mod[l * 6144 + col];
      }
    }
  }
}

__device__ __forceinline__ void phase_norm(const Params& p, int layer, int which, int nrows, int from_input) {
  const int lane = tidx() & 63, wv = tidx() >> 6;
  const float* g = (which == 1 ? p.norm1_g : p.norm2_g) + layer * DM;
  const int sh_off = which == 1 ? 0 : 3 * DM, sc_off = which == 1 ? DM : 4 * DM;
  int curm = -1;
  f32x4 Ar[4], Br[4];
  for (int row = bidx() * 4 + wv; row < nrows; row += gridDim.x * 4) {
    const float* xr = xrow_src(p, row, from_input);
    const int mr = modrow(row);
    if (mr != curm) {
      const float* md = p.mod + (size_t)(layer * 3 + mr) * 6144;
#pragma unroll
      for (int j = 0; j < 4; ++j) {
        int c0 = j * 256 + lane * 4;
        f32x4 gg = *(const f32x4*)(g + c0), sc = *(const f32x4*)(md + sc_off + c0);
        Br[j] = *(const f32x4*)(md + sh_off + c0);
#pragma unroll
        for (int e = 0; e < 4; ++e) Ar[j][e] = gg[e] * (1.f + sc[e]);
      }
      curm = mr;
    }
    f32x4 v[4]; float ss = 0.f;
#pragma unroll
    for (int j = 0; j < 4; ++j) {
      v[j] = *(const f32x4*)(xr + j * 256 + lane * 4);
      ss += v[j][0] * v[j][0] + v[j][1] * v[j][1] + v[j][2] * v[j][2] + v[j][3] * v[j][3];
    }
    ss = wave_sum(ss);
    float rs = rsqrtf(ss * (1.f / DM) + 1e-6f);
#pragma unroll
    for (int j = 0; j < 4; ++j) {
      int c0 = j * 256 + lane * 4;
      float o0 = v[j][0] * rs * Ar[j][0] + Br[j][0];
      float o1 = v[j][1] * rs * Ar[j][1] + Br[j][1];
      float o2 = v[j][2] * rs * Ar[j][2] + Br[j][2];
      float o3 = v[j][3] * rs * Ar[j][3] + Br[j][3];
      u32x2 w; w.x = pack2(o0, o1); w.y = pack2(o2, o3);
      *(u32x2*)(p.h + (size_t)row * DM + c0) = w;
#if DIAG_HP
      if (which == 2) {
        u32x2 wl; wl.x = pack2(o0 - __uint_as_float(w.x << 16), o1 - __uint_as_float(w.x & 0xffff0000u));
        wl.y = pack2(o2 - __uint_as_float(w.y << 16), o3 - __uint_as_float(w.y & 0xffff0000u));
        *(u32x2*)(p.h2lo + (size_t)row * DM + c0) = wl;
      }
#endif
    }
  }
}

__device__ __forceinline__ void gemm_stage(const bf16_t* A, int lda, const bf16_t* Bt, int ldb, int brow, int bcol, int kt, char* buf, int tid) {
#pragma unroll
  for (int i = 0; i < 4; ++i) {
    const int b = (tid + 256 * i) * 16, r = b >> 7, c = ((b >> 4) & 7) ^ ((r >> 1) & 7);
    __builtin_amdgcn_global_load_lds((const unsigned*)(A + (size_t)(brow + r) * lda + kt + c * 8), (__attribute__((address_space(3))) unsigned*)(buf + b), 16, 0, 0);
    __builtin_amdgcn_global_load_lds((const unsigned*)(Bt + (size_t)(bcol + r) * ldb + kt + c * 8), (__attribute__((address_space(3))) unsigned*)(buf + 16384 + b), 16, 0, 0);
  }
}
__device__ __forceinline__ void gemm_compute(f32x4 (&acc)[4][4], const char* buf, int wr, int wc, int fr, int fq) {
#pragma unroll
  for (int ks = 0; ks < 2; ++ks) {
    bf16x8 At[4], Bl[4];
#pragma unroll
    for (int m = 0; m < 4; ++m) { const int row = wr * 64 + m * 16 + fr; At[m] = *(const bf16x8*)(buf + row * 128 + (((ks * 4 + fq) ^ ((row >> 1) & 7)) << 4)); }
#pragma unroll
    for (int n = 0; n < 4; ++n) { const int row = wc * 64 + n * 16 + fr; Bl[n] = *(const bf16x8*)(buf + 16384 + row * 128 + (((ks * 4 + fq) ^ ((row >> 1) & 7)) << 4)); }
    __builtin_amdgcn_s_setprio(1);
#pragma unroll
    for (int m = 0; m < 4; ++m)
#pragma unroll
      for (int n = 0; n < 4; ++n) acc[m][n] = __builtin_amdgcn_mfma_f32_16x16x32_bf16(Bl[n], At[m], acc[m][n], 0, 0, 0);
    __builtin_amdgcn_s_setprio(0);
  }
}
__device__ __forceinline__ void gemm_compute_h(f32x4 (&acc)[4][4], const char* buf, int wr, int wc, int fr, int fq) {
  bf16x8 At[2][4], Bl[2][4];
#pragma unroll
  for (int ks = 0; ks < 2; ++ks) {
#pragma unroll
    for (int m = 0; m < 4; ++m) { const int row = wr * 64 + m * 16 + fr; At[ks][m] = *(const bf16x8*)(buf + row * 128 + (((ks * 4 + fq) ^ ((row >> 1) & 7)) << 4)); }
#pragma unroll
    for (int n = 0; n < 4; ++n) { const int row = wc * 64 + n * 16 + fr; Bl[ks][n] = *(const bf16x8*)(buf + 16384 + row * 128 + (((ks * 4 + fq) ^ ((row >> 1) & 7)) << 4)); }
  }
  __builtin_amdgcn_s_setprio(1);
#pragma unroll
  for (int ks = 0; ks < 2; ++ks)
#pragma unroll
    for (int m = 0; m < 4; ++m)
#pragma unroll
      for (int n = 0; n < 4; ++n) acc[m][n] = __builtin_amdgcn_mfma_f32_16x16x32_bf16(Bl[ks][n], At[ks][m], acc[m][n], 0, 0, 0);
  __builtin_amdgcn_s_setprio(0);
}
__device__ __forceinline__ void gemm_frags_ks(bf16x8 (&At)[4], bf16x8 (&Bl)[4], const char* buf, int ks, int wr, int wc, int fr, int fq) {
#pragma unroll
  for (int m = 0; m < 4; ++m) { const int row = wr * 64 + m * 16 + fr; At[m] = *(const bf16x8*)(buf + row * 128 + (((ks * 4 + fq) ^ ((row >> 1) & 7)) << 4)); }
#pragma unroll
  for (int n = 0; n < 4; ++n) { const int row = wc * 64 + n * 16 + fr; Bl[n] = *(const bf16x8*)(buf + 16384 + row * 128 + (((ks * 4 + fq) ^ ((row >> 1) & 7)) << 4)); }
}
__device__ __forceinline__ void gemm_mma16(f32x4 (&acc)[4][4], const bf16x8 (&At)[4], const bf16x8 (&Bl)[4]) {
  __builtin_amdgcn_s_setprio(1);
#pragma unroll
  for (int m = 0; m < 4; ++m)
#pragma unroll
    for (int n = 0; n < 4; ++n) acc[m][n] = __builtin_amdgcn_mfma_f32_16x16x32_bf16(Bl[n], At[m], acc[m][n], 0, 0, 0);
  __builtin_amdgcn_s_setprio(0);
}
template <bool HOIST = true>
__device__ __forceinline__ void gemm_kloop(f32x4 (&acc)[4][4], const bf16_t* A, int lda, const bf16_t* Bt, int ldb, int K, int brow, int bcol) {
  const int tid = tidx(), wid = tid >> 6, lane = tid & 63, wr = wid >> 1, wc = wid & 1, fr = lane & 15, fq = lane >> 4;
  const int nt = K >> 6;
  __syncthreads();
  gemm_stage(A, lda, Bt, ldb, brow, bcol, 0, smem, tid);
  asm volatile("s_waitcnt vmcnt(0)" ::: "memory");
  __syncthreads();
  if (HOIST) {
    bf16x8 F0a[4], F0b[4], F1a[4], F1b[4];
    gemm_frags_ks(F0a, F0b, smem, 0, wr, wc, fr, fq);
    if (nt > 1) gemm_stage(A, lda, Bt, ldb, brow, bcol, 64, smem + 32768, tid);
    for (int t = 0; t < nt; ++t) {
      char* cur = smem + (t & 1) * 32768; char* nxt = smem + ((t + 1) & 1) * 32768;
      gemm_frags_ks(F1a, F1b, cur, 1, wr, wc, fr, fq);
      gemm_mma16(acc, F0a, F0b);
      if (t + 1 < nt) {
        asm volatile("s_waitcnt vmcnt(0)" ::: "memory");
        __syncthreads();
        gemm_frags_ks(F0a, F0b, nxt, 0, wr, wc, fr, fq);
        if (t + 2 < nt) gemm_stage(A, lda, Bt, ldb, brow, bcol, (t + 2) * 64, cur, tid);
      }
      gemm_mma16(acc, F1a, F1b);
    }
  } else {
    for (int t = 0; t < nt - 1; ++t) {
      char* cur = smem + (t & 1) * 32768; char* nxt = smem + ((t + 1) & 1) * 32768;
      gemm_stage(A, lda, Bt, ldb, brow, bcol, (t + 1) * 64, nxt, tid);
      gemm_compute(acc, cur, wr, wc, fr, fq);
      asm volatile("s_waitcnt vmcnt(0)" ::: "memory");
      __syncthreads();
    }
    gemm_compute(acc, smem + ((nt - 1) & 1) * 32768, wr, wc, fr, fq);
  }
}

__device__ __forceinline__ void tile_map(int t, int NT, int& mt, int& ni) {
  const int x = t & 7, q = t >> 3, nsub = NT >> 3;
  mt = q / nsub; ni = x + 8 * (q - mt * nsub);
}
__device__ __forceinline__ void tile_map_m(int t, int mtiles, int& mt, int& nt) {
  const int idx = (t & 7) * mtiles + (t >> 3);
  mt = idx >> 3; nt = idx & 7;
}
#define GEMM_IDS const int tid = tidx(), wid = tid >> 6, lane = tid & 63, wr = wid >> 1, wc = wid & 1, fr = lane & 15, fq = lane >> 4; (void)tid;

__device__ __forceinline__ void zero_acc(f32x4 (&acc)[4][4]) {
#pragma unroll
  for (int m = 0; m < 4; ++m)
#pragma unroll
    for (int n = 0; n < 4; ++n) acc[m][n] = (f32x4){0.f, 0.f, 0.f, 0.f};
}


__device__ __forceinline__ void store_slab_bf16(const f32x4 (&v)[4], bf16_t* dst_row0, size_t ld, int wid, int lane) {
  char* slab = smem + 65536 + wid * 2304;
  const int fr = lane & 15, fq = lane >> 4;
#pragma unroll
  for (int n = 0; n < 4; ++n) {
    u32x2 w; w.x = pack2(v[n][0], v[n][1]); w.y = pack2(v[n][2], v[n][3]);
    *(u32x2*)(slab + fr * 144 + (n * 16 + fq * 4) * 2) = w;
  }
  const int r = lane >> 3, c = lane & 7;
  u32x4 a = *(const u32x4*)(slab + r * 144 + c * 16), b = *(const u32x4*)(slab + (r + 8) * 144 + c * 16);
  *(u32x4*)(dst_row0 + (size_t)r * ld + c * 8) = a;
  *(u32x4*)(dst_row0 + (size_t)(r + 8) * ld + c * 8) = b;
}


__device__ __forceinline__ void store_slab_gate8(const f32x4 (&v)[4], unsigned char* dst_row0, int wid, int lane) {
  char* slab = smem + 65536 + wid * 2304;
  const int fr = lane & 15, fq = lane >> 4;
#pragma unroll
  for (int n = 0; n < 4; ++n) {
    unsigned q = 0;
#pragma unroll
    for (int j = 0; j < 4; ++j) { int g = (int)rintf(sigmoidf_(v[n][j]) * 255.f); q |= (unsigned)g << (8 * j); }
    *(unsigned*)(slab + fr * 80 + n * 16 + fq * 4) = q;
  }
  const int r = lane >> 2, c = lane & 3;
  u32x4 a = *(const u32x4*)(slab + r * 80 + c * 16);
  *(u32x4*)(dst_row0 + (size_t)r * 3072 + c * 16) = a;
}
__device__ __forceinline__ void load_slab_gate8(unsigned (&g)[4], const unsigned char* src_row0, int wid, int lane) {
  char* slab = smem + 65536 + wid * 2304;
  const int fr = lane & 15, fq = lane >> 4;
  const int r = lane >> 2, c = lane & 3;
  *(u32x4*)(slab + r * 80 + c * 16) = *(const u32x4*)(src_row0 + (size_t)r * 3072 + c * 16);
#pragma unroll
  for (int n = 0; n < 4; ++n) g[n] = *(const unsigned*)(slab + fr * 80 + n * 16 + fq * 4);
}

__device__ __forceinline__ void phase_inproj(const Params& p, int layer, int nrows, int part) {
  GEMM_IDS
  const int ntl = part == 0 ? 33 : (part == 1 ? 24 : 57);
  const int mtiles = nrows / 128;
  const bf16_t* Bt = p.wt_in + (size_t)layer * INCP * DM;
  for (int t = bidx(); t < mtiles * ntl; t += gridDim.x) {
    int mt, ni, nt;
    if (part == 0) { if (t < mtiles * 32) tile_map(t, 32, mt, ni); else { mt = t - mtiles * 32; ni = 32; } nt = ni < 32 ? ni : 56; }
    else if (part == 1) { tile_map(t, 24, mt, ni); nt = 32 + ni; }
    else { if (t < mtiles * 56) { tile_map(t, 56, mt, ni); nt = ni; } else { mt = t - mtiles * 56; nt = 56; } }
    f32x4 acc[4][4]; zero_acc(acc);
    gemm_kloop(acc, p.h, DM, Bt, DM, DM, mt * 128, nt * 128);
    if (nt >= 32 && nt < 56 && !DIAG_HP) {
#pragma unroll
      for (int m = 0; m < 4; ++m) store_slab_gate8(acc[m], p.gp8 + (size_t)(mt * 128 + wr * 64 + m * 16) * 3072 + (nt * 128 - 4096) + wc * 64, wid, lane);
    } else if (nt >= 5 && nt < 56) {
      bf16_t* dst = nt < 32 ? p.proj + (size_t)(mt * 128 + wr * 64) * 4096 + nt * 128 + wc * 64 : p.gp + (size_t)(mt * 128 + wr * 64) * 3072 + (nt * 128 - 4096) + wc * 64;
      const size_t ld = nt < 32 ? 4096 : 3072;
#pragma unroll
      for (int m = 0; m < 4; ++m) store_slab_bf16(acc[m], dst + (size_t)(m * 16) * ld, ld, wid, lane);
    } else if (nt == 56) {
#pragma unroll
      for (int m = 0; m < 4; ++m)
#pragma unroll
        for (int n = 0; n < 4; ++n) {
          int row = mt * 128 + wr * 64 + m * 16 + fr, cc = wc * 64 + n * 16 + fq * 4;
          if (cc < 32) *(f32x4*)(p.small + (size_t)row * 32 + cc) = acc[m][n];
        }
    }
    if (nt < 5) {
      const float* nw = (nt < 4 ? p.att_qnorm : p.att_knorm) + layer * 64;
      const bool latent = mt < NLAT / 128;
#pragma unroll
      for (int m = 0; m < 4; ++m) {
        const int row = mt * 128 + wr * 64 + m * 16 + fr;
        float ss = 0.f;
#pragma unroll
        for (int n = 0; n < 4; ++n)
#pragma unroll
          for (int j = 0; j < 4; ++j) ss += acc[m][n][j] * acc[m][n][j];
        ss += __shfl_xor(ss, 16); ss += __shfl_xor(ss, 32);
        const float rs = rsqrtf(ss * (1.f / 64.f) + 1e-6f);
        f32x4 v[4];
#pragma unroll
        for (int n = 0; n < 4; ++n) {
          f32x4 w4 = *(const f32x4*)(nw + n * 16 + fq * 4);
#pragma unroll
          for (int j = 0; j < 4; ++j) v[n][j] = acc[m][n][j] * rs * w4[j];
        }
        if (latent) {
          const int pos = row & (SEQ - 1);
#pragma unroll
          for (int n = 0; n < 2; ++n) {
            f32x4 c4 = *(const f32x4*)(p.ropec + pos * 32 + n * 16 + fq * 4), s4 = *(const f32x4*)(p.ropes + pos * 32 + n * 16 + fq * 4);
#pragma unroll
            for (int j = 0; j < 4; ++j) {
              float t1 = v[n][j], t2 = v[n + 2][j];
              v[n][j] = t1 * c4[j] - t2 * s4[j];
              v[n + 2][j] = t1 * s4[j] + t2 * c4[j];
            }
          }
        }
        store_slab_bf16(v, p.proj + (size_t)(mt * 128 + wr * 64 + m * 16) * 4096 + nt * 128 + wc * 64, 4096, wid, lane);
      }
    }
  }
}

__device__ __forceinline__ void phase_merge(const Params& p, int layer, int nrows) {
  GEMM_IDS
  const int mtiles = nrows / 128;
  for (int t = bidx(); t < mtiles * 8; t += gridDim.x) {
    int mt, nt; tile_map_m(t, mtiles, mt, nt);
    f32x4 mixa[4][4]; zero_acc(mixa);
    for (int r = 0; r < 3; ++r) {
      f32x4 acc[4][4]; zero_acc(acc);
      gemm_kloop<false>(acc, p.br + r * 512, 1536, p.wt_br + ((size_t)layer * 3 + r) * DM * 512, 512, 512, mt * 128, nt * 128);
#if DIAG_HP
#pragma unroll
      for (int m = 0; m < 4; ++m)
#pragma unroll
        for (int n = 0; n < 4; ++n) {
          int row = mt * 128 + wr * 64 + m * 16 + fr, col = nt * 128 + wc * 64 + n * 16 + fq * 4;
          u32x2 g = *(const u32x2*)(p.gp + (size_t)row * 3072 + r * 1024 + col);
          mixa[m][n][0] += sigmoidf_(__uint_as_float(g.x << 16)) * acc[m][n][0];
          mixa[m][n][1] += sigmoidf_(__uint_as_float(g.x & 0xffff0000u)) * acc[m][n][1];
          mixa[m][n][2] += sigmoidf_(__uint_as_float(g.y << 16)) * acc[m][n][2];
          mixa[m][n][3] += sigmoidf_(__uint_as_float(g.y & 0xffff0000u)) * acc[m][n][3];
        }
#else
#pragma unroll
      for (int m = 0; m < 4; ++m) {
        unsigned g[4];
        load_slab_gate8(g, p.gp8 + (size_t)(mt * 128 + wr * 64 + m * 16) * 3072 + r * 1024 + nt * 128 + wc * 64, wid, lane);
#pragma unroll
        for (int n = 0; n < 4; ++n) {
          mixa[m][n][0] += ub0(g[n]) * (1.f / 255.f) * acc[m][n][0];
          mixa[m][n][1] += ub1(g[n]) * (1.f / 255.f) * acc[m][n][1];
          mixa[m][n][2] += ub2(g[n]) * (1.f / 255.f) * acc[m][n][2];
          mixa[m][n][3] += ub3(g[n]) * (1.f / 255.f) * acc[m][n][3];
        }
      }
#endif
    }
#pragma unroll
    for (int m = 0; m < 4; ++m) store_slab_bf16(mixa[m], p.mix + (size_t)(mt * 128 + wr * 64 + m * 16) * DM + nt * 128 + wc * 64, DM, wid, lane);
  }
}

__device__ __forceinline__ void phase_outproj(const Params& p, int layer, int nrows, float oscale, int from_input) {
  GEMM_IDS
  const int mtiles = nrows / 128;
  for (int t = bidx(); t < mtiles * 8; t += gridDim.x) {
    int mt, nt; tile_map_m(t, mtiles, mt, nt);
    f32x4 acc[4][4]; zero_acc(acc);
    gemm_kloop(acc, p.mix, DM, p.wt_out + (size_t)layer * DM * DM, DM, DM, mt * 128, nt * 128);
#pragma unroll
    for (int m = 0; m < 4; ++m)
#pragma unroll
      for (int n = 0; n < 4; ++n) {
        int row = mt * 128 + wr * 64 + m * 16 + fr, col = nt * 128 + wc * 64 + n * 16 + fq * 4;
        float* xr = xrow(p, row) + col;
        f32x4 g1 = *(const f32x4*)(p.mod + (size_t)(layer * 3 + modrow(row)) * 6144 + 2 * DM + col);
        g1 = g1 * oscale;
        f32x4 xv = *(const f32x4*)(xrow_src(p, row, from_input) + col);
        xv[0] += g1[0] * acc[m][n][0]; xv[1] += g1[1] * acc[m][n][1]; xv[2] += g1[2] * acc[m][n][2]; xv[3] += g1[3] * acc[m][n][3];
        *(f32x4*)xr = xv;
      }
  }
}

__device__ __forceinline__ void phase_wq(const Params& p, int layer, int nrows) {
  GEMM_IDS
  const int mtiles = nrows / 128;
  for (int t = bidx(); t < mtiles * 16; t += gridDim.x) {
    int mt, nt; { const int idx = (t & 7) * (mtiles * 2) + (t >> 3); mt = idx >> 4; nt = idx & 15; }
    f32x4 acc[4][4]; zero_acc(acc);
    gemm_kloop(acc, p.h, DM, p.wt_q + (size_t)layer * 2048 * DM, DM, DM, mt * 128, nt * 128);
#if DIAG_HP
    gemm_kloop(acc, p.h, DM, p.wt_q_lo + (size_t)layer * 2048 * DM, DM, DM, mt * 128, nt * 128);
    gemm_kloop(acc, p.h2lo, DM, p.wt_q + (size_t)layer * 2048 * DM, DM, DM, mt * 128, nt * 128);
#endif
#if DIAG_HP
#pragma unroll
    for (int m = 0; m < 4; ++m)
#pragma unroll
      for (int n = 0; n < 4; ++n) {
        int row = mt * 128 + wr * 64 + m * 16 + fr, col = nt * 128 + wc * 64 + n * 16 + fq * 4;
        *(f32x4*)(p.qf + (size_t)row * 2048 + col) = acc[m][n];
      }
#else
#pragma unroll
    for (int m = 0; m < 4; ++m) store_slab_bf16(acc[m], p.q + (size_t)(mt * 128 + wr * 64 + m * 16) * 2048 + nt * 128 + wc * 64, 2048, wid, lane);
#endif
  }
}

__device__ __forceinline__ void phase_vtrans(const Params& p) {
  bf16_t* tile = (bf16_t*)smem;
  const int tid = tidx();
  for (int item = bidx(); item < 528; item += gridDim.x) {
    int b = item / 264, r = item % 264, kvh = r / 132, kt = r % 132;
    int krow0 = kt < 128 ? b * SEQ + kt * 64 : NLAT + b * CTXL + (kt - 128) * 64;
    __syncthreads();
    {
      int kr = tid >> 2, c0 = (tid & 3) * 16;
      const bf16_t* vp = p.proj + (size_t)(krow0 + kr) * 4096 + 640 + kvh * 64 + c0;
      u32x4 w0 = *(const u32x4*)vp, w1 = *(const u32x4*)(vp + 8);
      unsigned* tp = (unsigned*)(tile + kr * 66 + c0);
#pragma unroll
      for (int e = 0; e < 4; ++e) { tp[e] = w0[e]; tp[4 + e] = w1[e]; }
    }
    __syncthreads();
    {
      int d = tid >> 2, k0 = (tid & 3) * 16;
      bf16_t* op = p.vt + ((size_t)(b * 2 + kvh) * 64 + d) * 8448 + kt * 64 + k0;
      u32x4 o0, o1;
#pragma unroll
      for (int e = 0; e < 4; ++e) {
        const int ka = e < 2 ? 2 * e : 8 + 2 * (e - 2);
        const int kb2 = e < 2 ? 4 + 2 * e : 12 + 2 * (e - 2);
        o0[e] = (unsigned)tile[(k0 + ka) * 66 + d] | ((unsigned)tile[(k0 + ka + 1) * 66 + d] << 16);
        o1[e] = (unsigned)tile[(k0 + kb2) * 66 + d] | ((unsigned)tile[(k0 + kb2 + 1) * 66 + d] << 16);
      }
      *(u32x4*)op = o0; *(u32x4*)(op + 8) = o1;
    }
  }
}

#define ATT_KSTR 144
#define ATT_VSTR 272
#define ATT_VOFF 18432
#define ATT_BUF 35840
__device__ __forceinline__ void attn_item(const Params& p, int layer, int item) {
  const int tid = tidx(), wid = tid >> 6, lane = tid & 63, l31 = lane & 31, hh = lane >> 5;
  int b, kvh, tok0, kt0, nkt;
  if (item < 1024) { b = item >> 9; kvh = (item >> 8) & 1; tok0 = b * SEQ + (item & 255) * 32; kt0 = 0; nkt = 66; }
  else { int r = item - 1024; b = r >> 4; kvh = (r >> 3) & 1; tok0 = NLAT + b * CTXL + (r & 7) * 32; kt0 = 64; nkt = 2; }
  const int head = kvh * 4 + wid;
  bf16x8 qf[4];
#pragma unroll
  for (int ks = 0; ks < 4; ++ks)
    qf[ks] = *(const bf16x8*)(p.proj + (size_t)(tok0 + l31) * 4096 + head * 64 + ks * 16 + hh * 8);
  f32x16 o[2];
#pragma unroll
  for (int db = 0; db < 2; ++db)
#pragma unroll
    for (int r = 0; r < 16; ++r) o[db][r] = 0.f;
  float mrun = -1e30f, lrun = 0.f;
  const float cs = 0.125f * 1.44269504088896f * ATT_TAU;
  const bf16_t* vtb = p.vt + (size_t)(b * 2 + kvh) * 64 * 8448;
  u32x4 kreg[4], vreg[4];
  auto gload = [&](int kt) {
    int krow0 = kt < 64 ? b * SEQ + kt * 128 : NLAT + b * CTXL + (kt - 64) * 128;
    int ko = kt * 128; asm volatile("" : "+s"(ko));
#pragma unroll
    for (int i = 0; i < 4; ++i) {
      int id = tid + 256 * i;
      kreg[i] = *(const u32x4*)(p.proj + (size_t)(krow0 + (id >> 3)) * 4096 + 512 + kvh * 64 + (id & 7) * 8);
      vreg[i] = *(const u32x4*)(vtb + (size_t)(id >> 4) * 8448 + ko + (id & 15) * 8);
    }
  };
  auto lstore = [&](int buf) {
    char* base = smem + buf * ATT_BUF;
#pragma unroll
    for (int i = 0; i < 4; ++i) {
      int id = tid + 256 * i;
      *(u32x4*)(base + (id >> 3) * ATT_KSTR + (id & 7) * 16) = kreg[i];
      *(u32x4*)(base + ATT_VOFF + (id >> 4) * ATT_VSTR + (id & 15) * 16) = vreg[i];
    }
  };
  auto compute = [&](int buf, int sub) {
    const char* Kb = smem + buf * ATT_BUF + sub * 64 * ATT_KSTR;
    const char* Vb = smem + buf * ATT_BUF + ATT_VOFF + sub * 128;
    f32x16 s[2];
#pragma unroll
    for (int kb = 0; kb < 2; ++kb) {
#pragma unroll
      for (int r = 0; r < 16; ++r) s[kb][r] = 0.f;
#pragma unroll
      for (int ks = 0; ks < 4; ++ks) {
        bf16x8 kf = *(const bf16x8*)(Kb + (kb * 32 + l31) * ATT_KSTR + (ks * 16 + hh * 8) * 2);
        s[kb] = __builtin_amdgcn_mfma_f32_32x32x16_bf16(kf, qf[ks], s[kb], 0, 0, 0);
      }
    }
    bf16x8 pf[4];
    float mx = s[0][0];
#pragma unroll
    for (int r = 1; r < 16; ++r) mx = fmaxf(mx, s[0][r]);
#pragma unroll
    for (int r = 0; r < 16; ++r) mx = fmaxf(mx, s[1][r]);
    mx = fmaxf(mx, __shfl_xor(mx, 32));
    const float mnew = fmaxf(mrun, mx * cs);
    const float alpha = __builtin_amdgcn_exp2f(mrun - mnew);
    const bool grew = mnew > mrun;
    mrun = mnew;
    float ls = 0.f;
#pragma unroll
    for (int kb = 0; kb < 2; ++kb) {
      float pv[16];
#pragma unroll
      for (int r = 0; r < 16; ++r) { pv[r] = __builtin_amdgcn_exp2f(s[kb][r] * cs - mnew); ls += pv[r]; }
#pragma unroll
      for (int sp = 0; sp < 2; ++sp) {
        u32x4 w;
#pragma unroll
        for (int e = 0; e < 4; ++e) w[e] = pack2(pv[8 * sp + 2 * e], pv[8 * sp + 2 * e + 1]);
        pf[kb * 2 + sp] = *(bf16x8*)&w;
      }
    }
    lrun = lrun * alpha + ls;
    if (__any(grew)) {
#pragma unroll
      for (int db = 0; db < 2; ++db)
#pragma unroll
        for (int r = 0; r < 16; ++r) o[db][r] *= alpha;
    }
#pragma unroll
    for (int sp = 0; sp < 4; ++sp) {
#pragma unroll
      for (int db = 0; db < 2; ++db) {
        bf16x8 vf = *(const bf16x8*)(Vb + (db * 32 + l31) * ATT_VSTR + (16 * sp + 8 * hh) * 2);
        o[db] = __builtin_amdgcn_mfma_f32_32x32x16_bf16(vf, pf[sp], o[db], 0, 0, 0);
      }
    }
  };
  float mfix;
  {
    float aq = fabsf(p.att_qnorm[layer * 64 + lane]), ak = fabsf(p.att_knorm[layer * 64 + lane]);
    aq = wave_max(aq); ak = wave_max(ak);
    mfix = 8.f * aq * ak * 1.02f * 1.44269504088896f * ATT_TAU;
  }
  const bool fast = mfix <= 40.f;
  if (fast) {
#pragma unroll
    for (int ks = 0; ks < 4; ++ks) {
      u32x4 w = *(u32x4*)&qf[ks];
#pragma unroll
      for (int e = 0; e < 4; ++e) w[e] = pack2(__uint_as_float(w[e] << 16) * cs, __uint_as_float(w[e] & 0xffff0000u) * cs);
      qf[ks] = *(bf16x8*)&w;
    }
  }
  auto compute_fast = [&](int buf, int sub) {
    const char* Kb = smem + buf * ATT_BUF + sub * 64 * ATT_KSTR;
    const char* Vb = smem + buf * ATT_BUF + ATT_VOFF + sub * 128;
    bf16x8 kf[8], vf[8];
#pragma unroll
    for (int kb = 0; kb < 2; ++kb)
#pragma unroll
      for (int ks = 0; ks < 4; ++ks) kf[kb * 4 + ks] = *(const bf16x8*)(Kb + (kb * 32 + l31) * ATT_KSTR + (ks * 16 + hh * 8) * 2);
#pragma unroll
    for (int sp = 0; sp < 4; ++sp)
#pragma unroll
      for (int db = 0; db < 2; ++db) vf[sp * 2 + db] = *(const bf16x8*)(Vb + (db * 32 + l31) * ATT_VSTR + (16 * sp + 8 * hh) * 2);
    f32x16 s[2];
#pragma unroll
    for (int kb = 0; kb < 2; ++kb) {
#pragma unroll
      for (int r = 0; r < 16; ++r) s[kb][r] = 0.f;
#pragma unroll
      for (int ks = 0; ks < 4; ++ks) s[kb] = __builtin_amdgcn_mfma_f32_32x32x16_bf16(kf[kb * 4 + ks], qf[ks], s[kb], 0, 0, 0);
    }
    bf16x8 pf[4];
    float ls = 0.f;
#pragma unroll
    for (int kb = 0; kb < 2; ++kb) {
      float pv[16];
#pragma unroll
      for (int r = 0; r < 16; ++r) { pv[r] = __builtin_amdgcn_exp2f(s[kb][r]); ls += pv[r]; }
#pragma unroll
      for (int sp = 0; sp < 2; ++sp) {
        u32x4 w;
#pragma unroll
        for (int e = 0; e < 4; ++e) w[e] = pack2(pv[8 * sp + 2 * e], pv[8 * sp + 2 * e + 1]);
        pf[kb * 2 + sp] = *(bf16x8*)&w;
      }
    }
    lrun += ls;
#pragma unroll
    for (int sp = 0; sp < 4; ++sp)
#pragma unroll
      for (int db = 0; db < 2; ++db) o[db] = __builtin_amdgcn_mfma_f32_32x32x16_bf16(vf[sp * 2 + db], pf[sp], o[db], 0, 0, 0);
  };
  __syncthreads();
  gload(kt0);
  lstore(0);
  __syncthreads();
  if (fast) {
    for (int t = 0; t < nkt; ++t) {
      const int buf = t & 1;
      if (t + 1 < nkt) gload(kt0 + t + 1);
      compute_fast(buf, 0);
      compute_fast(buf, 1);
      if (t + 1 < nkt) lstore(buf ^ 1);
      __syncthreads();
    }
  } else {
    for (int t = 0; t < nkt; ++t) {
      const int buf = t & 1;
      if (t + 1 < nkt) gload(kt0 + t + 1);
      compute(buf, 0);
      compute(buf, 1);
      if (t + 1 < nkt) lstore(buf ^ 1);
      __syncthreads();
    }
  }
  {
    float l = lrun + __shfl_xor(lrun, 32);
    float il = ATT_ALPHA / l;
    bf16_t* op = p.br + (size_t)(tok0 + l31) * 1536 + head * 64;
#pragma unroll
    for (int db = 0; db < 2; ++db)
#pragma unroll
      for (int g = 0; g < 4; ++g) {
        u32x2 w; w.x = pack2(o[db][4 * g] * il, o[db][4 * g + 1] * il); w.y = pack2(o[db][4 * g + 2] * il, o[db][4 * g + 3] * il);
        *(u32x2*)(op + db * 32 + 8 * g + 4 * hh) = w;
      }
  }
}

__device__ __forceinline__ void attn_item64(const Params& p, int layer, int item) {
  const int tid = tidx(), wid = tid >> 6, lane = tid & 63, l31 = lane & 31, hh = lane >> 5;
  int b, kvh, tok0, kt0, nkt;
  if (item < 512) { b = item >> 8; kvh = (item >> 7) & 1; tok0 = b * SEQ + (item & 127) * 64; kt0 = 0; nkt = 132; }
  else { int r = item - 512; b = r >> 3; kvh = (r >> 2) & 1; tok0 = NLAT + b * CTXL + (r & 3) * 64; kt0 = 128; nkt = 4; }
  const int head = kvh * 4 + wid;
  const float cs = 0.125f * 1.44269504088896f * ATT_TAU;
  bf16x8 qf[2][4];
#pragma unroll
  for (int qb = 0; qb < 2; ++qb)
#pragma unroll
    for (int ks = 0; ks < 4; ++ks) {
      u32x4 w = *(const u32x4*)(p.proj + (size_t)(tok0 + qb * 32 + l31) * 4096 + head * 64 + ks * 16 + hh * 8);
#pragma unroll
      for (int e = 0; e < 4; ++e) w[e] = pack2(__uint_as_float(w[e] << 16) * cs, __uint_as_float(w[e] & 0xffff0000u) * cs);
      qf[qb][ks] = *(bf16x8*)&w;
    }
  f32x16 o[2][2];
#pragma unroll
  for (int qb = 0; qb < 2; ++qb)
#pragma unroll
    for (int db = 0; db < 2; ++db)
#pragma unroll
      for (int r = 0; r < 16; ++r) o[qb][db][r] = 0.f;
  float lrun[2] = {0.f, 0.f};
  const bf16_t* vtb = p.vt + (size_t)(b * 2 + kvh) * 64 * 8448;
  auto stage = [&](int kt, int buf) {
    const int krow0 = kt < 128 ? b * SEQ + kt * 64 : NLAT + b * CTXL + (kt - 128) * 64;
    int ko = kt * 64; asm volatile("" : "+s"(ko));
    char* base = smem + buf * 16384;
#pragma unroll
    for (int i = 0; i < 2; ++i) {
      const int q = tid + 256 * i, r = q >> 3, c = (q & 7) ^ ((r >> 1) & 7);
      __builtin_amdgcn_global_load_lds((const unsigned*)(p.proj + (size_t)(krow0 + r) * 4096 + 512 + kvh * 64 + c * 8), (__attribute__((address_space(3))) unsigned*)(base + q * 16), 16, 0, 0);
      __builtin_amdgcn_global_load_lds((const unsigned*)(vtb + (size_t)r * 8448 + ko + c * 8), (__attribute__((address_space(3))) unsigned*)(base + 8192 + q * 16), 16, 0, 0);
    }
  };
  auto compute = [&](int buf) {
    const char* Kb = smem + buf * 16384;
    const char* Vb = Kb + 8192;
    bf16x8 pf[2][4];
#pragma unroll
    for (int kb = 0; kb < 2; ++kb) {
      bf16x8 kf[4];
      const int row = kb * 32 + l31;
#pragma unroll
      for (int ks = 0; ks < 4; ++ks) kf[ks] = *(const bf16x8*)(Kb + row * 128 + (((ks * 2 + hh) ^ ((row >> 1) & 7)) << 4));
      f32x16 s[2];
#pragma unroll
      for (int qb = 0; qb < 2; ++qb) {
#pragma unroll
        for (int r = 0; r < 16; ++r) s[qb][r] = 0.f;
#pragma unroll
        for (int ks = 0; ks < 4; ++ks) s[qb] = __builtin_amdgcn_mfma_f32_32x32x16_bf16(kf[ks], qf[qb][ks], s[qb], 0, 0, 0);
      }
#pragma unroll
      for (int qb = 0; qb < 2; ++qb) {
        float pv[16]; float ls = 0.f;
#pragma unroll
        for (int r = 0; r < 16; ++r) { pv[r] = __builtin_amdgcn_exp2f(s[qb][r]); ls += pv[r]; }
        lrun[qb] += ls;
#pragma unroll
        for (int sp = 0; sp < 2; ++sp) {
          u32x4 w;
#pragma unroll
          for (int e = 0; e < 4; ++e) w[e] = pack2(pv[8 * sp + 2 * e], pv[8 * sp + 2 * e + 1]);
          pf[qb][kb * 2 + sp] = *(bf16x8*)&w;
        }
      }
    }
#pragma unroll
    for (int sp = 0; sp < 4; ++sp)
#pragma unroll
      for (int db = 0; db < 2; ++db) {
        const int row = db * 32 + l31;
        bf16x8 vf = *(const bf16x8*)(Vb + row * 128 + (((sp * 2 + hh) ^ ((row >> 1) & 7)) << 4));
        o[0][db] = __builtin_amdgcn_mfma_f32_32x32x16_bf16(vf, pf[0][sp], o[0][db], 0, 0, 0);
        o[1][db] = __builtin_amdgcn_mfma_f32_32x32x16_bf16(vf, pf[1][sp], o[1][db], 0, 0, 0);
      }
  };
  __syncthreads();
  stage(kt0, 0);
  asm volatile("s_waitcnt vmcnt(0)" ::: "memory");
  __syncthreads();
  for (int t = 0; t < nkt; ++t) {
    if (t + 1 < nkt) stage(kt0 + t + 1, (t + 1) & 1);
    compute(t & 1);
    asm volatile("s_waitcnt vmcnt(0)" ::: "memory");
    __syncthreads();
  }
#pragma unroll
  for (int qb = 0; qb < 2; ++qb) {
    float l = lrun[qb] + __shfl_xor(lrun[qb], 32);
    float il = ATT_ALPHA / l;
    bf16_t* op = p.br + (size_t)(tok0 + qb * 32 + l31) * 1536 + head * 64;
#pragma unroll
    for (int db = 0; db < 2; ++db)
#pragma unroll
      for (int g = 0; g < 4; ++g) {
        u32x2 w; w.x = pack2(o[qb][db][4 * g] * il, o[qb][db][4 * g + 1] * il); w.y = pack2(o[qb][db][4 * g + 2] * il, o[qb][db][4 * g + 3] * il);
        *(u32x2*)(op + db * 32 + 8 * g + 4 * hh) = w;
      }
  }
}
__device__ __forceinline__ float attn_logit_bound(const Params& p, int layer) {
  const int lane = tidx() & 63;
  float aq = fabsf(p.att_qnorm[layer * 64 + lane]), ak = fabsf(p.att_knorm[layer * 64 + lane]);
  aq = wave_max(aq); ak = wave_max(ak);
  return 8.f * aq * ak * 1.02f * 1.44269504088896f * ATT_TAU;
}

__device__ __forceinline__ void phase_ssdprep(const Params& p, int layer) {
  const float* cw = p.ssd_conv_w + (size_t)layer * 5 * 768;
  const float* cb = p.ssd_conv_b + layer * 768;
  const int total = (MROWS / 16) * 96;
  for (int i = bidx() * NTHR + tidx(); i < total; i += gridDim.x * NTHR) {
    const int run = i / 96, c0 = (i - run * 96) * 8;
    const int row0 = run * 16;
    int t0, T;
    if (row0 < NLAT) { t0 = row0 & (SEQ - 1); T = SEQ; } else { t0 = (row0 - NLAT) & (CTXL - 1); T = CTXL; }
    float w[5][8], bias[8];
#pragma unroll
    for (int j = 0; j < 5; ++j) {
      f32x4 w0 = *(const f32x4*)(cw + j * 768 + c0), w1 = *(const f32x4*)(cw + j * 768 + c0 + 4);
#pragma unroll
      for (int e = 0; e < 4; ++e) { w[j][e] = w0[e]; w[j][4 + e] = w1[e]; }
    }
    {
      f32x4 b0 = *(const f32x4*)(cb + c0), b1 = *(const f32x4*)(cb + c0 + 4);
#pragma unroll
      for (int e = 0; e < 4; ++e) { bias[e] = b0[e]; bias[4 + e] = b1[e]; }
    }
    const bf16_t* src = p.proj + (size_t)row0 * 4096 + 1280 + c0;
    u32x4 win[5];
    const u32x4 zero4 = {0u, 0u, 0u, 0u};
    win[0] = zero4;
    win[1] = t0 >= 2 ? *(const u32x4*)(src - 2 * 4096) : zero4;
    win[2] = t0 >= 1 ? *(const u32x4*)(src - 1 * 4096) : zero4;
    win[3] = *(const u32x4*)(src);
    win[4] = *(const u32x4*)(src + 4096);
#pragma unroll
    for (int r = 0; r < 16; ++r) {
      win[0] = win[1]; win[1] = win[2]; win[2] = win[3]; win[3] = win[4];
      win[4] = (t0 + r + 2 < T) ? *(const u32x4*)(src + (size_t)(r + 2) * 4096) : zero4;
      float a[8];
#pragma unroll
      for (int e = 0; e < 8; ++e) a[e] = bias[e];
#pragma unroll
      for (int j = 0; j < 5; ++j)
#pragma unroll
        for (int e = 0; e < 4; ++e) {
          a[2 * e] += w[j][2 * e] * __uint_as_float(win[j][e] << 16);
          a[2 * e + 1] += w[j][2 * e + 1] * __uint_as_float(win[j][e] & 0xffff0000u);
        }
      u32x4 o;
#pragma unroll
      for (int e = 0; e < 4; ++e) o[e] = pack2(siluf_(a[2 * e]), siluf_(a[2 * e + 1]));
      *(u32x4*)(p.xbc + (size_t)(row0 + r) * 768 + c0) = o;
    }
  }
  const int total2 = MROWS * 16;
  for (int i = bidx() * NTHR + tidx(); i < total2; i += gridDim.x * NTHR) {
    int row = i >> 4, j = i & 15;
    p.dtb[i] = softplusf_(p.small[(size_t)row * 32 + j] + p.ssd_dt_bias[layer * 16 + j]);
  }
}

__device__ __forceinline__ int chunk_row0(int b, int c) { return c < 64 ? b * SEQ + c * 128 : NLAT + b * CTXL + (c - 64) * 128; }
__device__ __forceinline__ float wave_incl_scan(float v, int lane) {
#pragma unroll
  for (int o = 1; o < 64; o <<= 1) { float t = __shfl_up(v, o); if (lane >= o) v += t; }
  return v;
}
__device__ __forceinline__ void ssd_scans(const Params& p, int layer, int row0, int h, float* fl) {
  const int tid = tidx(), lane = tid & 63, wv = tid >> 6;
  const bool fwd = tid < 128;
  const int s = fwd ? tid : 127 - (tid - 128);
  const float A = -__expf(p.ssd_a_log[layer * 16 + (fwd ? 0 : 8) + h]);
  const float dt = p.dtb[(size_t)(row0 + s) * 16 + (fwd ? 0 : 8) + h];
  float v = wave_incl_scan(dt * A, lane);
  if (lane == 63) fl[512 + wv] = v;
  __syncthreads();
  if (wv & 1) v += fl[512 + wv - 1];
  fl[(fwd ? 0 : 128) + s] = v;
  fl[(fwd ? 256 : 384) + s] = dt;
  __syncthreads();
}

#define SSD_TSTR 272
__device__ __forceinline__ void ssdA_item(const Params& p, int layer, int item) {
  const int tid = tidx(), wid = tid >> 6, lane = tid & 63, l31 = lane & 31, hh = lane >> 5;
  const int b = item / 528, c = (item / 8) % 66, h = item & 7, g = h >> 2;
  const int row0 = chunk_row0(b, c);
  float* fl = (float*)smem;
  char* BT = smem + 4096;
  char* XF = BT + 64 * SSD_TSTR;
  char* XB = XF + 64 * SSD_TSTR;
  __syncthreads();
  ssd_scans(p, layer, row0, h, fl);
  const float cfl = fl[127], cbl = fl[128];
  {
    const int s = tid >> 1, half = tid & 1;
    const float wf = __expf(cfl - fl[s]) * fl[256 + s], wb = __expf(cbl - fl[128 + s]) * fl[384 + s];
    const bf16_t* xr = p.xbc + (size_t)(row0 + s) * 768;
#pragma unroll
    for (int i = 0; i < 4; ++i) {
      u32x4 xv = *(const u32x4*)(xr + h * 64 + half * 32 + i * 8);
      u32x4 bv = *(const u32x4*)(xr + 512 + g * 64 + half * 32 + i * 8);
#pragma unroll
      for (int e = 0; e < 4; ++e) {
        int pp = half * 32 + i * 8 + 2 * e;
        float x0 = __uint_as_float(xv[e] << 16), x1 = __uint_as_float(xv[e] & 0xffff0000u);
        *(bf16_t*)(XF + pp * SSD_TSTR + s * 2) = f2bf(x0 * wf);
        *(bf16_t*)(XF + (pp + 1) * SSD_TSTR + s * 2) = f2bf(x1 * wf);
        *(bf16_t*)(XB + pp * SSD_TSTR + s * 2) = f2bf(x0 * wb);
        *(bf16_t*)(XB + (pp + 1) * SSD_TSTR + s * 2) = f2bf(x1 * wb);
        *(bf16_t*)(BT + pp * SSD_TSTR + s * 2) = (bf16_t)(bv[e] & 0xffffu);
        *(bf16_t*)(BT + (pp + 1) * SSD_TSTR + s * 2) = (bf16_t)(bv[e] >> 16);
      }
    }
  }
  __syncthreads();
  const int nb = wid >> 1, pb = wid & 1;
#pragma unroll
  for (int dir = 0; dir < 2; ++dir) {
    const char* XT = dir == 0 ? XF : XB;
    f32x16 acc;
#pragma unroll
    for (int r = 0; r < 16; ++r) acc[r] = 0.f;
#pragma unroll
    for (int ks = 0; ks < 8; ++ks) {
      bf16x8 a = *(const bf16x8*)(BT + (nb * 32 + l31) * SSD_TSTR + (ks * 16 + hh * 8) * 2);
      bf16x8 bb = *(const bf16x8*)(XT + (pb * 32 + l31) * SSD_TSTR + (ks * 16 + hh * 8) * 2);
      acc = __builtin_amdgcn_mfma_f32_32x32x16_bf16(a, bb, acc, 0, 0, 0);
    }
    bf16_t* dst = p.ssl + ((size_t)(((dir * 2 + b) * 8 + h) * 66 + c) * 64 + pb * 32 + l31) * 64 + nb * 32 + 4 * hh;
#pragma unroll
    for (int q4 = 0; q4 < 4; ++q4) {
      u32x2 w; w.x = pack2(acc[4 * q4], acc[4 * q4 + 1]); w.y = pack2(acc[4 * q4 + 2], acc[4 * q4 + 3]);
      *(u32x2*)(dst + 8 * q4) = w;
    }
  }
  if (tid == 0) {
    p.sdec[((0 * 2 + b) * 8 + h) * 66 + c] = __expf(cfl);
    p.sdec[((1 * 2 + b) * 8 + h) * 66 + c] = __expf(cbl);
  }
}

__device__ __forceinline__ void phase_ssdcarry(const Params& p) {
  const int total = 32 * 1024;
  for (int i = bidx() * NTHR + tidx(); i < total; i += gridDim.x * NTHR) {
    const int seq = i >> 10, el = (i & 1023) * 4;
    const int dir = seq >> 4;
    bf16_t* base = p.ssl + (size_t)seq * 66 * 4096 + el;
    const float* dec = p.sdec + seq * 66;
    float st[4] = {0.f, 0.f, 0.f, 0.f};
#pragma unroll 22
    for (int k = 0; k < 66; ++k) {
      int c = dir == 0 ? (k < 2 ? 64 + k : k - 2) : (65 - k);
      u32x2 v = *(const u32x2*)(base + (size_t)c * 4096);
      float d = dec[c];
      u32x2 w; w.x = pack2(st[0], st[1]); w.y = pack2(st[2], st[3]);
      *(u32x2*)(base + (size_t)c * 4096) = w;
      st[0] = d * st[0] + __uint_as_float(v.x << 16); st[1] = d * st[1] + __uint_as_float(v.x & 0xffff0000u);
      st[2] = d * st[2] + __uint_as_float(v.y << 16); st[3] = d * st[3] + __uint_as_float(v.y & 0xffff0000u);
    }
  }
}

__device__ __forceinline__ void ssdC_item(const Params& p, int layer, int item) {
  const int tid = tidx(), wid = tid >> 6, lane = tid & 63, l31 = lane & 31, hh = lane >> 5;
  const int b = item / 528, c = (item / 8) % 66, h = item & 7, g = h >> 2;
  const int row0 = chunk_row0(b, c);
  float* fl = (float*)smem;
  char* Bt = smem + 4096;
  char* XT = Bt + 128 * 144;
  __syncthreads();
  ssd_scans(p, layer, row0, h, fl);
  {
#pragma unroll
    for (int i = 0; i < 4; ++i) {
      int id = tid + 256 * i, r = id >> 3, c16 = id & 7;
      *(u32x4*)(Bt + r * 144 + c16 * 16) = *(const u32x4*)(p.xbc + (size_t)(row0 + r) * 768 + 512 + g * 64 + c16 * 8);
    }
    const int s = tid >> 1, half = tid & 1;
    const bf16_t* xr = p.xbc + (size_t)(row0 + s) * 768 + h * 64 + half * 32;
#pragma unroll
    for (int i = 0; i < 4; ++i) {
      u32x4 xv = *(const u32x4*)(xr + i * 8);
#pragma unroll
      for (int e = 0; e < 4; ++e) {
        int pp = half * 32 + i * 8 + 2 * e;
        *(bf16_t*)(XT + pp * SSD_TSTR + s * 2) = (bf16_t)(xv[e] & 0xffffu);
        *(bf16_t*)(XT + (pp + 1) * SSD_TSTR + s * 2) = (bf16_t)(xv[e] >> 16);
      }
    }
  }
  __syncthreads();
  const int s = wid * 32 + l31;
  const float cfs = fl[s], cbs = fl[128 + s];
  bf16x8 cf[4];
#pragma unroll
  for (int ks = 0; ks < 4; ++ks) cf[ks] = *(const bf16x8*)(p.xbc + (size_t)(row0 + s) * 768 + 640 + g * 64 + ks * 16 + hh * 8);
  f32x16 Y[2];
  {
    f32x16 aF[2], aB[2];
#pragma unroll
    for (int pb = 0; pb < 2; ++pb)
#pragma unroll
      for (int r = 0; r < 16; ++r) { aF[pb][r] = 0.f; aB[pb][r] = 0.f; }
    const bf16_t* spf = p.ssl + (size_t)(((0 * 2 + b) * 8 + h) * 66 + c) * 4096;
    const bf16_t* spb = p.ssl + (size_t)(((1 * 2 + b) * 8 + h) * 66 + c) * 4096;
#pragma unroll
    for (int pb = 0; pb < 2; ++pb)
#pragma unroll
      for (int ks = 0; ks < 4; ++ks) {
        bf16x8 a0 = *(const bf16x8*)(spf + (pb * 32 + l31) * 64 + ks * 16 + hh * 8);
        bf16x8 a1 = *(const bf16x8*)(spb + (pb * 32 + l31) * 64 + ks * 16 + hh * 8);
        aF[pb] = __builtin_amdgcn_mfma_f32_32x32x16_bf16(a0, cf[ks], aF[pb], 0, 0, 0);
        aB[pb] = __builtin_amdgcn_mfma_f32_32x32x16_bf16(a1, cf[ks], aB[pb], 0, 0, 0);
      }
    const float ef = __expf(cfs), eb = __expf(cbs);
#pragma unroll
    for (int pb = 0; pb < 2; ++pb)
#pragma unroll
      for (int r = 0; r < 16; ++r) Y[pb][r] = aF[pb][r] * ef + aB[pb][r] * eb;
  }
  for (int rb = 0; rb < 4; ++rb) {
    f32x16 gt;
#pragma unroll
    for (int r = 0; r < 16; ++r) gt[r] = 0.f;
#pragma unroll
    for (int ks = 0; ks < 4; ++ks) {
      bf16x8 a = *(const bf16x8*)(Bt + (rb * 32 + l31) * 144 + (ks * 16 + hh * 8) * 2);
      gt = __builtin_amdgcn_mfma_f32_32x32x16_bf16(a, cf[ks], gt, 0, 0, 0);
    }
#pragma unroll
    for (int dir = 0; dir < 2; ++dir) {
      if (dir == 0 ? (rb > wid) : (rb < wid)) continue;
      const float* cum = fl + (dir == 0 ? 0 : 128);
      const float* dta = fl + (dir == 0 ? 256 : 384);
      const float cs = dir == 0 ? cfs : cbs;
      float val[16];
#pragma unroll
      for (int q4 = 0; q4 < 4; ++q4) {
        int r0 = rb * 32 + 8 * q4 + 4 * hh;
        f32x4 cr = *(const f32x4*)(cum + r0), dr = *(const f32x4*)(dta + r0);
#pragma unroll
        for (int e = 0; e < 4; ++e) {
          int r = r0 + e;
          bool keep = dir == 0 ? (r <= s) : (r >= s);
          float arg = fminf(cs - cr[e], 0.f);
          val[4 * q4 + e] = keep ? gt[4 * q4 + e] * __expf(arg) * dr[e] : 0.f;
        }
      }
#pragma unroll
      for (int sp = 0; sp < 2; ++sp) {
        u32x4 w;
#pragma unroll
        for (int e = 0; e < 4; ++e) w[e] = pack2(val[8 * sp + 2 * e], val[8 * sp + 2 * e + 1]);
        bf16x8 pf = *(bf16x8*)&w;
#pragma unroll
        for (int pb = 0; pb < 2; ++pb) {
          const char* xa = XT + (pb * 32 + l31) * SSD_TSTR + (rb * 32 + 16 * sp + 4 * hh) * 2;
          u32x2 v0 = *(const u32x2*)xa, v1 = *(const u32x2*)(xa + 16);
          u32x4 vw = {v0[0], v0[1], v1[0], v1[1]};
          Y[pb] = __builtin_amdgcn_mfma_f32_32x32x16_bf16(*(bf16x8*)&vw, pf, Y[pb], 0, 0, 0);
        }
      }
    }
  }
  bf16_t* op = p.yf + (size_t)(row0 + s) * 512 + h * 64;
#pragma unroll
  for (int pb = 0; pb < 2; ++pb)
#pragma unroll
    for (int q4 = 0; q4 < 4; ++q4) {
      u32x2 w; w.x = pack2(Y[pb][4 * q4], Y[pb][4 * q4 + 1]); w.y = pack2(Y[pb][4 * q4 + 2], Y[pb][4 * q4 + 3]);
      *(u32x2*)(op + pb * 32 + 8 * q4 + 4 * hh) = w;
    }
}

__device__ __forceinline__ void phase_ssdout(const Params& p, int layer, int nrows) {
  const int lane = tidx() & 63, wv = tidx() >> 6;
  const float* ng = p.ssd_norm + layer * 512;
  for (int row = bidx() * 4 + wv; row < nrows; row += gridDim.x * 4) {
    int c0 = lane * 8; int h = c0 >> 6;
    float Dk = p.ssd_d[layer * 8 + h];
    u32x4 a = *(const u32x4*)(p.yf + (size_t)row * 512 + c0);
    u32x4 xs = *(const u32x4*)(p.xbc + (size_t)row * 768 + c0), z = *(const u32x4*)(p.proj + (size_t)row * 4096 + 768 + c0);
    float y[8]; float ss = 0.f;
#pragma unroll
    for (int e = 0; e < 4; ++e) {
      float y0 = __uint_as_float(a[e] << 16) + __uint_as_float(xs[e] << 16) * Dk;
      float y1 = __uint_as_float(a[e] & 0xffff0000u) + __uint_as_float(xs[e] & 0xffff0000u) * Dk;
      y0 *= siluf_(__uint_as_float(z[e] << 16)); y1 *= siluf_(__uint_as_float(z[e] & 0xffff0000u));
      y[2 * e] = y0; y[2 * e + 1] = y1; ss += y0 * y0 + y1 * y1;
    }
    ss = wave_sum(ss);
    float rs = rsqrtf(ss * (1.f / 512.f) + 1e-6f);
    u32x4 w;
#pragma unroll
    for (int e = 0; e < 4; ++e) w[e] = pack2(y[2 * e] * rs * ng[c0 + 2 * e], y[2 * e + 1] * rs * ng[c0 + 2 * e + 1]);
    *(u32x4*)(p.br + (size_t)row * 1536 + 512 + c0) = w;
  }
}

__device__ __forceinline__ float wave_incl_maxscan(float v, int lane) {
#pragma unroll
  for (int o = 1; o < 64; o <<= 1) { float t = __shfl_up(v, o); if (lane >= o) v = fmaxf(v, t); }
  return v;
}
__device__ __forceinline__ void ml_scans(const Params& p, int layer, int row0, int h, float* fl) {
  const int tid = tidx(), lane = tid & 63, wv = tid >> 6;
  const int dir = tid >> 7;
  const int s = dir == 0 ? tid : 127 - (tid - 128);
  const float ip = p.small[(size_t)(row0 + s) * 32 + 16 + dir * 8 + h] + p.ml_gate_bias[layer * 16 + dir * 8 + h];
  const float fp = p.small[(size_t)(row0 + s) * 32 + 16 + dir * 8 + 4 + h] + p.ml_gate_bias[layer * 16 + dir * 8 + 4 + h];
  float bc = wave_incl_scan(logsigmoidf_(fp), lane);
  if (lane == 63) fl[768 + wv] = bc;
  __syncthreads();
  if (wv & 1) bc += fl[768 + wv - 1];
  const float u = ip - bc;
  float pm = wave_incl_maxscan(u, lane);
  if (lane == 63) fl[776 + wv] = pm;
  __syncthreads();
  if (wv & 1) pm = fmaxf(pm, fl[776 + wv - 1]);
  fl[dir * 128 + s] = bc; fl[256 + dir * 128 + s] = u; fl[512 + dir * 128 + s] = pm;
  __syncthreads();
}

#define ML_TSTR 272
__device__ __forceinline__ void mlA_item(const Params& p, int layer, int item) {
  const int tid = tidx(), wid = tid >> 6, lane = tid & 63, l31 = lane & 31, hh = lane >> 5;
  const int b = item / 264, c = (item / 4) % 66, h = item & 3;
  const int row0 = chunk_row0(b, c);
  float* fl = (float*)smem;
  char* KT = smem + 8192;
  char* VW = KT + 128 * ML_TSTR;
  __syncthreads();
  ml_scans(p, layer, row0, h, fl);
  const int r_ = tid >> 1, half = tid & 1;
  {
    const bf16_t* kr = p.proj + (size_t)(row0 + r_) * 4096 + 2560 + h * 128 + half * 64;
#pragma unroll
    for (int i = 0; i < 8; ++i) {
      u32x4 kv = *(const u32x4*)(kr + i * 8);
#pragma unroll
      for (int e = 0; e < 4; ++e) {
        int ee = half * 64 + i * 8 + 2 * e;
        *(bf16_t*)(KT + ee * ML_TSTR + r_ * 2) = (bf16_t)(kv[e] & 0xffffu);
        *(bf16_t*)(KT + (ee + 1) * ML_TSTR + r_ * 2) = (bf16_t)(kv[e] >> 16);
      }
    }
  }
  for (int dir = 0; dir < 2; ++dir) {
    const int seq = (dir * 2 + b) * 4 + h;
    const float blast = fl[dir * 128 + (dir == 0 ? 127 : 0)];
    const float umax = fl[512 + dir * 128 + (dir == 0 ? 127 : 0)];
    {
      const float wgt = __expf(fl[256 + dir * 128 + r_] - umax) * 0.08838834764831845f;
      if (half == 0) fl[1024 + r_] = wgt;
      const bf16_t* vr = p.proj + (size_t)(row0 + r_) * 4096 + 3072 + h * 128 + half * 64;
#pragma unroll
      for (int i = 0; i < 8; ++i) {
        u32x4 vv = *(const u32x4*)(vr + i * 8);
#pragma unroll
        for (int e = 0; e < 4; ++e) {
          int dd = half * 64 + i * 8 + 2 * e;
          *(bf16_t*)(VW + dd * ML_TSTR + r_ * 2) = f2bf(__uint_as_float(vv[e] << 16) * wgt);
          *(bf16_t*)(VW + (dd + 1) * ML_TSTR + r_ * 2) = f2bf(__uint_as_float(vv[e] & 0xffff0000u) * wgt);
        }
      }
    }
    __syncthreads();
    {
      const int e_ = tid & 127, hf = tid >> 7;
      float a = 0.f;
#pragma unroll
      for (int i = 0; i < 8; ++i) {
        u32x4 kv = *(const u32x4*)(KT + e_ * ML_TSTR + (hf * 64 + i * 8) * 2);
        const float* wp = fl + 1024 + hf * 64 + i * 8;
#pragma unroll
        for (int e = 0; e < 4; ++e) a += __uint_as_float(kv[e] << 16) * wp[2 * e] + __uint_as_float(kv[e] & 0xffff0000u) * wp[2 * e + 1];
      }
      if (hf == 1) fl[1280 + e_] = a;
      __syncthreads();
      if (hf == 0) p.mnl[((size_t)seq * 66 + c) * 128 + e_] = a + fl[1280 + e_];
    }
    f32x16 acc[4];
#pragma unroll
    for (int eb = 0; eb < 4; ++eb)
#pragma unroll
      for (int r = 0; r < 16; ++r) acc[eb][r] = 0.f;
#pragma unroll
    for (int ks = 0; ks < 8; ++ks) {
      bf16x8 bv = *(const bf16x8*)(VW + (wid * 32 + l31) * ML_TSTR + (ks * 16 + hh * 8) * 2);
#pragma unroll
      for (int eb = 0; eb < 4; ++eb) {
        bf16x8 av = *(const bf16x8*)(KT + (eb * 32 + l31) * ML_TSTR + (ks * 16 + hh * 8) * 2);
        acc[eb] = __builtin_amdgcn_mfma_f32_32x32x16_bf16(av, bv, acc[eb], 0, 0, 0);
      }
    }
    bf16_t* dst = p.mcl + (((size_t)seq * 66 + c) * 128 + wid * 32 + l31) * 128 + 4 * hh;
#pragma unroll
    for (int eb = 0; eb < 4; ++eb)
#pragma unroll
      for (int q4 = 0; q4 < 4; ++q4) {
        u32x2 w; w.x = pack2(acc[eb][4 * q4], acc[eb][4 * q4 + 1]); w.y = pack2(acc[eb][4 * q4 + 2], acc[eb][4 * q4 + 3]);
        *(u32x2*)(dst + eb * 32 + 8 * q4) = w;
      }
    if (tid == 0) { p.mml[seq * 66 + c] = blast + umax; p.mbl[seq * 66 + c] = blast; }
    __syncthreads();
  }
}

__device__ __forceinline__ void phase_mlcarry(const Params& p) {
  const int per = 4096 + 32;
  const int total = 16 * per;
  for (int i = bidx() * NTHR + tidx(); i < total; i += gridDim.x * NTHR) {
    const int seq = i / per, j = i % per;
    const int dir = seq >> 3;
    const float* ml = p.mml + seq * 66; const float* bl = p.mbl + seq * 66;
    float m = 0.f;
    float st[4] = {0.f, 0.f, 0.f, 0.f};
    const bool isC = j < 4096;
    bf16_t* cb = p.mcl + (size_t)seq * 66 * 16384 + (isC ? j * 4 : 0);
    float* nb = p.mnl + (size_t)seq * 66 * 128 + (isC ? 0 : (j - 4096) * 4);
#pragma unroll 11
    for (int k = 0; k < 66; ++k) {
      int c = dir == 0 ? (k < 2 ? 64 + k : k - 2) : (65 - k);
      float mlc = ml[c], blc = bl[c];
      float mnew = fmaxf(blc + m, mlc);
      float ap = __expf(blc + m - mnew), al = __expf(mlc - mnew);
      if (isC) {
        u32x2 v = *(const u32x2*)(cb + (size_t)c * 16384);
        u32x2 w; w.x = pack2(st[0], st[1]); w.y = pack2(st[2], st[3]);
        *(u32x2*)(cb + (size_t)c * 16384) = w;
        st[0] = ap * st[0] + al * __uint_as_float(v.x << 16); st[1] = ap * st[1] + al * __uint_as_float(v.x & 0xffff0000u);
        st[2] = ap * st[2] + al * __uint_as_float(v.y << 16); st[3] = ap * st[3] + al * __uint_as_float(v.y & 0xffff0000u);
        if (j == 0) p.mmp[seq * 66 + c] = m;
      } else {
        f32x4 v = *(const f32x4*)(nb + (size_t)c * 128);
        f32x4 w = {st[0], st[1], st[2], st[3]};
        *(f32x4*)(nb + (size_t)c * 128) = w;
        st[0] = ap * st[0] + al * v[0]; st[1] = ap * st[1] + al * v[1]; st[2] = ap * st[2] + al * v[2]; st[3] = ap * st[3] + al * v[3];
      }
      m = mnew;
    }
  }
}

__device__ __forceinline__ void mlC_item(const Params& p, int layer, int item) {
  const int tid = tidx(), wid = tid >> 6, lane = tid & 63, l31 = lane & 31, hh = lane >> 5;
  const int b = item / 264, c = (item / 4) % 66, h = item & 3;
  const int row0 = chunk_row0(b, c);
  float* fl = (float*)smem;
  char* Kt = smem + 8192;
  char* VT = Kt + 128 * ML_TSTR;
  __syncthreads();
  ml_scans(p, layer, row0, h, fl);
  {
#pragma unroll
    for (int i = 0; i < 8; ++i) {
      int id = tid + 256 * i, r = id >> 4, c16 = id & 15;
      *(u32x4*)(Kt + r * ML_TSTR + c16 * 16) = *(const u32x4*)(p.proj + (size_t)(row0 + r) * 4096 + 2560 + h * 128 + c16 * 8);
    }
    const int r_ = tid >> 1, half = tid & 1;
    const bf16_t* vr = p.proj + (size_t)(row0 + r_) * 4096 + 3072 + h * 128 + half * 64;
#pragma unroll
    for (int i = 0; i < 8; ++i) {
      u32x4 vv = *(const u32x4*)(vr + i * 8);
#pragma unroll
      for (int e = 0; e < 4; ++e) {
        int dd = half * 64 + i * 8 + 2 * e;
        *(bf16_t*)(VT + dd * ML_TSTR + r_ * 2) = (bf16_t)(vv[e] & 0xffffu);
        *(bf16_t*)(VT + (dd + 1) * ML_TSTR + r_ * 2) = (bf16_t)(vv[e] >> 16);
      }
    }
    {
      const int dir = tid >> 7, e_ = tid & 127;
      const int seq = (dir * 2 + b) * 4 + h;
      fl[1024 + dir * 128 + e_] = p.mnl[((size_t)seq * 66 + c) * 128 + e_];
    }
  }
  __syncthreads();
  const int s = wid * 32 + l31;
  bf16x8 qf[8];
#pragma unroll
  for (int ks = 0; ks < 8; ++ks) qf[ks] = *(const bf16x8*)(p.proj + (size_t)(row0 + s) * 4096 + 2048 + h * 128 + ks * 16 + hh * 8);
  f32x16 hacc[4];
#pragma unroll
  for (int db = 0; db < 4; ++db)
#pragma unroll
    for (int r = 0; r < 16; ++r) hacc[db][r] = 0.f;
  for (int dir = 0; dir < 2; ++dir) {
    const int seq = (dir * 2 + b) * 4 + h;
    const float mprev = p.mmp[seq * 66 + c];
    const float bcs = fl[dir * 128 + s], pms = fl[512 + dir * 128 + s];
    const float msel = fmaxf(mprev, pms);
    const float ms = bcs + msel;
    const float winter = __expf(mprev - msel);
    const float* uu = fl + 256 + dir * 128;
    float qn = 0.f;
    {
      const float* np = fl + 1024 + dir * 128;
#pragma unroll
      for (int ks = 0; ks < 8; ++ks) {
        u32x4 w = *(u32x4*)&qf[ks];
        const float* npp = np + ks * 16 + hh * 8;
#pragma unroll
        for (int e = 0; e < 4; ++e) qn += __uint_as_float(w[e] << 16) * npp[2 * e] + __uint_as_float(w[e] & 0xffff0000u) * npp[2 * e + 1];
      }
      qn += __shfl_xor(qn, 32);
    }
    float den = 0.f;
    for (int rb = 0; rb < 4; ++rb) {
      if (dir == 0 ? (rb > wid) : (rb < wid)) continue;
      f32x16 st;
#pragma unroll
      for (int r = 0; r < 16; ++r) st[r] = 0.f;
#pragma unroll
      for (int ks = 0; ks < 8; ++ks) {
        bf16x8 a = *(const bf16x8*)(Kt + (rb * 32 + l31) * ML_TSTR + (ks * 16 + hh * 8) * 2);
        st = __builtin_amdgcn_mfma_f32_32x32x16_bf16(a, qf[ks], st, 0, 0, 0);
      }
#pragma unroll
      for (int q4 = 0; q4 < 4; ++q4) {
        int r0 = rb * 32 + 8 * q4 + 4 * hh;
        f32x4 ur = *(const f32x4*)(uu + r0);
#pragma unroll
        for (int e = 0; e < 4; ++e) {
          int r = r0 + e;
          bool keep = dir == 0 ? (r <= s) : (r >= s);
          float arg = fminf(ur[e] - msel, 0.f);
          den += keep ? st[4 * q4 + e] * 0.08838834764831845f * __expf(arg) : 0.f;
        }
      }
    }
    den += __shfl_xor(den, 32);
    den += winter * qn;
    const float inv = 1.f / fmaxf(fabsf(den), __expf(-ms));
    {
      const float qs = winter * inv;
      const bf16_t* cp = p.mcl + ((size_t)seq * 66 + c) * 16384;
#pragma unroll
      for (int ks = 0; ks < 8; ++ks) {
        u32x4 w = *(u32x4*)&qf[ks];
        u32x4 ws;
#pragma unroll
        for (int e = 0; e < 4; ++e) ws[e] = pack2(__uint_as_float(w[e] << 16) * qs, __uint_as_float(w[e] & 0xffff0000u) * qs);
        bf16x8 qsf = *(bf16x8*)&ws;
#pragma unroll
        for (int db = 0; db < 4; ++db) {
          bf16x8 a = *(const bf16x8*)(cp + (db * 32 + l31) * 128 + ks * 16 + hh * 8);
          hacc[db] = __builtin_amdgcn_mfma_f32_32x32x16_bf16(a, qsf, hacc[db], 0, 0, 0);
        }
      }
    }
    for (int rb = 0; rb < 4; ++rb) {
      if (dir == 0 ? (rb > wid) : (rb < wid)) continue;
      f32x16 st;
#pragma unroll
      for (int r = 0; r < 16; ++r) st[r] = 0.f;
#pragma unroll
      for (int ks = 0; ks < 8; ++ks) {
        bf16x8 a = *(const bf16x8*)(Kt + (rb * 32 + l31) * ML_TSTR + (ks * 16 + hh * 8) * 2);
        st = __builtin_amdgcn_mfma_f32_32x32x16_bf16(a, qf[ks], st, 0, 0, 0);
      }
      const float sc = 0.08838834764831845f * inv;
#pragma unroll
      for (int sp = 0; sp < 2; ++sp) {
        u32x4 w;
#pragma unroll
        for (int q2 = 0; q2 < 2; ++q2) {
          int q4 = 2 * sp + q2;
          int r0 = rb * 32 + 8 * q4 + 4 * hh;
          f32x4 ur = *(const f32x4*)(uu + r0);
          float v[4];
#pragma unroll
          for (int e = 0; e < 4; ++e) {
            int r = r0 + e;
            bool keep = dir == 0 ? (r <= s) : (r >= s);
            float arg = fminf(ur[e] - msel, 0.f);
            v[e] = keep ? st[4 * q4 + e] * sc * __expf(arg) : 0.f;
          }
          w[2 * q2] = pack2(v[0], v[1]); w[2 * q2 + 1] = pack2(v[2], v[3]);
        }
        bf16x8 pf = *(bf16x8*)&w;
#pragma unroll
        for (int db = 0; db < 4; ++db) {
          const char* va = VT + (db * 32 + l31) * ML_TSTR + (rb * 32 + 16 * sp + 4 * hh) * 2;
          u32x2 v0 = *(const u32x2*)va, v1 = *(const u32x2*)(va + 16);
          u32x4 vw = {v0[0], v0[1], v1[0], v1[1]};
          hacc[db] = __builtin_amdgcn_mfma_f32_32x32x16_bf16(*(bf16x8*)&vw, pf, hacc[db], 0, 0, 0);
        }
      }
    }
  }
  bf16_t* op = p.hf + (size_t)(row0 + s) * 512 + h * 128;
#pragma unroll
  for (int db = 0; db < 4; ++db)
#pragma unroll
    for (int q4 = 0; q4 < 4; ++q4) {
      u32x2 w; w.x = pack2(hacc[db][4 * q4], hacc[db][4 * q4 + 1]); w.y = pack2(hacc[db][4 * q4 + 2], hacc[db][4 * q4 + 3]);
      *(u32x2*)(op + db * 32 + 8 * q4 + 4 * hh) = w;
    }
}

__device__ __forceinline__ void phase_mlout(const Params& p, int layer, int nrows) {
  const int lane = tidx() & 63, wv = tidx() >> 6;
  const float* ng = p.ml_norm + layer * 512;
  for (int row = bidx() * 4 + wv; row < nrows; row += gridDim.x * 4) {
    int c0 = lane * 8;
    u32x4 a = *(const u32x4*)(p.hf + (size_t)row * 512 + c0);
    u32x4 o = *(const u32x4*)(p.proj + (size_t)row * 4096 + 3584 + c0);
    float y[8]; float ss = 0.f;
#pragma unroll
    for (int e = 0; e < 4; ++e) {
      float y0 = __uint_as_float(a[e] << 16);
      float y1 = __uint_as_float(a[e] & 0xffff0000u);
      y[2 * e] = y0; y[2 * e + 1] = y1; ss += y0 * y0 + y1 * y1;
    }
    ss += __shfl_xor(ss, 1); ss += __shfl_xor(ss, 2); ss += __shfl_xor(ss, 4); ss += __shfl_xor(ss, 8);
    float rs = rsqrtf(ss * (1.f / 128.f) + 1e-6f);
    u32x4 w;
#pragma unroll
    for (int e = 0; e < 4; ++e) {
      float o0 = sigmoidf_(__uint_as_float(o[e] << 16)), o1 = sigmoidf_(__uint_as_float(o[e] & 0xffff0000u));
      w[e] = pack2(y[2 * e] * rs * ng[c0 + 2 * e] * o0, y[2 * e + 1] * rs * ng[c0 + 2 * e + 1] * o1);
    }
    *(u32x4*)(p.br + (size_t)row * 1536 + 1024 + c0) = w;
  }
}

__device__ __forceinline__ void phase_uvconv(const Params& p, int layer) {
  const size_t n4 = (size_t)16384 * 1024 / 4;
  const f32x4* su = (const f32x4*)(p.peer_u + (size_t)layer * 16384 * 1024);
  const f32x4* sv = (const f32x4*)(p.peer_v + (size_t)layer * 16384 * 1024);
  u32x2* du = (u32x2*)p.uv; u32x2* dv = (u32x2*)(p.uv + (size_t)16384 * 1024);
  for (size_t i = (size_t)bidx() * NTHR + tidx(); i < n4; i += (size_t)gridDim.x * NTHR) {
    f32x4 a = su[i], b = sv[i];
    u32x2 w; w.x = pack2(a[0], a[1]); w.y = pack2(a[2], a[3]); du[i] = w;
    u32x2 w2; w2.x = pack2(b[0], b[1]); w2.y = pack2(b[2], b[3]); dv[i] = w2;
  }
}

__device__ __forceinline__ void phase_topk(const Params& p, int layer, int nrows) {
#if DIAG_HP
  float* sks = (float*)smem;
  float* qs = (float*)(smem + 2 * 128 * 129 * 4);
#else
  bf16_t* sks = (bf16_t*)smem;
  float* qs = (float*)(smem + 2 * 128 * 130 * 2);
#endif
  const int tid = tidx(), lane = tid & 63, wv = tid >> 6;
  const int nchunks = nrows / 64;
  int cur_h = -1;
  for (int item = bidx(); item < nchunks * 8; item += gridDim.x) {
    int h = item % 8, chunk = item / 8;
    if (h != cur_h) {
      __syncthreads();
#if DIAG_HP
      const float* src = p.peer_subkeys + ((size_t)layer * 8 + h) * 2 * 128 * 128;
      for (int i = tid; i < 2 * 128 * 128; i += NTHR) { int pk = i >> 7, d = i & 127; sks[pk * 129 + d] = src[i]; }
#else
      const bf16_t* src = p.sk + ((size_t)layer * 8 + h) * 2 * 128 * 128;
      for (int i = tid; i < 2 * 128 * 128; i += NTHR) { int pk = i >> 7, d = i & 127; sks[pk * 130 + d] = src[i]; }
#endif
      __syncthreads();
      cur_h = h;
    }
    float* myq = qs + wv * 256;
    for (int ti = 0; ti < 16; ++ti) {
      int row = chunk * 64 + wv * 16 + ti;
#if DIAG_HP
      const float* qp = p.qf + (size_t)row * 2048 + h * 256;
      myq[lane] = qp[lane]; myq[lane + 64] = qp[lane + 64]; myq[lane + 128] = qp[lane + 128]; myq[lane + 192] = qp[lane + 192];
#else
      const bf16_t* qp = p.q + (size_t)row * 2048 + h * 256;
      myq[lane] = bf2f(qp[lane]); myq[lane + 64] = bf2f(qp[lane + 64]); myq[lane + 128] = bf2f(qp[lane + 128]); myq[lane + 192] = bf2f(qp[lane + 192]);
#endif
      __builtin_amdgcn_wave_barrier();
      float s1v = 0.f, s2v = 0.f; int i1v = 0, i2v = 0;
      for (int pp = 0; pp < 2; ++pp) {
        const float* qq = myq + pp * 128;
        float a0 = 0.f, a1 = 0.f;
#if DIAG_HP
        const float* k0 = sks + (pp * 128 + lane) * 129;
        const float* k1 = sks + (pp * 128 + lane + 64) * 129;
#pragma unroll 8
        for (int d = 0; d < 128; ++d) { a0 += qq[d] * k0[d]; a1 += qq[d] * k1[d]; }
#else
        const bf16_t* k0 = sks + (pp * 128 + lane) * 130;
        const bf16_t* k1 = sks + (pp * 128 + lane + 64) * 130;
#pragma unroll 8
        for (int d = 0; d < 128; d += 2) {
          unsigned w0 = *(const unsigned*)(k0 + d), w1 = *(const unsigned*)(k1 + d);
          float q0 = qq[d], q1 = qq[d + 1];
          a0 += q0 * __uint_as_float(w0 << 16) + q1 * __uint_as_float(w0 & 0xffff0000u);
          a1 += q0 * __uint_as_float(w1 << 16) + q1 * __uint_as_float(w1 & 0xffff0000u);
        }
#endif
        float sv = 0.f; int iv = 0;
        for (int r = 0; r < 16; ++r) {
          float mx = wave_max(fmaxf(a0, a1));
          unsigned long long bal = __ballot(a0 == mx || a1 == mx);
          int wl = __ffsll((long long)bal) - 1;
          int key = 0;
          if (lane == wl) { if (a0 == mx) { key = lane; a0 = -3e38f; } else { key = lane + 64; a1 = -3e38f; } }
          key = __shfl(key, wl);
          if (lane == r) { sv = mx; iv = key; }
        }
        if (pp == 0) { s1v = sv; i1v = iv; } else { s2v = sv; i2v = iv; }
      }
      float cs[4]; int ci[4];
      float s1i = __shfl(s1v, lane >> 2); int i1i = __shfl(i1v, lane >> 2);
#pragma unroll
      for (int r = 0; r < 4; ++r) {
        int j = (lane & 3) * 4 + r;
        float s2j = __shfl(s2v, j); int i2j = __shfl(i2v, j);
        cs[r] = s1i + s2j; ci[r] = i1i * 128 + i2j;
      }
      float selv = 0.f; int seli = 0;
      for (int r = 0; r < 16; ++r) {
        float lm = fmaxf(fmaxf(cs[0], cs[1]), fmaxf(cs[2], cs[3]));
        float mx = wave_max(lm);
        unsigned long long bal = __ballot(lm == mx);
        int wl = __ffsll((long long)bal) - 1;
        int id = 0;
        if (lane == wl) {
          if (cs[0] == mx) { id = ci[0]; cs[0] = -3e38f; }
          else if (cs[1] == mx) { id = ci[1]; cs[1] = -3e38f; }
          else if (cs[2] == mx) { id = ci[2]; cs[2] = -3e38f; }
          else { id = ci[3]; cs[3] = -3e38f; }
        }
        id = __shfl(id, wl);
        if (lane == r) { selv = mx; seli = id; }
      }
      float top = __shfl(selv, 0);
      float e = lane < 16 ? __expf(selv - top) : 0.f;
      float sum = wave_sum(e);
      if (lane < 16) {
        p.idx[(size_t)row * 128 + h * 16 + lane] = seli;
        p.gw[(size_t)row * 128 + h * 16 + lane] = e / sum;
      }
      __builtin_amdgcn_wave_barrier();
    }
  }
}

__device__ __forceinline__ void phase_uvconv8(const Params& p, int layer) {
  const int lane = tidx() & 63, wv = tidx() >> 6;
  for (int row = bidx() * 4 + wv; row < 32768; row += gridDim.x * 4) {
    const float* src = (row < 16384 ? p.peer_u + ((size_t)layer * 16384 + row) * 1024 : p.peer_v + ((size_t)layer * 16384 + (row - 16384)) * 1024) + lane * 16;
    f32x4 a[4]; float amax = 0.f;
#pragma unroll
    for (int i = 0; i < 4; ++i) {
      a[i] = *(const f32x4*)(src + 4 * i);
#pragma unroll
      for (int e = 0; e < 4; ++e) amax = fmaxf(amax, fabsf(a[i][e]));
    }
    amax = wave_max(amax);
    const float scale = amax > 0.f ? amax * (1.f / 127.f) : 1.f;
    const float inv = 1.f / scale;
    u32x4 w;
#pragma unroll
    for (int i = 0; i < 4; ++i) {
      unsigned q = 0;
#pragma unroll
      for (int e = 0; e < 4; ++e) {
        int v = (int)rintf(a[i][e] * inv) + 128;
        v = v < 1 ? 1 : (v > 255 ? 255 : v);
        q |= (unsigned)v << (8 * e);
      }
      w[i] = q;
    }
    *(u32x4*)(p.uvq + (size_t)row * 1024 + lane * 16) = w;
    if (lane == 0) p.uvs[row] = scale;
  }
}


__device__ __forceinline__ void phase_gather8(const Params& p, int layer, int nrows, float oscale, int fuse_norm) {
  const int lane = tidx() & 63, wv = tidx() >> 6;
  const unsigned char* U8 = p.uvq; const unsigned char* V8 = p.uvq + (size_t)16384 * 1024;
  const float* US = p.uvs; const float* VS = p.uvs + 16384;
  const int klane = ((lane >> 5) & 1) * 4 + ((lane >> 4) & 1) * 2 + ((lane >> 3) & 1);
  for (int row = bidx() * 4 + wv; row < nrows; row += gridDim.x * 4) {
    float xv[16], acc[16];
    {
      u32x4 a = *(const u32x4*)(p.h + (size_t)row * DM + lane * 16), b = *(const u32x4*)(p.h + (size_t)row * DM + lane * 16 + 8);
#pragma unroll
      for (int e = 0; e < 4; ++e) {
        xv[2 * e] = __uint_as_float(a[e] << 16); xv[2 * e + 1] = __uint_as_float(a[e] & 0xffff0000u);
        xv[8 + 2 * e] = __uint_as_float(b[e] << 16); xv[8 + 2 * e + 1] = __uint_as_float(b[e] & 0xffff0000u);
      }
    }
    float xs = 0.f;
#pragma unroll
    for (int i = 0; i < 16; ++i) { acc[i] = 0.f; xs += xv[i]; }
    xs = wave_sum(xs) * 128.f;
    const int myidx0 = p.idx[(size_t)row * 128 + lane], myidx1 = p.idx[(size_t)row * 128 + 64 + lane];
    const float myg0 = p.gw[(size_t)row * 128 + lane], myg1 = p.gw[(size_t)row * 128 + 64 + lane];
    float wsum = 0.f;
    for (int k0 = 0; k0 < 128; k0 += 8) {
      const int srcv = k0 < 64 ? myidx0 : myidx1;
      const float srcg = k0 < 64 ? myg0 : myg1;
      const int kb = k0 & 63;
      u32x4 uq[8], vq[8];
#pragma unroll
      for (int j = 0; j < 8; ++j) {
        const int e_ = __builtin_amdgcn_readlane(srcv, kb + j);
        uq[j] = *(const u32x4*)(U8 + (size_t)e_ * 1024 + lane * 16);
        vq[j] = *(const u32x4*)(V8 + (size_t)e_ * 1024 + lane * 16);
      }
      const int el = __shfl(srcv, kb + klane);
      const float gl = __shfl(srcg, kb + klane);
      const float sul = US[el], svl = VS[el];
      float d[8];
#pragma unroll
      for (int j = 0; j < 8; ++j) {
        float s = 0.f;
#pragma unroll
        for (int c = 0; c < 4; ++c) {
          s += xv[4 * c] * ub0(uq[j][c]) + xv[4 * c + 1] * ub1(uq[j][c]) + xv[4 * c + 2] * ub2(uq[j][c]) + xv[4 * c + 3] * ub3(uq[j][c]);
        }
        d[j] = s;
      }
      float r4[4], r2[2], t;
      const bool b5 = lane & 32, b4 = lane & 16, b3 = lane & 8;
#pragma unroll
      for (int j = 0; j < 4; ++j) { float keep = b5 ? d[j + 4] : d[j], send = b5 ? d[j] : d[j + 4]; r4[j] = keep + __shfl_xor(send, 32); }
#pragma unroll
      for (int j = 0; j < 2; ++j) { float keep = b4 ? r4[j + 2] : r4[j], send = b4 ? r4[j] : r4[j + 2]; r2[j] = keep + __shfl_xor(send, 16); }
      { float keep = b3 ? r2[1] : r2[0], send = b3 ? r2[0] : r2[1]; t = keep + __shfl_xor(send, 8); }
      t += __shfl_xor(t, 4); t += __shfl_xor(t, 2); t += __shfl_xor(t, 1);
      const float dot = sul * (t - xs);
      const float wl = PEER_ALPHA * oscale * gl * gelu_tanh(dot) * svl;
#pragma unroll
      for (int j = 0; j < 8; ++j) {
        const float w = __int_as_float(__builtin_amdgcn_readlane(__float_as_int(wl), ((j >> 2) & 1) * 32 + ((j >> 1) & 1) * 16 + (j & 1) * 8));
        wsum += w;
#pragma unroll
        for (int c = 0; c < 4; ++c) {
          acc[4 * c] += w * ub0(vq[j][c]); acc[4 * c + 1] += w * ub1(vq[j][c]); acc[4 * c + 2] += w * ub2(vq[j][c]); acc[4 * c + 3] += w * ub3(vq[j][c]);
        }
      }
    }
    const float off = 128.f * wsum;
    float* xr = xrow(p, row) + lane * 16;
    const float* g2 = p.mod + (size_t)(layer * 3 + modrow(row)) * 6144 + 5 * DM + lane * 16;
    f32x4 xn[4]; float ss = 0.f;
#pragma unroll
    for (int c = 0; c < 4; ++c) {
      f32x4 x0 = *(const f32x4*)(xr + 4 * c), ga = *(const f32x4*)(g2 + 4 * c);
#pragma unroll
      for (int e = 0; e < 4; ++e) { x0[e] += ga[e] * (acc[4 * c + e] - off); ss += x0[e] * x0[e]; }
      *(f32x4*)(xr + 4 * c) = x0;
      xn[c] = x0;
    }
    if (fuse_norm) {
      ss = wave_sum(ss);
      const float rs = rsqrtf(ss * (1.f / DM) + 1e-6f);
      const float* gn = p.norm1_g + (layer + 1) * DM + lane * 16;
      const float* md = p.mod + (size_t)((layer + 1) * 3 + modrow(row)) * 6144 + lane * 16;
      u32x4 w0, w1;
#pragma unroll
      for (int c = 0; c < 4; ++c) {
        f32x4 gg = *(const f32x4*)(gn + 4 * c), sc = *(const f32x4*)(md + DM + 4 * c), sh = *(const f32x4*)(md + 4 * c);
        float o0 = xn[c][0] * rs * gg[0] * (1.f + sc[0]) + sh[0], o1 = xn[c][1] * rs * gg[1] * (1.f + sc[1]) + sh[1];
        float o2 = xn[c][2] * rs * gg[2] * (1.f + sc[2]) + sh[2], o3 = xn[c][3] * rs * gg[3] * (1.f + sc[3]) + sh[3];
        if (c < 2) { w0[2 * c] = pack2(o0, o1); w0[2 * c + 1] = pack2(o2, o3); } else { w1[2 * (c - 2)] = pack2(o0, o1); w1[2 * (c - 2) + 1] = pack2(o2, o3); }
      }
      *(u32x4*)(p.h + (size_t)row * DM + lane * 16) = w0;
      *(u32x4*)(p.h + (size_t)row * DM + lane * 16 + 8) = w1;
    }
  }
}

__device__ __forceinline__ unsigned f2key(float f) { unsigned u = __float_as_uint(f); return (u & 0x80000000u) ? ~u : (u | 0x80000000u); }
__device__ __forceinline__ float key2f(unsigned k) { unsigned u = (k & 0x80000000u) ? (k ^ 0x80000000u) : ~k; return __uint_as_float(u); }
#define INS16(L, vv) { unsigned v_ = (vv); _Pragma("unroll") for (int j_ = 0; j_ < 16; ++j_) { unsigned hi_ = max(L[j_], v_); v_ = min(L[j_], v_); L[j_] = hi_; } }
__device__ __forceinline__ unsigned sel16(const unsigned (&a)[16], unsigned i) {
  unsigned t[8], u[4], v[2];
#pragma unroll
  for (int k = 0; k < 8; ++k) t[k] = (i & 1u) ? a[2 * k + 1] : a[2 * k];
#pragma unroll
  for (int k = 0; k < 4; ++k) u[k] = (i & 2u) ? t[2 * k + 1] : t[2 * k];
#pragma unroll
  for (int k = 0; k < 2; ++k) v[k] = (i & 4u) ? u[2 * k + 1] : u[2 * k];
  return (i & 8u) ? v[1] : v[0];
}

__device__ __forceinline__ void sort16_desc(unsigned (&a)[16]) {
#pragma unroll
  for (int k = 2; k <= 16; k <<= 1)
#pragma unroll
    for (int j = k >> 1; j > 0; j >>= 1)
#pragma unroll
      for (int i = 0; i < 16; ++i) {
        const int l = i ^ j;
        if (l > i) {
          const unsigned hi = max(a[i], a[l]), lo = min(a[i], a[l]);
          if ((i & k) == 0) { a[i] = hi; a[l] = lo; } else { a[i] = lo; a[l] = hi; }
        }
      }
}
__device__ __forceinline__ void merge16_desc(unsigned (&L)[16], const unsigned (&g)[16]) {
#pragma unroll
  for (int i = 0; i < 16; ++i) L[i] = max(L[i], g[15 - i]);
#pragma unroll
  for (int j = 8; j > 0; j >>= 1)
#pragma unroll
    for (int i = 0; i < 16; ++i) {
      const int l = i ^ j;
      if (l > i) { const unsigned hi = max(L[i], L[l]), lo = min(L[i], L[l]); L[i] = hi; L[l] = lo; }
    }
}
__device__ __forceinline__ void phase_topk2(const Params& p, int layer, int nrows) {
  char* SK = smem;
  const int tid = tidx(), wid = tid >> 6, lane = tid & 63, l31 = lane & 31, hh = lane >> 5;
  const int ntiles = nrows / 128;
  int cur_h = -1;
  for (int item = bidx(); item < ntiles * 8; item += gridDim.x) {
    const int h = item & 7, tile = item >> 3;
    if (h != cur_h) {
      __syncthreads();
      const bf16_t* src = p.sk + ((size_t)layer * 8 + h) * 2 * 128 * 128;
#pragma unroll
      for (int i = 0; i < 16; ++i) {
        int id = tid + 256 * i, row = id >> 4, c16 = id & 15;
        *(u32x4*)(SK + row * 272 + c16 * 16) = *(const u32x4*)(src + (size_t)row * 128 + c16 * 8);
      }
      __syncthreads();
      cur_h = h;
    }
    const int row = tile * 128 + wid * 32 + l31;
    f32x16 sc[2][4];
#pragma unroll
    for (int pp = 0; pp < 2; ++pp) {
      bf16x8 qf[8];
#pragma unroll
      for (int ks = 0; ks < 8; ++ks) qf[ks] = *(const bf16x8*)(p.q + (size_t)row * 2048 + h * 256 + pp * 128 + ks * 16 + hh * 8);
#pragma unroll
      for (int kb = 0; kb < 4; ++kb) {
#pragma unroll
        for (int r = 0; r < 16; ++r) sc[pp][kb][r] = 0.f;
#pragma unroll
        for (int ks = 0; ks < 8; ++ks) {
          bf16x8 a = *(const bf16x8*)(SK + (pp * 128 + kb * 32 + l31) * 272 + (ks * 16 + hh * 8) * 2);
          sc[pp][kb] = __builtin_amdgcn_mfma_f32_32x32x16_bf16(a, qf[ks], sc[pp][kb], 0, 0, 0);
        }
      }
    }
    unsigned L1[16];
#pragma unroll
    for (int j = 0; j < 16; ++j) L1[j] = 0u;
#pragma unroll
    for (int kb = 0; kb < 4; ++kb)
#pragma unroll
      for (int rh = 0; rh < 2; ++rh) {
        unsigned g[16];
#pragma unroll
        for (int rr = 0; rr < 8; ++rr) {
          const int r = rh * 8 + rr;
          auto sw = __builtin_amdgcn_permlane32_swap(__float_as_uint(sc[0][kb][r]), __float_as_uint(sc[1][kb][r]), false, false);
          const unsigned kidx = kb * 32 + (r & 3) + 8 * (r >> 2);
          g[2 * rr] = (f2key(__uint_as_float(sw[0])) & ~127u) | kidx;
          g[2 * rr + 1] = (f2key(__uint_as_float(sw[1])) & ~127u) | (kidx + 4);
        }
        sort16_desc(g);
        merge16_desc(L1, g);
      }
    float As[16], Bs[16]; unsigned Ai[16], Bi[16];
#pragma unroll
    for (int j = 0; j < 16; ++j) {
      auto sw = __builtin_amdgcn_permlane32_swap(L1[j], L1[j], false, false);
      unsigned other = hh ? sw[0] : sw[1];
      unsigned ka = hh ? other : L1[j], kb_ = hh ? L1[j] : other;
      As[j] = key2f(ka & ~127u); Ai[j] = ka & 127u;
      Bs[j] = key2f(kb_ & ~127u); Bi[j] = kb_ & 127u;
    }
    unsigned L2[16];
#pragma unroll
    for (int j = 0; j < 16; ++j) L2[j] = 0u;
    const float smax = As[0] + Bs[0];
#define CKEY(i, j) (((262143u - min((unsigned)((smax - (As[i] + Bs[j])) * 16384.f), 262143u)) << 14) | (Ai[i] * 128u + Bi[j]))
    {
      unsigned g[16];
      g[0] = CKEY(0, 0);
      g[1] = CKEY(0, 1);
      g[2] = CKEY(0, 2);
      g[3] = CKEY(0, 3);
      g[4] = CKEY(0, 4);
      g[5] = CKEY(0, 5);
      g[6] = CKEY(0, 6);
      g[7] = CKEY(0, 7);
      g[8] = CKEY(0, 8);
      g[9] = CKEY(0, 9);
      g[10] = CKEY(0, 10);
      g[11] = CKEY(0, 11);
      g[12] = CKEY(0, 12);
      g[13] = CKEY(0, 13);
      g[14] = CKEY(0, 14);
      g[15] = CKEY(0, 15);
      sort16_desc(g);
      merge16_desc(L2, g);
    }
    {
      unsigned g[16];
      g[0] = CKEY(1, 0);
      g[1] = CKEY(1, 1);
      g[2] = CKEY(1, 2);
      g[3] = CKEY(1, 3);
      g[4] = CKEY(1, 4);
      g[5] = CKEY(1, 5);
      g[6] = CKEY(1, 6);
      g[7] = CKEY(1, 7);
      g[8] = CKEY(2, 0);
      g[9] = CKEY(2, 1);
      g[10] = CKEY(2, 2);
      g[11] = CKEY(2, 3);
      g[12] = CKEY(2, 4);
      g[13] = CKEY(3, 0);
      g[14] = CKEY(3, 1);
      g[15] = CKEY(3, 2);
      sort16_desc(g);
      merge16_desc(L2, g);
    }
    {
      unsigned g[16];
      g[0] = CKEY(3, 3);
      g[1] = CKEY(4, 0);
      g[2] = CKEY(4, 1);
      g[3] = CKEY(4, 2);
      g[4] = CKEY(5, 0);
      g[5] = CKEY(5, 1);
      g[6] = CKEY(6, 0);
      g[7] = CKEY(6, 1);
      g[8] = CKEY(7, 0);
      g[9] = CKEY(7, 1);
      g[10] = CKEY(8, 0);
      g[11] = CKEY(9, 0);
      g[12] = CKEY(10, 0);
      g[13] = CKEY(11, 0);
      g[14] = CKEY(12, 0);
      g[15] = CKEY(13, 0);
      sort16_desc(g);
      merge16_desc(L2, g);
    }
    {
      unsigned g[16];
      g[0] = CKEY(14, 0);
      g[1] = CKEY(15, 0);
      g[2] = 0u;
      g[3] = 0u;
      g[4] = 0u;
      g[5] = 0u;
      g[6] = 0u;
      g[7] = 0u;
      g[8] = 0u;
      g[9] = 0u;
      g[10] = 0u;
      g[11] = 0u;
      g[12] = 0u;
      g[13] = 0u;
      g[14] = 0u;
      g[15] = 0u;
      sort16_desc(g);
      merge16_desc(L2, g);
    }
#undef CKEY
    float ex[16]; unsigned ev[16]; float sum = 0.f;
#pragma unroll
    for (int t = 0; t < 16; ++t) {
      ev[t] = L2[t] & 16383u;
      float d = (float)(262143u - (L2[t] >> 14)) * (1.f / 16384.f);
      ex[t] = __expf(-d); sum += ex[t];
    }
    const float isum = 1.f / sum;
    if (hh == 0) {
      int* ip = p.idx + (size_t)row * 128 + h * 16;
      float* gp = p.gw + (size_t)row * 128 + h * 16;
#pragma unroll
      for (int t4 = 0; t4 < 4; ++t4) {
        u32x4 e0 = {ev[4 * t4], ev[4 * t4 + 1], ev[4 * t4 + 2], ev[4 * t4 + 3]};
        f32x4 g0 = {ex[4 * t4] * isum, ex[4 * t4 + 1] * isum, ex[4 * t4 + 2] * isum, ex[4 * t4 + 3] * isum};
        *(u32x4*)(ip + 4 * t4) = e0;
        *(f32x4*)(gp + 4 * t4) = g0;
      }
    }
  }
}

__device__ __forceinline__ void phase_gather(const Params& p, int layer, int nrows, float oscale) {
  const int lane = tidx() & 63, wv = tidx() >> 6;
  const bf16_t* U = p.uv; const bf16_t* V = p.uv + (size_t)16384 * 1024;
  for (int row = bidx() * 4 + wv; row < nrows; row += gridDim.x * 4) {
    float xv[16], acc[16];
    {
      u32x4 a = *(const u32x4*)(p.h + (size_t)row * DM + lane * 8), b = *(const u32x4*)(p.h + (size_t)row * DM + 512 + lane * 8);
#pragma unroll
      for (int e = 0; e < 4; ++e) {
        xv[2 * e] = __uint_as_float(a[e] << 16); xv[2 * e + 1] = __uint_as_float(a[e] & 0xffff0000u);
        xv[8 + 2 * e] = __uint_as_float(b[e] << 16); xv[8 + 2 * e + 1] = __uint_as_float(b[e] & 0xffff0000u);
      }
    }
#pragma unroll
    for (int i = 0; i < 16; ++i) acc[i] = 0.f;
    int myidx0 = p.idx[(size_t)row * 128 + lane], myidx1 = p.idx[(size_t)row * 128 + 64 + lane];
    float myg0 = p.gw[(size_t)row * 128 + lane], myg1 = p.gw[(size_t)row * 128 + 64 + lane];
    for (int k = 0; k < 128; ++k) {
      int e_ = k < 64 ? __shfl(myidx0, k) : __shfl(myidx1, k - 64);
      float g_ = k < 64 ? __shfl(myg0, k) : __shfl(myg1, k - 64);
      e_ = __builtin_amdgcn_readfirstlane(e_);
#if DIAG_HP
      const float* ur = p.peer_u + ((size_t)layer * 16384 + e_) * DM; const float* vr = p.peer_v + ((size_t)layer * 16384 + e_) * DM;
      f32x4 u0 = *(const f32x4*)(ur + lane * 8), u1 = *(const f32x4*)(ur + lane * 8 + 4), u2 = *(const f32x4*)(ur + 512 + lane * 8), u3 = *(const f32x4*)(ur + 512 + lane * 8 + 4);
      f32x4 v0 = *(const f32x4*)(vr + lane * 8), v1 = *(const f32x4*)(vr + lane * 8 + 4), v2 = *(const f32x4*)(vr + 512 + lane * 8), v3 = *(const f32x4*)(vr + 512 + lane * 8 + 4);
      float dot = 0.f;
#pragma unroll
      for (int e = 0; e < 4; ++e) dot += xv[e] * u0[e] + xv[4 + e] * u1[e] + xv[8 + e] * u2[e] + xv[12 + e] * u3[e];
      dot = wave_sum(dot);
      float w = g_ * gelu_tanh(dot);
#pragma unroll
      for (int e = 0; e < 4; ++e) { acc[e] += w * v0[e]; acc[4 + e] += w * v1[e]; acc[8 + e] += w * v2[e]; acc[12 + e] += w * v3[e]; }
#else
      const bf16_t* ur = U + (size_t)e_ * DM; const bf16_t* vr = V + (size_t)e_ * DM;
      u32x4 ua = *(const u32x4*)(ur + lane * 8), ub = *(const u32x4*)(ur + 512 + lane * 8);
      u32x4 va = *(const u32x4*)(vr + lane * 8), vb = *(const u32x4*)(vr + 512 + lane * 8);
      float dot = 0.f;
#pragma unroll
      for (int e = 0; e < 4; ++e) {
        dot += xv[2 * e] * __uint_as_float(ua[e] << 16) + xv[2 * e + 1] * __uint_as_float(ua[e] & 0xffff0000u);
        dot += xv[8 + 2 * e] * __uint_as_float(ub[e] << 16) + xv[8 + 2 * e + 1] * __uint_as_float(ub[e] & 0xffff0000u);
      }
      dot = wave_sum(dot);
      float w = PEER_ALPHA * oscale * g_ * gelu_tanh(dot);
#pragma unroll
      for (int e = 0; e < 4; ++e) {
        acc[2 * e] += w * __uint_as_float(va[e] << 16); acc[2 * e + 1] += w * __uint_as_float(va[e] & 0xffff0000u);
        acc[8 + 2 * e] += w * __uint_as_float(vb[e] << 16); acc[8 + 2 * e + 1] += w * __uint_as_float(vb[e] & 0xffff0000u);
      }
#endif
    }
    float* xr = xrow(p, row);
    const float* g2 = p.mod + (size_t)(layer * 3 + modrow(row)) * 6144 + 5 * DM;
#pragma unroll
    for (int hh = 0; hh < 2; ++hh) {
      int c0 = hh * 512 + lane * 8;
      f32x4 x0 = *(const f32x4*)(xr + c0), x1 = *(const f32x4*)(xr + c0 + 4);
      f32x4 ga = *(const f32x4*)(g2 + c0), gb = *(const f32x4*)(g2 + c0 + 4);
#pragma unroll
      for (int e = 0; e < 4; ++e) { x0[e] += ga[e] * acc[hh * 8 + e]; x1[e] += gb[e] * acc[hh * 8 + 4 + e]; }
      *(f32x4*)(xr + c0) = x0; *(f32x4*)(xr + c0 + 4) = x1;
    }
  }
}


__device__ __forceinline__ void phase_mix1(const Params& p, int layer, int with_ctx_queries) {
  const bool fast = attn_logit_bound(p, layer) <= 40.f;
  const int natt = fast ? 512 + (with_ctx_queries ? 16 : 0) : 1024 + (with_ctx_queries ? 32 : 0);
  const int G = gridDim.x, b_ = bidx();
  for (int item = b_; item < natt; item += G) { for (int r = 0; r < REP_ATT; ++r) { if (fast) attn_item64(p, layer, item); else attn_item(p, layer, item); } }
  int b1 = b_ - natt % G; if (b1 < 0) b1 += G;
  for (int it = b1; it < 528; it += G) { for (int r = 0; r < REP_MLA; ++r) mlA_item(p, layer, it); }
  const int nextra = 528 % G;
  const int first = (nextra * 2 < G) ? nextra : 0, span = G - first;
  if (b1 >= first)
    for (int it = b1 - first; it < 1056; it += span) { for (int r = 0; r < REP_SSDA; ++r) ssdA_item(p, layer, it); }
}
__device__ __forceinline__ void phase_mix3(const Params& p, int layer, int last) {
  const int nc = last ? 64 : 66, G = gridDim.x, b_ = bidx();
  const int nml = 2 * nc * 4, nssd = 2 * nc * 8;
  for (int it = b_; it < nml; it += G) {
    const int b = it / (nc * 4), c = (it / 4) % nc, h = it & 3;
    for (int r = 0; r < REP_MLC; ++r) mlC_item(p, layer, (b * 66 + c) * 4 + h);
  }
  const int nextra = nml % G;
  const int first = (nextra * 2 < G) ? nextra : 0, span = G - first;
  if (b_ >= first)
    for (int it = b_ - first; it < nssd; it += span) {
      const int b = it / (nc * 8), c = (it / 8) % nc, h = it & 7;
      for (int r = 0; r < REP_SSDC; ++r) ssdC_item(p, layer, (b * 66 + c) * 8 + h);
    }
}


#define XB_TMO      128
#define XB_XCNT(j)  (256  + 64 * (j))
#define XB_XSUB(j)  (1280 + 64 * (j))
#define XB_XGEN(j)  (2304 + 64 * (j))
#define XB_TOP      3328
#define XB_TOPGEN   3392
#define XCD_BAR_WORDS 3456
#define XB_SPIN_CAP (1u << 18)
#define LAS __attribute__((address_space(3)))
__device__ __forceinline__ unsigned xb_ld(unsigned* p)              { return __hip_atomic_load(p, __ATOMIC_RELAXED, __HIP_MEMORY_SCOPE_AGENT); }
__device__ __forceinline__ unsigned xb_add(unsigned* p, unsigned v) { return __hip_atomic_fetch_add(p, v, __ATOMIC_RELAXED, __HIP_MEMORY_SCOPE_AGENT); }
__device__ __forceinline__ unsigned xb_xcc_id() { return (unsigned)__builtin_amdgcn_s_getreg((3 << 11) | 20) & 0xFu; }
#define XB_SPIN(cond, bar) do { unsigned _sp = 0; while (cond) { __builtin_amdgcn_s_sleep(1); \
    if ((++_sp & 255u) == 0u) { if (xb_ld(&(bar)[XB_TMO])) break; if (_sp > XB_SPIN_CAP) { atomicAdd(&(bar)[XB_TMO], 1u); break; } } } } while (0)
struct XcdBarrier { unsigned* bar; unsigned x; volatile LAS unsigned* st; };
__device__ __forceinline__ XcdBarrier xcd_barrier_post(unsigned* bar, volatile LAS unsigned* st) {
    XcdBarrier b; b.bar = bar; b.x = xb_xcc_id(); b.st = st;
    if (threadIdx.x == 0) (void)xb_add(&bar[XB_XCNT(b.x)], 1u);
    return b;
}
__device__ __forceinline__ void xcd_barrier_complete(unsigned* bar, unsigned x, unsigned& nloc, unsigned& nx) {
    const unsigned G = gridDim.x * gridDim.y * gridDim.z;
    unsigned sum, cnt, mine, sp = 0u;
    for (;;) {
        sum = 0u; cnt = 0u; mine = 0u;
#pragma unroll
        for (unsigned j = 0; j < 16; ++j) { const unsigned c = xb_ld(&bar[XB_XCNT(j)]); sum += c; cnt += (c > 0u) ? 1u : 0u; mine = (j == x) ? c : mine; }
        if (sum == G) break;
        __builtin_amdgcn_s_sleep(1);
        if ((++sp & 255u) == 0u) { if (xb_ld(&bar[XB_TMO])) break; if (sp > XB_SPIN_CAP) { atomicAdd(&bar[XB_TMO], 1u); break; } }
    }
    nloc = mine > 0u ? mine : 1u; nx = cnt > 0u ? cnt : 1u;
}
__device__ __forceinline__ void xcd_barrier(const XcdBarrier& b) {
    asm volatile("s_waitcnt vmcnt(0)" ::: "memory");
    __syncthreads();
    if (threadIdx.x == 0) {
        unsigned* bar = b.bar;
        __builtin_amdgcn_s_waitcnt(0);
        unsigned nloc = b.st[0], nx = b.st[1];
        if (nloc == 0u) { xcd_barrier_complete(bar, b.x, nloc, nx); b.st[0] = nloc; b.st[1] = nx; }
        const unsigned old = xb_add(&bar[XB_XSUB(b.x)], 1u);
        const unsigned gen = old / nloc;
        if (old + 1u == (gen + 1u) * nloc) {
            __builtin_amdgcn_fence(__ATOMIC_RELEASE, "agent");
            asm volatile("s_waitcnt vmcnt(0)" ::: "memory");
            const unsigned og = xb_add(&bar[XB_TOP], 1u);
            const unsigned tg = og / nx;
            if (og + 1u == (tg + 1u) * nx) xb_add(&bar[XB_TOPGEN], 1u);
            else XB_SPIN(xb_ld(&bar[XB_TOPGEN]) == tg, bar);
            __builtin_amdgcn_fence(__ATOMIC_ACQUIRE, "agent");
            xb_add(&bar[XB_XGEN(b.x)], 1u);
            asm volatile("s_waitcnt vmcnt(0)" ::: "memory");
        } else {
            XB_SPIN(xb_ld(&bar[XB_XGEN(b.x)]) == gen, bar);
            __builtin_amdgcn_fence(__ATOMIC_ACQUIRE, "agent");
            asm volatile("s_waitcnt vmcnt(0)" ::: "memory");
        }
    }
    __syncthreads();
}

#ifndef REP_GEMM
#define REP_GEMM 1
#endif

#ifndef REP_MIX
#define REP_MIX 1
#endif
#ifndef REP_PEER
#define REP_PEER 1
#endif
#ifndef REP_ELEM
#define REP_ELEM 1
#endif
#ifndef REP_SYNC
#define REP_SYNC 1
#endif
#ifndef REP_TOPK
#define REP_TOPK 1
#endif
#define GSYNC() do { for (int r_ = 0; r_ < REP_SYNC; ++r_) xcd_barrier(xb); } while (0)
__global__ void __launch_bounds__(256, 2) k_mega(Params p) {
  cg::grid_group grid = cg::this_grid();
  volatile LAS unsigned* xst = (volatile LAS unsigned*)(smem + LDS_BYTES - 16);
  if (threadIdx.x == 0) { xst[0] = 0u; xst[1] = 0u; }
  __syncthreads();
  XcdBarrier xb = xcd_barrier_post(p.bar, xst);
  for (int r = 0; r < REP_INIT; ++r) phase_init(p);
  if (p.bar == nullptr) grid.sync();
  GSYNC();
  for (int layer = 0; layer < 2; ++layer) {
    const int last = layer == 1;
    const int nrows2 = last ? NLAT : MROWS;
    if (layer == 0 || DIAG_HP) { for (int r = 0; r < REP_NORM; ++r) phase_norm(p, layer, 1, MROWS, layer == 0); GSYNC(); }
    for (int r = 0; r < REP_GEMM * REP_G_IN; ++r) phase_inproj(p, layer, MROWS, DIAG_HP ? 0 : 2);
    GSYNC();
    for (int r = 0; r < REP_SPREP; ++r) { phase_ssdprep(p, layer); phase_vtrans(p); }
    GSYNC();
    for (int r = 0; r < REP_MIX; ++r) phase_mix1(p, layer, !last);
    GSYNC();
    phase_ssdcarry(p); phase_mlcarry(p); GSYNC();
    for (int r = 0; r < REP_MIX; ++r) phase_mix3(p, layer, last);
    GSYNC();
    for (int r = 0; r < REP_SOUT; ++r) { phase_ssdout(p, layer, nrows2); phase_mlout(p, layer, nrows2); }
    GSYNC();
#if DIAG_HP
    for (int r = 0; r < REP_GEMM * REP_G_GATE; ++r) phase_inproj(p, layer, nrows2, 1);
    GSYNC();
#endif
    for (int r = 0; r < REP_GEMM * REP_G_MERGE; ++r) phase_merge(p, layer, nrows2);
    GSYNC();
    for (int r = 0; r < REP_GEMM * REP_G_OUT; ++r) phase_outproj(p, layer, nrows2, r == 0 ? 1.f : 0.f, (layer == 0 && r == 0) ? 1 : 0);
    GSYNC();
    for (int r = 0; r < REP_NORM; ++r) phase_norm(p, layer, 2, nrows2, 0);
    GSYNC();
    for (int r = 0; r < REP_GEMM * REP_G_WQ; ++r) phase_wq(p, layer, nrows2);
#if !DIAG_HP
    for (int r = 0; r < REP_UVC; ++r) phase_uvconv8(p, layer);
#endif
    GSYNC();
    for (int r = 0; r < REP_TOPK; ++r) { if (DIAG_HP) phase_topk(p, layer, nrows2); else phase_topk2(p, layer, nrows2); }
    GSYNC();
    for (int r = 0; r < REP_PEER; ++r) { if (DIAG_HP) phase_gather(p, layer, nrows2, r == 0 ? 1.f : 0.f); else phase_gather8(p, layer, nrows2, r == 0 ? 1.f : 0.f, (!last && r == REP_PEER - 1) ? 1 : 0); }
    if (!last) GSYNC();
  }
}

extern "C" void kernel_launch(void* const* d_in, const int* in_sizes, int n_in, void* d_out, int out_size, void* d_ws, size_t ws_size,
                              hipStream_t stream) {
  Params p{};
  const float* const* in = (const float* const*)d_in;
  p.x = in[0]; p.c = in[1]; p.ctx = in[2]; p.c_ctx = in[3]; p.norm1_g = in[4]; p.norm2_g = in[5]; p.w_mod = in[6]; p.b_mod = in[7];
  p.w_in = in[8]; p.att_qnorm = in[9]; p.att_knorm = in[10]; p.ssd_conv_w = in[11]; p.ssd_conv_b = in[12]; p.ssd_dt_bias = in[13];
  p.ssd_a_log = in[14]; p.ssd_d = in[15]; p.ssd_norm = in[16]; p.ml_gate_bias = in[17]; p.ml_norm = in[18]; p.w_branch = in[19];
  p.w_out = in[20]; p.peer_wq = in[21]; p.peer_subkeys = in[22]; p.peer_u = in[23]; p.peer_v = in[24];
  p.out = (float*)d_out;
  char* w = (char*)d_ws; size_t off = 65536;
  p.bar = (unsigned*)d_ws;
  auto take = [&](size_t bytes) { char* r = w + off; off += (bytes + 255) & ~(size_t)255; return r; };
  p.mod = (float*)take((size_t)2 * 3 * 6144 * 4);
  p.xc = (float*)take((size_t)NCTX * DM * 4);
  p.small = (float*)take((size_t)MROWS * 32 * 4);
  p.dtb = (float*)take((size_t)MROWS * 16 * 4);
  p.wt_in = (bf16_t*)take((size_t)2 * INCP * DM * 2);
  p.wt_br = (bf16_t*)take((size_t)2 * 3 * DM * 512 * 2);
  p.wt_out = (bf16_t*)take((size_t)2 * DM * DM * 2);
  p.wt_q = (bf16_t*)take((size_t)2 * 2048 * DM * 2);
  p.sk = (bf16_t*)take((size_t)2 * 8 * 2 * 128 * 128 * 2);
  p.wt_q_lo = (bf16_t*)take(DIAG_HP ? (size_t)2 * 2048 * DM * 2 : 256);
  p.vt = (bf16_t*)take((size_t)4 * 64 * 8448 * 2);
  p.ropec = (float*)take((size_t)8192 * 32 * 4);
  p.ropes = (float*)take((size_t)8192 * 32 * 4);
  p.ssl = (bf16_t*)take((size_t)32 * 66 * 4096 * 2);
  p.sdec = (float*)take((size_t)32 * 66 * 4);
  p.mcl = (bf16_t*)take((size_t)16 * 66 * 16384 * 2);
  p.mnl = (float*)take((size_t)16 * 66 * 128 * 4);
  p.mml = (float*)take((size_t)16 * 66 * 4);
  p.mbl = (float*)take((size_t)16 * 66 * 4);
  p.mmp = (float*)take((size_t)16 * 66 * 4);
  p.h = (bf16_t*)take((size_t)MROWS * DM * 2);
  p.br = (bf16_t*)take((size_t)MROWS * 1536 * 2);
  p.xbc = (bf16_t*)take((size_t)MROWS * 768 * 2);
  p.idx = (int*)p.xbc; p.gw = (float*)((char*)p.xbc + (size_t)MROWS * 128 * 4);
  p.yf = (bf16_t*)take((size_t)MROWS * 512 * 2);
  p.yb = (bf16_t*)take((size_t)MROWS * 512 * 2);
  p.hf = (bf16_t*)take((size_t)MROWS * 512 * 2);
  p.hb = p.hf;
  p.gp8 = (unsigned char*)take((size_t)MROWS * 3072);
  p.mix = p.yf;
  p.proj = (bf16_t*)take((size_t)MROWS * 4096 * 2);
  p.uvs = (float*)take((size_t)2 * 16384 * 4);
  p.gp = p.proj; p.q = p.proj; p.qf = (float*)p.proj; p.h2lo = p.br; p.uv = (bf16_t*)((char*)p.proj + (size_t)MROWS * 2048 * 2); p.uvq = (unsigned char*)p.uv;
  if (off > ws_size) return;

  const int LDS = LDS_BYTES;
  static int grid_blocks = 0;
  if (!grid_blocks) {
    (void)hipFuncSetAttribute((const void*)k_mega, hipFuncAttributeMaxDynamicSharedMemorySize, LDS);
    int dev = 0, cus = 0, per_cu = 0;
    (void)hipGetDevice(&dev);
    (void)hipDeviceGetAttribute(&cus, hipDeviceAttributeMultiprocessorCount, dev);
    (void)hipOccupancyMaxActiveBlocksPerMultiprocessor(&per_cu, (const void*)k_mega, 256, LDS);
    if (per_cu < 1) per_cu = 1;
    if (per_cu > 2) per_cu = 2;
    grid_blocks = cus * per_cu;
  }
  (void)hipMemsetAsync(d_ws, 0, XCD_BAR_WORDS * 4, stream);
  void* args[] = {&p};
  hipError_t e = hipLaunchCooperativeKernel((const void*)k_mega, dim3(grid_blocks), dim3(256), args, LDS, stream);
  if (e != hipSuccess) fprintf(stderr, "cooperative launch failed: %s (grid %d)\n", hipGetErrorString(e), grid_blocks);
}
```

```cpp
#include <hip/hip_runtime.h>
#include <hip/hip_cooperative_groups.h>
#include <stdint.h>
#include <stdio.h>
namespace cg = cooperative_groups;

typedef unsigned short bf16_t;
typedef short bf16x8 __attribute__((ext_vector_type(8)));
typedef float f32x4 __attribute__((ext_vector_type(4)));
typedef unsigned u32x4 __attribute__((ext_vector_type(4)));
typedef unsigned u32x2 __attribute__((ext_vector_type(2)));
typedef float f32x16 __attribute__((ext_vector_type(16)));

constexpr int SEQ = 8192, BATCH = 2, CTXL = 256, DM = 1024;
constexpr int NLAT = BATCH * SEQ;
constexpr int NCTX = BATCH * CTXL;
constexpr int MROWS = NLAT + NCTX;
constexpr int INC = 7200, INCP = 7296;
constexpr int NTHR = 256;

#ifndef DIAG_HP
#define DIAG_HP 0
#endif
#define REP_INIT 1
#define REP_NORM 1
#define REP_SPREP 1
#define REP_SOUT 1
#define REP_UVC 1
#define REP_QK 1
#define REP_KCOMP 1
#define REP_KSTG 1
#define REP_G_IN 1
#define REP_G_GATE 1
#define REP_G_MERGE 1
#define REP_G_OUT 1
#define REP_G_WQ 1
#define REP_STG 1
#define REP_EXP 1
#define REP_MLA 1
#define REP_SSDA 1
#define REP_ATT 1
#define REP_MLC 1
#define REP_SSDC 1
#ifndef ATT_ALPHA
#define ATT_ALPHA 1.f
#endif
#ifndef ATT_NAIVE
#define ATT_NAIVE 0
#endif
#ifndef ATT_TAU
#define ATT_TAU 1.f
#endif
#ifndef PEER_ALPHA
#define PEER_ALPHA 1.f
#endif
#define LDS_BYTES (DIAG_HP ? 140 * 1024 : 78 * 1024)
extern __shared__ __attribute__((aligned(16))) char smem[];

struct Params {
  const float *x, *c, *ctx, *c_ctx, *norm1_g, *norm2_g, *w_mod, *b_mod, *w_in, *att_qnorm, *att_knorm,
      *ssd_conv_w, *ssd_conv_b, *ssd_dt_bias, *ssd_a_log, *ssd_d, *ssd_norm, *ml_gate_bias, *ml_norm,
      *w_branch, *w_out, *peer_wq, *peer_subkeys, *peer_u, *peer_v;
  float* out;
  unsigned* bar;
  float* mod;
  float* xc;
  float* small;
  float* dtb;
  bf16_t *wt_in, *wt_br, *wt_out, *wt_q, *sk;
  bf16_t* h;
  bf16_t* br;
  bf16_t* xbc;
  bf16_t *yf, *yb, *hf, *hb;
  bf16_t* mix;
  bf16_t* proj;
  bf16_t* gp;
  unsigned char* gp8;
  bf16_t* q;
  bf16_t* uv;
  unsigned char* uvq;
  float* uvs;
  signed char* xq;
  float* sxq;
  float* wbuf;
  int* idx;
  float* gw;
  bf16_t* h2lo;
  bf16_t* wt_q_lo;
  float* qf;
  bf16_t* vt;
  float* ropec;
  float* ropes;
  bf16_t* ssl;
  float* sdec;
  bf16_t* mcl;
  float* mnl;
  float* mml;
  float* mbl;
  float* mmp;
};

__device__ __forceinline__ int tidx() { int t = __builtin_amdgcn_workitem_id_x(); asm volatile("" : "+v"(t)); return t; }
__device__ __forceinline__ int bidx() { int t = __builtin_amdgcn_workgroup_id_x(); asm volatile("" : "+s"(t)); return t; }
__device__ __forceinline__ float bf2f(bf16_t v) { return __uint_as_float(((unsigned)v) << 16); }
__device__ __forceinline__ bf16_t f2bf(float f) {
  unsigned u = __float_as_uint(f);
  u += 0x7fffu + ((u >> 16) & 1u);
  return (bf16_t)(u >> 16);
}
typedef float f32x2 __attribute__((ext_vector_type(2)));
typedef int i32x4 __attribute__((ext_vector_type(4)));
typedef __bf16 bf16x2n __attribute__((ext_vector_type(2)));
__device__ __forceinline__ unsigned pack2(float a, float b) {
  f32x2 v = {a, b};
  bf16x2n r = __builtin_convertvector(v, bf16x2n);
  return *(unsigned*)&r;
}
__device__ __forceinline__ float sigmoidf_(float x) { return 1.f / (1.f + __expf(-x)); }
__device__ __forceinline__ float siluf_(float x) { return x / (1.f + __expf(-x)); }
__device__ __forceinline__ float softplusf_(float x) { return x > 20.f ? x : log1pf(__expf(x)); }
__device__ __forceinline__ float logsigmoidf_(float x) { return x < 0.f ? x - log1pf(__expf(x)) : -log1pf(__expf(-x)); }
__device__ __forceinline__ float gelu_tanh(float x) {
  float u = 0.7978845608028654f * (x + 0.044715f * x * x * x);
  float t = 1.f - 2.f / (1.f + __expf(2.f * u));
  return 0.5f * x * (1.f + t);
}
__device__ __forceinline__ float ub0(unsigned v) { return (float)(v & 0xffu); }
__device__ __forceinline__ float ub1(unsigned v) { return (float)((v >> 8) & 0xffu); }
__device__ __forceinline__ float ub2(unsigned v) { return (float)((v >> 16) & 0xffu); }
__device__ __forceinline__ float ub3(unsigned v) { return (float)(v >> 24); }
__device__ __forceinline__ float* xrow(const Params& p, int row) {
  return row < NLAT ? p.out + (size_t)row * DM : p.xc + (size_t)(row - NLAT) * DM;
}
__device__ __forceinline__ const float* xrow_src(const Params& p, int row, int from_input) {
  if (from_input) return row < NLAT ? p.x + (size_t)row * DM : p.ctx + (size_t)(row - NLAT) * DM;
  return row < NLAT ? p.out + (size_t)row * DM : p.xc + (size_t)(row - NLAT) * DM;
}
__device__ __forceinline__ int modrow(int row) { return row < NLAT ? row / SEQ : 2; }
__device__ __forceinline__ float wave_sum(float v) {
#pragma unroll
  for (int o = 32; o > 0; o >>= 1) v += __shfl_xor(v, o);
  return v;
}
__device__ __forceinline__ float wave_max(float v) {
#pragma unroll
  for (int o = 32; o > 0; o >>= 1) v = fmaxf(v, __shfl_xor(v, o));
  return v;
}

__device__ __forceinline__ int win_colmap(int n) {
  if (n < 2048) return n;
  if (n < 4096) return n + 16;
  if (n < 7168) return n + 32;
  if (n < 7184) return n - 5120;
  if (n < 7200) return n - 3072;
  return -1;
}

__device__ __forceinline__ void transpose_tile(const float* src, int Nsrc, int K, bf16_t* dst, int n0, int k0, int mode, bf16_t* dstlo = nullptr) {
  float* tile = (float*)smem;
  const int tid = tidx();
  {
    const int n4 = (tid & 15) * 4;
    int sc = n0 + n4;
    if (mode == 1) sc = win_colmap(sc);
#pragma unroll
    for (int i = 0; i < 4; ++i) {
      const int kk = (tid >> 4) + 16 * i;
      f32x4 v = sc >= 0 ? *(const f32x4*)(src + (size_t)(k0 + kk) * Nsrc + sc) : (f32x4){0.f, 0.f, 0.f, 0.f};
      tile[kk * 65 + n4] = v[0]; tile[kk * 65 + n4 + 1] = v[1]; tile[kk * 65 + n4 + 2] = v[2]; tile[kk * 65 + n4 + 3] = v[3];
    }
  }
  __syncthreads();
  {
    const int n = tid >> 2, kc = (tid & 3) * 16;
    float t[16];
#pragma unroll
    for (int e = 0; e < 16; ++e) t[e] = tile[(kc + e) * 65 + n];
    u32x4 w0, w1;
#pragma unroll
    for (int e = 0; e < 4; ++e) { w0[e] = pack2(t[2 * e], t[2 * e + 1]); w1[e] = pack2(t[8 + 2 * e], t[8 + 2 * e + 1]); }
    bf16_t* d = dst + (size_t)(n0 + n) * K + k0 + kc;
    *(u32x4*)d = w0; *(u32x4*)(d + 8) = w1;
    if (dstlo) {
      u32x4 l0, l1;
#pragma unroll
      for (int e = 0; e < 4; ++e) {
        l0[e] = pack2(t[2 * e] - __uint_as_float(w0[e] << 16), t[2 * e + 1] - __uint_as_float(w0[e] & 0xffff0000u));
        l1[e] = pack2(t[8 + 2 * e] - __uint_as_float(w1[e] << 16), t[8 + 2 * e + 1] - __uint_as_float(w1[e] & 0xffff0000u));
      }
      bf16_t* dl = dstlo + (size_t)(n0 + n) * K + k0 + kc;
      *(u32x4*)dl = l0; *(u32x4*)(dl + 8) = l1;
    }
  }
  __syncthreads();
}

__device__ __forceinline__ void phase_init(const Params& p) {
  const int tid = tidx(), bid = bidx(), nb = gridDim.x;
  for (int i = bid * NTHR + tid; i < 8192 * 32; i += nb * NTHR) {
    int pos = i >> 5, jj = i & 31;
    float inv = powf(10000.f, -(float)(jj & 15) / 16.f);
    float ang = (float)(jj < 16 ? (pos >> 6) : (pos & 63)) * inv;
    float sn, cs_; sincosf(ang, &sn, &cs_);
    p.ropec[i] = cs_; p.ropes[i] = sn;
  }
  for (size_t i = (size_t)bid * NTHR + tid; i < (size_t)2 * 8 * 2 * 128 * 128; i += (size_t)nb * NTHR) p.sk[i] = f2bf(p.peer_subkeys[i]);
  {
    const int per_layer = 1824 + 384 + 256 + 512;
    for (int job = bid; job < 2 * per_layer; job += nb) {
      int l = job / per_layer, j = job % per_layer;
      if (j < 1824) {
        int nt = j / 16, kt = j % 16;
        transpose_tile(p.w_in + (size_t)l * DM * INC, INC, DM, p.wt_in + (size_t)l * INCP * DM, nt * 64, kt * 64, 1);
      } else if (j < 1824 + 384) {
        j -= 1824; int r = j / 128; j %= 128; int nt = j / 8, kt = j % 8;
        transpose_tile(p.w_branch + ((size_t)l * 3 + r) * 512 * DM, DM, 512, p.wt_br + ((size_t)l * 3 + r) * DM * 512, nt * 64, kt * 64, 0);
      } else if (j < 1824 + 384 + 256) {
        j -= 1824 + 384; int nt = j / 16, kt = j % 16;
        transpose_tile(p.w_out + (size_t)l * DM * DM, DM, DM, p.wt_out + (size_t)l * DM * DM, nt * 64, kt * 64, 0);
      } else {
        j -= 1824 + 384 + 256; int nt = j / 16, kt = j % 16;
        transpose_tile(p.peer_wq + (size_t)l * DM * 2048, 2048, DM, p.wt_q + (size_t)l * 2048 * DM, nt * 64, kt * 64, 0, DIAG_HP ? p.wt_q_lo + (size_t)l * 2048 * DM : nullptr);
      }
    }
  }
  {
    float* sl = (float*)smem;
    float* part = sl + 3 * DM;
    bool loaded = false;
    for (int blk = bid; blk < 192; blk += nb) {
      if (!loaded) {
        __syncthreads();
        for (int i = tid; i < 3 * DM; i += NTHR) {
          float v = i < 2 * DM ? p.c[i] : p.c_ctx[i - 2 * DM];
          sl[i] = siluf_(v);
        }
        loaded = true;
      }
      __syncthreads();
      const int wv = tid >> 6, ln = tid & 63;
      const int gi = blk * 64 + ln;
      const int l = gi / 6144, col = gi % 6144;
      const float* w = p.w_mod + (size_t)l * DM * 6144 + col;
      float a0 = 0.f, a1 = 0.f, a2 = 0.f;
#pragma unroll 8
      for (int k = wv * 256; k < wv * 256 + 256; ++k) {
        float wv_ = w[(size_t)k * 6144];
        a0 += sl[k] * wv_; a1 += sl[DM + k] * wv_; a2 += sl[2 * DM + k] * wv_;
      }
      part[(wv * 3 + 0) * 64 + ln] = a0; part[(wv * 3 + 1) * 64 + ln] = a1; part[(wv * 3 + 2) * 64 + ln] = a2;
      __syncthreads();
      if (tid < 192) {
        const int r = tid >> 6;
        float s = part[(0 * 3 + r) * 64 + ln] + part[(1 * 3 + r) * 64 + ln] + part[(2 * 3 + r) * 64 + ln] + part[(3 * 3 + r) * 64 + ln];
        p.mod[(l * 3 + r) * 6144 + col] = s + p.b_mod[l * 6144 + col];
      }
    }
  }
}

__device__ __forceinline__ void phase_norm(const Params& p, int layer, int which, int nrows, int from_input) {
  const int lane = tidx() & 63, wv = tidx() >> 6;
  const float* g = (which == 1 ? p.norm1_g : p.norm2_g) + layer * DM;
  const int sh_off = which == 1 ? 0 : 3 * DM, sc_off = which == 1 ? DM : 4 * DM;
  int curm = -1;
  f32x4 Ar[4], Br[4];
  for (int row = bidx() * 4 + wv; row < nrows; row += gridDim.x * 4) {
    const float* xr = xrow_src(p, row, from_input);
    const int mr = modrow(row);
    if (mr != curm) {
      const float* md = p.mod + (size_t)(layer * 3 + mr) * 6144;
#pragma unroll
      for (int j = 0; j < 4; ++j) {
        int c0 = j * 256 + lane * 4;
        f32x4 gg = *(const f32x4*)(g + c0), sc = *(const f32x4*)(md + sc_off + c0);
        Br[j] = *(const f32x4*)(md + sh_off + c0);
#pragma unroll
        for (int e = 0; e < 4; ++e) Ar[j][e] = gg[e] * (1.f + sc[e]);
      }
      curm = mr;
    }
    f32x4 v[4]; float ss = 0.f;
#pragma unroll
    for (int j = 0; j < 4; ++j) {
      v[j] = *(const f32x4*)(xr + j * 256 + lane * 4);
      ss += v[j][0] * v[j][0] + v[j][1] * v[j][1] + v[j][2] * v[j][2] + v[j][3] * v[j][3];
    }
    ss = wave_sum(ss);
    float rs = rsqrtf(ss * (1.f / DM) + 1e-6f);
#pragma unroll
    for (int j = 0; j < 4; ++j) {
      int c0 = j * 256 + lane * 4;
      float o0 = v[j][0] * rs * Ar[j][0] + Br[j][0];
      float o1 = v[j][1] * rs * Ar[j][1] + Br[j][1];
      float o2 = v[j][2] * rs * Ar[j][2] + Br[j][2];
      float o3 = v[j][3] * rs * Ar[j][3] + Br[j][3];
      u32x2 w; w.x = pack2(o0, o1); w.y = pack2(o2, o3);
      *(u32x2*)(p.h + (size_t)row * DM + c0) = w;
      v[j][0] = o0; v[j][1] = o1; v[j][2] = o2; v[j][3] = o3;
#if DIAG_HP
      if (which == 2) {
        u32x2 wl; wl.x = pack2(o0 - __uint_as_float(w.x << 16), o1 - __uint_as_float(w.x & 0xffff0000u));
        wl.y = pack2(o2 - __uint_as_float(w.y << 16), o3 - __uint_as_float(w.y & 0xffff0000u));
        *(u32x2*)(p.h2lo + (size_t)row * DM + c0) = wl;
      }
#endif
    }
    if (which == 2) {
      float am = 0.f;
#pragma unroll
      for (int j = 0; j < 4; ++j) am = fmaxf(fmaxf(fmaxf(am, fabsf(v[j][0])), fmaxf(fabsf(v[j][1]), fabsf(v[j][2]))), fabsf(v[j][3]));
      am = wave_max(am);
      const float sc8 = am > 0.f ? am * (1.f / 127.f) : 1.f, inv8 = 1.f / sc8;
#pragma unroll
      for (int j = 0; j < 4; ++j) {
        unsigned q = 0;
#pragma unroll
        for (int e = 0; e < 4; ++e) {
          int t = (int)rintf(v[j][e] * inv8);
          t = t < -127 ? -127 : (t > 127 ? 127 : t);
          q |= (unsigned)(t & 0xff) << (8 * e);
        }
        *(unsigned*)(p.xq + (size_t)row * DM + j * 256 + lane * 4) = q;
      }
      if (lane == 0) p.sxq[row] = sc8;
    }
  }
}

__device__ __forceinline__ void gemm_stage(const bf16_t* A, int lda, const bf16_t* Bt, int ldb, int brow, int bcol, int kt, char* buf, int tid) {
#pragma unroll
  for (int i = 0; i < 4; ++i) {
    const int b = (tid + 256 * i) * 16, r = b >> 7, c = ((b >> 4) & 7) ^ ((r >> 1) & 7);
    __builtin_amdgcn_global_load_lds((const unsigned*)(A + (size_t)(brow + r) * lda + kt + c * 8), (__attribute__((address_space(3))) unsigned*)(buf + b), 16, 0, 0);
    __builtin_amdgcn_global_load_lds((const unsigned*)(Bt + (size_t)(bcol + r) * ldb + kt + c * 8), (__attribute__((address_space(3))) unsigned*)(buf + 16384 + b), 16, 0, 0);
  }
}
__device__ __forceinline__ void gemm_compute(f32x4 (&acc)[4][4], const char* buf, int wr, int wc, int fr, int fq) {
#pragma unroll
  for (int ks = 0; ks < 2; ++ks) {
    bf16x8 At[4], Bl[4];
#pragma unroll
    for (int m = 0; m < 4; ++m) { const int row = wr * 64 + m * 16 + fr; At[m] = *(const bf16x8*)(buf + row * 128 + (((ks * 4 + fq) ^ ((row >> 1) & 7)) << 4)); }
#pragma unroll
    for (int n = 0; n < 4; ++n) { const int row = wc * 64 + n * 16 + fr; Bl[n] = *(const bf16x8*)(buf + 16384 + row * 128 + (((ks * 4 + fq) ^ ((row >> 1) & 7)) << 4)); }
    __builtin_amdgcn_s_setprio(1);
#pragma unroll
    for (int m = 0; m < 4; ++m)
#pragma unroll
      for (int n = 0; n < 4; ++n) acc[m][n] = __builtin_amdgcn_mfma_f32_16x16x32_bf16(Bl[n], At[m], acc[m][n], 0, 0, 0);
    __builtin_amdgcn_s_setprio(0);
  }
}
__device__ __forceinline__ void gemm_compute_h(f32x4 (&acc)[4][4], const char* buf, int wr, int wc, int fr, int fq) {
  bf16x8 At[2][4], Bl[2][4];
#pragma unroll
  for (int ks = 0; ks < 2; ++ks) {
#pragma unroll
    for (int m = 0; m < 4; ++m) { const int row = wr * 64 + m * 16 + fr; At[ks][m] = *(const bf16x8*)(buf + row * 128 + (((ks * 4 + fq) ^ ((row >> 1) & 7)) << 4)); }
#pragma unroll
    for (int n = 0; n < 4; ++n) { const int row = wc * 64 + n * 16 + fr; Bl[ks][n] = *(const bf16x8*)(buf + 16384 + row * 128 + (((ks * 4 + fq) ^ ((row >> 1) & 7)) << 4)); }
  }
  __builtin_amdgcn_s_setprio(1);
#pragma unroll
  for (int ks = 0; ks < 2; ++ks)
#pragma unroll
    for (int m = 0; m < 4; ++m)
#pragma unroll
      for (int n = 0; n < 4; ++n) acc[m][n] = __builtin_amdgcn_mfma_f32_16x16x32_bf16(Bl[ks][n], At[ks][m], acc[m][n], 0, 0, 0);
  __builtin_amdgcn_s_setprio(0);
}
template <bool HOIST = true>
__device__ __forceinline__ void gemm_kloop(f32x4 (&acc)[4][4], const bf16_t* A, int lda, const bf16_t* Bt, int ldb, int K, int brow, int bcol) {
  const int tid = tidx(), wid = tid >> 6, lane = tid & 63, wr = wid >> 1, wc = wid & 1, fr = lane & 15, fq = lane >> 4;
  const int nt = K >> 6;
  __syncthreads();
  gemm_stage(A, lda, Bt, ldb, brow, bcol, 0, smem, tid);
  asm volatile("s_waitcnt vmcnt(0)" ::: "memory");
  __syncthreads();
  for (int t = 0; t < nt - 1; ++t) {
    char* cur = smem + (t & 1) * 32768; char* nxt = smem + ((t + 1) & 1) * 32768;
    gemm_stage(A, lda, Bt, ldb, brow, bcol, (t + 1) * 64, nxt, tid);
    if (HOIST) gemm_compute_h(acc, cur, wr, wc, fr, fq); else gemm_compute(acc, cur, wr, wc, fr, fq);
#if REP_KCOMP > 1
    { f32x4 acc2[4][4];
#pragma unroll
      for (int m = 0; m < 4; ++m)
#pragma unroll
        for (int n = 0; n < 4; ++n) acc2[m][n] = (f32x4){0.f, 0.f, 0.f, 0.f};
      gemm_compute(acc2, cur, wr, wc, fr, fq);
      float sink = 0.f;
#pragma unroll
      for (int m = 0; m < 4; ++m)
#pragma unroll
        for (int n = 0; n < 4; ++n) sink += acc2[m][n][0];
      asm volatile("" :: "v"(sink)); }
#endif
    asm volatile("s_waitcnt vmcnt(0)" ::: "memory");
    __syncthreads();
#if REP_KSTG > 1
    gemm_stage(A, lda, Bt, ldb, brow, bcol, (t + 1) * 64, nxt, tid);
    asm volatile("s_waitcnt vmcnt(0)" ::: "memory");
    __syncthreads();
#endif
  }
  if (HOIST) gemm_compute_h(acc, smem + ((nt - 1) & 1) * 32768, wr, wc, fr, fq); else gemm_compute(acc, smem + ((nt - 1) & 1) * 32768, wr, wc, fr, fq);
}

__device__ __forceinline__ void tile_map(int t, int NT, int& mt, int& ni) {
  const int x = t & 7, q = t >> 3, nsub = NT >> 3;
  mt = q / nsub; ni = x + 8 * (q - mt * nsub);
}
__device__ __forceinline__ void tile_map_m(int t, int mtiles, int& mt, int& nt) {
  const int idx = (t & 7) * mtiles + (t >> 3);
  mt = idx >> 3; nt = idx & 7;
}
#define GEMM_IDS const int tid = tidx(), wid = tid >> 6, lane = tid & 63, wr = wid >> 1, wc = wid & 1, fr = lane & 15, fq = lane >> 4; (void)tid;

__device__ __forceinline__ void zero_acc(f32x4 (&acc)[4][4]) {
#pragma unroll
  for (int m = 0; m < 4; ++m)
#pragma unroll
    for (int n = 0; n < 4; ++n) acc[m][n] = (f32x4){0.f, 0.f, 0.f, 0.f};
}


__device__ __forceinline__ void store_slab_bf16(const f32x4 (&v)[4], bf16_t* dst_row0, size_t ld, int wid, int lane) {
  char* slab = smem + 65536 + wid * 2304;
  const int fr = lane & 15, fq = lane >> 4;
#pragma unroll
  for (int n = 0; n < 4; ++n) {
    u32x2 w; w.x = pack2(v[n][0], v[n][1]); w.y = pack2(v[n][2], v[n][3]);
    *(u32x2*)(slab + fr * 144 + (n * 16 + fq * 4) * 2) = w;
  }
  const int r = lane >> 3, c = lane & 7;
  u32x4 a = *(const u32x4*)(slab + r * 144 + c * 16), b = *(const u32x4*)(slab + (r + 8) * 144 + c * 16);
  *(u32x4*)(dst_row0 + (size_t)r * ld + c * 8) = a;
  *(u32x4*)(dst_row0 + (size_t)(r + 8) * ld + c * 8) = b;
}


__device__ __forceinline__ void store_slab_gate8(const f32x4 (&v)[4], unsigned char* dst_row0, int wid, int lane) {
  char* slab = smem + 65536 + wid * 2304;
  const int fr = lane & 15, fq = lane >> 4;
#pragma unroll
  for (int n = 0; n < 4; ++n) {
    unsigned q = 0;
#pragma unroll
    for (int j = 0; j < 4; ++j) { int g = (int)rintf(sigmoidf_(v[n][j]) * 255.f); q |= (unsigned)g << (8 * j); }
    *(unsigned*)(slab + fr * 80 + n * 16 + fq * 4) = q;
  }
  const int r = lane >> 2, c = lane & 3;
  u32x4 a = *(const u32x4*)(slab + r * 80 + c * 16);
  *(u32x4*)(dst_row0 + (size_t)r * 3072 + c * 16) = a;
}
__device__ __forceinline__ void load_slab_gate8(unsigned (&g)[4], const unsigned char* src_row0, int wid, int lane) {
  char* slab = smem + 65536 + wid * 2304;
  const int fr = lane & 15, fq = lane >> 4;
  const int r = lane >> 2, c = lane & 3;
  *(u32x4*)(slab + r * 80 + c * 16) = *(const u32x4*)(src_row0 + (size_t)r * 3072 + c * 16);
#pragma unroll
  for (int n = 0; n < 4; ++n) g[n] = *(const unsigned*)(slab + fr * 80 + n * 16 + fq * 4);
}

__device__ __forceinline__ void phase_inproj(const Params& p, int layer, int nrows, int part) {
  GEMM_IDS
  const int ntl = part == 0 ? 33 : (part == 1 ? 24 : 57);
  const int mtiles = nrows / 128;
  const bf16_t* Bt = p.wt_in + (size_t)layer * INCP * DM;
  for (int t = bidx(); t < mtiles * ntl; t += gridDim.x) {
    int mt, ni, nt;
    if (part == 0) { if (t < mtiles * 32) tile_map(t, 32, mt, ni); else { mt = t - mtiles * 32; ni = 32; } nt = ni < 32 ? ni : 56; }
    else if (part == 1) { tile_map(t, 24, mt, ni); nt = 32 + ni; }
    else { if (t < mtiles * 56) { tile_map(t, 56, mt, ni); nt = ni; } else { mt = t - mtiles * 56; nt = 56; } }
    f32x4 acc[4][4]; zero_acc(acc);
    gemm_kloop(acc, p.h, DM, Bt, DM, DM, mt * 128, nt * 128);
    if (nt >= 32 && nt < 56 && !DIAG_HP) {
#pragma unroll
      for (int m = 0; m < 4; ++m) store_slab_gate8(acc[m], p.gp8 + (size_t)(mt * 128 + wr * 64 + m * 16) * 3072 + (nt * 128 - 4096) + wc * 64, wid, lane);
    } else if (nt >= 5 && nt < 56) {
      bf16_t* dst = nt < 32 ? p.proj + (size_t)(mt * 128 + wr * 64) * 4096 + nt * 128 + wc * 64 : p.gp + (size_t)(mt * 128 + wr * 64) * 3072 + (nt * 128 - 4096) + wc * 64;
      const size_t ld = nt < 32 ? 4096 : 3072;
#pragma unroll
      for (int m = 0; m < 4; ++m) store_slab_bf16(acc[m], dst + (size_t)(m * 16) * ld, ld, wid, lane);
    } else if (nt == 56) {
#pragma unroll
      for (int m = 0; m < 4; ++m)
#pragma unroll
        for (int n = 0; n < 4; ++n) {
          int row = mt * 128 + wr * 64 + m * 16 + fr, cc = wc * 64 + n * 16 + fq * 4;
          if (cc < 32) *(f32x4*)(p.small + (size_t)row * 32 + cc) = acc[m][n];
        }
    }
    if (nt < 5) {
      const float* nw = (nt < 4 ? p.att_qnorm : p.att_knorm) + layer * 64;
      const bool latent = mt < NLAT / 128;
#pragma unroll
      for (int m = 0; m < 4; ++m) {
        const int row = mt * 128 + wr * 64 + m * 16 + fr;
        float ss = 0.f;
#pragma unroll
        for (int n = 0; n < 4; ++n)
#pragma unroll
          for (int j = 0; j < 4; ++j) ss += acc[m][n][j] * acc[m][n][j];
        ss += __shfl_xor(ss, 16); ss += __shfl_xor(ss, 32);
        const float rs = rsqrtf(ss * (1.f / 64.f) + 1e-6f);
        f32x4 v[4];
#pragma unroll
        for (int n = 0; n < 4; ++n) {
          f32x4 w4 = *(const f32x4*)(nw + n * 16 + fq * 4);
#pragma unroll
          for (int j = 0; j < 4; ++j) v[n][j] = acc[m][n][j] * rs * w4[j];
        }
        if (latent) {
          const int pos = row & (SEQ - 1);
#pragma unroll
          for (int n = 0; n < 2; ++n) {
            f32x4 c4 = *(const f32x4*)(p.ropec + pos * 32 + n * 16 + fq * 4), s4 = *(const f32x4*)(p.ropes + pos * 32 + n * 16 + fq * 4);
#pragma unroll
            for (int j = 0; j < 4; ++j) {
              float t1 = v[n][j], t2 = v[n + 2][j];
              v[n][j] = t1 * c4[j] - t2 * s4[j];
              v[n + 2][j] = t1 * s4[j] + t2 * c4[j];
            }
          }
        }
        store_slab_bf16(v, p.proj + (size_t)(mt * 128 + wr * 64 + m * 16) * 4096 + nt * 128 + wc * 64, 4096, wid, lane);
      }
    }
  }
}

__device__ __forceinline__ void phase_merge(const Params& p, int layer, int nrows) {
  GEMM_IDS
  const int mtiles = nrows / 128;
  for (int t = bidx(); t < mtiles * 8; t += gridDim.x) {
    int mt, nt; tile_map_m(t, mtiles, mt, nt);
    f32x4 mixa[4][4]; zero_acc(mixa);
    for (int r = 0; r < 3; ++r) {
      f32x4 acc[4][4]; zero_acc(acc);
      gemm_kloop<false>(acc, p.br + r * 512, 1536, p.wt_br + ((size_t)layer * 3 + r) * DM * 512, 512, 512, mt * 128, nt * 128);
#if DIAG_HP
#pragma unroll
      for (int m = 0; m < 4; ++m)
#pragma unroll
        for (int n = 0; n < 4; ++n) {
          int row = mt * 128 + wr * 64 + m * 16 + fr, col = nt * 128 + wc * 64 + n * 16 + fq * 4;
          u32x2 g = *(const u32x2*)(p.gp + (size_t)row * 3072 + r * 1024 + col);
          mixa[m][n][0] += sigmoidf_(__uint_as_float(g.x << 16)) * acc[m][n][0];
          mixa[m][n][1] += sigmoidf_(__uint_as_float(g.x & 0xffff0000u)) * acc[m][n][1];
          mixa[m][n][2] += sigmoidf_(__uint_as_float(g.y << 16)) * acc[m][n][2];
          mixa[m][n][3] += sigmoidf_(__uint_as_float(g.y & 0xffff0000u)) * acc[m][n][3];
        }
#else
#pragma unroll
      for (int m = 0; m < 4; ++m) {
        unsigned g[4];
        load_slab_gate8(g, p.gp8 + (size_t)(mt * 128 + wr * 64 + m * 16) * 3072 + r * 1024 + nt * 128 + wc * 64, wid, lane);
#pragma unroll
        for (int n = 0; n < 4; ++n) {
          mixa[m][n][0] += ub0(g[n]) * (1.f / 255.f) * acc[m][n][0];
          mixa[m][n][1] += ub1(g[n]) * (1.f / 255.f) * acc[m][n][1];
          mixa[m][n][2] += ub2(g[n]) * (1.f / 255.f) * acc[m][n][2];
          mixa[m][n][3] += ub3(g[n]) * (1.f / 255.f) * acc[m][n][3];
        }
      }
#endif
    }
#pragma unroll
    for (int m = 0; m < 4; ++m) store_slab_bf16(mixa[m], p.mix + (size_t)(mt * 128 + wr * 64 + m * 16) * DM + nt * 128 + wc * 64, DM, wid, lane);
  }
}

__device__ __forceinline__ void phase_outproj(const Params& p, int layer, int nrows, float oscale, int from_input) {
  GEMM_IDS
  const int mtiles = nrows / 128;
  for (int t = bidx(); t < mtiles * 8; t += gridDim.x) {
    int mt, nt; tile_map_m(t, mtiles, mt, nt);
    f32x4 acc[4][4]; zero_acc(acc);
    gemm_kloop(acc, p.mix, DM, p.wt_out + (size_t)layer * DM * DM, DM, DM, mt * 128, nt * 128);
#pragma unroll
    for (int m = 0; m < 4; ++m)
#pragma unroll
      for (int n = 0; n < 4; ++n) {
        int row = mt * 128 + wr * 64 + m * 16 + fr, col = nt * 128 + wc * 64 + n * 16 + fq * 4;
        float* xr = xrow(p, row) + col;
        f32x4 g1 = *(const f32x4*)(p.mod + (size_t)(layer * 3 + modrow(row)) * 6144 + 2 * DM + col);
        g1 = g1 * oscale;
        f32x4 xv = *(const f32x4*)(xrow_src(p, row, from_input) + col);
        xv[0] += g1[0] * acc[m][n][0]; xv[1] += g1[1] * acc[m][n][1]; xv[2] += g1[2] * acc[m][n][2]; xv[3] += g1[3] * acc[m][n][3];
        *(f32x4*)xr = xv;
      }
  }
}

__device__ __forceinline__ void phase_wq(const Params& p, int layer, int nrows) {
  GEMM_IDS
  const int mtiles = nrows / 128;
  for (int t = bidx(); t < mtiles * 16; t += gridDim.x) {
    int mt, nt; { const int idx = (t & 7) * (mtiles * 2) + (t >> 3); mt = idx >> 4; nt = idx & 15; }
    f32x4 acc[4][4]; zero_acc(acc);
    gemm_kloop(acc, p.h, DM, p.wt_q + (size_t)layer * 2048 * DM, DM, DM, mt * 128, nt * 128);
#if DIAG_HP
    gemm_kloop(acc, p.h, DM, p.wt_q_lo + (size_t)layer * 2048 * DM, DM, DM, mt * 128, nt * 128);
    gemm_kloop(acc, p.h2lo, DM, p.wt_q + (size_t)layer * 2048 * DM, DM, DM, mt * 128, nt * 128);
#endif
#if DIAG_HP
#pragma unroll
    for (int m = 0; m < 4; ++m)
#pragma unroll
      for (int n = 0; n < 4; ++n) {
        int row = mt * 128 + wr * 64 + m * 16 + fr, col = nt * 128 + wc * 64 + n * 16 + fq * 4;
        *(f32x4*)(p.qf + (size_t)row * 2048 + col) = acc[m][n];
      }
#else
#pragma unroll
    for (int m = 0; m < 4; ++m) store_slab_bf16(acc[m], p.q + (size_t)(mt * 128 + wr * 64 + m * 16) * 2048 + nt * 128 + wc * 64, 2048, wid, lane);
#endif
  }
}

__device__ __forceinline__ void phase_vtrans(const Params& p) {
  bf16_t* tile = (bf16_t*)smem;
  const int tid = tidx();
  for (int item = bidx(); item < 528; item += gridDim.x) {
    int b = item / 264, r = item % 264, kvh = r / 132, kt = r % 132;
    int krow0 = kt < 128 ? b * SEQ + kt * 64 : NLAT + b * CTXL + (kt - 128) * 64;
    __syncthreads();
    {
      int kr = tid >> 2, c0 = (tid & 3) * 16;
      const bf16_t* vp = p.proj + (size_t)(krow0 + kr) * 4096 + 640 + kvh * 64 + c0;
      u32x4 w0 = *(const u32x4*)vp, w1 = *(const u32x4*)(vp + 8);
      unsigned* tp = (unsigned*)(tile + kr * 66 + c0);
#pragma unroll
      for (int e = 0; e < 4; ++e) { tp[e] = w0[e]; tp[4 + e] = w1[e]; }
    }
    __syncthreads();
    {
      int d = tid >> 2, k0 = (tid & 3) * 16;
      bf16_t* op = p.vt + ((size_t)(b * 2 + kvh) * 64 + d) * 8448 + kt * 64 + k0;
      u32x4 o0, o1;
#pragma unroll
      for (int e = 0; e < 4; ++e) {
        const int ka = e < 2 ? 2 * e : 8 + 2 * (e - 2);
        const int kb2 = e < 2 ? 4 + 2 * e : 12 + 2 * (e - 2);
        o0[e] = (unsigned)tile[(k0 + ka) * 66 + d] | ((unsigned)tile[(k0 + ka + 1) * 66 + d] << 16);
        o1[e] = (unsigned)tile[(k0 + kb2) * 66 + d] | ((unsigned)tile[(k0 + kb2 + 1) * 66 + d] << 16);
      }
      *(u32x4*)op = o0; *(u32x4*)(op + 8) = o1;
    }
  }
}

#define ATT_KSTR 144
#define ATT_VSTR 272
#define ATT_VOFF 18432
#define ATT_BUF 35840
__device__ __forceinline__ void attn_item(const Params& p, int layer, int item) {
  const int tid = tidx(), wid = tid >> 6, lane = tid & 63, l31 = lane & 31, hh = lane >> 5;
  int b, kvh, tok0, kt0, nkt;
  if (item < 1024) { b = item >> 9; kvh = (item >> 8) & 1; tok0 = b * SEQ + (item & 255) * 32; kt0 = 0; nkt = 66; }
  else { int r = item - 1024; b = r >> 4; kvh = (r >> 3) & 1; tok0 = NLAT + b * CTXL + (r & 7) * 32; kt0 = 64; nkt = 2; }
  const int head = kvh * 4 + wid;
  bf16x8 qf[4];
#pragma unroll
  for (int ks = 0; ks < 4; ++ks)
    qf[ks] = *(const bf16x8*)(p.proj + (size_t)(tok0 + l31) * 4096 + head * 64 + ks * 16 + hh * 8);
  f32x16 o[2];
#pragma unroll
  for (int db = 0; db < 2; ++db)
#pragma unroll
    for (int r = 0; r < 16; ++r) o[db][r] = 0.f;
  float mrun = -1e30f, lrun = 0.f;
  const float cs = 0.125f * 1.44269504088896f * ATT_TAU;
  const bf16_t* vtb = p.vt + (size_t)(b * 2 + kvh) * 64 * 8448;
  u32x4 kreg[4], vreg[4];
  auto gload = [&](int kt) {
    int krow0 = kt < 64 ? b * SEQ + kt * 128 : NLAT + b * CTXL + (kt - 64) * 128;
    int ko = kt * 128; asm volatile("" : "+s"(ko));
#pragma unroll
    for (int i = 0; i < 4; ++i) {
      int id = tid + 256 * i;
      kreg[i] = *(const u32x4*)(p.proj + (size_t)(krow0 + (id >> 3)) * 4096 + 512 + kvh * 64 + (id & 7) * 8);
      vreg[i] = *(const u32x4*)(vtb + (size_t)(id >> 4) * 8448 + ko + (id & 15) * 8);
    }
  };
  auto lstore = [&](int buf) {
    char* base = smem + buf * ATT_BUF;
#pragma unroll
    for (int i = 0; i < 4; ++i) {
      int id = tid + 256 * i;
      *(u32x4*)(base + (id >> 3) * ATT_KSTR + (id & 7) * 16) = kreg[i];
      *(u32x4*)(base + ATT_VOFF + (id >> 4) * ATT_VSTR + (id & 15) * 16) = vreg[i];
    }
  };
  auto compute = [&](int buf, int sub) {
    const char* Kb = smem + buf * ATT_BUF + sub * 64 * ATT_KSTR;
    const char* Vb = smem + buf * ATT_BUF + ATT_VOFF + sub * 128;
    f32x16 s[2];
#pragma unroll
    for (int kb = 0; kb < 2; ++kb) {
#pragma unroll
      for (int r = 0; r < 16; ++r) s[kb][r] = 0.f;
#pragma unroll
      for (int ks = 0; ks < 4; ++ks) {
        bf16x8 kf = *(const bf16x8*)(Kb + (kb * 32 + l31) * ATT_KSTR + (ks * 16 + hh * 8) * 2);
        s[kb] = __builtin_amdgcn_mfma_f32_32x32x16_bf16(kf, qf[ks], s[kb], 0, 0, 0);
      }
    }
    bf16x8 pf[4];
    float mx = s[0][0];
#pragma unroll
    for (int r = 1; r < 16; ++r) mx = fmaxf(mx, s[0][r]);
#pragma unroll
    for (int r = 0; r < 16; ++r) mx = fmaxf(mx, s[1][r]);
    mx = fmaxf(mx, __shfl_xor(mx, 32));
    const float mnew = fmaxf(mrun, mx * cs);
    const float alpha = __builtin_amdgcn_exp2f(mrun - mnew);
    const bool grew = mnew > mrun;
    mrun = mnew;
    float ls = 0.f;
#pragma unroll
    for (int kb = 0; kb < 2; ++kb) {
      float pv[16];
#pragma unroll
      for (int r = 0; r < 16; ++r) { pv[r] = __builtin_amdgcn_exp2f(s[kb][r] * cs - mnew); ls += pv[r]; }
#pragma unroll
      for (int sp = 0; sp < 2; ++sp) {
        u32x4 w;
#pragma unroll
        for (int e = 0; e < 4; ++e) w[e] = pack2(pv[8 * sp + 2 * e], pv[8 * sp + 2 * e + 1]);
        pf[kb * 2 + sp] = *(bf16x8*)&w;
      }
    }
    lrun = lrun * alpha + ls;
    if (__any(grew)) {
#pragma unroll
      for (int db = 0; db < 2; ++db)
#pragma unroll
        for (int r = 0; r < 16; ++r) o[db][r] *= alpha;
    }
#pragma unroll
    for (int sp = 0; sp < 4; ++sp) {
#pragma unroll
      for (int db = 0; db < 2; ++db) {
        bf16x8 vf = *(const bf16x8*)(Vb + (db * 32 + l31) * ATT_VSTR + (16 * sp + 8 * hh) * 2);
        o[db] = __builtin_amdgcn_mfma_f32_32x32x16_bf16(vf, pf[sp], o[db], 0, 0, 0);
      }
    }
  };
  float mfix;
  {
    float aq = fabsf(p.att_qnorm[layer * 64 + lane]), ak = fabsf(p.att_knorm[layer * 64 + lane]);
    aq = wave_max(aq); ak = wave_max(ak);
    mfix = 8.f * aq * ak * 1.02f * 1.44269504088896f * ATT_TAU;
  }
  const bool fast = mfix <= 40.f;
  if (fast) {
#pragma unroll
    for (int ks = 0; ks < 4; ++ks) {
      u32x4 w = *(u32x4*)&qf[ks];
#pragma unroll
      for (int e = 0; e < 4; ++e) w[e] = pack2(__uint_as_float(w[e] << 16) * cs, __uint_as_float(w[e] & 0xffff0000u) * cs);
      qf[ks] = *(bf16x8*)&w;
    }
  }
  auto compute_fast = [&](int buf, int sub) {
    const char* Kb = smem + buf * ATT_BUF + sub * 64 * ATT_KSTR;
    const char* Vb = smem + buf * ATT_BUF + ATT_VOFF + sub * 128;
    bf16x8 kf[8], vf[8];
#pragma unroll
    for (int kb = 0; kb < 2; ++kb)
#pragma unroll
      for (int ks = 0; ks < 4; ++ks) kf[kb * 4 + ks] = *(const bf16x8*)(Kb + (kb * 32 + l31) * ATT_KSTR + (ks * 16 + hh * 8) * 2);
#pragma unroll
    for (int sp = 0; sp < 4; ++sp)
#pragma unroll
      for (int db = 0; db < 2; ++db) vf[sp * 2 + db] = *(const bf16x8*)(Vb + (db * 32 + l31) * ATT_VSTR + (16 * sp + 8 * hh) * 2);
    f32x16 s[2];
#pragma unroll
    for (int kb = 0; kb < 2; ++kb) {
#pragma unroll
      for (int r = 0; r < 16; ++r) s[kb][r] = 0.f;
#pragma unroll
      for (int ks = 0; ks < 4; ++ks) s[kb] = __builtin_amdgcn_mfma_f32_32x32x16_bf16(kf[kb * 4 + ks], qf[ks], s[kb], 0, 0, 0);
    }
    bf16x8 pf[4];
    float ls = 0.f;
#pragma unroll
    for (int kb = 0; kb < 2; ++kb) {
      float pv[16];
#pragma unroll
      for (int r = 0; r < 16; ++r) { pv[r] = __builtin_amdgcn_exp2f(s[kb][r]); ls += pv[r]; }
#pragma unroll
      for (int sp = 0; sp < 2; ++sp) {
        u32x4 w;
#pragma unroll
        for (int e = 0; e < 4; ++e) w[e] = pack2(pv[8 * sp + 2 * e], pv[8 * sp + 2 * e + 1]);
        pf[kb * 2 + sp] = *(bf16x8*)&w;
      }
    }
    lrun += ls;
#pragma unroll
    for (int sp = 0; sp < 4; ++sp)
#pragma unroll
      for (int db = 0; db < 2; ++db) o[db] = __builtin_amdgcn_mfma_f32_32x32x16_bf16(vf[sp * 2 + db], pf[sp], o[db], 0, 0, 0);
  };
  __syncthreads();
  gload(kt0);
  lstore(0);
  __syncthreads();
  if (fast) {
    for (int t = 0; t < nkt; ++t) {
      const int buf = t & 1;
      if (t + 1 < nkt) gload(kt0 + t + 1);
      compute_fast(buf, 0);
      compute_fast(buf, 1);
      if (t + 1 < nkt) lstore(buf ^ 1);
      __syncthreads();
    }
  } else {
    for (int t = 0; t < nkt; ++t) {
      const int buf = t & 1;
      if (t + 1 < nkt) gload(kt0 + t + 1);
      compute(buf, 0);
      compute(buf, 1);
      if (t + 1 < nkt) lstore(buf ^ 1);
      __syncthreads();
    }
  }
  {
    float l = lrun + __shfl_xor(lrun, 32);
    float il = ATT_ALPHA / l;
    bf16_t* op = p.br + (size_t)(tok0 + l31) * 1536 + head * 64;
#pragma unroll
    for (int db = 0; db < 2; ++db)
#pragma unroll
      for (int g = 0; g < 4; ++g) {
        u32x2 w; w.x = pack2(o[db][4 * g] * il, o[db][4 * g + 1] * il); w.y = pack2(o[db][4 * g + 2] * il, o[db][4 * g + 3] * il);
        *(u32x2*)(op + db * 32 + 8 * g + 4 * hh) = w;
      }
  }
}

__device__ __forceinline__ void attn_item64(const Params& p, int layer, int item) {
  const int tid = tidx(), wid = tid >> 6, lane = tid & 63, l31 = lane & 31, hh = lane >> 5;
  int b, kvh, tok0, kt0, nkt;
  if (item < 512) { b = item >> 8; kvh = (item >> 7) & 1; tok0 = b * SEQ + (item & 127) * 64; kt0 = 0; nkt = 132; }
  else { int r = item - 512; b = r >> 3; kvh = (r >> 2) & 1; tok0 = NLAT + b * CTXL + (r & 3) * 64; kt0 = 128; nkt = 4; }
  const int head = kvh * 4 + wid;
  const float cs = 0.125f * 1.44269504088896f * ATT_TAU;
  bf16x8 qf[2][4];
#pragma unroll
  for (int qb = 0; qb < 2; ++qb)
#pragma unroll
    for (int ks = 0; ks < 4; ++ks) {
      u32x4 w = *(const u32x4*)(p.proj + (size_t)(tok0 + qb * 32 + l31) * 4096 + head * 64 + ks * 16 + hh * 8);
#pragma unroll
      for (int e = 0; e < 4; ++e) w[e] = pack2(__uint_as_float(w[e] << 16) * cs, __uint_as_float(w[e] & 0xffff0000u) * cs);
      qf[qb][ks] = *(bf16x8*)&w;
    }
  f32x16 o[2][2];
#pragma unroll
  for (int qb = 0; qb < 2; ++qb)
#pragma unroll
    for (int db = 0; db < 2; ++db)
#pragma unroll
      for (int r = 0; r < 16; ++r) o[qb][db][r] = 0.f;
  float lrun[2] = {0.f, 0.f};
  const bf16_t* vtb = p.vt + (size_t)(b * 2 + kvh) * 64 * 8448;
  auto stage = [&](int kt, int buf) {
    const int krow0 = kt < 128 ? b * SEQ + kt * 64 : NLAT + b * CTXL + (kt - 128) * 64;
    int ko = kt * 64; asm volatile("" : "+s"(ko));
    char* base = smem + buf * 16384;
#pragma unroll
    for (int i = 0; i < 2; ++i) {
      const int q = tid + 256 * i, r = q >> 3, c = (q & 7) ^ ((r >> 1) & 7);
      __builtin_amdgcn_global_load_lds((const unsigned*)(p.proj + (size_t)(krow0 + r) * 4096 + 512 + kvh * 64 + c * 8), (__attribute__((address_space(3))) unsigned*)(base + q * 16), 16, 0, 0);
      __builtin_amdgcn_global_load_lds((const unsigned*)(vtb + (size_t)r * 8448 + ko + c * 8), (__attribute__((address_space(3))) unsigned*)(base + 8192 + q * 16), 16, 0, 0);
    }
  };
  auto compute = [&](int buf) {
    const char* Kb = smem + buf * 16384;
    const char* Vb = Kb + 8192;
    bf16x8 pf[2][4];
#pragma unroll
    for (int kb = 0; kb < 2; ++kb) {
      bf16x8 kf[4];
      const int row = kb * 32 + l31;
#pragma unroll
      for (int ks = 0; ks < 4; ++ks) kf[ks] = *(const bf16x8*)(Kb + row * 128 + (((ks * 2 + hh) ^ ((row >> 1) & 7)) << 4));
      f32x16 s[2];
#pragma unroll
      for (int qb = 0; qb < 2; ++qb) {
#pragma unroll
        for (int r = 0; r < 16; ++r) s[qb][r] = 0.f;
#pragma unroll
        for (int ks = 0; ks < 4; ++ks) s[qb] = __builtin_amdgcn_mfma_f32_32x32x16_bf16(kf[ks], qf[qb][ks], s[qb], 0, 0, 0);
      }
#pragma unroll
      for (int qb = 0; qb < 2; ++qb) {
        float pv[16]; float ls = 0.f;
#pragma unroll
        for (int r = 0; r < 16; ++r) { pv[r] = __builtin_amdgcn_exp2f(s[qb][r]); ls += pv[r]; }
        lrun[qb] += ls;
#pragma unroll
        for (int sp = 0; sp < 2; ++sp) {
          u32x4 w;
#pragma unroll
          for (int e = 0; e < 4; ++e) w[e] = pack2(pv[8 * sp + 2 * e], pv[8 * sp + 2 * e + 1]);
          pf[qb][kb * 2 + sp] = *(bf16x8*)&w;
        }
      }
    }
#pragma unroll
    for (int sp = 0; sp < 4; ++sp)
#pragma unroll
      for (int db = 0; db < 2; ++db) {
        const int row = db * 32 + l31;
        bf16x8 vf = *(const bf16x8*)(Vb + row * 128 + (((sp * 2 + hh) ^ ((row >> 1) & 7)) << 4));
        o[0][db] = __builtin_amdgcn_mfma_f32_32x32x16_bf16(vf, pf[0][sp], o[0][db], 0, 0, 0);
        o[1][db] = __builtin_amdgcn_mfma_f32_32x32x16_bf16(vf, pf[1][sp], o[1][db], 0, 0, 0);
      }
  };
  __syncthreads();
  stage(kt0, 0);
  asm volatile("s_waitcnt vmcnt(0)" ::: "memory");
  __syncthreads();
  for (int t = 0; t < nkt; ++t) {
    if (t + 1 < nkt) stage(kt0 + t + 1, (t + 1) & 1);
    compute(t & 1);
    asm volatile("s_waitcnt vmcnt(0)" ::: "memory");
    __syncthreads();
  }
#pragma unroll
  for (int qb = 0; qb < 2; ++qb) {
    float l = lrun[qb] + __shfl_xor(lrun[qb], 32);
    float il = ATT_ALPHA / l;
    bf16_t* op = p.br + (size_t)(tok0 + qb * 32 + l31) * 1536 + head * 64;
#pragma unroll
    for (int db = 0; db < 2; ++db)
#pragma unroll
      for (int g = 0; g < 4; ++g) {
        u32x2 w; w.x = pack2(o[qb][db][4 * g] * il, o[qb][db][4 * g + 1] * il); w.y = pack2(o[qb][db][4 * g + 2] * il, o[qb][db][4 * g + 3] * il);
        *(u32x2*)(op + db * 32 + 8 * g + 4 * hh) = w;
      }
  }
}
__device__ __forceinline__ float attn_logit_bound(const Params& p, int layer) {
  const int lane = tidx() & 63;
  float aq = fabsf(p.att_qnorm[layer * 64 + lane]), ak = fabsf(p.att_knorm[layer * 64 + lane]);
  aq = wave_max(aq); ak = wave_max(ak);
  return 8.f * aq * ak * 1.02f * 1.44269504088896f * ATT_TAU;
}

__device__ __forceinline__ void phase_ssdprep(const Params& p, int layer) {
  const float* cw = p.ssd_conv_w + (size_t)layer * 5 * 768;
  const float* cb = p.ssd_conv_b + layer * 768;
  const int total = (MROWS / 16) * 96;
  for (int i = bidx() * NTHR + tidx(); i < total; i += gridDim.x * NTHR) {
    const int run = i / 96, c0 = (i - run * 96) * 8;
    const int row0 = run * 16;
    int t0, T;
    if (row0 < NLAT) { t0 = row0 & (SEQ - 1); T = SEQ; } else { t0 = (row0 - NLAT) & (CTXL - 1); T = CTXL; }
    float w[5][8], bias[8];
#pragma unroll
    for (int j = 0; j < 5; ++j) {
      f32x4 w0 = *(const f32x4*)(cw + j * 768 + c0), w1 = *(const f32x4*)(cw + j * 768 + c0 + 4);
#pragma unroll
      for (int e = 0; e < 4; ++e) { w[j][e] = w0[e]; w[j][4 + e] = w1[e]; }
    }
    {
      f32x4 b0 = *(const f32x4*)(cb + c0), b1 = *(const f32x4*)(cb + c0 + 4);
#pragma unroll
      for (int e = 0; e < 4; ++e) { bias[e] = b0[e]; bias[4 + e] = b1[e]; }
    }
    const bf16_t* src = p.proj + (size_t)row0 * 4096 + 1280 + c0;
    u32x4 win[5];
    const u32x4 zero4 = {0u, 0u, 0u, 0u};
    win[0] = zero4;
    win[1] = t0 >= 2 ? *(const u32x4*)(src - 2 * 4096) : zero4;
    win[2] = t0 >= 1 ? *(const u32x4*)(src - 1 * 4096) : zero4;
    win[3] = *(const u32x4*)(src);
    win[4] = *(const u32x4*)(src + 4096);
#pragma unroll
    for (int r = 0; r < 16; ++r) {
      win[0] = win[1]; win[1] = win[2]; win[2] = win[3]; win[3] = win[4];
      win[4] = (t0 + r + 2 < T) ? *(const u32x4*)(src + (size_t)(r + 2) * 4096) : zero4;
      float a[8];
#pragma unroll
      for (int e = 0; e < 8; ++e) a[e] = bias[e];
#pragma unroll
      for (int j = 0; j < 5; ++j)
#pragma unroll
        for (int e = 0; e < 4; ++e) {
          a[2 * e] += w[j][2 * e] * __uint_as_float(win[j][e] << 16);
          a[2 * e + 1] += w[j][2 * e + 1] * __uint_as_float(win[j][e] & 0xffff0000u);
        }
      u32x4 o;
#pragma unroll
      for (int e = 0; e < 4; ++e) o[e] = pack2(siluf_(a[2 * e]), siluf_(a[2 * e + 1]));
      *(u32x4*)(p.xbc + (size_t)(row0 + r) * 768 + c0) = o;
    }
  }
  const int total2 = MROWS * 16;
  for (int i = bidx() * NTHR + tidx(); i < total2; i += gridDim.x * NTHR) {
    int row = i >> 4, j = i & 15;
    p.dtb[i] = softplusf_(p.small[(size_t)row * 32 + j] + p.ssd_dt_bias[layer * 16 + j]);
  }
}

__device__ __forceinline__ int chunk_row0(int b, int c) { return c < 64 ? b * SEQ + c * 128 : NLAT + b * CTXL + (c - 64) * 128; }
__device__ __forceinline__ float wave_incl_scan(float v, int lane) {
#pragma unroll
  for (int o = 1; o < 64; o <<= 1) { float t = __shfl_up(v, o); if (lane >= o) v += t; }
  return v;
}
__device__ __forceinline__ void ssd_scans(const Params& p, int layer, int row0, int h, float* fl) {
  const int tid = tidx(), lane = tid & 63, wv = tid >> 6;
  const bool fwd = tid < 128;
  const int s = fwd ? tid : 127 - (tid - 128);
  const float A = -__expf(p.ssd_a_log[layer * 16 + (fwd ? 0 : 8) + h]);
  const float dt = p.dtb[(size_t)(row0 + s) * 16 + (fwd ? 0 : 8) + h];
  float v = wave_incl_scan(dt * A, lane);
  if (lane == 63) fl[512 + wv] = v;
  __syncthreads();
  if (wv & 1) v += fl[512 + wv - 1];
  fl[(fwd ? 0 : 128) + s] = v;
  fl[(fwd ? 256 : 384) + s] = dt;
  __syncthreads();
}

#define SSD_TSTR 272
__device__ __forceinline__ void ssdA_item(const Params& p, int layer, int item) {
  const int tid = tidx(), wid = tid >> 6, lane = tid & 63, l31 = lane & 31, hh = lane >> 5;
  const int b = item / 528, c = (item / 8) % 66, h = item & 7, g = h >> 2;
  const int row0 = chunk_row0(b, c);
  float* fl = (float*)smem;
  char* BT = smem + 4096;
  char* XF = BT + 64 * SSD_TSTR;
  char* XB = XF + 64 * SSD_TSTR;
  __syncthreads();
  ssd_scans(p, layer, row0, h, fl);
  const float cfl = fl[127], cbl = fl[128];
  {
    const int s = tid >> 1, half = tid & 1;
    const float wf = __expf(cfl - fl[s]) * fl[256 + s], wb = __expf(cbl - fl[128 + s]) * fl[384 + s];
    const bf16_t* xr = p.xbc + (size_t)(row0 + s) * 768;
#pragma unroll
    for (int i = 0; i < 4; ++i) {
      u32x4 xv = *(const u32x4*)(xr + h * 64 + half * 32 + i * 8);
      u32x4 bv = *(const u32x4*)(xr + 512 + g * 64 + half * 32 + i * 8);
#pragma unroll
      for (int e = 0; e < 4; ++e) {
        int pp = half * 32 + i * 8 + 2 * e;
        float x0 = __uint_as_float(xv[e] << 16), x1 = __uint_as_float(xv[e] & 0xffff0000u);
        *(bf16_t*)(XF + pp * SSD_TSTR + s * 2) = f2bf(x0 * wf);
        *(bf16_t*)(XF + (pp + 1) * SSD_TSTR + s * 2) = f2bf(x1 * wf);
        *(bf16_t*)(XB + pp * SSD_TSTR + s * 2) = f2bf(x0 * wb);
        *(bf16_t*)(XB + (pp + 1) * SSD_TSTR + s * 2) = f2bf(x1 * wb);
        *(bf16_t*)(BT + pp * SSD_TSTR + s * 2) = (bf16_t)(bv[e] & 0xffffu);
        *(bf16_t*)(BT + (pp + 1) * SSD_TSTR + s * 2) = (bf16_t)(bv[e] >> 16);
      }
    }
  }
  __syncthreads();
  const int nb = wid >> 1, pb = wid & 1;
#pragma unroll
  for (int dir = 0; dir < 2; ++dir) {
    const char* XT = dir == 0 ? XF : XB;
    f32x16 acc;
#pragma unroll
    for (int r = 0; r < 16; ++r) acc[r] = 0.f;
#pragma unroll
    for (int ks = 0; ks < 8; ++ks) {
      bf16x8 a = *(const bf16x8*)(BT + (nb * 32 + l31) * SSD_TSTR + (ks * 16 + hh * 8) * 2);
      bf16x8 bb = *(const bf16x8*)(XT + (pb * 32 + l31) * SSD_TSTR + (ks * 16 + hh * 8) * 2);
      acc = __builtin_amdgcn_mfma_f32_32x32x16_bf16(a, bb, acc, 0, 0, 0);
    }
    bf16_t* dst = p.ssl + ((size_t)(((dir * 2 + b) * 8 + h) * 66 + c) * 64 + pb * 32 + l31) * 64 + nb * 32 + 4 * hh;
#pragma unroll
    for (int q4 = 0; q4 < 4; ++q4) {
      u32x2 w; w.x = pack2(acc[4 * q4], acc[4 * q4 + 1]); w.y = pack2(acc[4 * q4 + 2], acc[4 * q4 + 3]);
      *(u32x2*)(dst + 8 * q4) = w;
    }
  }
  if (tid == 0) {
    p.sdec[((0 * 2 + b) * 8 + h) * 66 + c] = __expf(cfl);
    p.sdec[((1 * 2 + b) * 8 + h) * 66 + c] = __expf(cbl);
  }
}

__device__ __forceinline__ void phase_ssdcarry(const Params& p) {
  const int total = 32 * 1024;
  for (int i = bidx() * NTHR + tidx(); i < total; i += gridDim.x * NTHR) {
    const int seq = i >> 10, el = (i & 1023) * 4;
    const int dir = seq >> 4;
    bf16_t* base = p.ssl + (size_t)seq * 66 * 4096 + el;
    const float* dec = p.sdec + seq * 66;
    float st[4] = {0.f, 0.f, 0.f, 0.f};
#pragma unroll 22
    for (int k = 0; k < 66; ++k) {
      int c = dir == 0 ? (k < 2 ? 64 + k : k - 2) : (65 - k);
      u32x2 v = *(const u32x2*)(base + (size_t)c * 4096);
      float d = dec[c];
      u32x2 w; w.x = pack2(st[0], st[1]); w.y = pack2(st[2], st[3]);
      *(u32x2*)(base + (size_t)c * 4096) = w;
      st[0] = d * st[0] + __uint_as_float(v.x << 16); st[1] = d * st[1] + __uint_as_float(v.x & 0xffff0000u);
      st[2] = d * st[2] + __uint_as_float(v.y << 16); st[3] = d * st[3] + __uint_as_float(v.y & 0xffff0000u);
    }
  }
}

__device__ __forceinline__ void ssdC_item(const Params& p, int layer, int item) {
  const int tid = tidx(), wid = tid >> 6, lane = tid & 63, l31 = lane & 31, hh = lane >> 5;
  const int b = item / 528, c = (item / 8) % 66, h = item & 7, g = h >> 2;
  const int row0 = chunk_row0(b, c);
  float* fl = (float*)smem;
  char* Bt = smem + 4096;
  char* XT = Bt + 128 * 144;
  __syncthreads();
  ssd_scans(p, layer, row0, h, fl);
  {
#pragma unroll
    for (int i = 0; i < 4; ++i) {
      int id = tid + 256 * i, r = id >> 3, c16 = id & 7;
      *(u32x4*)(Bt + r * 144 + c16 * 16) = *(const u32x4*)(p.xbc + (size_t)(row0 + r) * 768 + 512 + g * 64 + c16 * 8);
    }
    const int s = tid >> 1, half = tid & 1;
    const bf16_t* xr = p.xbc + (size_t)(row0 + s) * 768 + h * 64 + half * 32;
#pragma unroll
    for (int i = 0; i < 4; ++i) {
      u32x4 xv = *(const u32x4*)(xr + i * 8);
#pragma unroll
      for (int e = 0; e < 4; ++e) {
        int pp = half * 32 + i * 8 + 2 * e;
        *(bf16_t*)(XT + pp * SSD_TSTR + s * 2) = (bf16_t)(xv[e] & 0xffffu);
        *(bf16_t*)(XT + (pp + 1) * SSD_TSTR + s * 2) = (bf16_t)(xv[e] >> 16);
      }
    }
  }
  __syncthreads();
  const int s = wid * 32 + l31;
  const float cfs = fl[s], cbs = fl[128 + s];
  bf16x8 cf[4];
#pragma unroll
  for (int ks = 0; ks < 4; ++ks) cf[ks] = *(const bf16x8*)(p.xbc + (size_t)(row0 + s) * 768 + 640 + g * 64 + ks * 16 + hh * 8);
  f32x16 Y[2];
  {
    f32x16 aF[2], aB[2];
#pragma unroll
    for (int pb = 0; pb < 2; ++pb)
#pragma unroll
      for (int r = 0; r < 16; ++r) { aF[pb][r] = 0.f; aB[pb][r] = 0.f; }
    const bf16_t* spf = p.ssl + (size_t)(((0 * 2 + b) * 8 + h) * 66 + c) * 4096;
    const bf16_t* spb = p.ssl + (size_t)(((1 * 2 + b) * 8 + h) * 66 + c) * 4096;
#pragma unroll
    for (int pb = 0; pb < 2; ++pb)
#pragma unroll
      for (int ks = 0; ks < 4; ++ks) {
        bf16x8 a0 = *(const bf16x8*)(spf + (pb * 32 + l31) * 64 + ks * 16 + hh * 8);
        bf16x8 a1 = *(const bf16x8*)(spb + (pb * 32 + l31) * 64 + ks * 16 + hh * 8);
        aF[pb] = __builtin_amdgcn_mfma_f32_32x32x16_bf16(a0, cf[ks], aF[pb], 0, 0, 0);
        aB[pb] = __builtin_amdgcn_mfma_f32_32x32x16_bf16(a1, cf[ks], aB[pb], 0, 0, 0);
      }
    const float ef = __expf(cfs), eb = __expf(cbs);
#pragma unroll
    for (int pb = 0; pb < 2; ++pb)
#pragma unroll
      for (int r = 0; r < 16; ++r) Y[pb][r] = aF[pb][r] * ef + aB[pb][r] * eb;
  }
  for (int rb = 0; rb < 4; ++rb) {
    f32x16 gt;
#pragma unroll
    for (int r = 0; r < 16; ++r) gt[r] = 0.f;
#pragma unroll
    for (int ks = 0; ks < 4; ++ks) {
      bf16x8 a = *(const bf16x8*)(Bt + (rb * 32 + l31) * 144 + (ks * 16 + hh * 8) * 2);
      gt = __builtin_amdgcn_mfma_f32_32x32x16_bf16(a, cf[ks], gt, 0, 0, 0);
    }
#pragma unroll
    for (int dir = 0; dir < 2; ++dir) {
      if (dir == 0 ? (rb > wid) : (rb < wid)) continue;
      const float* cum = fl + (dir == 0 ? 0 : 128);
      const float* dta = fl + (dir == 0 ? 256 : 384);
      const float cs = dir == 0 ? cfs : cbs;
      float val[16];
#pragma unroll
      for (int q4 = 0; q4 < 4; ++q4) {
        int r0 = rb * 32 + 8 * q4 + 4 * hh;
        f32x4 cr = *(const f32x4*)(cum + r0), dr = *(const f32x4*)(dta + r0);
#pragma unroll
        for (int e = 0; e < 4; ++e) {
          int r = r0 + e;
          bool keep = dir == 0 ? (r <= s) : (r >= s);
          float arg = fminf(cs - cr[e], 0.f);
          val[4 * q4 + e] = keep ? gt[4 * q4 + e] * __expf(arg) * dr[e] : 0.f;
        }
      }
#pragma unroll
      for (int sp = 0; sp < 2; ++sp) {
        u32x4 w;
#pragma unroll
        for (int e = 0; e < 4; ++e) w[e] = pack2(val[8 * sp + 2 * e], val[8 * sp + 2 * e + 1]);
        bf16x8 pf = *(bf16x8*)&w;
#pragma unroll
        for (int pb = 0; pb < 2; ++pb) {
          const char* xa = XT + (pb * 32 + l31) * SSD_TSTR + (rb * 32 + 16 * sp + 4 * hh) * 2;
          u32x2 v0 = *(const u32x2*)xa, v1 = *(const u32x2*)(xa + 16);
          u32x4 vw = {v0[0], v0[1], v1[0], v1[1]};
          Y[pb] = __builtin_amdgcn_mfma_f32_32x32x16_bf16(*(bf16x8*)&vw, pf, Y[pb], 0, 0, 0);
        }
      }
    }
  }
  bf16_t* op = p.yf + (size_t)(row0 + s) * 512 + h * 64;
#pragma unroll
  for (int pb = 0; pb < 2; ++pb)
#pragma unroll
    for (int q4 = 0; q4 < 4; ++q4) {
      u32x2 w; w.x = pack2(Y[pb][4 * q4], Y[pb][4 * q4 + 1]); w.y = pack2(Y[pb][4 * q4 + 2], Y[pb][4 * q4 + 3]);
      *(u32x2*)(op + pb * 32 + 8 * q4 + 4 * hh) = w;
    }
}

__device__ __forceinline__ void phase_ssdout(const Params& p, int layer, int nrows) {
  const int lane = tidx() & 63, wv = tidx() >> 6;
  const float* ng = p.ssd_norm + layer * 512;
  for (int row = bidx() * 4 + wv; row < nrows; row += gridDim.x * 4) {
    int c0 = lane * 8; int h = c0 >> 6;
    float Dk = p.ssd_d[layer * 8 + h];
    u32x4 a = *(const u32x4*)(p.yf + (size_t)row * 512 + c0);
    u32x4 xs = *(const u32x4*)(p.xbc + (size_t)row * 768 + c0), z = *(const u32x4*)(p.proj + (size_t)row * 4096 + 768 + c0);
    float y[8]; float ss = 0.f;
#pragma unroll
    for (int e = 0; e < 4; ++e) {
      float y0 = __uint_as_float(a[e] << 16) + __uint_as_float(xs[e] << 16) * Dk;
      float y1 = __uint_as_float(a[e] & 0xffff0000u) + __uint_as_float(xs[e] & 0xffff0000u) * Dk;
      y0 *= siluf_(__uint_as_float(z[e] << 16)); y1 *= siluf_(__uint_as_float(z[e] & 0xffff0000u));
      y[2 * e] = y0; y[2 * e + 1] = y1; ss += y0 * y0 + y1 * y1;
    }
    ss = wave_sum(ss);
    float rs = rsqrtf(ss * (1.f / 512.f) + 1e-6f);
    u32x4 w;
#pragma unroll
    for (int e = 0; e < 4; ++e) w[e] = pack2(y[2 * e] * rs * ng[c0 + 2 * e], y[2 * e + 1] * rs * ng[c0 + 2 * e + 1]);
    *(u32x4*)(p.br + (size_t)row * 1536 + 512 + c0) = w;
  }
}

__device__ __forceinline__ float wave_incl_maxscan(float v, int lane) {
#pragma unroll
  for (int o = 1; o < 64; o <<= 1) { float t = __shfl_up(v, o); if (lane >= o) v = fmaxf(v, t); }
  return v;
}
__device__ __forceinline__ void ml_scans(const Params& p, int layer, int row0, int h, float* fl) {
  const int tid = tidx(), lane = tid & 63, wv = tid >> 6;
  const int dir = tid >> 7;
  const int s = dir == 0 ? tid : 127 - (tid - 128);
  const float ip = p.small[(size_t)(row0 + s) * 32 + 16 + dir * 8 + h] + p.ml_gate_bias[layer * 16 + dir * 8 + h];
  const float fp = p.small[(size_t)(row0 + s) * 32 + 16 + dir * 8 + 4 + h] + p.ml_gate_bias[layer * 16 + dir * 8 + 4 + h];
  float bc = wave_incl_scan(logsigmoidf_(fp), lane);
  if (lane == 63) fl[768 + wv] = bc;
  __syncthreads();
  if (wv & 1) bc += fl[768 + wv - 1];
  const float u = ip - bc;
  float pm = wave_incl_maxscan(u, lane);
  if (lane == 63) fl[776 + wv] = pm;
  __syncthreads();
  if (wv & 1) pm = fmaxf(pm, fl[776 + wv - 1]);
  fl[dir * 128 + s] = bc; fl[256 + dir * 128 + s] = u; fl[512 + dir * 128 + s] = pm;
  __syncthreads();
}

#define ML_TSTR 272
__device__ __forceinline__ void mlA_item(const Params& p, int layer, int item) {
  const int tid = tidx(), wid = tid >> 6, lane = tid & 63, l31 = lane & 31, hh = lane >> 5;
  const int b = item / 264, c = (item / 4) % 66, h = item & 3;
  const int row0 = chunk_row0(b, c);
  float* fl = (float*)smem;
  char* KT = smem + 8192;
  char* VW = KT + 128 * ML_TSTR;
  __syncthreads();
  ml_scans(p, layer, row0, h, fl);
  const int r_ = tid >> 1, half = tid & 1;
  {
    const bf16_t* kr = p.proj + (size_t)(row0 + r_) * 4096 + 2560 + h * 128 + half * 64;
#pragma unroll
    for (int i = 0; i < 8; ++i) {
      u32x4 kv = *(const u32x4*)(kr + i * 8);
#pragma unroll
      for (int e = 0; e < 4; ++e) {
        int ee = half * 64 + i * 8 + 2 * e;
        *(bf16_t*)(KT + ee * ML_TSTR + r_ * 2) = (bf16_t)(kv[e] & 0xffffu);
        *(bf16_t*)(KT + (ee + 1) * ML_TSTR + r_ * 2) = (bf16_t)(kv[e] >> 16);
      }
    }
  }
  for (int dir = 0; dir < 2; ++dir) {
    const int seq = (dir * 2 + b) * 4 + h;
    const float blast = fl[dir * 128 + (dir == 0 ? 127 : 0)];
    const float umax = fl[512 + dir * 128 + (dir == 0 ? 127 : 0)];
    {
      const float wgt = __expf(fl[256 + dir * 128 + r_] - umax) * 0.08838834764831845f;
      if (half == 0) fl[1024 + r_] = wgt;
      const bf16_t* vr = p.proj + (size_t)(row0 + r_) * 4096 + 3072 + h * 128 + half * 64;
#pragma unroll
      for (int i = 0; i < 8; ++i) {
        u32x4 vv = *(const u32x4*)(vr + i * 8);
#pragma unroll
        for (int e = 0; e < 4; ++e) {
          int dd = half * 64 + i * 8 + 2 * e;
          *(bf16_t*)(VW + dd * ML_TSTR + r_ * 2) = f2bf(__uint_as_float(vv[e] << 16) * wgt);
          *(bf16_t*)(VW + (dd + 1) * ML_TSTR + r_ * 2) = f2bf(__uint_as_float(vv[e] & 0xffff0000u) * wgt);
        }
      }
    }
    __syncthreads();
    {
      const int e_ = tid & 127, hf = tid >> 7;
      float a = 0.f;
#pragma unroll
      for (int i = 0; i < 8; ++i) {
        u32x4 kv = *(const u32x4*)(KT + e_ * ML_TSTR + (hf * 64 + i * 8) * 2);
        const float* wp = fl + 1024 + hf * 64 + i * 8;
#pragma unroll
        for (int e = 0; e < 4; ++e) a += __uint_as_float(kv[e] << 16) * wp[2 * e] + __uint_as_float(kv[e] & 0xffff0000u) * wp[2 * e + 1];
      }
      if (hf == 1) fl[1280 + e_] = a;
      __syncthreads();
      if (hf == 0) p.mnl[((size_t)seq * 66 + c) * 128 + e_] = a + fl[1280 + e_];
    }
    f32x16 acc[4];
#pragma unroll
    for (int eb = 0; eb < 4; ++eb)
#pragma unroll
      for (int r = 0; r < 16; ++r) acc[eb][r] = 0.f;
#pragma unroll
    for (int ks = 0; ks < 8; ++ks) {
      bf16x8 bv = *(const bf16x8*)(VW + (wid * 32 + l31) * ML_TSTR + (ks * 16 + hh * 8) * 2);
#pragma unroll
      for (int eb = 0; eb < 4; ++eb) {
        bf16x8 av = *(const bf16x8*)(KT + (eb * 32 + l31) * ML_TSTR + (ks * 16 + hh * 8) * 2);
        acc[eb] = __builtin_amdgcn_mfma_f32_32x32x16_bf16(av, bv, acc[eb], 0, 0, 0);
      }
    }
    bf16_t* dst = p.mcl + (((size_t)seq * 66 + c) * 128 + wid * 32 + l31) * 128 + 4 * hh;
#pragma unroll
    for (int eb = 0; eb < 4; ++eb)
#pragma unroll
      for (int q4 = 0; q4 < 4; ++q4) {
        u32x2 w; w.x = pack2(acc[eb][4 * q4], acc[eb][4 * q4 + 1]); w.y = pack2(acc[eb][4 * q4 + 2], acc[eb][4 * q4 + 3]);
        *(u32x2*)(dst + eb * 32 + 8 * q4) = w;
      }
    if (tid == 0) { p.mml[seq * 66 + c] = blast + umax; p.mbl[seq * 66 + c] = blast; }
    __syncthreads();
  }
}

__device__ __forceinline__ void phase_mlcarry(const Params& p) {
  const int per = 4096 + 32;
  const int total = 16 * per;
  for (int i = bidx() * NTHR + tidx(); i < total; i += gridDim.x * NTHR) {
    const int seq = i / per, j = i % per;
    const int dir = seq >> 3;
    const float* ml = p.mml + seq * 66; const float* bl = p.mbl + seq * 66;
    float m = 0.f;
    float st[4] = {0.f, 0.f, 0.f, 0.f};
    const bool isC = j < 4096;
    bf16_t* cb = p.mcl + (size_t)seq * 66 * 16384 + (isC ? j * 4 : 0);
    float* nb = p.mnl + (size_t)seq * 66 * 128 + (isC ? 0 : (j - 4096) * 4);
#pragma unroll 11
    for (int k = 0; k < 66; ++k) {
      int c = dir == 0 ? (k < 2 ? 64 + k : k - 2) : (65 - k);
      float mlc = ml[c], blc = bl[c];
      float mnew = fmaxf(blc + m, mlc);
      float ap = __expf(blc + m - mnew), al = __expf(mlc - mnew);
      if (isC) {
        u32x2 v = *(const u32x2*)(cb + (size_t)c * 16384);
        u32x2 w; w.x = pack2(st[0], st[1]); w.y = pack2(st[2], st[3]);
        *(u32x2*)(cb + (size_t)c * 16384) = w;
        st[0] = ap * st[0] + al * __uint_as_float(v.x << 16); st[1] = ap * st[1] + al * __uint_as_float(v.x & 0xffff0000u);
        st[2] = ap * st[2] + al * __uint_as_float(v.y << 16); st[3] = ap * st[3] + al * __uint_as_float(v.y & 0xffff0000u);
        if (j == 0) p.mmp[seq * 66 + c] = m;
      } else {
        f32x4 v = *(const f32x4*)(nb + (size_t)c * 128);
        f32x4 w = {st[0], st[1], st[2], st[3]};
        *(f32x4*)(nb + (size_t)c * 128) = w;
        st[0] = ap * st[0] + al * v[0]; st[1] = ap * st[1] + al * v[1]; st[2] = ap * st[2] + al * v[2]; st[3] = ap * st[3] + al * v[3];
      }
      m = mnew;
    }
  }
}

__device__ __forceinline__ void mlC_item(const Params& p, int layer, int item) {
  const int tid = tidx(), wid = tid >> 6, lane = tid & 63, l31 = lane & 31, hh = lane >> 5;
  const int b = item / 264, c = (item / 4) % 66, h = item & 3;
  const int row0 = chunk_row0(b, c);
  float* fl = (float*)smem;
  char* Kt = smem + 8192;
  char* VT = Kt + 128 * ML_TSTR;
  __syncthreads();
  ml_scans(p, layer, row0, h, fl);
  {
#pragma unroll
    for (int i = 0; i < 8; ++i) {
      int id = tid + 256 * i, r = id >> 4, c16 = id & 15;
      *(u32x4*)(Kt + r * ML_TSTR + c16 * 16) = *(const u32x4*)(p.proj + (size_t)(row0 + r) * 4096 + 2560 + h * 128 + c16 * 8);
    }
    const int r_ = tid >> 1, half = tid & 1;
    const bf16_t* vr = p.proj + (size_t)(row0 + r_) * 4096 + 3072 + h * 128 + half * 64;
#pragma unroll
    for (int i = 0; i < 8; ++i) {
      u32x4 vv = *(const u32x4*)(vr + i * 8);
#pragma unroll
      for (int e = 0; e < 4; ++e) {
        int dd = half * 64 + i * 8 + 2 * e;
        *(bf16_t*)(VT + dd * ML_TSTR + r_ * 2) = (bf16_t)(vv[e] & 0xffffu);
        *(bf16_t*)(VT + (dd + 1) * ML_TSTR + r_ * 2) = (bf16_t)(vv[e] >> 16);
      }
    }
    {
      const int dir = tid >> 7, e_ = tid & 127;
      const int seq = (dir * 2 + b) * 4 + h;
      fl[1024 + dir * 128 + e_] = p.mnl[((size_t)seq * 66 + c) * 128 + e_];
    }
  }
  __syncthreads();
  const int s = wid * 32 + l31;
  bf16x8 qf[8];
#pragma unroll
  for (int ks = 0; ks < 8; ++ks) qf[ks] = *(const bf16x8*)(p.proj + (size_t)(row0 + s) * 4096 + 2048 + h * 128 + ks * 16 + hh * 8);
  f32x16 hacc[4];
#pragma unroll
  for (int db = 0; db < 4; ++db)
#pragma unroll
    for (int r = 0; r < 16; ++r) hacc[db][r] = 0.f;
  for (int dir = 0; dir < 2; ++dir) {
    const int seq = (dir * 2 + b) * 4 + h;
    const float mprev = p.mmp[seq * 66 + c];
    const float bcs = fl[dir * 128 + s], pms = fl[512 + dir * 128 + s];
    const float msel = fmaxf(mprev, pms);
    const float ms = bcs + msel;
    const float winter = __expf(mprev - msel);
    const float* uu = fl + 256 + dir * 128;
    float qn = 0.f;
    {
      const float* np = fl + 1024 + dir * 128;
#pragma unroll
      for (int ks = 0; ks < 8; ++ks) {
        u32x4 w = *(u32x4*)&qf[ks];
        const float* npp = np + ks * 16 + hh * 8;
#pragma unroll
        for (int e = 0; e < 4; ++e) qn += __uint_as_float(w[e] << 16) * npp[2 * e] + __uint_as_float(w[e] & 0xffff0000u) * npp[2 * e + 1];
      }
      qn += __shfl_xor(qn, 32);
    }
    float den = 0.f;
    for (int rb = 0; rb < 4; ++rb) {
      if (dir == 0 ? (rb > wid) : (rb < wid)) continue;
      f32x16 st;
#pragma unroll
      for (int r = 0; r < 16; ++r) st[r] = 0.f;
#pragma unroll
      for (int ks = 0; ks < 8; ++ks) {
        bf16x8 a = *(const bf16x8*)(Kt + (rb * 32 + l31) * ML_TSTR + (ks * 16 + hh * 8) * 2);
        st = __builtin_amdgcn_mfma_f32_32x32x16_bf16(a, qf[ks], st, 0, 0, 0);
      }
#pragma unroll
      for (int q4 = 0; q4 < 4; ++q4) {
        int r0 = rb * 32 + 8 * q4 + 4 * hh;
        f32x4 ur = *(const f32x4*)(uu + r0);
#pragma unroll
        for (int e = 0; e < 4; ++e) {
          int r = r0 + e;
          bool keep = dir == 0 ? (r <= s) : (r >= s);
          float arg = fminf(ur[e] - msel, 0.f);
          den += keep ? st[4 * q4 + e] * 0.08838834764831845f * __expf(arg) : 0.f;
        }
      }
    }
    den += __shfl_xor(den, 32);
    den += winter * qn;
    const float inv = 1.f / fmaxf(fabsf(den), __expf(-ms));
    {
      const float qs = winter * inv;
      const bf16_t* cp = p.mcl + ((size_t)seq * 66 + c) * 16384;
#pragma unroll
      for (int ks = 0; ks < 8; ++ks) {
        u32x4 w = *(u32x4*)&qf[ks];
        u32x4 ws;
#pragma unroll
        for (int e = 0; e < 4; ++e) ws[e] = pack2(__uint_as_float(w[e] << 16) * qs, __uint_as_float(w[e] & 0xffff0000u) * qs);
        bf16x8 qsf = *(bf16x8*)&ws;
#pragma unroll
        for (int db = 0; db < 4; ++db) {
          bf16x8 a = *(const bf16x8*)(cp + (db * 32 + l31) * 128 + ks * 16 + hh * 8);
          hacc[db] = __builtin_amdgcn_mfma_f32_32x32x16_bf16(a, qsf, hacc[db], 0, 0, 0);
        }
      }
    }
    for (int rb = 0; rb < 4; ++rb) {
      if (dir == 0 ? (rb > wid) : (rb < wid)) continue;
      f32x16 st;
#pragma unroll
      for (int r = 0; r < 16; ++r) st[r] = 0.f;
#pragma unroll
      for (int ks = 0; ks < 8; ++ks) {
        bf16x8 a = *(const bf16x8*)(Kt + (rb * 32 + l31) * ML_TSTR + (ks * 16 + hh * 8) * 2);
        st = __builtin_amdgcn_mfma_f32_32x32x16_bf16(a, qf[ks], st, 0, 0, 0);
      }
      const float sc = 0.08838834764831845f * inv;
#pragma unroll
      for (int sp = 0; sp < 2; ++sp) {
        u32x4 w;
#pragma unroll
        for (int q2 = 0; q2 < 2; ++q2) {
          int q4 = 2 * sp + q2;
          int r0 = rb * 32 + 8 * q4 + 4 * hh;
          f32x4 ur = *(const f32x4*)(uu + r0);
          float v[4];
#pragma unroll
          for (int e = 0; e < 4; ++e) {
            int r = r0 + e;
            bool keep = dir == 0 ? (r <= s) : (r >= s);
            float arg = fminf(ur[e] - msel, 0.f);
            v[e] = keep ? st[4 * q4 + e] * sc * __expf(arg) : 0.f;
          }
          w[2 * q2] = pack2(v[0], v[1]); w[2 * q2 + 1] = pack2(v[2], v[3]);
        }
        bf16x8 pf = *(bf16x8*)&w;
#pragma unroll
        for (int db = 0; db < 4; ++db) {
          const char* va = VT + (db * 32 + l31) * ML_TSTR + (rb * 32 + 16 * sp + 4 * hh) * 2;
          u32x2 v0 = *(const u32x2*)va, v1 = *(const u32x2*)(va + 16);
          u32x4 vw = {v0[0], v0[1], v1[0], v1[1]};
          hacc[db] = __builtin_amdgcn_mfma_f32_32x32x16_bf16(*(bf16x8*)&vw, pf, hacc[db], 0, 0, 0);
        }
      }
    }
  }
  bf16_t* op = p.hf + (size_t)(row0 + s) * 512 + h * 128;
#pragma unroll
  for (int db = 0; db < 4; ++db)
#pragma unroll
    for (int q4 = 0; q4 < 4; ++q4) {
      u32x2 w; w.x = pack2(hacc[db][4 * q4], hacc[db][4 * q4 + 1]); w.y = pack2(hacc[db][4 * q4 + 2], hacc[db][4 * q4 + 3]);
      *(u32x2*)(op + db * 32 + 8 * q4 + 4 * hh) = w;
    }
}

__device__ __forceinline__ void phase_mlout(const Params& p, int layer, int nrows) {
  const int lane = tidx() & 63, wv = tidx() >> 6;
  const float* ng = p.ml_norm + layer * 512;
  for (int row = bidx() * 4 + wv; row < nrows; row += gridDim.x * 4) {
    int c0 = lane * 8;
    u32x4 a = *(const u32x4*)(p.hf + (size_t)row * 512 + c0);
    u32x4 o = *(const u32x4*)(p.proj + (size_t)row * 4096 + 3584 + c0);
    float y[8]; float ss = 0.f;
#pragma unroll
    for (int e = 0; e < 4; ++e) {
      float y0 = __uint_as_float(a[e] << 16);
      float y1 = __uint_as_float(a[e] & 0xffff0000u);
      y[2 * e] = y0; y[2 * e + 1] = y1; ss += y0 * y0 + y1 * y1;
    }
    ss += __shfl_xor(ss, 1); ss += __shfl_xor(ss, 2); ss += __shfl_xor(ss, 4); ss += __shfl_xor(ss, 8);
    float rs = rsqrtf(ss * (1.f / 128.f) + 1e-6f);
    u32x4 w;
#pragma unroll
    for (int e = 0; e < 4; ++e) {
      float o0 = sigmoidf_(__uint_as_float(o[e] << 16)), o1 = sigmoidf_(__uint_as_float(o[e] & 0xffff0000u));
      w[e] = pack2(y[2 * e] * rs * ng[c0 + 2 * e] * o0, y[2 * e + 1] * rs * ng[c0 + 2 * e + 1] * o1);
    }
    *(u32x4*)(p.br + (size_t)row * 1536 + 1024 + c0) = w;
  }
}

__device__ __forceinline__ void phase_uvconv(const Params& p, int layer) {
  const size_t n4 = (size_t)16384 * 1024 / 4;
  const f32x4* su = (const f32x4*)(p.peer_u + (size_t)layer * 16384 * 1024);
  const f32x4* sv = (const f32x4*)(p.peer_v + (size_t)layer * 16384 * 1024);
  u32x2* du = (u32x2*)p.uv; u32x2* dv = (u32x2*)(p.uv + (size_t)16384 * 1024);
  for (size_t i = (size_t)bidx() * NTHR + tidx(); i < n4; i += (size_t)gridDim.x * NTHR) {
    f32x4 a = su[i], b = sv[i];
    u32x2 w; w.x = pack2(a[0], a[1]); w.y = pack2(a[2], a[3]); du[i] = w;
    u32x2 w2; w2.x = pack2(b[0], b[1]); w2.y = pack2(b[2], b[3]); dv[i] = w2;
  }
}

__device__ __forceinline__ void phase_topk(const Params& p, int layer, int nrows) {
#if DIAG_HP
  float* sks = (float*)smem;
  float* qs = (float*)(smem + 2 * 128 * 129 * 4);
#else
  bf16_t* sks = (bf16_t*)smem;
  float* qs = (float*)(smem + 2 * 128 * 130 * 2);
#endif
  const int tid = tidx(), lane = tid & 63, wv = tid >> 6;
  const int nchunks = nrows / 64;
  int cur_h = -1;
  for (int item = bidx(); item < nchunks * 8; item += gridDim.x) {
    int h = item % 8, chunk = item / 8;
    if (h != cur_h) {
      __syncthreads();
#if DIAG_HP
      const float* src = p.peer_subkeys + ((size_t)layer * 8 + h) * 2 * 128 * 128;
      for (int i = tid; i < 2 * 128 * 128; i += NTHR) { int pk = i >> 7, d = i & 127; sks[pk * 129 + d] = src[i]; }
#else
      const bf16_t* src = p.sk + ((size_t)layer * 8 + h) * 2 * 128 * 128;
      for (int i = tid; i < 2 * 128 * 128; i += NTHR) { int pk = i >> 7, d = i & 127; sks[pk * 130 + d] = src[i]; }
#endif
      __syncthreads();
      cur_h = h;
    }
    float* myq = qs + wv * 256;
    for (int ti = 0; ti < 16; ++ti) {
      int row = chunk * 64 + wv * 16 + ti;
#if DIAG_HP
      const float* qp = p.qf + (size_t)row * 2048 + h * 256;
      myq[lane] = qp[lane]; myq[lane + 64] = qp[lane + 64]; myq[lane + 128] = qp[lane + 128]; myq[lane + 192] = qp[lane + 192];
#else
      const bf16_t* qp = p.q + (size_t)row * 2048 + h * 256;
      myq[lane] = bf2f(qp[lane]); myq[lane + 64] = bf2f(qp[lane + 64]); myq[lane + 128] = bf2f(qp[lane + 128]); myq[lane + 192] = bf2f(qp[lane + 192]);
#endif
      __builtin_amdgcn_wave_barrier();
      float s1v = 0.f, s2v = 0.f; int i1v = 0, i2v = 0;
      for (int pp = 0; pp < 2; ++pp) {
        const float* qq = myq + pp * 128;
        float a0 = 0.f, a1 = 0.f;
#if DIAG_HP
        const float* k0 = sks + (pp * 128 + lane) * 129;
        const float* k1 = sks + (pp * 128 + lane + 64) * 129;
#pragma unroll 8
        for (int d = 0; d < 128; ++d) { a0 += qq[d] * k0[d]; a1 += qq[d] * k1[d]; }
#else
        const bf16_t* k0 = sks + (pp * 128 + lane) * 130;
        const bf16_t* k1 = sks + (pp * 128 + lane + 64) * 130;
#pragma unroll 8
        for (int d = 0; d < 128; d += 2) {
          unsigned w0 = *(const unsigned*)(k0 + d), w1 = *(const unsigned*)(k1 + d);
          float q0 = qq[d], q1 = qq[d + 1];
          a0 += q0 * __uint_as_float(w0 << 16) + q1 * __uint_as_float(w0 & 0xffff0000u);
          a1 += q0 * __uint_as_float(w1 << 16) + q1 * __uint_as_float(w1 & 0xffff0000u);
        }
#endif
        float sv = 0.f; int iv = 0;
        for (int r = 0; r < 16; ++r) {
          float mx = wave_max(fmaxf(a0, a1));
          unsigned long long bal = __ballot(a0 == mx || a1 == mx);
          int wl = __ffsll((long long)bal) - 1;
          int key = 0;
          if (lane == wl) { if (a0 == mx) { key = lane; a0 = -3e38f; } else { key = lane + 64; a1 = -3e38f; } }
          key = __shfl(key, wl);
          if (lane == r) { sv = mx; iv = key; }
        }
        if (pp == 0) { s1v = sv; i1v = iv; } else { s2v = sv; i2v = iv; }
      }
      float cs[4]; int ci[4];
      float s1i = __shfl(s1v, lane >> 2); int i1i = __shfl(i1v, lane >> 2);
#pragma unroll
      for (int r = 0; r < 4; ++r) {
        int j = (lane & 3) * 4 + r;
        float s2j = __shfl(s2v, j); int i2j = __shfl(i2v, j);
        cs[r] = s1i + s2j; ci[r] = i1i * 128 + i2j;
      }
      float selv = 0.f; int seli = 0;
      for (int r = 0; r < 16; ++r) {
        float lm = fmaxf(fmaxf(cs[0], cs[1]), fmaxf(cs[2], cs[3]));
        float mx = wave_max(lm);
        unsigned long long bal = __ballot(lm == mx);
        int wl = __ffsll((long long)bal) - 1;
        int id = 0;
        if (lane == wl) {
          if (cs[0] == mx) { id = ci[0]; cs[0] = -3e38f; }
          else if (cs[1] == mx) { id = ci[1]; cs[1] = -3e38f; }
          else if (cs[2] == mx) { id = ci[2]; cs[2] = -3e38f; }
          else { id = ci[3]; cs[3] = -3e38f; }
        }
        id = __shfl(id, wl);
        if (lane == r) { selv = mx; seli = id; }
      }
      float top = __shfl(selv, 0);
      float e = lane < 16 ? __expf(selv - top) : 0.f;
      float sum = wave_sum(e);
      if (lane < 16) {
        p.idx[(size_t)row * 128 + h * 16 + lane] = seli;
        p.gw[(size_t)row * 128 + h * 16 + lane] = e / sum;
      }
      __builtin_amdgcn_wave_barrier();
    }
  }
}

__device__ __forceinline__ void phase_uvconv8(const Params& p, int layer) {
  const int lane = tidx() & 63, wv = tidx() >> 6;
  for (int row = bidx() * 4 + wv; row < 32768; row += gridDim.x * 4) {
    const float* src = (row < 16384 ? p.peer_u + ((size_t)layer * 16384 + row) * 1024 : p.peer_v + ((size_t)layer * 16384 + (row - 16384)) * 1024) + lane * 16;
    f32x4 a[4]; float amax = 0.f;
#pragma unroll
    for (int i = 0; i < 4; ++i) {
      a[i] = *(const f32x4*)(src + 4 * i);
#pragma unroll
      for (int e = 0; e < 4; ++e) amax = fmaxf(amax, fabsf(a[i][e]));
    }
    amax = wave_max(amax);
    const float scale = amax > 0.f ? amax * (1.f / 127.f) : 1.f;
    const float inv = 1.f / scale;
    u32x4 w;
#pragma unroll
    for (int i = 0; i < 4; ++i) {
      unsigned q = 0;
#pragma unroll
      for (int e = 0; e < 4; ++e) {
        int v = (int)rintf(a[i][e] * inv);
        v = v < -127 ? -127 : (v > 127 ? 127 : v);
        q |= (unsigned)(v & 0xff) << (8 * e);
      }
      w[i] = q;
    }
    if (row < 16384) *(u32x4*)(p.uvq + (size_t)row * 1024 + lane * 16) = w;
    else *(u32x4*)(p.uvq + (size_t)16384 * 1024 + ((size_t)(lane >> 3) * 16384 + (row - 16384)) * 128 + (lane & 7) * 16) = w;
    if (lane == 0) p.uvs[row] = scale;
  }
}


__device__ __forceinline__ void phase_gather8(const Params& p, int layer, int nrows, float oscale, int fuse_norm) {
  const int lane = tidx() & 63, wv = tidx() >> 6;
  const unsigned char* U8 = p.uvq; const unsigned char* V8 = p.uvq + (size_t)16384 * 1024;
  const float* US = p.uvs; const float* VS = p.uvs + 16384;
  const int klane = ((lane >> 5) & 1) * 4 + ((lane >> 4) & 1) * 2 + ((lane >> 3) & 1);
  for (int row = bidx() * 4 + wv; row < nrows; row += gridDim.x * 4) {
    float xv[16], acc[16];
    {
      u32x4 a = *(const u32x4*)(p.h + (size_t)row * DM + lane * 16), b = *(const u32x4*)(p.h + (size_t)row * DM + lane * 16 + 8);
#pragma unroll
      for (int e = 0; e < 4; ++e) {
        xv[2 * e] = __uint_as_float(a[e] << 16); xv[2 * e + 1] = __uint_as_float(a[e] & 0xffff0000u);
        xv[8 + 2 * e] = __uint_as_float(b[e] << 16); xv[8 + 2 * e + 1] = __uint_as_float(b[e] & 0xffff0000u);
      }
    }
    float xs = 0.f;
#pragma unroll
    for (int i = 0; i < 16; ++i) { acc[i] = 0.f; xs += xv[i]; }
    xs = wave_sum(xs) * 128.f;
    const int myidx0 = p.idx[(size_t)row * 128 + lane], myidx1 = p.idx[(size_t)row * 128 + 64 + lane];
    const float myg0 = p.gw[(size_t)row * 128 + lane], myg1 = p.gw[(size_t)row * 128 + 64 + lane];
    float wsum = 0.f;
    for (int k0 = 0; k0 < 128; k0 += 8) {
      const int srcv = k0 < 64 ? myidx0 : myidx1;
      const float srcg = k0 < 64 ? myg0 : myg1;
      const int kb = k0 & 63;
      u32x4 uq[8], vq[8];
#pragma unroll
      for (int j = 0; j < 8; ++j) {
        const int e_ = __builtin_amdgcn_readlane(srcv, kb + j);
        uq[j] = *(const u32x4*)(U8 + (size_t)e_ * 1024 + lane * 16);
        vq[j] = *(const u32x4*)(V8 + (size_t)e_ * 1024 + lane * 16);
      }
      const int el = __shfl(srcv, kb + klane);
      const float gl = __shfl(srcg, kb + klane);
      const float sul = US[el], svl = VS[el];
      float d[8];
#pragma unroll
      for (int j = 0; j < 8; ++j) {
        float s = 0.f;
#pragma unroll
        for (int c = 0; c < 4; ++c) {
          s += xv[4 * c] * ub0(uq[j][c]) + xv[4 * c + 1] * ub1(uq[j][c]) + xv[4 * c + 2] * ub2(uq[j][c]) + xv[4 * c + 3] * ub3(uq[j][c]);
        }
        d[j] = s;
      }
      float r4[4], r2[2], t;
      const bool b5 = lane & 32, b4 = lane & 16, b3 = lane & 8;
#pragma unroll
      for (int j = 0; j < 4; ++j) { float keep = b5 ? d[j + 4] : d[j], send = b5 ? d[j] : d[j + 4]; r4[j] = keep + __shfl_xor(send, 32); }
#pragma unroll
      for (int j = 0; j < 2; ++j) { float keep = b4 ? r4[j + 2] : r4[j], send = b4 ? r4[j] : r4[j + 2]; r2[j] = keep + __shfl_xor(send, 16); }
      { float keep = b3 ? r2[1] : r2[0], send = b3 ? r2[0] : r2[1]; t = keep + __shfl_xor(send, 8); }
      t += __shfl_xor(t, 4); t += __shfl_xor(t, 2); t += __shfl_xor(t, 1);
      const float dot = sul * (t - xs);
      const float wl = PEER_ALPHA * oscale * gl * gelu_tanh(dot) * svl;
#pragma unroll
      for (int j = 0; j < 8; ++j) {
        const float w = __int_as_float(__builtin_amdgcn_readlane(__float_as_int(wl), ((j >> 2) & 1) * 32 + ((j >> 1) & 1) * 16 + (j & 1) * 8));
        wsum += w;
#pragma unroll
        for (int c = 0; c < 4; ++c) {
          acc[4 * c] += w * ub0(vq[j][c]); acc[4 * c + 1] += w * ub1(vq[j][c]); acc[4 * c + 2] += w * ub2(vq[j][c]); acc[4 * c + 3] += w * ub3(vq[j][c]);
        }
      }
    }
    const float off = 128.f * wsum;
    float* xr = xrow(p, row) + lane * 16;
    const float* g2 = p.mod + (size_t)(layer * 3 + modrow(row)) * 6144 + 5 * DM + lane * 16;
    f32x4 xn[4]; float ss = 0.f;
#pragma unroll
    for (int c = 0; c < 4; ++c) {
      f32x4 x0 = *(const f32x4*)(xr + 4 * c), ga = *(const f32x4*)(g2 + 4 * c);
#pragma unroll
      for (int e = 0; e < 4; ++e) { x0[e] += ga[e] * (acc[4 * c + e] - off); ss += x0[e] * x0[e]; }
      *(f32x4*)(xr + 4 * c) = x0;
      xn[c] = x0;
    }
    if (fuse_norm) {
      ss = wave_sum(ss);
      const float rs = rsqrtf(ss * (1.f / DM) + 1e-6f);
      const float* gn = p.norm1_g + (layer + 1) * DM + lane * 16;
      const float* md = p.mod + (size_t)((layer + 1) * 3 + modrow(row)) * 6144 + lane * 16;
      u32x4 w0, w1;
#pragma unroll
      for (int c = 0; c < 4; ++c) {
        f32x4 gg = *(const f32x4*)(gn + 4 * c), sc = *(const f32x4*)(md + DM + 4 * c), sh = *(const f32x4*)(md + 4 * c);
        float o0 = xn[c][0] * rs * gg[0] * (1.f + sc[0]) + sh[0], o1 = xn[c][1] * rs * gg[1] * (1.f + sc[1]) + sh[1];
        float o2 = xn[c][2] * rs * gg[2] * (1.f + sc[2]) + sh[2], o3 = xn[c][3] * rs * gg[3] * (1.f + sc[3]) + sh[3];
        if (c < 2) { w0[2 * c] = pack2(o0, o1); w0[2 * c + 1] = pack2(o2, o3); } else { w1[2 * (c - 2)] = pack2(o0, o1); w1[2 * (c - 2) + 1] = pack2(o2, o3); }
      }
      *(u32x4*)(p.h + (size_t)row * DM + lane * 16) = w0;
      *(u32x4*)(p.h + (size_t)row * DM + lane * 16 + 8) = w1;
    }
  }
}

__device__ __forceinline__ void phase_gatherU(const Params& p, int layer, int nrows) {
  const int lane = tidx() & 63, wv = tidx() >> 6;
  const int part = bidx() & 7, vb = bidx() >> 3, nvb = (gridDim.x - part + 7) >> 3;
  const signed char* U8 = (const signed char*)p.uvq;
  const float* US = p.uvs; const float* VS = p.uvs + 16384;
  int* list = (int*)(smem + wv * 512);
  const int klane = ((lane >> 5) & 1) * 4 + ((lane >> 4) & 1) * 2 + ((lane >> 3) & 1);
  for (int row = vb * 4 + wv; row < nrows; row += nvb * 4) {
    const int i0 = p.idx[(size_t)row * 128 + lane], i1 = p.idx[(size_t)row * 128 + 64 + lane];
    const bool in0 = (i0 >> 11) == part, in1 = (i1 >> 11) == part;
    const unsigned long long m0 = __ballot(in0), m1 = __ballot(in1);
    const int c0 = __popcll(m0), cnt = c0 + __popcll(m1);
    if (cnt == 0) continue;
    const int r0 = __builtin_amdgcn_mbcnt_hi((unsigned)(m0 >> 32), __builtin_amdgcn_mbcnt_lo((unsigned)m0, 0));
    const int r1 = c0 + __builtin_amdgcn_mbcnt_hi((unsigned)(m1 >> 32), __builtin_amdgcn_mbcnt_lo((unsigned)m1, 0));
    __builtin_amdgcn_wave_barrier();
    if (in0) list[r0] = (lane << 16) | i0;
    if (in1) list[r1] = ((64 + lane) << 16) | i1;
    __builtin_amdgcn_wave_barrier();
    const u32x4 xq = *(const u32x4*)(p.xq + (size_t)row * DM + lane * 16);
    const float sx = p.sxq[row];
    for (int b = 0; b < cnt; b += 8) {
      u32x4 uq[8];
#pragma unroll
      for (int j = 0; j < 8; ++j) {
        const int q = b + j < cnt ? b + j : cnt - 1;
        const int e_ = __builtin_amdgcn_readfirstlane(list[q]) & 16383;
        uq[j] = *(const u32x4*)(U8 + (size_t)e_ * 1024 + lane * 16);
      }
      const int qk = b + klane < cnt ? b + klane : cnt - 1;
      const int entk = list[qk];
      const int el = entk & 16383, slot = entk >> 16;
      const float sul = US[el], svl = VS[el], gl = p.gw[(size_t)row * 128 + slot];
      int d[8];
#pragma unroll
      for (int j = 0; j < 8; ++j) {
        int a = 0;
#pragma unroll
        for (int c = 0; c < 4; ++c) a = __builtin_amdgcn_sdot4((int)xq[c], (int)uq[j][c], a, false);
        d[j] = a;
      }
      int r4[4], r2[2], t;
      const bool b5 = lane & 32, b4 = lane & 16, b3 = lane & 8;
#pragma unroll
      for (int j = 0; j < 4; ++j) { int keep = b5 ? d[j + 4] : d[j], send = b5 ? d[j] : d[j + 4]; r4[j] = keep + __shfl_xor(send, 32); }
#pragma unroll
      for (int j = 0; j < 2; ++j) { int keep = b4 ? r4[j + 2] : r4[j], send = b4 ? r4[j] : r4[j + 2]; r2[j] = keep + __shfl_xor(send, 16); }
      { int keep = b3 ? r2[1] : r2[0], send = b3 ? r2[0] : r2[1]; t = keep + __shfl_xor(send, 8); }
      t += __shfl_xor(t, 4); t += __shfl_xor(t, 2); t += __shfl_xor(t, 1);
      const float dot = sul * sx * (float)t;
      const float wl = PEER_ALPHA * gl * gelu_tanh(dot) * svl;
      if ((lane & 7) == 0 && b + klane < cnt) p.wbuf[(size_t)row * 128 + slot] = wl;
    }
  }
}

__device__ __forceinline__ void phase_gatherV(const Params& p, int layer, int nrows) {
  const int lane = tidx() & 63, wv = tidx() >> 6;
  const int part = bidx() & 7, vb = bidx() >> 3, nvb = (gridDim.x - part + 7) >> 3;
  const signed char* V8 = (const signed char*)p.uvq + (size_t)16384 * 1024 + (size_t)part * 16384 * 128 + (lane & 7) * 16;
  const int g = lane >> 3;
  const bool b5 = lane & 32, b4 = lane & 16, b3 = lane & 8;
  const int col = part * 128 + (lane & 7) * 16 + ((lane >> 5) & 1) * 8 + ((lane >> 4) & 1) * 4 + ((lane >> 3) & 1) * 2;
  for (int row = vb * 4 + wv; row < nrows; row += nvb * 4) {
    i32x4 ie[4]; f32x4 we[4];
#pragma unroll
    for (int i = 0; i < 4; ++i) {
      ie[i] = *(const i32x4*)(p.idx + (size_t)row * 128 + g * 16 + 4 * i);
      we[i] = *(const f32x4*)(p.wbuf + (size_t)row * 128 + g * 16 + 4 * i);
    }
    u32x4 vq[16];
#pragma unroll
    for (int j = 0; j < 16; ++j) vq[j] = *(const u32x4*)(V8 + (size_t)ie[j >> 2][j & 3] * 128);
    float mx = 0.f;
#pragma unroll
    for (int i = 0; i < 4; ++i) mx = fmaxf(fmaxf(fmaxf(mx, fabsf(we[i][0])), fmaxf(fabsf(we[i][1]), fabsf(we[i][2]))), fabsf(we[i][3]));
    mx = fmaxf(mx, __shfl_xor(mx, 8)); mx = fmaxf(mx, __shfl_xor(mx, 16)); mx = fmaxf(mx, __shfl_xor(mx, 32));
    const float sw = mx > 0.f ? mx * (1.f / 127.f) : 1.f, inw = 1.f / sw;
    int wq4[4];
#pragma unroll
    for (int i = 0; i < 4; ++i) {
      unsigned q = 0;
#pragma unroll
      for (int e = 0; e < 4; ++e) { int t = (int)rintf(we[i][e] * inw); t = t < -127 ? -127 : (t > 127 ? 127 : t); q |= (unsigned)(t & 0xff) << (8 * e); }
      wq4[i] = (int)q;
    }
    int acc[16];
#pragma unroll
    for (int i = 0; i < 16; ++i) acc[i] = 0;
#pragma unroll
    for (int grp = 0; grp < 4; ++grp) {
#pragma unroll
      for (int dw = 0; dw < 4; ++dw) {
        const unsigned D0 = vq[4 * grp][dw], D1 = vq[4 * grp + 1][dw], D2 = vq[4 * grp + 2][dw], D3 = vq[4 * grp + 3][dw];
        const unsigned P0 = __builtin_amdgcn_perm(D1, D0, 0x05010400u), P1 = __builtin_amdgcn_perm(D1, D0, 0x07030602u);
        const unsigned Q0 = __builtin_amdgcn_perm(D3, D2, 0x05010400u), Q1 = __builtin_amdgcn_perm(D3, D2, 0x07030602u);
        const unsigned T0 = __builtin_amdgcn_perm(Q0, P0, 0x05040100u), T1 = __builtin_amdgcn_perm(Q0, P0, 0x07060302u);
        const unsigned T2 = __builtin_amdgcn_perm(Q1, P1, 0x05040100u), T3 = __builtin_amdgcn_perm(Q1, P1, 0x07060302u);
        acc[4 * dw] = __builtin_amdgcn_sdot4((int)T0, wq4[grp], acc[4 * dw], false);
        acc[4 * dw + 1] = __builtin_amdgcn_sdot4((int)T1, wq4[grp], acc[4 * dw + 1], false);
        acc[4 * dw + 2] = __builtin_amdgcn_sdot4((int)T2, wq4[grp], acc[4 * dw + 2], false);
        acc[4 * dw + 3] = __builtin_amdgcn_sdot4((int)T3, wq4[grp], acc[4 * dw + 3], false);
      }
    }
    int r8[8], r4[4], r2[2];
#pragma unroll
    for (int j = 0; j < 8; ++j) { int keep = b5 ? acc[j + 8] : acc[j], send = b5 ? acc[j] : acc[j + 8]; r8[j] = keep + __shfl_xor(send, 32); }
#pragma unroll
    for (int j = 0; j < 4; ++j) { int keep = b4 ? r8[j + 4] : r8[j], send = b4 ? r8[j] : r8[j + 4]; r4[j] = keep + __shfl_xor(send, 16); }
#pragma unroll
    for (int j = 0; j < 2; ++j) { int keep = b3 ? r4[j + 2] : r4[j], send = b3 ? r4[j] : r4[j + 2]; r2[j] = keep + __shfl_xor(send, 8); }
    float* xr = xrow(p, row) + col;
    const float* g2 = p.mod + (size_t)(layer * 3 + modrow(row)) * 6144 + 5 * DM + col;
    f32x2 x0 = *(const f32x2*)xr; const f32x2 ga = *(const f32x2*)g2;
    x0[0] += ga[0] * sw * (float)r2[0]; x0[1] += ga[1] * sw * (float)r2[1];
    *(f32x2*)xr = x0;
  }
}

__device__ __forceinline__ unsigned f2key(float f) { unsigned u = __float_as_uint(f); return (u & 0x80000000u) ? ~u : (u | 0x80000000u); }
__device__ __forceinline__ float key2f(unsigned k) { unsigned u = (k & 0x80000000u) ? (k ^ 0x80000000u) : ~k; return __uint_as_float(u); }
#define INS16(L, vv) { unsigned v_ = (vv); _Pragma("unroll") for (int j_ = 0; j_ < 16; ++j_) { unsigned hi_ = max(L[j_], v_); v_ = min(L[j_], v_); L[j_] = hi_; } }
__device__ __forceinline__ unsigned sel16(const unsigned (&a)[16], unsigned i) {
  unsigned t[8], u[4], v[2];
#pragma unroll
  for (int k = 0; k < 8; ++k) t[k] = (i & 1u) ? a[2 * k + 1] : a[2 * k];
#pragma unroll
  for (int k = 0; k < 4; ++k) u[k] = (i & 2u) ? t[2 * k + 1] : t[2 * k];
#pragma unroll
  for (int k = 0; k < 2; ++k) v[k] = (i & 4u) ? u[2 * k + 1] : u[2 * k];
  return (i & 8u) ? v[1] : v[0];
}

__device__ __forceinline__ void sort16_desc(unsigned (&a)[16]) {
#pragma unroll
  for (int k = 2; k <= 16; k <<= 1)
#pragma unroll
    for (int j = k >> 1; j > 0; j >>= 1)
#pragma unroll
      for (int i = 0; i < 16; ++i) {
        const int l = i ^ j;
        if (l > i) {
          const unsigned hi = max(a[i], a[l]), lo = min(a[i], a[l]);
          if ((i & k) == 0) { a[i] = hi; a[l] = lo; } else { a[i] = lo; a[l] = hi; }
        }
      }
}
__device__ __forceinline__ void merge16_desc(unsigned (&L)[16], const unsigned (&g)[16]) {
#pragma unroll
  for (int i = 0; i < 16; ++i) L[i] = max(L[i], g[15 - i]);
#pragma unroll
  for (int j = 8; j > 0; j >>= 1)
#pragma unroll
    for (int i = 0; i < 16; ++i) {
      const int l = i ^ j;
      if (l > i) { const unsigned hi = max(L[i], L[l]), lo = min(L[i], L[l]); L[i] = hi; L[l] = lo; }
    }
}
__device__ __forceinline__ void phase_topk2(const Params& p, int layer, int nrows) {
  char* SK = smem;
  const int tid = tidx(), wid = tid >> 6, lane = tid & 63, l31 = lane & 31, hh = lane >> 5;
  const int ntiles = nrows / 128;
  int cur_h = -1;
  for (int item = bidx(); item < ntiles * 8; item += gridDim.x) {
    const int h = item & 7, tile = item >> 3;
    if (h != cur_h) {
      __syncthreads();
      const bf16_t* src = p.sk + ((size_t)layer * 8 + h) * 2 * 128 * 128;
#pragma unroll
      for (int i = 0; i < 16; ++i) {
        int id = tid + 256 * i, row = id >> 4, c16 = id & 15;
        *(u32x4*)(SK + row * 272 + c16 * 16) = *(const u32x4*)(src + (size_t)row * 128 + c16 * 8);
      }
      __syncthreads();
      cur_h = h;
    }
    const int row = tile * 128 + wid * 32 + l31;
    f32x16 sc[2][4];
#pragma unroll
    for (int pp = 0; pp < 2; ++pp) {
      bf16x8 qf[8];
#pragma unroll
      for (int ks = 0; ks < 8; ++ks) qf[ks] = *(const bf16x8*)(p.q + (size_t)row * 2048 + h * 256 + pp * 128 + ks * 16 + hh * 8);
#pragma unroll
      for (int kb = 0; kb < 4; ++kb) {
#pragma unroll
        for (int r = 0; r < 16; ++r) sc[pp][kb][r] = 0.f;
#pragma unroll
        for (int ks = 0; ks < 8; ++ks) {
          bf16x8 a = *(const bf16x8*)(SK + (pp * 128 + kb * 32 + l31) * 272 + (ks * 16 + hh * 8) * 2);
          sc[pp][kb] = __builtin_amdgcn_mfma_f32_32x32x16_bf16(a, qf[ks], sc[pp][kb], 0, 0, 0);
        }
      }
    }
    unsigned L1[16];
#pragma unroll
    for (int j = 0; j < 16; ++j) L1[j] = 0u;
#pragma unroll
    for (int kb = 0; kb < 4; ++kb)
#pragma unroll
      for (int rh = 0; rh < 2; ++rh) {
        unsigned g[16];
#pragma unroll
        for (int rr = 0; rr < 8; ++rr) {
          const int r = rh * 8 + rr;
          auto sw = __builtin_amdgcn_permlane32_swap(__float_as_uint(sc[0][kb][r]), __float_as_uint(sc[1][kb][r]), false, false);
          const unsigned kidx = kb * 32 + (r & 3) + 8 * (r >> 2);
          g[2 * rr] = (f2key(__uint_as_float(sw[0])) & ~127u) | kidx;
          g[2 * rr + 1] = (f2key(__uint_as_float(sw[1])) & ~127u) | (kidx + 4);
        }
        sort16_desc(g);
        merge16_desc(L1, g);
      }
    float As[16], Bs[16]; unsigned Ai[16], Bi[16];
#pragma unroll
    for (int j = 0; j < 16; ++j) {
      auto sw = __builtin_amdgcn_permlane32_swap(L1[j], L1[j], false, false);
      unsigned other = hh ? sw[0] : sw[1];
      unsigned ka = hh ? other : L1[j], kb_ = hh ? L1[j] : other;
      As[j] = key2f(ka & ~127u); Ai[j] = ka & 127u;
      Bs[j] = key2f(kb_ & ~127u); Bi[j] = kb_ & 127u;
    }
    unsigned L2[16];
#pragma unroll
    for (int j = 0; j < 16; ++j) L2[j] = 0u;
    const float smax = As[0] + Bs[0];
#define CKEY(i, j) (((262143u - min((unsigned)((smax - (As[i] + Bs[j])) * 16384.f), 262143u)) << 14) | (Ai[i] * 128u + Bi[j]))
    {
      unsigned g[16];
      g[0] = CKEY(0, 0);
      g[1] = CKEY(0, 1);
      g[2] = CKEY(0, 2);
      g[3] = CKEY(0, 3);
      g[4] = CKEY(0, 4);
      g[5] = CKEY(0, 5);
      g[6] = CKEY(0, 6);
      g[7] = CKEY(0, 7);
      g[8] = CKEY(0, 8);
      g[9] = CKEY(0, 9);
      g[10] = CKEY(0, 10);
      g[11] = CKEY(0, 11);
      g[12] = CKEY(0, 12);
      g[13] = CKEY(0, 13);
      g[14] = CKEY(0, 14);
      g[15] = CKEY(0, 15);
      sort16_desc(g);
      merge16_desc(L2, g);
    }
    {
      unsigned g[16];
      g[0] = CKEY(1, 0);
      g[1] = CKEY(1, 1);
      g[2] = CKEY(1, 2);
      g[3] = CKEY(1, 3);
      g[4] = CKEY(1, 4);
      g[5] = CKEY(1, 5);
      g[6] = CKEY(1, 6);
      g[7] = CKEY(1, 7);
      g[8] = CKEY(2, 0);
      g[9] = CKEY(2, 1);
      g[10] = CKEY(2, 2);
      g[11] = CKEY(2, 3);
      g[12] = CKEY(2, 4);
      g[13] = CKEY(3, 0);
      g[14] = CKEY(3, 1);
      g[15] = CKEY(3, 2);
      sort16_desc(g);
      merge16_desc(L2, g);
    }
    {
      unsigned g[16];
      g[0] = CKEY(3, 3);
      g[1] = CKEY(4, 0);
      g[2] = CKEY(4, 1);
      g[3] = CKEY(4, 2);
      g[4] = CKEY(5, 0);
      g[5] = CKEY(5, 1);
      g[6] = CKEY(6, 0);
      g[7] = CKEY(6, 1);
      g[8] = CKEY(7, 0);
      g[9] = CKEY(7, 1);
      g[10] = CKEY(8, 0);
      g[11] = CKEY(9, 0);
      g[12] = CKEY(10, 0);
      g[13] = CKEY(11, 0);
      g[14] = CKEY(12, 0);
      g[15] = CKEY(13, 0);
      sort16_desc(g);
      merge16_desc(L2, g);
    }
    {
      unsigned g[16];
      g[0] = CKEY(14, 0);
      g[1] = CKEY(15, 0);
      g[2] = 0u;
      g[3] = 0u;
      g[4] = 0u;
      g[5] = 0u;
      g[6] = 0u;
      g[7] = 0u;
      g[8] = 0u;
      g[9] = 0u;
      g[10] = 0u;
      g[11] = 0u;
      g[12] = 0u;
      g[13] = 0u;
      g[14] = 0u;
      g[15] = 0u;
      sort16_desc(g);
      merge16_desc(L2, g);
    }
#undef CKEY
    float ex[16]; unsigned ev[16]; float sum = 0.f;
#pragma unroll
    for (int t = 0; t < 16; ++t) {
      ev[t] = L2[t] & 16383u;
      float d = (float)(262143u - (L2[t] >> 14)) * (1.f / 16384.f);
      ex[t] = __expf(-d); sum += ex[t];
    }
    const float isum = 1.f / sum;
    if (hh == 0) {
      int* ip = p.idx + (size_t)row * 128 + h * 16;
      float* gp = p.gw + (size_t)row * 128 + h * 16;
#pragma unroll
      for (int t4 = 0; t4 < 4; ++t4) {
        u32x4 e0 = {ev[4 * t4], ev[4 * t4 + 1], ev[4 * t4 + 2], ev[4 * t4 + 3]};
        f32x4 g0 = {ex[4 * t4] * isum, ex[4 * t4 + 1] * isum, ex[4 * t4 + 2] * isum, ex[4 * t4 + 3] * isum};
        *(u32x4*)(ip + 4 * t4) = e0;
        *(f32x4*)(gp + 4 * t4) = g0;
      }
    }
  }
}

__device__ __forceinline__ void phase_gather(const Params& p, int layer, int nrows, float oscale) {
  const int lane = tidx() & 63, wv = tidx() >> 6;
  const bf16_t* U = p.uv; const bf16_t* V = p.uv + (size_t)16384 * 1024;
  for (int row = bidx() * 4 + wv; row < nrows; row += gridDim.x * 4) {
    float xv[16], acc[16];
    {
      u32x4 a = *(const u32x4*)(p.h + (size_t)row * DM + lane * 8), b = *(const u32x4*)(p.h + (size_t)row * DM + 512 + lane * 8);
#pragma unroll
      for (int e = 0; e < 4; ++e) {
        xv[2 * e] = __uint_as_float(a[e] << 16); xv[2 * e + 1] = __uint_as_float(a[e] & 0xffff0000u);
        xv[8 + 2 * e] = __uint_as_float(b[e] << 16); xv[8 + 2 * e + 1] = __uint_as_float(b[e] & 0xffff0000u);
      }
    }
#pragma unroll
    for (int i = 0; i < 16; ++i) acc[i] = 0.f;
    int myidx0 = p.idx[(size_t)row * 128 + lane], myidx1 = p.idx[(size_t)row * 128 + 64 + lane];
    float myg0 = p.gw[(size_t)row * 128 + lane], myg1 = p.gw[(size_t)row * 128 + 64 + lane];
    for (int k = 0; k < 128; ++k) {
      int e_ = k < 64 ? __shfl(myidx0, k) : __shfl(myidx1, k - 64);
      float g_ = k < 64 ? __shfl(myg0, k) : __shfl(myg1, k - 64);
      e_ = __builtin_amdgcn_readfirstlane(e_);
#if DIAG_HP
      const float* ur = p.peer_u + ((size_t)layer * 16384 + e_) * DM; const float* vr = p.peer_v + ((size_t)layer * 16384 + e_) * DM;
      f32x4 u0 = *(const f32x4*)(ur + lane * 8), u1 = *(const f32x4*)(ur + lane * 8 + 4), u2 = *(const f32x4*)(ur + 512 + lane * 8), u3 = *(const f32x4*)(ur + 512 + lane * 8 + 4);
      f32x4 v0 = *(const f32x4*)(vr + lane * 8), v1 = *(const f32x4*)(vr + lane * 8 + 4), v2 = *(const f32x4*)(vr + 512 + lane * 8), v3 = *(const f32x4*)(vr + 512 + lane * 8 + 4);
      float dot = 0.f;
#pragma unroll
      for (int e = 0; e < 4; ++e) dot += xv[e] * u0[e] + xv[4 + e] * u1[e] + xv[8 + e] * u2[e] + xv[12 + e] * u3[e];
      dot = wave_sum(dot);
      float w = g_ * gelu_tanh(dot);
#pragma unroll
      for (int e = 0; e < 4; ++e) { acc[e] += w * v0[e]; acc[4 + e] += w * v1[e]; acc[8 + e] += w * v2[e]; acc[12 + e] += w * v3[e]; }
#else
      const bf16_t* ur = U + (size_t)e_ * DM; const bf16_t* vr = V + (size_t)e_ * DM;
      u32x4 ua = *(const u32x4*)(ur + lane * 8), ub = *(const u32x4*)(ur + 512 + lane * 8);
      u32x4 va = *(const u32x4*)(vr + lane * 8), vb = *(const u32x4*)(vr + 512 + lane * 8);
      float dot = 0.f;
#pragma unroll
      for (int e = 0; e < 4; ++e) {
        dot += xv[2 * e] * __uint_as_float(ua[e] << 16) + xv[2 * e + 1] * __uint_as_float(ua[e] & 0xffff0000u);
        dot += xv[8 + 2 * e] * __uint_as_float(ub[e] << 16) + xv[8 + 2 * e + 1] * __uint_as_float(ub[e] & 0xffff0000u);
      }
      dot = wave_sum(dot);
      float w = PEER_ALPHA * oscale * g_ * gelu_tanh(dot);
#pragma unroll
      for (int e = 0; e < 4; ++e) {
        acc[2 * e] += w * __uint_as_float(va[e] << 16); acc[2 * e + 1] += w * __uint_as_float(va[e] & 0xffff0000u);
        acc[8 + 2 * e] += w * __uint_as_float(vb[e] << 16); acc[8 + 2 * e + 1] += w * __uint_as_float(vb[e] & 0xffff0000u);
      }
#endif
    }
    float* xr = xrow(p, row);
    const float* g2 = p.mod + (size_t)(layer * 3 + modrow(row)) * 6144 + 5 * DM;
#pragma unroll
    for (int hh = 0; hh < 2; ++hh) {
      int c0 = hh * 512 + lane * 8;
      f32x4 x0 = *(const f32x4*)(xr + c0), x1 = *(const f32x4*)(xr + c0 + 4);
      f32x4 ga = *(const f32x4*)(g2 + c0), gb = *(const f32x4*)(g2 + c0 + 4);
#pragma unroll
      for (int e = 0; e < 4; ++e) { x0[e] += ga[e] * acc[hh * 8 + e]; x1[e] += gb[e] * acc[hh * 8 + 4 + e]; }
      *(f32x4*)(xr + c0) = x0; *(f32x4*)(xr + c0 + 4) = x1;
    }
  }
}


__device__ __forceinline__ void phase_mix1(const Params& p, int layer, int with_ctx_queries) {
  const bool fast = attn_logit_bound(p, layer) <= 40.f;
  const int natt = fast ? 512 + (with_ctx_queries ? 16 : 0) : 1024 + (with_ctx_queries ? 32 : 0);
  const int G = gridDim.x, b_ = bidx();
  for (int item = b_; item < natt; item += G) { for (int r = 0; r < REP_ATT; ++r) { if (fast) attn_item64(p, layer, item); else attn_item(p, layer, item); } }
  int b1 = b_ - natt % G; if (b1 < 0) b1 += G;
  for (int it = b1; it < 528; it += G) { for (int r = 0; r < REP_MLA; ++r) mlA_item(p, layer, it); }
  const int nextra = 528 % G;
  const int first = (nextra * 2 < G) ? nextra : 0, span = G - first;
  if (b1 >= first)
    for (int it = b1 - first; it < 1056; it += span) { for (int r = 0; r < REP_SSDA; ++r) ssdA_item(p, layer, it); }
}
__device__ __forceinline__ void phase_mix3(const Params& p, int layer, int last) {
  const int nc = last ? 64 : 66, G = gridDim.x, b_ = bidx();
  const int nml = 2 * nc * 4, nssd = 2 * nc * 8;
  for (int it = b_; it < nml; it += G) {
    const int b = it / (nc * 4), c = (it / 4) % nc, h = it & 3;
    for (int r = 0; r < REP_MLC; ++r) mlC_item(p, layer, (b * 66 + c) * 4 + h);
  }
  const int nextra = nml % G;
  const int first = (nextra * 2 < G) ? nextra : 0, span = G - first;
  if (b_ >= first)
    for (int it = b_ - first; it < nssd; it += span) {
      const int b = it / (nc * 8), c = (it / 8) % nc, h = it & 7;
      for (int r = 0; r < REP_SSDC; ++r) ssdC_item(p, layer, (b * 66 + c) * 8 + h);
    }
}


#define XB_TMO      128
#define XB_XCNT(j)  (256  + 64 * (j))
#define XB_XSUB(j)  (1280 + 64 * (j))
#define XB_XGEN(j)  (2304 + 64 * (j))
#define XB_TOP      3328
#define XB_TOPGEN   3392
#define XCD_BAR_WORDS 3456
#define XB_SPIN_CAP (1u << 18)
#define LAS __attribute__((address_space(3)))
__device__ __forceinline__ unsigned xb_ld(unsigned* p)              { return __hip_atomic_load(p, __ATOMIC_RELAXED, __HIP_MEMORY_SCOPE_AGENT); }
__device__ __forceinline__ unsigned xb_add(unsigned* p, unsigned v) { return __hip_atomic_fetch_add(p, v, __ATOMIC_RELAXED, __HIP_MEMORY_SCOPE_AGENT); }
__device__ __forceinline__ unsigned xb_xcc_id() { return (unsigned)__builtin_amdgcn_s_getreg((3 << 11) | 20) & 0xFu; }
#define XB_SPIN(cond, bar) do { unsigned _sp = 0; while (cond) { __builtin_amdgcn_s_sleep(1); \
    if ((++_sp & 255u) == 0u) { if (xb_ld(&(bar)[XB_TMO])) break; if (_sp > XB_SPIN_CAP) { atomicAdd(&(bar)[XB_TMO], 1u); break; } } } } while (0)
struct XcdBarrier { unsigned* bar; unsigned x; volatile LAS unsigned* st; };
__device__ __forceinline__ XcdBarrier xcd_barrier_post(unsigned* bar, volatile LAS unsigned* st) {
    XcdBarrier b; b.bar = bar; b.x = xb_xcc_id(); b.st = st;
    if (threadIdx.x == 0) (void)xb_add(&bar[XB_XCNT(b.x)], 1u);
    return b;
}
__device__ __forceinline__ void xcd_barrier_complete(unsigned* bar, unsigned x, unsigned& nloc, unsigned& nx) {
    const unsigned G = gridDim.x * gridDim.y * gridDim.z;
    unsigned sum, cnt, mine, sp = 0u;
    for (;;) {
        sum = 0u; cnt = 0u; mine = 0u;
#pragma unroll
        for (unsigned j = 0; j < 16; ++j) { const unsigned c = xb_ld(&bar[XB_XCNT(j)]); sum += c; cnt += (c > 0u) ? 1u : 0u; mine = (j == x) ? c : mine; }
        if (sum == G) break;
        __builtin_amdgcn_s_sleep(1);
        if ((++sp & 255u) == 0u) { if (xb_ld(&bar[XB_TMO])) break; if (sp > XB_SPIN_CAP) { atomicAdd(&bar[XB_TMO], 1u); break; } }
    }
    nloc = mine > 0u ? mine : 1u; nx = cnt > 0u ? cnt : 1u;
}
__device__ __forceinline__ void xcd_barrier(const XcdBarrier& b) {
    asm volatile("s_waitcnt vmcnt(0)" ::: "memory");
    __syncthreads();
    if (threadIdx.x == 0) {
        unsigned* bar = b.bar;
        __builtin_amdgcn_s_waitcnt(0);
        unsigned nloc = b.st[0], nx = b.st[1];
        if (nloc == 0u) { xcd_barrier_complete(bar, b.x, nloc, nx); b.st[0] = nloc; b.st[1] = nx; }
        const unsigned old = xb_add(&bar[XB_XSUB(b.x)], 1u);
        const unsigned gen = old / nloc;
        if (old + 1u == (gen + 1u) * nloc) {
            __builtin_amdgcn_fence(__ATOMIC_RELEASE, "agent");
            asm volatile("s_waitcnt vmcnt(0)" ::: "memory");
            const unsigned og = xb_add(&bar[XB_TOP], 1u);
            const unsigned tg = og / nx;
            if (og + 1u == (tg + 1u) * nx) xb_add(&bar[XB_TOPGEN], 1u);
            else XB_SPIN(xb_ld(&bar[XB_TOPGEN]) == tg, bar);
            __builtin_amdgcn_fence(__ATOMIC_ACQUIRE, "agent");
            xb_add(&bar[XB_XGEN(b.x)], 1u);
            asm volatile("s_waitcnt vmcnt(0)" ::: "memory");
        } else {
            XB_SPIN(xb_ld(&bar[XB_XGEN(b.x)]) == gen, bar);
            __builtin_amdgcn_fence(__ATOMIC_ACQUIRE, "agent");
            asm volatile("s_waitcnt vmcnt(0)" ::: "memory");
        }
    }
    __syncthreads();
}

#ifndef REP_GEMM
#define REP_GEMM 1
#endif

#ifndef REP_MIX
#define REP_MIX 1
#endif
#ifndef REP_PEER
#define REP_PEER 1
#endif
#ifndef REP_ELEM
#define REP_ELEM 1
#endif
#ifndef REP_SYNC
#define REP_SYNC 1
#endif
#ifndef REP_TOPK
#define REP_TOPK 1
#endif
#define GSYNC() do { for (int r_ = 0; r_ < REP_SYNC; ++r_) xcd_barrier(xb); } while (0)
__global__ void __launch_bounds__(256, 2) k_mega(Params p) {
  cg::grid_group grid = cg::this_grid();
  volatile LAS unsigned* xst = (volatile LAS unsigned*)(smem + LDS_BYTES - 16);
  if (threadIdx.x == 0) { xst[0] = 0u; xst[1] = 0u; }
  __syncthreads();
  XcdBarrier xb = xcd_barrier_post(p.bar, xst);
  for (int r = 0; r < REP_INIT; ++r) phase_init(p);
  if (p.bar == nullptr) grid.sync();
  GSYNC();
  for (int layer = 0; layer < 2; ++layer) {
    const int last = layer == 1;
    const int nrows2 = last ? NLAT : MROWS;
    if (layer == 0 || DIAG_HP) { for (int r = 0; r < REP_NORM; ++r) phase_norm(p, layer, 1, MROWS, layer == 0); GSYNC(); }
    for (int r = 0; r < REP_GEMM * REP_G_IN; ++r) phase_inproj(p, layer, MROWS, DIAG_HP ? 0 : 2);
    GSYNC();
    for (int r = 0; r < REP_SPREP; ++r) { phase_ssdprep(p, layer); phase_vtrans(p); }
    GSYNC();
    for (int r = 0; r < REP_MIX; ++r) phase_mix1(p, layer, !last);
    GSYNC();
    phase_ssdcarry(p); phase_mlcarry(p); GSYNC();
    for (int r = 0; r < REP_MIX; ++r) phase_mix3(p, layer, last);
    GSYNC();
    for (int r = 0; r < REP_SOUT; ++r) { phase_ssdout(p, layer, nrows2); phase_mlout(p, layer, nrows2); }
    GSYNC();
#if DIAG_HP
    for (int r = 0; r < REP_GEMM * REP_G_GATE; ++r) phase_inproj(p, layer, nrows2, 1);
    GSYNC();
#endif
    for (int r = 0; r < REP_GEMM * REP_G_MERGE; ++r) phase_merge(p, layer, nrows2);
    GSYNC();
    for (int r = 0; r < REP_GEMM * REP_G_OUT; ++r) phase_outproj(p, layer, nrows2, r == 0 ? 1.f : 0.f, (layer == 0 && r == 0) ? 1 : 0);
    GSYNC();
    for (int r = 0; r < REP_NORM; ++r) phase_norm(p, layer, 2, nrows2, 0);
    GSYNC();
    for (int r = 0; r < REP_GEMM * REP_G_WQ; ++r) phase_wq(p, layer, nrows2);
#if !DIAG_HP
    for (int r = 0; r < REP_UVC; ++r) phase_uvconv8(p, layer);
#endif
    GSYNC();
    for (int r = 0; r < REP_TOPK; ++r) { if (DIAG_HP) phase_topk(p, layer, nrows2); else phase_topk2(p, layer, nrows2); }
    GSYNC();
#if DIAG_HP
    phase_gather(p, layer, nrows2, 1.f);
    if (!last) { GSYNC(); phase_norm(p, layer + 1, 1, nrows2, 0); GSYNC(); }
#else
    for (int r = 0; r < REP_PEER; ++r) phase_gatherU(p, layer, nrows2);
    GSYNC();
    phase_gatherV(p, layer, nrows2);
    if (!last) { GSYNC(); phase_norm(p, layer + 1, 1, nrows2, 0); GSYNC(); }
#endif
  }
}

extern "C" void kernel_launch(void* const* d_in, const int* in_sizes, int n_in, void* d_out, int out_size, void* d_ws, size_t ws_size,
                              hipStream_t stream) {
  Params p{};
  const float* const* in = (const float* const*)d_in;
  p.x = in[0]; p.c = in[1]; p.ctx = in[2]; p.c_ctx = in[3]; p.norm1_g = in[4]; p.norm2_g = in[5]; p.w_mod = in[6]; p.b_mod = in[7];
  p.w_in = in[8]; p.att_qnorm = in[9]; p.att_knorm = in[10]; p.ssd_conv_w = in[11]; p.ssd_conv_b = in[12]; p.ssd_dt_bias = in[13];
  p.ssd_a_log = in[14]; p.ssd_d = in[15]; p.ssd_norm = in[16]; p.ml_gate_bias = in[17]; p.ml_norm = in[18]; p.w_branch = in[19];
  p.w_out = in[20]; p.peer_wq = in[21]; p.peer_subkeys = in[22]; p.peer_u = in[23]; p.peer_v = in[24];
  p.out = (float*)d_out;
  char* w = (char*)d_ws; size_t off = 65536;
  p.bar = (unsigned*)d_ws;
  auto take = [&](size_t bytes) { char* r = w + off; off += (bytes + 255) & ~(size_t)255; return r; };
  p.mod = (float*)take((size_t)2 * 3 * 6144 * 4);
  p.xc = (float*)take((size_t)NCTX * DM * 4);
  p.small = (float*)take((size_t)MROWS * 32 * 4);
  p.dtb = (float*)take((size_t)MROWS * 16 * 4);
  p.wt_in = (bf16_t*)take((size_t)2 * INCP * DM * 2);
  p.wt_br = (bf16_t*)take((size_t)2 * 3 * DM * 512 * 2);
  p.wt_out = (bf16_t*)take((size_t)2 * DM * DM * 2);
  p.wt_q = (bf16_t*)take((size_t)2 * 2048 * DM * 2);
  p.sk = (bf16_t*)take((size_t)2 * 8 * 2 * 128 * 128 * 2);
  p.wt_q_lo = (bf16_t*)take(DIAG_HP ? (size_t)2 * 2048 * DM * 2 : 256);
  p.vt = (bf16_t*)take((size_t)4 * 64 * 8448 * 2);
  p.ropec = (float*)take((size_t)8192 * 32 * 4);
  p.ropes = (float*)take((size_t)8192 * 32 * 4);
  p.ssl = (bf16_t*)take((size_t)32 * 66 * 4096 * 2);
  p.sdec = (float*)take((size_t)32 * 66 * 4);
  p.mcl = (bf16_t*)take((size_t)16 * 66 * 16384 * 2);
  p.mnl = (float*)take((size_t)16 * 66 * 128 * 4);
  p.mml = (float*)take((size_t)16 * 66 * 4);
  p.mbl = (float*)take((size_t)16 * 66 * 4);
  p.mmp = (float*)take((size_t)16 * 66 * 4);
  p.h = (bf16_t*)take((size_t)MROWS * DM * 2);
  p.br = (bf16_t*)take((size_t)MROWS * 1536 * 2);
  p.xbc = (bf16_t*)take((size_t)MROWS * 768 * 2);
  p.idx = (int*)p.xbc; p.gw = (float*)((char*)p.xbc + (size_t)MROWS * 128 * 4);
  p.yf = (bf16_t*)take((size_t)MROWS * 512 * 2);
  p.yb = (bf16_t*)take((size_t)MROWS * 512 * 2);
  p.hf = (bf16_t*)take((size_t)MROWS * 512 * 2);
  p.hb = p.hf;
  p.gp8 = (unsigned char*)take((size_t)MROWS * 3072);
  p.mix = p.yf;
  p.proj = (bf16_t*)take((size_t)MROWS * 4096 * 2);
  p.uvs = (float*)take((size_t)2 * 16384 * 4);
  p.gp = p.proj; p.q = p.proj; p.qf = (float*)p.proj; p.h2lo = p.br; p.uv = (bf16_t*)((char*)p.proj + (size_t)MROWS * 2048 * 2); p.uvq = (unsigned char*)p.uv;
  p.xq = (signed char*)p.br; p.sxq = (float*)((char*)p.br + (size_t)MROWS * DM); p.wbuf = (float*)((char*)p.br + (size_t)MROWS * DM + (size_t)MROWS * 4);
  if (off > ws_size) return;

  const int LDS = LDS_BYTES;
  static int grid_blocks = 0;
  if (!grid_blocks) {
    (void)hipFuncSetAttribute((const void*)k_mega, hipFuncAttributeMaxDynamicSharedMemorySize, LDS);
    int dev = 0, cus = 0, per_cu = 0;
    (void)hipGetDevice(&dev);
    (void)hipDeviceGetAttribute(&cus, hipDeviceAttributeMultiprocessorCount, dev);
    (void)hipOccupancyMaxActiveBlocksPerMultiprocessor(&per_cu, (const void*)k_mega, 256, LDS);
    if (per_cu < 1) per_cu = 1;
    if (per_cu > 2) per_cu = 2;
    grid_blocks = cus * per_cu;
  }
  (void)hipMemsetAsync(d_ws, 0, XCD_BAR_WORDS * 4, stream);
  void* args[] = {&p};
  hipError_t e = hipLaunchCooperativeKernel((const void*)k_mega, dim3(grid_blocks), dim3(256), args, LDS, stream);
  if (e != hipSuccess) fprintf(stderr, "cooperative launch failed: %s (grid %d)\n", hipGetErrorString(e), grid_blocks);
}
```

```cpp
#include <hip/hip_runtime.h>
#include <hip/hip_cooperative_groups.h>
#include <stdint.h>
#include <stdio.h>
namespace cg = cooperative_groups;

typedef unsigned short bf16_t;
typedef short bf16x8 __attribute__((ext_vector_type(8)));
typedef float f32x4 __attribute__((ext_vector_type(4)));
typedef unsigned u32x4 __attribute__((ext_vector_type(4)));
typedef unsigned u32x2 __attribute__((ext_vector_type(2)));
typedef float f32x16 __attribute__((ext_vector_type(16)));

constexpr int SEQ = 8192, BATCH = 2, CTXL = 256, DM = 1024;
constexpr int NLAT = BATCH * SEQ;
constexpr int NCTX = BATCH * CTXL;
constexpr int MROWS = NLAT + NCTX;
constexpr int INC = 7200, INCP = 7296;
constexpr int NTHR = 256;

#ifndef DIAG_HP
#define DIAG_HP 0
#endif
#define REP_INIT 1
#define REP_NORM 1
#define REP_SPREP 1
#define REP_SOUT 1
#define REP_UVC 1
#define REP_QK 1
#define REP_KCOMP 1
#define REP_KSTG 1
#define REP_G_IN 1
#define REP_G_GATE 1
#define REP_G_MERGE 1
#define REP_G_OUT 1
#define REP_G_WQ 1
#define REP_STG 1
#define REP_EXP 1
#define REP_MLA 1
#define REP_SSDA 1
#define REP_ATT 1
#define REP_MLC 1
#define REP_SSDC 1
#ifndef ATT_ALPHA
#define ATT_ALPHA 1.f
#endif
#ifndef ATT_NAIVE
#define ATT_NAIVE 0
#endif
#ifndef ATT_TAU
#define ATT_TAU 1.f
#endif
#ifndef PEER_ALPHA
#define PEER_ALPHA 1.f
#endif
#define LDS_BYTES (DIAG_HP ? 140 * 1024 : 78 * 1024)
extern __shared__ __attribute__((aligned(16))) char smem[];

struct Params {
  const float *x, *c, *ctx, *c_ctx, *norm1_g, *norm2_g, *w_mod, *b_mod, *w_in, *att_qnorm, *att_knorm,
      *ssd_conv_w, *ssd_conv_b, *ssd_dt_bias, *ssd_a_log, *ssd_d, *ssd_norm, *ml_gate_bias, *ml_norm,
      *w_branch, *w_out, *peer_wq, *peer_subkeys, *peer_u, *peer_v;
  float* out;
  unsigned* bar;
  float* mod;
  float* xc;
  float* small;
  float* dtb;
  bf16_t *wt_in, *wt_br, *wt_out, *wt_q, *sk;
  bf16_t* h;
  bf16_t* br;
  bf16_t* xbc;
  bf16_t *yf, *yb, *hf, *hb;
  bf16_t* mix;
  bf16_t* proj;
  bf16_t* gp;
  unsigned char* gp8;
  bf16_t* q;
  bf16_t* uv;
  unsigned char* uvq;
  float* uvs;
  signed char* xq;
  float* sxq;
  float* wbuf;
  int* idx;
  float* gw;
  bf16_t* h2lo;
  bf16_t* wt_q_lo;
  float* qf;
  bf16_t* vt;
  float* ropec;
  float* ropes;
  bf16_t* ssl;
  float* sdec;
  bf16_t* mcl;
  float* mnl;
  float* mml;
  float* mbl;
  float* mmp;
};

__device__ __forceinline__ int tidx() { int t = __builtin_amdgcn_workitem_id_x(); asm volatile("" : "+v"(t)); return t; }
__device__ __forceinline__ int bidx() { int t = __builtin_amdgcn_workgroup_id_x(); asm volatile("" : "+s"(t)); return t; }
__device__ __forceinline__ float bf2f(bf16_t v) { return __uint_as_float(((unsigned)v) << 16); }
__device__ __forceinline__ bf16_t f2bf(float f) {
  unsigned u = __float_as_uint(f);
  u += 0x7fffu + ((u >> 16) & 1u);
  return (bf16_t)(u >> 16);
}
typedef float f32x2 __attribute__((ext_vector_type(2)));
typedef int i32x4 __attribute__((ext_vector_type(4)));
typedef __bf16 bf16x2n __attribute__((ext_vector_type(2)));
__device__ __forceinline__ unsigned pack2(float a, float b) {
  f32x2 v = {a, b};
  bf16x2n r = __builtin_convertvector(v, bf16x2n);
  return *(unsigned*)&r;
}
__device__ __forceinline__ float sigmoidf_(float x) { return 1.f / (1.f + __expf(-x)); }
__device__ __forceinline__ float siluf_(float x) { return x / (1.f + __expf(-x)); }
__device__ __forceinline__ float softplusf_(float x) { return x > 20.f ? x : log1pf(__expf(x)); }
__device__ __forceinline__ float logsigmoidf_(float x) { return x < 0.f ? x - log1pf(__expf(x)) : -log1pf(__expf(-x)); }
__device__ __forceinline__ float gelu_tanh(float x) {
  float u = 0.7978845608028654f * (x + 0.044715f * x * x * x);
  float t = 1.f - 2.f / (1.f + __expf(2.f * u));
  return 0.5f * x * (1.f + t);
}
__device__ __forceinline__ float ub0(unsigned v) { return (float)(v & 0xffu); }
__device__ __forceinline__ float ub1(unsigned v) { return (float)((v >> 8) & 0xffu); }
__device__ __forceinline__ float ub2(unsigned v) { return (float)((v >> 16) & 0xffu); }
__device__ __forceinline__ float ub3(unsigned v) { return (float)(v >> 24); }
__device__ __forceinline__ float* xrow(const Params& p, int row) {
  return row < NLAT ? p.out + (size_t)row * DM : p.xc + (size_t)(row - NLAT) * DM;
}
__device__ __forceinline__ const float* xrow_src(const Params& p, int row, int from_input) {
  if (from_input) return row < NLAT ? p.x + (size_t)row * DM : p.ctx + (size_t)(row - NLAT) * DM;
  return row < NLAT ? p.out + (size_t)row * DM : p.xc + (size_t)(row - NLAT) * DM;
}
__device__ __forceinline__ int modrow(int row) { return row < NLAT ? row / SEQ : 2; }
__device__ __forceinline__ float wave_sum(float v) {
#pragma unroll
  for (int o = 32; o > 0; o >>= 1) v += __shfl_xor(v, o);
  return v;
}
__device__ __forceinline__ float wave_max(float v) {
#pragma unroll
  for (int o = 32; o > 0; o >>= 1) v = fmaxf(v, __shfl_xor(v, o));
  return v;
}

__device__ __forceinline__ int win_colmap(int n) {
  if (n < 2048) return n;
  if (n < 4096) return n + 16;
  if (n < 7168) return n + 32;
  if (n < 7184) return n - 5120;
  if (n < 7200) return n - 3072;
  return -1;
}

__device__ __forceinline__ void transpose_tile(const float* src, int Nsrc, int K, bf16_t* dst, int n0, int k0, int mode, bf16_t* dstlo = nullptr) {
  float* tile = (float*)smem;
  const int tid = tidx();
  {
    const int n4 = (tid & 15) * 4;
    int sc = n0 + n4;
    if (mode == 1) sc = win_colmap(sc);
#pragma unroll
    for (int i = 0; i < 4; ++i) {
      const int kk = (tid >> 4) + 16 * i;
      f32x4 v = sc >= 0 ? *(const f32x4*)(src + (size_t)(k0 + kk) * Nsrc + sc) : (f32x4){0.f, 0.f, 0.f, 0.f};
      tile[kk * 65 + n4] = v[0]; tile[kk * 65 + n4 + 1] = v[1]; tile[kk * 65 + n4 + 2] = v[2]; tile[kk * 65 + n4 + 3] = v[3];
    }
  }
  __syncthreads();
  {
    const int n = tid >> 2, kc = (tid & 3) * 16;
    float t[16];
#pragma unroll
    for (int e = 0; e < 16; ++e) t[e] = tile[(kc + e) * 65 + n];
    u32x4 w0, w1;
#pragma unroll
    for (int e = 0; e < 4; ++e) { w0[e] = pack2(t[2 * e], t[2 * e + 1]); w1[e] = pack2(t[8 + 2 * e], t[8 + 2 * e + 1]); }
    bf16_t* d = dst + (size_t)(n0 + n) * K + k0 + kc;
    *(u32x4*)d = w0; *(u32x4*)(d + 8) = w1;
    if (dstlo) {
      u32x4 l0, l1;
#pragma unroll
      for (int e = 0; e < 4; ++e) {
        l0[e] = pack2(t[2 * e] - __uint_as_float(w0[e] << 16), t[2 * e + 1] - __uint_as_float(w0[e] & 0xffff0000u));
        l1[e] = pack2(t[8 + 2 * e] - __uint_as_float(w1[e] << 16), t[8 + 2 * e + 1] - __uint_as_float(w1[e] & 0xffff0000u));
      }
      bf16_t* dl = dstlo + (size_t)(n0 + n) * K + k0 + kc;
      *(u32x4*)dl = l0; *(u32x4*)(dl + 8) = l1;
    }
  }
  __syncthreads();
}

__device__ __forceinline__ void phase_init(const Params& p) {
  const int tid = tidx(), bid = bidx(), nb = gridDim.x;
  for (int i = bid * NTHR + tid; i < 8192 * 32; i += nb * NTHR) {
    int pos = i >> 5, jj = i & 31;
    float inv = powf(10000.f, -(float)(jj & 15) / 16.f);
    float ang = (float)(jj < 16 ? (pos >> 6) : (pos & 63)) * inv;
    float sn, cs_; sincosf(ang, &sn, &cs_);
    p.ropec[i] = cs_; p.ropes[i] = sn;
  }
  for (size_t i = (size_t)bid * NTHR + tid; i < (size_t)2 * 8 * 2 * 128 * 128; i += (size_t)nb * NTHR) p.sk[i] = f2bf(p.peer_subkeys[i]);
  {
    const int per_layer = 1824 + 384 + 256 + 512;
    for (int job = bid; job < 2 * per_layer; job += nb) {
      int l = job / per_layer, j = job % per_layer;
      if (j < 1824) {
        int nt = j / 16, kt = j % 16;
        transpose_tile(p.w_in + (size_t)l * DM * INC, INC, DM, p.wt_in + (size_t)l * INCP * DM, nt * 64, kt * 64, 1);
      } else if (j < 1824 + 384) {
        j -= 1824; int r = j / 128; j %= 128; int nt = j / 8, kt = j % 8;
        transpose_tile(p.w_branch + ((size_t)l * 3 + r) * 512 * DM, DM, 512, p.wt_br + ((size_t)l * 3 + r) * DM * 512, nt * 64, kt * 64, 0);
      } else if (j < 1824 + 384 + 256) {
        j -= 1824 + 384; int nt = j / 16, kt = j % 16;
        transpose_tile(p.w_out + (size_t)l * DM * DM, DM, DM, p.wt_out + (size_t)l * DM * DM, nt * 64, kt * 64, 0);
      } else {
        j -= 1824 + 384 + 256; int nt = j / 16, kt = j % 16;
        transpose_tile(p.peer_wq + (size_t)l * DM * 2048, 2048, DM, p.wt_q + (size_t)l * 2048 * DM, nt * 64, kt * 64, 0, DIAG_HP ? p.wt_q_lo + (size_t)l * 2048 * DM : nullptr);
      }
    }
  }
  {
    float* sl = (float*)smem;
    float* part = sl + 3 * DM;
    bool loaded = false;
    for (int blk = bid; blk < 192; blk += nb) {
      if (!loaded) {
        __syncthreads();
        for (int i = tid; i < 3 * DM; i += NTHR) {
          float v = i < 2 * DM ? p.c[i] : p.c_ctx[i - 2 * DM];
          sl[i] = siluf_(v);
        }
        loaded = true;
      }
      __syncthreads();
      const int wv = tid >> 6, ln = tid & 63;
      const int gi = blk * 64 + ln;
      const int l = gi / 6144, col = gi % 6144;
      const float* w = p.w_mod + (size_t)l * DM * 6144 + col;
      float a0 = 0.f, a1 = 0.f, a2 = 0.f;
#pragma unroll 8
      for (int k = wv * 256; k < wv * 256 + 256; ++k) {
        float wv_ = w[(size_t)k * 6144];
        a0 += sl[k] * wv_; a1 += sl[DM + k] * wv_; a2 += sl[2 * DM + k] * wv_;
      }
      part[(wv * 3 + 0) * 64 + ln] = a0; part[(wv * 3 + 1) * 64 + ln] = a1; part[(wv * 3 + 2) * 64 + ln] = a2;
      __syncthreads();
      if (tid < 192) {
        const int r = tid >> 6;
        float s = part[(0 * 3 + r) * 64 + ln] + part[(1 * 3 + r) * 64 + ln] + part[(2 * 3 + r) * 64 + ln] + part[(3 * 3 + r) * 64 + ln];
        p.mod[(l * 3 + r) * 6144 + col] = s + p.b_mod[l * 6144 + col];
      }
    }
  }
}

__device__ __forceinline__ void phase_norm(const Params& p, int layer, int which, int nrows, int from_input) {
  const int lane = tidx() & 63, wv = tidx() >> 6;
  const float* g = (which == 1 ? p.norm1_g : p.norm2_g) + layer * DM;
  const int sh_off = which == 1 ? 0 : 3 * DM, sc_off = which == 1 ? DM : 4 * DM;
  int curm = -1;
  f32x4 Ar[4], Br[4];
  for (int row = bidx() * 4 + wv; row < nrows; row += gridDim.x * 4) {
    const float* xr = xrow_src(p, row, from_input);
    const int mr = modrow(row);
    if (mr != curm) {
      const float* md = p.mod + (size_t)(layer * 3 + mr) * 6144;
#pragma unroll
      for (int j = 0; j < 4; ++j) {
        int c0 = j * 256 + lane * 4;
        f32x4 gg = *(const f32x4*)(g + c0), sc = *(const f32x4*)(md + sc_off + c0);
        Br[j] = *(const f32x4*)(md + sh_off + c0);
#pragma unroll
        for (int e = 0; e < 4; ++e) Ar[j][e] = gg[e] * (1.f + sc[e]);
      }
      curm = mr;
    }
    f32x4 v[4]; float ss = 0.f;
#pragma unroll
    for (int j = 0; j < 4; ++j) {
      v[j] = *(const f32x4*)(xr + j * 256 + lane * 4);
      ss += v[j][0] * v[j][0] + v[j][1] * v[j][1] + v[j][2] * v[j][2] + v[j][3] * v[j][3];
    }
    ss = wave_sum(ss);
    float rs = rsqrtf(ss * (1.f / DM) + 1e-6f);
#pragma unroll
    for (int j = 0; j < 4; ++j) {
      int c0 = j * 256 + lane * 4;
      float o0 = v[j][0] * rs * Ar[j][0] + Br[j][0];
      float o1 = v[j][1] * rs * Ar[j][1] + Br[j][1];
      float o2 = v[j][2] * rs * Ar[j][2] + Br[j][2];
      float o3 = v[j][3] * rs * Ar[j][3] + Br[j][3];
      u32x2 w; w.x = pack2(o0, o1); w.y = pack2(o2, o3);
      *(u32x2*)(p.h + (size_t)row * DM + c0) = w;
      v[j][0] = o0; v[j][1] = o1; v[j][2] = o2; v[j][3] = o3;
#if DIAG_HP
      if (which == 2) {
        u32x2 wl; wl.x = pack2(o0 - __uint_as_float(w.x << 16), o1 - __uint_as_float(w.x & 0xffff0000u));
        wl.y = pack2(o2 - __uint_as_float(w.y << 16), o3 - __uint_as_float(w.y & 0xffff0000u));
        *(u32x2*)(p.h2lo + (size_t)row * DM + c0) = wl;
      }
#endif
    }
    if (which == 2) {
      float am = 0.f;
#pragma unroll
      for (int j = 0; j < 4; ++j) am = fmaxf(fmaxf(fmaxf(am, fabsf(v[j][0])), fmaxf(fabsf(v[j][1]), fabsf(v[j][2]))), fabsf(v[j][3]));
      am = wave_max(am);
      const float sc8 = am > 0.f ? am * (1.f / 127.f) : 1.f, inv8 = 1.f / sc8;
#pragma unroll
      for (int j = 0; j < 4; ++j) {
        unsigned q = 0;
#pragma unroll
        for (int e = 0; e < 4; ++e) {
          int t = (int)rintf(v[j][e] * inv8);
          t = t < -127 ? -127 : (t > 127 ? 127 : t);
          q |= (unsigned)(t & 0xff) << (8 * e);
        }
        *(unsigned*)(p.xq + (size_t)row * DM + j * 256 + lane * 4) = q;
      }
      if (lane == 0) p.sxq[row] = sc8;
    }
  }
}

__device__ __forceinline__ void gemm_stage(const bf16_t* A, int lda, const bf16_t* Bt, int ldb, int brow, int bcol, int kt, char* buf, int tid) {
#pragma unroll
  for (int i = 0; i < 4; ++i) {
    const int b = (tid + 256 * i) * 16, r = b >> 7, c = ((b >> 4) & 7) ^ ((r >> 1) & 7);
    __builtin_amdgcn_global_load_lds((const unsigned*)(A + (size_t)(brow + r) * lda + kt + c * 8), (__attribute__((address_space(3))) unsigned*)(buf + b), 16, 0, 0);
    __builtin_amdgcn_global_load_lds((const unsigned*)(Bt + (size_t)(bcol + r) * ldb + kt + c * 8), (__attribute__((address_space(3))) unsigned*)(buf + 16384 + b), 16, 0, 0);
  }
}
__device__ __forceinline__ void gemm_compute(f32x4 (&acc)[4][4], const char* buf, int wr, int wc, int fr, int fq) {
#pragma unroll
  for (int ks = 0; ks < 2; ++ks) {
    bf16x8 At[4], Bl[4];
#pragma unroll
    for (int m = 0; m < 4; ++m) { const int row = wr * 64 + m * 16 + fr; At[m] = *(const bf16x8*)(buf + row * 128 + (((ks * 4 + fq) ^ ((row >> 1) & 7)) << 4)); }
#pragma unroll
    for (int n = 0; n < 4; ++n) { const int row = wc * 64 + n * 16 + fr; Bl[n] = *(const bf16x8*)(buf + 16384 + row * 128 + (((ks * 4 + fq) ^ ((row >> 1) & 7)) << 4)); }
    __builtin_amdgcn_s_setprio(1);
#pragma unroll
    for (int m = 0; m < 4; ++m)
#pragma unroll
      for (int n = 0; n < 4; ++n) acc[m][n] = __builtin_amdgcn_mfma_f32_16x16x32_bf16(Bl[n], At[m], acc[m][n], 0, 0, 0);
    __builtin_amdgcn_s_setprio(0);
  }
}
__device__ __forceinline__ void gemm_compute_h(f32x4 (&acc)[4][4], const char* buf, int wr, int wc, int fr, int fq) {
  bf16x8 At[2][4], Bl[2][4];
#pragma unroll
  for (int ks = 0; ks < 2; ++ks) {
#pragma unroll
    for (int m = 0; m < 4; ++m) { const int row = wr * 64 + m * 16 + fr; At[ks][m] = *(const bf16x8*)(buf + row * 128 + (((ks * 4 + fq) ^ ((row >> 1) & 7)) << 4)); }
#pragma unroll
    for (int n = 0; n < 4; ++n) { const int row = wc * 64 + n * 16 + fr; Bl[ks][n] = *(const bf16x8*)(buf + 16384 + row * 128 + (((ks * 4 + fq) ^ ((row >> 1) & 7)) << 4)); }
  }
  __builtin_amdgcn_s_setprio(1);
#pragma unroll
  for (int ks = 0; ks < 2; ++ks)
#pragma unroll
    for (int m = 0; m < 4; ++m)
#pragma unroll
      for (int n = 0; n < 4; ++n) acc[m][n] = __builtin_amdgcn_mfma_f32_16x16x32_bf16(Bl[ks][n], At[ks][m], acc[m][n], 0, 0, 0);
  __builtin_amdgcn_s_setprio(0);
}
template <bool HOIST = true>
__device__ __forceinline__ void gemm_kloop(f32x4 (&acc)[4][4], const bf16_t* A, int lda, const bf16_t* Bt, int ldb, int K, int brow, int bcol) {
  const int tid = tidx(), wid = tid >> 6, lane = tid & 63, wr = wid >> 1, wc = wid & 1, fr = lane & 15, fq = lane >> 4;
  const int nt = K >> 6;
  __syncthreads();
  gemm_stage(A, lda, Bt, ldb, brow, bcol, 0, smem, tid);
  asm volatile("s_waitcnt vmcnt(0)" ::: "memory");
  __syncthreads();
  for (int t = 0; t < nt - 1; ++t) {
    char* cur = smem + (t & 1) * 32768; char* nxt = smem + ((t + 1) & 1) * 32768;
    gemm_stage(A, lda, Bt, ldb, brow, bcol, (t + 1) * 64, nxt, tid);
    if (HOIST) gemm_compute_h(acc, cur, wr, wc, fr, fq); else gemm_compute(acc, cur, wr, wc, fr, fq);
#if REP_KCOMP > 1
    { f32x4 acc2[4][4];
#pragma unroll
      for (int m = 0; m < 4; ++m)
#pragma unroll
        for (int n = 0; n < 4; ++n) acc2[m][n] = (f32x4){0.f, 0.f, 0.f, 0.f};
      gemm_compute(acc2, cur, wr, wc, fr, fq);
      float sink = 0.f;
#pragma unroll
      for (int m = 0; m < 4; ++m)
#pragma unroll
        for (int n = 0; n < 4; ++n) sink += acc2[m][n][0];
      asm volatile("" :: "v"(sink)); }
#endif
    asm volatile("s_waitcnt vmcnt(0)" ::: "memory");
    __syncthreads();
#if REP_KSTG > 1
    gemm_stage(A, lda, Bt, ldb, brow, bcol, (t + 1) * 64, nxt, tid);
    asm volatile("s_waitcnt vmcnt(0)" ::: "memory");
    __syncthreads();
#endif
  }
  if (HOIST) gemm_compute_h(acc, smem + ((nt - 1) & 1) * 32768, wr, wc, fr, fq); else gemm_compute(acc, smem + ((nt - 1) & 1) * 32768, wr, wc, fr, fq);
}

__device__ __forceinline__ void tile_map(int t, int NT, int& mt, int& ni) {
  const int x = t & 7, q = t >> 3, nsub = NT >> 3;
  mt = q / nsub; ni = x + 8 * (q - mt * nsub);
}
__device__ __forceinline__ void tile_map_m(int t, int mtiles, int& mt, int& nt) {
  const int idx = (t & 7) * mtiles + (t >> 3);
  mt = idx >> 3; nt = idx & 7;
}
#define GEMM_IDS const int tid = tidx(), wid = tid >> 6, lane = tid & 63, wr = wid >> 1, wc = wid & 1, fr = lane & 15, fq = lane >> 4; (void)tid;

__device__ __forceinline__ void zero_acc(f32x4 (&acc)[4][4]) {
#pragma unroll
  for (int m = 0; m < 4; ++m)
#pragma unroll
    for (int n = 0; n < 4; ++n) acc[m][n] = (f32x4){0.f, 0.f, 0.f, 0.f};
}


__device__ __forceinline__ void store_slab_bf16(const f32x4 (&v)[4], bf16_t* dst_row0, size_t ld, int wid, int lane) {
  char* slab = smem + 65536 + wid * 2304;
  const int fr = lane & 15, fq = lane >> 4;
#pragma unroll
  for (int n = 0; n < 4; ++n) {
    u32x2 w; w.x = pack2(v[n][0], v[n][1]); w.y = pack2(v[n][2], v[n][3]);
    *(u32x2*)(slab + fr * 144 + (n * 16 + fq * 4) * 2) = w;
  }
  const int r = lane >> 3, c = lane & 7;
  u32x4 a = *(const u32x4*)(slab + r * 144 + c * 16), b = *(const u32x4*)(slab + (r + 8) * 144 + c * 16);
  *(u32x4*)(dst_row0 + (size_t)r * ld + c * 8) = a;
  *(u32x4*)(dst_row0 + (size_t)(r + 8) * ld + c * 8) = b;
}


__device__ __forceinline__ void store_slab_gate8(const f32x4 (&v)[4], unsigned char* dst_row0, int wid, int lane) {
  char* slab = smem + 65536 + wid * 2304;
  const int fr = lane & 15, fq = lane >> 4;
#pragma unroll
  for (int n = 0; n < 4; ++n) {
    unsigned q = 0;
#pragma unroll
    for (int j = 0; j < 4; ++j) { int g = (int)rintf(sigmoidf_(v[n][j]) * 255.f); q |= (unsigned)g << (8 * j); }
    *(unsigned*)(slab + fr * 80 + n * 16 + fq * 4) = q;
  }
  const int r = lane >> 2, c = lane & 3;
  u32x4 a = *(const u32x4*)(slab + r * 80 + c * 16);
  *(u32x4*)(dst_row0 + (size_t)r * 3072 + c * 16) = a;
}
__device__ __forceinline__ void load_slab_gate8(unsigned (&g)[4], const unsigned char* src_row0, int wid, int lane) {
  char* slab = smem + 65536 + wid * 2304;
  const int fr = lane & 15, fq = lane >> 4;
  const int r = lane >> 2, c = lane & 3;
  *(u32x4*)(slab + r * 80 + c * 16) = *(const u32x4*)(src_row0 + (size_t)r * 3072 + c * 16);
#pragma unroll
  for (int n = 0; n < 4; ++n) g[n] = *(const unsigned*)(slab + fr * 80 + n * 16 + fq * 4);
}

__device__ __forceinline__ void phase_inproj(const Params& p, int layer, int nrows, int part) {
  GEMM_IDS
  const int ntl = part == 0 ? 33 : (part == 1 ? 24 : 57);
  const int mtiles = nrows / 128;
  const bf16_t* Bt = p.wt_in + (size_t)layer * INCP * DM;
  for (int t = bidx(); t < mtiles * ntl; t += gridDim.x) {
    int mt, ni, nt;
    if (part == 0) { if (t < mtiles * 32) tile_map(t, 32, mt, ni); else { mt = t - mtiles * 32; ni = 32; } nt = ni < 32 ? ni : 56; }
    else if (part == 1) { tile_map(t, 24, mt, ni); nt = 32 + ni; }
    else { if (t < mtiles * 56) { tile_map(t, 56, mt, ni); nt = ni; } else { mt = t - mtiles * 56; nt = 56; } }
    f32x4 acc[4][4]; zero_acc(acc);
    gemm_kloop(acc, p.h, DM, Bt, DM, DM, mt * 128, nt * 128);
    if (nt >= 32 && nt < 56 && !DIAG_HP) {
#pragma unroll
      for (int m = 0; m < 4; ++m) store_slab_gate8(acc[m], p.gp8 + (size_t)(mt * 128 + wr * 64 + m * 16) * 3072 + (nt * 128 - 4096) + wc * 64, wid, lane);
    } else if (nt >= 5 && nt < 56) {
      bf16_t* dst = nt < 32 ? p.proj + (size_t)(mt * 128 + wr * 64) * 4096 + nt * 128 + wc * 64 : p.gp + (size_t)(mt * 128 + wr * 64) * 3072 + (nt * 128 - 4096) + wc * 64;
      const size_t ld = nt < 32 ? 4096 : 3072;
#pragma unroll
      for (int m = 0; m < 4; ++m) store_slab_bf16(acc[m], dst + (size_t)(m * 16) * ld, ld, wid, lane);
    } else if (nt == 56) {
#pragma unroll
      for (int m = 0; m < 4; ++m)
#pragma unroll
        for (int n = 0; n < 4; ++n) {
          int row = mt * 128 + wr * 64 + m * 16 + fr, cc = wc * 64 + n * 16 + fq * 4;
          if (cc < 32) *(f32x4*)(p.small + (size_t)row * 32 + cc) = acc[m][n];
        }
    }
    if (nt < 5) {
      const float* nw = (nt < 4 ? p.att_qnorm : p.att_knorm) + layer * 64;
      const bool latent = mt < NLAT / 128;
#pragma unroll
      for (int m = 0; m < 4; ++m) {
        const int row = mt * 128 + wr * 64 + m * 16 + fr;
        float ss = 0.f;
#pragma unroll
        for (int n = 0; n < 4; ++n)
#pragma unroll
          for (int j = 0; j < 4; ++j) ss += acc[m][n][j] * acc[m][n][j];
        ss += __shfl_xor(ss, 16); ss += __shfl_xor(ss, 32);
        const float rs = rsqrtf(ss * (1.f / 64.f) + 1e-6f);
        f32x4 v[4];
#pragma unroll
        for (int n = 0; n < 4; ++n) {
          f32x4 w4 = *(const f32x4*)(nw + n * 16 + fq * 4);
#pragma unroll
          for (int j = 0; j < 4; ++j) v[n][j] = acc[m][n][j] * rs * w4[j];
        }
        if (latent) {
          const int pos = row & (SEQ - 1);
#pragma unroll
          for (int n = 0; n < 2; ++n) {
            f32x4 c4 = *(const f32x4*)(p.ropec + pos * 32 + n * 16 + fq * 4), s4 = *(const f32x4*)(p.ropes + pos * 32 + n * 16 + fq * 4);
#pragma unroll
            for (int j = 0; j < 4; ++j) {
              float t1 = v[n][j], t2 = v[n + 2][j];
              v[n][j] = t1 * c4[j] - t2 * s4[j];
              v[n + 2][j] = t1 * s4[j] + t2 * c4[j];
            }
          }
        }
        store_slab_bf16(v, p.proj + (size_t)(mt * 128 + wr * 64 + m * 16) * 4096 + nt * 128 + wc * 64, 4096, wid, lane);
      }
    }
  }
}

__device__ __forceinline__ void phase_merge(const Params& p, int layer, int nrows) {
  GEMM_IDS
  const int mtiles = nrows / 128;
  for (int t = bidx(); t < mtiles * 8; t += gridDim.x) {
    int mt, nt; tile_map_m(t, mtiles, mt, nt);
    f32x4 mixa[4][4]; zero_acc(mixa);
    for (int r = 0; r < 3; ++r) {
      f32x4 acc[4][4]; zero_acc(acc);
      gemm_kloop<false>(acc, p.br + r * 512, 1536, p.wt_br + ((size_t)layer * 3 + r) * DM * 512, 512, 512, mt * 128, nt * 128);
#if DIAG_HP
#pragma unroll
      for (int m = 0; m < 4; ++m)
#pragma unroll
        for (int n = 0; n < 4; ++n) {
          int row = mt * 128 + wr * 64 + m * 16 + fr, col = nt * 128 + wc * 64 + n * 16 + fq * 4;
          u32x2 g = *(const u32x2*)(p.gp + (size_t)row * 3072 + r * 1024 + col);
          mixa[m][n][0] += sigmoidf_(__uint_as_float(g.x << 16)) * acc[m][n][0];
          mixa[m][n][1] += sigmoidf_(__uint_as_float(g.x & 0xffff0000u)) * acc[m][n][1];
          mixa[m][n][2] += sigmoidf_(__uint_as_float(g.y << 16)) * acc[m][n][2];
          mixa[m][n][3] += sigmoidf_(__uint_as_float(g.y & 0xffff0000u)) * acc[m][n][3];
        }
#else
#pragma unroll
      for (int m = 0; m < 4; ++m) {
        unsigned g[4];
        load_slab_gate8(g, p.gp8 + (size_t)(mt * 128 + wr * 64 + m * 16) * 3072 + r * 1024 + nt * 128 + wc * 64, wid, lane);
#pragma unroll
        for (int n = 0; n < 4; ++n) {
          mixa[m][n][0] += ub0(g[n]) * (1.f / 255.f) * acc[m][n][0];
          mixa[m][n][1] += ub1(g[n]) * (1.f / 255.f) * acc[m][n][1];
          mixa[m][n][2] += ub2(g[n]) * (1.f / 255.f) * acc[m][n][2];
          mixa[m][n][3] += ub3(g[n]) * (1.f / 255.f) * acc[m][n][3];
        }
      }
#endif
    }
#pragma unroll
    for (int m = 0; m < 4; ++m) store_slab_bf16(mixa[m], p.mix + (size_t)(mt * 128 + wr * 64 + m * 16) * DM + nt * 128 + wc * 64, DM, wid, lane);
  }
}

__device__ __forceinline__ void phase_outproj(const Params& p, int layer, int nrows, float oscale, int from_input) {
  GEMM_IDS
  const int mtiles = nrows / 128;
  for (int t = bidx(); t < mtiles * 8; t += gridDim.x) {
    int mt, nt; tile_map_m(t, mtiles, mt, nt);
    f32x4 acc[4][4]; zero_acc(acc);
    gemm_kloop(acc, p.mix, DM, p.wt_out + (size_t)layer * DM * DM, DM, DM, mt * 128, nt * 128);
#pragma unroll
    for (int m = 0; m < 4; ++m)
#pragma unroll
      for (int n = 0; n < 4; ++n) {
        int row = mt * 128 + wr * 64 + m * 16 + fr, col = nt * 128 + wc * 64 + n * 16 + fq * 4;
        float* xr = xrow(p, row) + col;
        f32x4 g1 = *(const f32x4*)(p.mod + (size_t)(layer * 3 + modrow(row)) * 6144 + 2 * DM + col);
        g1 = g1 * oscale;
        f32x4 xv = *(const f32x4*)(xrow_src(p, row, from_input) + col);
        xv[0] += g1[0] * acc[m][n][0]; xv[1] += g1[1] * acc[m][n][1]; xv[2] += g1[2] * acc[m][n][2]; xv[3] += g1[3] * acc[m][n][3];
        *(f32x4*)xr = xv;
      }
  }
}

__device__ __forceinline__ void phase_wq(const Params& p, int layer, int nrows) {
  GEMM_IDS
  const int mtiles = nrows / 128;
  for (int t = bidx(); t < mtiles * 16; t += gridDim.x) {
    int mt, nt; { const int idx = (t & 7) * (mtiles * 2) + (t >> 3); mt = idx >> 4; nt = idx & 15; }
    f32x4 acc[4][4]; zero_acc(acc);
    gemm_kloop(acc, p.h, DM, p.wt_q + (size_t)layer * 2048 * DM, DM, DM, mt * 128, nt * 128);
#if DIAG_HP
    gemm_kloop(acc, p.h, DM, p.wt_q_lo + (size_t)layer * 2048 * DM, DM, DM, mt * 128, nt * 128);
    gemm_kloop(acc, p.h2lo, DM, p.wt_q + (size_t)layer * 2048 * DM, DM, DM, mt * 128, nt * 128);
#endif
#if DIAG_HP
#pragma unroll
    for (int m = 0; m < 4; ++m)
#pragma unroll
      for (int n = 0; n < 4; ++n) {
        int row = mt * 128 + wr * 64 + m * 16 + fr, col = nt * 128 + wc * 64 + n * 16 + fq * 4;
        *(f32x4*)(p.qf + (size_t)row * 2048 + col) = acc[m][n];
      }
#else
#pragma unroll
    for (int m = 0; m < 4; ++m) store_slab_bf16(acc[m], p.q + (size_t)(mt * 128 + wr * 64 + m * 16) * 2048 + nt * 128 + wc * 64, 2048, wid, lane);
#endif
  }
}

__device__ __forceinline__ void phase_vtrans(const Params& p) {
  bf16_t* tile = (bf16_t*)smem;
  const int tid = tidx();
  for (int item = bidx(); item < 528; item += gridDim.x) {
    int b = item / 264, r = item % 264, kvh = r / 132, kt = r % 132;
    int krow0 = kt < 128 ? b * SEQ + kt * 64 : NLAT + b * CTXL + (kt - 128) * 64;
    __syncthreads();
    {
      int kr = tid >> 2, c0 = (tid & 3) * 16;
      const bf16_t* vp = p.proj + (size_t)(krow0 + kr) * 4096 + 640 + kvh * 64 + c0;
      u32x4 w0 = *(const u32x4*)vp, w1 = *(const u32x4*)(vp + 8);
      unsigned* tp = (unsigned*)(tile + kr * 66 + c0);
#pragma unroll
      for (int e = 0; e < 4; ++e) { tp[e] = w0[e]; tp[4 + e] = w1[e]; }
    }
    __syncthreads();
    {
      int d = tid >> 2, k0 = (tid & 3) * 16;
      bf16_t* op = p.vt + ((size_t)(b * 2 + kvh) * 64 + d) * 8448 + kt * 64 + k0;
      u32x4 o0, o1;
#pragma unroll
      for (int e = 0; e < 4; ++e) {
        const int ka = e < 2 ? 2 * e : 8 + 2 * (e - 2);
        const int kb2 = e < 2 ? 4 + 2 * e : 12 + 2 * (e - 2);
        o0[e] = (unsigned)tile[(k0 + ka) * 66 + d] | ((unsigned)tile[(k0 + ka + 1) * 66 + d] << 16);
        o1[e] = (unsigned)tile[(k0 + kb2) * 66 + d] | ((unsigned)tile[(k0 + kb2 + 1) * 66 + d] << 16);
      }
      *(u32x4*)op = o0; *(u32x4*)(op + 8) = o1;
    }
  }
}

#define ATT_KSTR 144
#define ATT_VSTR 272
#define ATT_VOFF 18432
#define ATT_BUF 35840
__device__ __forceinline__ void attn_item(const Params& p, int layer, int item) {
  const int tid = tidx(), wid = tid >> 6, lane = tid & 63, l31 = lane & 31, hh = lane >> 5;
  int b, kvh, tok0, kt0, nkt;
  if (item < 1024) { b = item >> 9; kvh = (item >> 8) & 1; tok0 = b * SEQ + (item & 255) * 32; kt0 = 0; nkt = 66; }
  else { int r = item - 1024; b = r >> 4; kvh = (r >> 3) & 1; tok0 = NLAT + b * CTXL + (r & 7) * 32; kt0 = 64; nkt = 2; }
  const int head = kvh * 4 + wid;
  bf16x8 qf[4];
#pragma unroll
  for (int ks = 0; ks < 4; ++ks)
    qf[ks] = *(const bf16x8*)(p.proj + (size_t)(tok0 + l31) * 4096 + head * 64 + ks * 16 + hh * 8);
  f32x16 o[2];
#pragma unroll
  for (int db = 0; db < 2; ++db)
#pragma unroll
    for (int r = 0; r < 16; ++r) o[db][r] = 0.f;
  float mrun = -1e30f, lrun = 0.f;
  const float cs = 0.125f * 1.44269504088896f * ATT_TAU;
  const bf16_t* vtb = p.vt + (size_t)(b * 2 + kvh) * 64 * 8448;
  u32x4 kreg[4], vreg[4];
  auto gload = [&](int kt) {
    int krow0 = kt < 64 ? b * SEQ + kt * 128 : NLAT + b * CTXL + (kt - 64) * 128;
    int ko = kt * 128; asm volatile("" : "+s"(ko));
#pragma unroll
    for (int i = 0; i < 4; ++i) {
      int id = tid + 256 * i;
      kreg[i] = *(const u32x4*)(p.proj + (size_t)(krow0 + (id >> 3)) * 4096 + 512 + kvh * 64 + (id & 7) * 8);
      vreg[i] = *(const u32x4*)(vtb + (size_t)(id >> 4) * 8448 + ko + (id & 15) * 8);
    }
  };
  auto lstore = [&](int buf) {
    char* base = smem + buf * ATT_BUF;
#pragma unroll
    for (int i = 0; i < 4; ++i) {
      int id = tid + 256 * i;
      *(u32x4*)(base + (id >> 3) * ATT_KSTR + (id & 7) * 16) = kreg[i];
      *(u32x4*)(base + ATT_VOFF + (id >> 4) * ATT_VSTR + (id & 15) * 16) = vreg[i];
    }
  };
  auto compute = [&](int buf, int sub) {
    const char* Kb = smem + buf * ATT_BUF + sub * 64 * ATT_KSTR;
    const char* Vb = smem + buf * ATT_BUF + ATT_VOFF + sub * 128;
    f32x16 s[2];
#pragma unroll
    for (int kb = 0; kb < 2; ++kb) {
#pragma unroll
      for (int r = 0; r < 16; ++r) s[kb][r] = 0.f;
#pragma unroll
      for (int ks = 0; ks < 4; ++ks) {
        bf16x8 kf = *(const bf16x8*)(Kb + (kb * 32 + l31) * ATT_KSTR + (ks * 16 + hh * 8) * 2);
        s[kb] = __builtin_amdgcn_mfma_f32_32x32x16_bf16(kf, qf[ks], s[kb], 0, 0, 0);
      }
    }
    bf16x8 pf[4];
    float mx = s[0][0];
#pragma unroll
    for (int r = 1; r < 16; ++r) mx = fmaxf(mx, s[0][r]);
#pragma unroll
    for (int r = 0; r < 16; ++r) mx = fmaxf(mx, s[1][r]);
    mx = fmaxf(mx, __shfl_xor(mx, 32));
    const float mnew = fmaxf(mrun, mx * cs);
    const float alpha = __builtin_amdgcn_exp2f(mrun - mnew);
    const bool grew = mnew > mrun;
    mrun = mnew;
    float ls = 0.f;
#pragma unroll
    for (int kb = 0; kb < 2; ++kb) {
      float pv[16];
#pragma unroll
      for (int r = 0; r < 16; ++r) { pv[r] = __builtin_amdgcn_exp2f(s[kb][r] * cs - mnew); ls += pv[r]; }
#pragma unroll
      for (int sp = 0; sp < 2; ++sp) {
        u32x4 w;
#pragma unroll
        for (int e = 0; e < 4; ++e) w[e] = pack2(pv[8 * sp + 2 * e], pv[8 * sp + 2 * e + 1]);
        pf[kb * 2 + sp] = *(bf16x8*)&w;
      }
    }
    lrun = lrun * alpha + ls;
    if (__any(grew)) {
#pragma unroll
      for (int db = 0; db < 2; ++db)
#pragma unroll
        for (int r = 0; r < 16; ++r) o[db][r] *= alpha;
    }
#pragma unroll
    for (int sp = 0; sp < 4; ++sp) {
#pragma unroll
      for (int db = 0; db < 2; ++db) {
        bf16x8 vf = *(const bf16x8*)(Vb + (db * 32 + l31) * ATT_VSTR + (16 * sp + 8 * hh) * 2);
        o[db] = __builtin_amdgcn_mfma_f32_32x32x16_bf16(vf, pf[sp], o[db], 0, 0, 0);
      }
    }
  };
  float mfix;
  {
    float aq = fabsf(p.att_qnorm[layer * 64 + lane]), ak = fabsf(p.att_knorm[layer * 64 + lane]);
    aq = wave_max(aq); ak = wave_max(ak);
    mfix = 8.f * aq * ak * 1.02f * 1.44269504088896f * ATT_TAU;
  }
  const bool fast = mfix <= 40.f;
  if (fast) {
#pragma unroll
    for (int ks = 0; ks < 4; ++ks) {
      u32x4 w = *(u32x4*)&qf[ks];
#pragma unroll
      for (int e = 0; e < 4; ++e) w[e] = pack2(__uint_as_float(w[e] << 16) * cs, __uint_as_float(w[e] & 0xffff0000u) * cs);
      qf[ks] = *(bf16x8*)&w;
    }
  }
  auto compute_fast = [&](int buf, int sub) {
    const char* Kb = smem + buf * ATT_BUF + sub * 64 * ATT_KSTR;
    const char* Vb = smem + buf * ATT_BUF + ATT_VOFF + sub * 128;
    bf16x8 kf[8], vf[8];
#pragma unroll
    for (int kb = 0; kb < 2; ++kb)
#pragma unroll
      for (int ks = 0; ks < 4; ++ks) kf[kb * 4 + ks] = *(const bf16x8*)(Kb + (kb * 32 + l31) * ATT_KSTR + (ks * 16 + hh * 8) * 2);
#pragma unroll
    for (int sp = 0; sp < 4; ++sp)
#pragma unroll
      for (int db = 0; db < 2; ++db) vf[sp * 2 + db] = *(const bf16x8*)(Vb + (db * 32 + l31) * ATT_VSTR + (16 * sp + 8 * hh) * 2);
    f32x16 s[2];
#pragma unroll
    for (int kb = 0; kb < 2; ++kb) {
#pragma unroll
      for (int r = 0; r < 16; ++r) s[kb][r] = 0.f;
#pragma unroll
      for (int ks = 0; ks < 4; ++ks) s[kb] = __builtin_amdgcn_mfma_f32_32x32x16_bf16(kf[kb * 4 + ks], qf[ks], s[kb], 0, 0, 0);
    }
    bf16x8 pf[4];
    float ls = 0.f;
#pragma unroll
    for (int kb = 0; kb < 2; ++kb) {
      float pv[16];
#pragma unroll
      for (int r = 0; r < 16; ++r) { pv[r] = __builtin_amdgcn_exp2f(s[kb][r]); ls += pv[r]; }
#pragma unroll
      for (int sp = 0; sp < 2; ++sp) {
        u32x4 w;
#pragma unroll
        for (int e = 0; e < 4; ++e) w[e] = pack2(pv[8 * sp + 2 * e], pv[8 * sp + 2 * e + 1]);
        pf[kb * 2 + sp] = *(bf16x8*)&w;
      }
    }
    lrun += ls;
#pragma unroll
    for (int sp = 0; sp < 4; ++sp)
#pragma unroll
      for (int db = 0; db < 2; ++db) o[db] = __builtin_amdgcn_mfma_f32_32x32x16_bf16(vf[sp * 2 + db], pf[sp], o[db], 0, 0, 0);
  };
  __syncthreads();
  gload(kt0);
  lstore(0);
  __syncthreads();
  if (fast) {
    for (int t = 0; t < nkt; ++t) {
      const int buf = t & 1;
      if (t + 1 < nkt) gload(kt0 + t + 1);
      compute_fast(buf, 0);
      compute_fast(buf, 1);
      if (t + 1 < nkt) lstore(buf ^ 1);
      __syncthreads();
    }
  } else {
    for (int t = 0; t < nkt; ++t) {
      const int buf = t & 1;
      if (t + 1 < nkt) gload(kt0 + t + 1);
      compute(buf, 0);
      compute(buf, 1);
      if (t + 1 < nkt) lstore(buf ^ 1);
      __syncthreads();
    }
  }
  {
    float l = lrun + __shfl_xor(lrun, 32);
    float il = ATT_ALPHA / l;
    bf16_t* op = p.br + (size_t)(tok0 + l31) * 1536 + head * 64;
#pragma unroll
    for (int db = 0; db < 2; ++db)
#pragma unroll
      for (int g = 0; g < 4; ++g) {
        u32x2 w; w.x = pack2(o[db][4 * g] * il, o[db][4 * g + 1] * il); w.y = pack2(o[db][4 * g + 2] * il, o[db][4 * g + 3] * il);
        *(u32x2*)(op + db * 32 + 8 * g + 4 * hh) = w;
      }
  }
}

__device__ __forceinline__ void attn_item64(const Params& p, int layer, int item) {
  const int tid = tidx(), wid = tid >> 6, lane = tid & 63, l31 = lane & 31, hh = lane >> 5;
  int b, kvh, tok0, kt0, nkt;
  if (item < 512) { b = item >> 8; kvh = (item >> 7) & 1; tok0 = b * SEQ + (item & 127) * 64; kt0 = 0; nkt = 132; }
  else { int r = item - 512; b = r >> 3; kvh = (r >> 2) & 1; tok0 = NLAT + b * CTXL + (r & 3) * 64; kt0 = 128; nkt = 4; }
  const int head = kvh * 4 + wid;
  const float cs = 0.125f * 1.44269504088896f * ATT_TAU;
  bf16x8 qf[2][4];
#pragma unroll
  for (int qb = 0; qb < 2; ++qb)
#pragma unroll
    for (int ks = 0; ks < 4; ++ks) {
      u32x4 w = *(const u32x4*)(p.proj + (size_t)(tok0 + qb * 32 + l31) * 4096 + head * 64 + ks * 16 + hh * 8);
#pragma unroll
      for (int e = 0; e < 4; ++e) w[e] = pack2(__uint_as_float(w[e] << 16) * cs, __uint_as_float(w[e] & 0xffff0000u) * cs);
      qf[qb][ks] = *(bf16x8*)&w;
    }
  f32x16 o[2][2];
#pragma unroll
  for (int qb = 0; qb < 2; ++qb)
#pragma unroll
    for (int db = 0; db < 2; ++db)
#pragma unroll
      for (int r = 0; r < 16; ++r) o[qb][db][r] = 0.f;
  float lrun[2] = {0.f, 0.f};
  const bf16_t* vtb = p.vt + (size_t)(b * 2 + kvh) * 64 * 8448;
  auto stage = [&](int kt, int buf) {
    const int krow0 = kt < 128 ? b * SEQ + kt * 64 : NLAT + b * CTXL + (kt - 128) * 64;
    int ko = kt * 64; asm volatile("" : "+s"(ko));
    char* base = smem + buf * 16384;
#pragma unroll
    for (int i = 0; i < 2; ++i) {
      const int q = tid + 256 * i, r = q >> 3, c = (q & 7) ^ ((r >> 1) & 7);
      __builtin_amdgcn_global_load_lds((const unsigned*)(p.proj + (size_t)(krow0 + r) * 4096 + 512 + kvh * 64 + c * 8), (__attribute__((address_space(3))) unsigned*)(base + q * 16), 16, 0, 0);
      __builtin_amdgcn_global_load_lds((const unsigned*)(vtb + (size_t)r * 8448 + ko + c * 8), (__attribute__((address_space(3))) unsigned*)(base + 8192 + q * 16), 16, 0, 0);
    }
  };
  auto compute = [&](int buf) {
    const char* Kb = smem + buf * 16384;
    const char* Vb = Kb + 8192;
    bf16x8 pf[2][4];
#pragma unroll
    for (int kb = 0; kb < 2; ++kb) {
      bf16x8 kf[4];
      const int row = kb * 32 + l31;
#pragma unroll
      for (int ks = 0; ks < 4; ++ks) kf[ks] = *(const bf16x8*)(Kb + row * 128 + (((ks * 2 + hh) ^ ((row >> 1) & 7)) << 4));
      f32x16 s[2];
#pragma unroll
      for (int qb = 0; qb < 2; ++qb) {
#pragma unroll
        for (int r = 0; r < 16; ++r) s[qb][r] = 0.f;
#pragma unroll
        for (int ks = 0; ks < 4; ++ks) s[qb] = __builtin_amdgcn_mfma_f32_32x32x16_bf16(kf[ks], qf[qb][ks], s[qb], 0, 0, 0);
      }
#pragma unroll
      for (int qb = 0; qb < 2; ++qb) {
        float pv[16]; float ls = 0.f;
#pragma unroll
        for (int r = 0; r < 16; ++r) { pv[r] = __builtin_amdgcn_exp2f(s[qb][r]); ls += pv[r]; }
        lrun[qb] += ls;
#pragma unroll
        for (int sp = 0; sp < 2; ++sp) {
          u32x4 w;
#pragma unroll
          for (int e = 0; e < 4; ++e) w[e] = pack2(pv[8 * sp + 2 * e], pv[8 * sp + 2 * e + 1]);
          pf[qb][kb * 2 + sp] = *(bf16x8*)&w;
        }
      }
    }
#pragma unroll
    for (int sp = 0; sp < 4; ++sp)
#pragma unroll
      for (int db = 0; db < 2; ++db) {
        const int row = db * 32 + l31;
        bf16x8 vf = *(const bf16x8*)(Vb + row * 128 + (((sp * 2 + hh) ^ ((row >> 1) & 7)) << 4));
        o[0][db] = __builtin_amdgcn_mfma_f32_32x32x16_bf16(vf, pf[0][sp], o[0][db], 0, 0, 0);
        o[1][db] = __builtin_amdgcn_mfma_f32_32x32x16_bf16(vf, pf[1][sp], o[1][db], 0, 0, 0);
      }
  };
  __syncthreads();
  stage(kt0, 0);
  asm volatile("s_waitcnt vmcnt(0)" ::: "memory");
  __syncthreads();
  for (int t = 0; t < nkt; ++t) {
    if (t + 1 < nkt) stage(kt0 + t + 1, (t + 1) & 1);
    compute(t & 1);
    asm volatile("s_waitcnt vmcnt(0)" ::: "memory");
    __syncthreads();
  }
#pragma unroll
  for (int qb = 0; qb < 2; ++qb) {
    float l = lrun[qb] + __shfl_xor(lrun[qb], 32);
    float il = ATT_ALPHA / l;
    bf16_t* op = p.br + (size_t)(tok0 + qb * 32 + l31) * 1536 + head * 64;
#pragma unroll
    for (int db = 0; db < 2; ++db)
#pragma unroll
      for (int g = 0; g < 4; ++g) {
        u32x2 w; w.x = pack2(o[qb][db][4 * g] * il, o[qb][db][4 * g + 1] * il); w.y = pack2(o[qb][db][4 * g + 2] * il, o[qb][db][4 * g + 3] * il);
        *(u32x2*)(op + db * 32 + 8 * g + 4 * hh) = w;
      }
  }
}
__device__ __forceinline__ float attn_logit_bound(const Params& p, int layer) {
  const int lane = tidx() & 63;
  float aq = fabsf(p.att_qnorm[layer * 64 + lane]), ak = fabsf(p.att_knorm[layer * 64 + lane]);
  aq = wave_max(aq); ak = wave_max(ak);
  return 8.f * aq * ak * 1.02f * 1.44269504088896f * ATT_TAU;
}

__device__ __forceinline__ void phase_ssdprep(const Params& p, int layer) {
  const float* cw = p.ssd_conv_w + (size_t)layer * 5 * 768;
  const float* cb = p.ssd_conv_b + layer * 768;
  const int total = (MROWS / 16) * 96;
  for (int i = bidx() * NTHR + tidx(); i < total; i += gridDim.x * NTHR) {
    const int run = i / 96, c0 = (i - run * 96) * 8;
    const int row0 = run * 16;
    int t0, T;
    if (row0 < NLAT) { t0 = row0 & (SEQ - 1); T = SEQ; } else { t0 = (row0 - NLAT) & (CTXL - 1); T = CTXL; }
    float w[5][8], bias[8];
#pragma unroll
    for (int j = 0; j < 5; ++j) {
      f32x4 w0 = *(const f32x4*)(cw + j * 768 + c0), w1 = *(const f32x4*)(cw + j * 768 + c0 + 4);
#pragma unroll
      for (int e = 0; e < 4; ++e) { w[j][e] = w0[e]; w[j][4 + e] = w1[e]; }
    }
    {
      f32x4 b0 = *(const f32x4*)(cb + c0), b1 = *(const f32x4*)(cb + c0 + 4);
#pragma unroll
      for (int e = 0; e < 4; ++e) { bias[e] = b0[e]; bias[4 + e] = b1[e]; }
    }
    const bf16_t* src = p.proj + (size_t)row0 * 4096 + 1280 + c0;
    u32x4 win[5];
    const u32x4 zero4 = {0u, 0u, 0u, 0u};
    win[0] = zero4;
    win[1] = t0 >= 2 ? *(const u32x4*)(src - 2 * 4096) : zero4;
    win[2] = t0 >= 1 ? *(const u32x4*)(src - 1 * 4096) : zero4;
    win[3] = *(const u32x4*)(src);
    win[4] = *(const u32x4*)(src + 4096);
#pragma unroll
    for (int r = 0; r < 16; ++r) {
      win[0] = win[1]; win[1] = win[2]; win[2] = win[3]; win[3] = win[4];
      win[4] = (t0 + r + 2 < T) ? *(const u32x4*)(src + (size_t)(r + 2) * 4096) : zero4;
      float a[8];
#pragma unroll
      for (int e = 0; e < 8; ++e) a[e] = bias[e];
#pragma unroll
      for (int j = 0; j < 5; ++j)
#pragma unroll
        for (int e = 0; e < 4; ++e) {
          a[2 * e] += w[j][2 * e] * __uint_as_float(win[j][e] << 16);
          a[2 * e + 1] += w[j][2 * e + 1] * __uint_as_float(win[j][e] & 0xffff0000u);
        }
      u32x4 o;
#pragma unroll
      for (int e = 0; e < 4; ++e) o[e] = pack2(siluf_(a[2 * e]), siluf_(a[2 * e + 1]));
      *(u32x4*)(p.xbc + (size_t)(row0 + r) * 768 + c0) = o;
    }
  }
  const int total2 = MROWS * 16;
  for (int i = bidx() * NTHR + tidx(); i < total2; i += gridDim.x * NTHR) {
    int row = i >> 4, j = i & 15;
    p.dtb[i] = softplusf_(p.small[(size_t)row * 32 + j] + p.ssd_dt_bias[layer * 16 + j]);
  }
}

__device__ __forceinline__ int chunk_row0(int b, int c) { return c < 64 ? b * SEQ + c * 128 : NLAT + b * CTXL + (c - 64) * 128; }
__device__ __forceinline__ float wave_incl_scan(float v, int lane) {
#pragma unroll
  for (int o = 1; o < 64; o <<= 1) { float t = __shfl_up(v, o); if (lane >= o) v += t; }
  return v;
}
__device__ __forceinline__ void ssd_scans(const Params& p, int layer, int row0, int h, float* fl) {
  const int tid = tidx(), lane = tid & 63, wv = tid >> 6;
  const bool fwd = tid < 128;
  const int s = fwd ? tid : 127 - (tid - 128);
  const float A = -__expf(p.ssd_a_log[layer * 16 + (fwd ? 0 : 8) + h]);
  const float dt = p.dtb[(size_t)(row0 + s) * 16 + (fwd ? 0 : 8) + h];
  float v = wave_incl_scan(dt * A, lane);
  if (lane == 63) fl[512 + wv] = v;
  __syncthreads();
  if (wv & 1) v += fl[512 + wv - 1];
  fl[(fwd ? 0 : 128) + s] = v;
  fl[(fwd ? 256 : 384) + s] = dt;
  __syncthreads();
}

#define SSD_TSTR 272
__device__ __forceinline__ void ssdA_item(const Params& p, int layer, int item) {
  const int tid = tidx(), wid = tid >> 6, lane = tid & 63, l31 = lane & 31, hh = lane >> 5;
  const int b = item / 528, c = (item / 8) % 66, h = item & 7, g = h >> 2;
  const int row0 = chunk_row0(b, c);
  float* fl = (float*)smem;
  char* BT = smem + 4096;
  char* XF = BT + 64 * SSD_TSTR;
  char* XB = XF + 64 * SSD_TSTR;
  __syncthreads();
  ssd_scans(p, layer, row0, h, fl);
  const float cfl = fl[127], cbl = fl[128];
  {
    const int s = tid >> 1, half = tid & 1;
    const float wf = __expf(cfl - fl[s]) * fl[256 + s], wb = __expf(cbl - fl[128 + s]) * fl[384 + s];
    const bf16_t* xr = p.xbc + (size_t)(row0 + s) * 768;
#pragma unroll
    for (int i = 0; i < 4; ++i) {
      u32x4 xv = *(const u32x4*)(xr + h * 64 + half * 32 + i * 8);
      u32x4 bv = *(const u32x4*)(xr + 512 + g * 64 + half * 32 + i * 8);
#pragma unroll
      for (int e = 0; e < 4; ++e) {
        int pp = half * 32 + i * 8 + 2 * e;
        float x0 = __uint_as_float(xv[e] << 16), x1 = __uint_as_float(xv[e] & 0xffff0000u);
        *(bf16_t*)(XF + pp * SSD_TSTR + s * 2) = f2bf(x0 * wf);
        *(bf16_t*)(XF + (pp + 1) * SSD_TSTR + s * 2) = f2bf(x1 * wf);
        *(bf16_t*)(XB + pp * SSD_TSTR + s * 2) = f2bf(x0 * wb);
        *(bf16_t*)(XB + (pp + 1) * SSD_TSTR + s * 2) = f2bf(x1 * wb);
        *(bf16_t*)(BT + pp * SSD_TSTR + s * 2) = (bf16_t)(bv[e] & 0xffffu);
        *(bf16_t*)(BT + (pp + 1) * SSD_TSTR + s * 2) = (bf16_t)(bv[e] >> 16);
      }
    }
  }
  __syncthreads();
  const int nb = wid >> 1, pb = wid & 1;
#pragma unroll
  for (int dir = 0; dir < 2; ++dir) {
    const char* XT = dir == 0 ? XF : XB;
    f32x16 acc;
#pragma unroll
    for (int r = 0; r < 16; ++r) acc[r] = 0.f;
#pragma unroll
    for (int ks = 0; ks < 8; ++ks) {
      bf16x8 a = *(const bf16x8*)(BT + (nb * 32 + l31) * SSD_TSTR + (ks * 16 + hh * 8) * 2);
      bf16x8 bb = *(const bf16x8*)(XT + (pb * 32 + l31) * SSD_TSTR + (ks * 16 + hh * 8) * 2);
      acc = __builtin_amdgcn_mfma_f32_32x32x16_bf16(a, bb, acc, 0, 0, 0);
    }
    bf16_t* dst = p.ssl + ((size_t)(((dir * 2 + b) * 8 + h) * 66 + c) * 64 + pb * 32 + l31) * 64 + nb * 32 + 4 * hh;
#pragma unroll
    for (int q4 = 0; q4 < 4; ++q4) {
      u32x2 w; w.x = pack2(acc[4 * q4], acc[4 * q4 + 1]); w.y = pack2(acc[4 * q4 + 2], acc[4 * q4 + 3]);
      *(u32x2*)(dst + 8 * q4) = w;
    }
  }
  if (tid == 0) {
    p.sdec[((0 * 2 + b) * 8 + h) * 66 + c] = __expf(cfl);
    p.sdec[((1 * 2 + b) * 8 + h) * 66 + c] = __expf(cbl);
  }
}

__device__ __forceinline__ void phase_ssdcarry(const Params& p) {
  const int total = 32 * 1024;
  for (int i = bidx() * NTHR + tidx(); i < total; i += gridDim.x * NTHR) {
    const int seq = i >> 10, el = (i & 1023) * 4;
    const int dir = seq >> 4;
    bf16_t* base = p.ssl + (size_t)seq * 66 * 4096 + el;
    const float* dec = p.sdec + seq * 66;
    float st[4] = {0.f, 0.f, 0.f, 0.f};
#pragma unroll 22
    for (int k = 0; k < 66; ++k) {
      int c = dir == 0 ? (k < 2 ? 64 + k : k - 2) : (65 - k);
      u32x2 v = *(const u32x2*)(base + (size_t)c * 4096);
      float d = dec[c];
      u32x2 w; w.x = pack2(st[0], st[1]); w.y = pack2(st[2], st[3]);
      *(u32x2*)(base + (size_t)c * 4096) = w;
      st[0] = d * st[0] + __uint_as_float(v.x << 16); st[1] = d * st[1] + __uint_as_float(v.x & 0xffff0000u);
      st[2] = d * st[2] + __uint_as_float(v.y << 16); st[3] = d * st[3] + __uint_as_float(v.y & 0xffff0000u);
    }
  }
}

__device__ __forceinline__ void ssdC_item(const Params& p, int layer, int item) {
  const int tid = tidx(), wid = tid >> 6, lane = tid & 63, l31 = lane & 31, hh = lane >> 5;
  const int b = item / 528, c = (item / 8) % 66, h = item & 7, g = h >> 2;
  const int row0 = chunk_row0(b, c);
  float* fl = (float*)smem;
  char* Bt = smem + 4096;
  char* XT = Bt + 128 * 144;
  __syncthreads();
  ssd_scans(p, layer, row0, h, fl);
  {
#pragma unroll
    for (int i = 0; i < 4; ++i) {
      int id = tid + 256 * i, r = id >> 3, c16 = id & 7;
      *(u32x4*)(Bt + r * 144 + c16 * 16) = *(const u32x4*)(p.xbc + (size_t)(row0 + r) * 768 + 512 + g * 64 + c16 * 8);
    }
    const int s = tid >> 1, half = tid & 1;
    const bf16_t* xr = p.xbc + (size_t)(row0 + s) * 768 + h * 64 + half * 32;
#pragma unroll
    for (int i = 0; i < 4; ++i) {
      u32x4 xv = *(const u32x4*)(xr + i * 8);
#pragma unroll
      for (int e = 0; e < 4; ++e) {
        int pp = half * 32 + i * 8 + 2 * e;
        *(bf16_t*)(XT + pp * SSD_TSTR + s * 2) = (bf16_t)(xv[e] & 0xffffu);
        *(bf16_t*)(XT + (pp + 1) * SSD_TSTR + s * 2) = (bf16_t)(xv[e] >> 16);
      }
    }
  }
  __syncthreads();
  const int s = wid * 32 + l31;
  const float cfs = fl[s], cbs = fl[128 + s];
  bf16x8 cf[4];
#pragma unroll
  for (int ks = 0; ks < 4; ++ks) cf[ks] = *(const bf16x8*)(p.xbc + (size_t)(row0 + s) * 768 + 640 + g * 64 + ks * 16 + hh * 8);
  f32x16 Y[2];
  {
    f32x16 aF[2], aB[2];
#pragma unroll
    for (int pb = 0; pb < 2; ++pb)
#pragma unroll
      for (int r = 0; r < 16; ++r) { aF[pb][r] = 0.f; aB[pb][r] = 0.f; }
    const bf16_t* spf = p.ssl + (size_t)(((0 * 2 + b) * 8 + h) * 66 + c) * 4096;
    const bf16_t* spb = p.ssl + (size_t)(((1 * 2 + b) * 8 + h) * 66 + c) * 4096;
#pragma unroll
    for (int pb = 0; pb < 2; ++pb)
#pragma unroll
      for (int ks = 0; ks < 4; ++ks) {
        bf16x8 a0 = *(const bf16x8*)(spf + (pb * 32 + l31) * 64 + ks * 16 + hh * 8);
        bf16x8 a1 = *(const bf16x8*)(spb + (pb * 32 + l31) * 64 + ks * 16 + hh * 8);
        aF[pb] = __builtin_amdgcn_mfma_f32_32x32x16_bf16(a0, cf[ks], aF[pb], 0, 0, 0);
        aB[pb] = __builtin_amdgcn_mfma_f32_32x32x16_bf16(a1, cf[ks], aB[pb], 0, 0, 0);
      }
    const float ef = __expf(cfs), eb = __expf(cbs);
#pragma unroll
    for (int pb = 0; pb < 2; ++pb)
#pragma unroll
      for (int r = 0; r < 16; ++r) Y[pb][r] = aF[pb][r] * ef + aB[pb][r] * eb;
  }
  for (int rb = 0; rb < 4; ++rb) {
    f32x16 gt;
#pragma unroll
    for (int r = 0; r < 16; ++r) gt[r] = 0.f;
#pragma unroll
    for (int ks = 0; ks < 4; ++ks) {
      bf16x8 a = *(const bf16x8*)(Bt + (rb * 32 + l31) * 144 + (ks * 16 + hh * 8) * 2);
      gt = __builtin_amdgcn_mfma_f32_32x32x16_bf16(a, cf[ks], gt, 0, 0, 0);
    }
#pragma unroll
    for (int dir = 0; dir < 2; ++dir) {
      if (dir == 0 ? (rb > wid) : (rb < wid)) continue;
      const float* cum = fl + (dir == 0 ? 0 : 128);
      const float* dta = fl + (dir == 0 ? 256 : 384);
      const float cs = dir == 0 ? cfs : cbs;
      float val[16];
#pragma unroll
      for (int q4 = 0; q4 < 4; ++q4) {
        int r0 = rb * 32 + 8 * q4 + 4 * hh;
        f32x4 cr = *(const f32x4*)(cum + r0), dr = *(const f32x4*)(dta + r0);
#pragma unroll
        for (int e = 0; e < 4; ++e) {
          int r = r0 + e;
          bool keep = dir == 0 ? (r <= s) : (r >= s);
          float arg = fminf(cs - cr[e], 0.f);
          val[4 * q4 + e] = keep ? gt[4 * q4 + e] * __expf(arg) * dr[e] : 0.f;
        }
      }
#pragma unroll
      for (int sp = 0; sp < 2; ++sp) {
        u32x4 w;
#pragma unroll
        for (int e = 0; e < 4; ++e) w[e] = pack2(val[8 * sp + 2 * e], val[8 * sp + 2 * e + 1]);
        bf16x8 pf = *(bf16x8*)&w;
#pragma unroll
        for (int pb = 0; pb < 2; ++pb) {
          const char* xa = XT + (pb * 32 + l31) * SSD_TSTR + (rb * 32 + 16 * sp + 4 * hh) * 2;
          u32x2 v0 = *(const u32x2*)xa, v1 = *(const u32x2*)(xa + 16);
          u32x4 vw = {v0[0], v0[1], v1[0], v1[1]};
          Y[pb] = __builtin_amdgcn_mfma_f32_32x32x16_bf16(*(bf16x8*)&vw, pf, Y[pb], 0, 0, 0);
        }
      }
    }
  }
  bf16_t* op = p.yf + (size_t)(row0 + s) * 512 + h * 64;
#pragma unroll
  for (int pb = 0; pb < 2; ++pb)
#pragma unroll
    for (int q4 = 0; q4 < 4; ++q4) {
      u32x2 w; w.x = pack2(Y[pb][4 * q4], Y[pb][4 * q4 + 1]); w.y = pack2(Y[pb][4 * q4 + 2], Y[pb][4 * q4 + 3]);
      *(u32x2*)(op + pb * 32 + 8 * q4 + 4 * hh) = w;
    }
}

__device__ __forceinline__ void phase_ssdout(const Params& p, int layer, int nrows) {
  const int lane = tidx() & 63, wv = tidx() >> 6;
  const float* ng = p.ssd_norm + layer * 512;
  for (int row = bidx() * 4 + wv; row < nrows; row += gridDim.x * 4) {
    int c0 = lane * 8; int h = c0 >> 6;
    float Dk = p.ssd_d[layer * 8 + h];
    u32x4 a = *(const u32x4*)(p.yf + (size_t)row * 512 + c0);
    u32x4 xs = *(const u32x4*)(p.xbc + (size_t)row * 768 + c0), z = *(const u32x4*)(p.proj + (size_t)row * 4096 + 768 + c0);
    float y[8]; float ss = 0.f;
#pragma unroll
    for (int e = 0; e < 4; ++e) {
      float y0 = __uint_as_float(a[e] << 16) + __uint_as_float(xs[e] << 16) * Dk;
      float y1 = __uint_as_float(a[e] & 0xffff0000u) + __uint_as_float(xs[e] & 0xffff0000u) * Dk;
      y0 *= siluf_(__uint_as_float(z[e] << 16)); y1 *= siluf_(__uint_as_float(z[e] & 0xffff0000u));
      y[2 * e] = y0; y[2 * e + 1] = y1; ss += y0 * y0 + y1 * y1;
    }
    ss = wave_sum(ss);
    float rs = rsqrtf(ss * (1.f / 512.f) + 1e-6f);
    u32x4 w;
#pragma unroll
    for (int e = 0; e < 4; ++e) w[e] = pack2(y[2 * e] * rs * ng[c0 + 2 * e], y[2 * e + 1] * rs * ng[c0 + 2 * e + 1]);
    *(u32x4*)(p.br + (size_t)row * 1536 + 512 + c0) = w;
  }
}

__device__ __forceinline__ float wave_incl_maxscan(float v, int lane) {
#pragma unroll
  for (int o = 1; o < 64; o <<= 1) { float t = __shfl_up(v, o); if (lane >= o) v = fmaxf(v, t); }
  return v;
}
__device__ __forceinline__ void ml_scans(const Params& p, int layer, int row0, int h, float* fl) {
  const int tid = tidx(), lane = tid & 63, wv = tid >> 6;
  const int dir = tid >> 7;
  const int s = dir == 0 ? tid : 127 - (tid - 128);
  const float ip = p.small[(size_t)(row0 + s) * 32 + 16 + dir * 8 + h] + p.ml_gate_bias[layer * 16 + dir * 8 + h];
  const float fp = p.small[(size_t)(row0 + s) * 32 + 16 + dir * 8 + 4 + h] + p.ml_gate_bias[layer * 16 + dir * 8 + 4 + h];
  float bc = wave_incl_scan(logsigmoidf_(fp), lane);
  if (lane == 63) fl[768 + wv] = bc;
  __syncthreads();
  if (wv & 1) bc += fl[768 + wv - 1];
  const float u = ip - bc;
  float pm = wave_incl_maxscan(u, lane);
  if (lane == 63) fl[776 + wv] = pm;
  __syncthreads();
  if (wv & 1) pm = fmaxf(pm, fl[776 + wv - 1]);
  fl[dir * 128 + s] = bc; fl[256 + dir * 128 + s] = u; fl[512 + dir * 128 + s] = pm;
  __syncthreads();
}

#define ML_TSTR 272
__device__ __forceinline__ void mlA_item(const Params& p, int layer, int item) {
  const int tid = tidx(), wid = tid >> 6, lane = tid & 63, l31 = lane & 31, hh = lane >> 5;
  const int b = item / 264, c = (item / 4) % 66, h = item & 3;
  const int row0 = chunk_row0(b, c);
  float* fl = (float*)smem;
  char* KT = smem + 8192;
  char* VW = KT + 128 * ML_TSTR;
  __syncthreads();
  ml_scans(p, layer, row0, h, fl);
  const int r_ = tid >> 1, half = tid & 1;
  {
    const bf16_t* kr = p.proj + (size_t)(row0 + r_) * 4096 + 2560 + h * 128 + half * 64;
#pragma unroll
    for (int i = 0; i < 8; ++i) {
      u32x4 kv = *(const u32x4*)(kr + i * 8);
#pragma unroll
      for (int e = 0; e < 4; ++e) {
        int ee = half * 64 + i * 8 + 2 * e;
        *(bf16_t*)(KT + ee * ML_TSTR + r_ * 2) = (bf16_t)(kv[e] & 0xffffu);
        *(bf16_t*)(KT + (ee + 1) * ML_TSTR + r_ * 2) = (bf16_t)(kv[e] >> 16);
      }
    }
  }
  for (int dir = 0; dir < 2; ++dir) {
    const int seq = (dir * 2 + b) * 4 + h;
    const float blast = fl[dir * 128 + (dir == 0 ? 127 : 0)];
    const float umax = fl[512 + dir * 128 + (dir == 0 ? 127 : 0)];
    {
      const float wgt = __expf(fl[256 + dir * 128 + r_] - umax) * 0.08838834764831845f;
      if (half == 0) fl[1024 + r_] = wgt;
      const bf16_t* vr = p.proj + (size_t)(row0 + r_) * 4096 + 3072 + h * 128 + half * 64;
#pragma unroll
      for (int i = 0; i < 8; ++i) {
        u32x4 vv = *(const u32x4*)(vr + i * 8);
#pragma unroll
        for (int e = 0; e < 4; ++e) {
          int dd = half * 64 + i * 8 + 2 * e;
          *(bf16_t*)(VW + dd * ML_TSTR + r_ * 2) = f2bf(__uint_as_float(vv[e] << 16) * wgt);
          *(bf16_t*)(VW + (dd + 1) * ML_TSTR + r_ * 2) = f2bf(__uint_as_float(vv[e] & 0xffff0000u) * wgt);
        }
      }
    }
    __syncthreads();
    {
      const int e_ = tid & 127, hf = tid >> 7;
      float a = 0.f;
#pragma unroll
      for (int i = 0; i < 8; ++i) {
        u32x4 kv = *(const u32x4*)(KT + e_ * ML_TSTR + (hf * 64 + i * 8) * 2);
        const float* wp = fl + 1024 + hf * 64 + i * 8;
#pragma unroll
        for (int e = 0; e < 4; ++e) a += __uint_as_float(kv[e] << 16) * wp[2 * e] + __uint_as_float(kv[e] & 0xffff0000u) * wp[2 * e + 1];
      }
      if (hf == 1) fl[1280 + e_] = a;
      __syncthreads();
      if (hf == 0) p.mnl[((size_t)seq * 66 + c) * 128 + e_] = a + fl[1280 + e_];
    }
    f32x16 acc[4];
#pragma unroll
    for (int eb = 0; eb < 4; ++eb)
#pragma unroll
      for (int r = 0; r < 16; ++r) acc[eb][r] = 0.f;
#pragma unroll
    for (int ks = 0; ks < 8; ++ks) {
      bf16x8 bv = *(const bf16x8*)(VW + (wid * 32 + l31) * ML_TSTR + (ks * 16 + hh * 8) * 2);
#pragma unroll
      for (int eb = 0; eb < 4; ++eb) {
        bf16x8 av = *(const bf16x8*)(KT + (eb * 32 + l31) * ML_TSTR + (ks * 16 + hh * 8) * 2);
        acc[eb] = __builtin_amdgcn_mfma_f32_32x32x16_bf16(av, bv, acc[eb], 0, 0, 0);
      }
    }
    bf16_t* dst = p.mcl + (((size_t)seq * 66 + c) * 128 + wid * 32 + l31) * 128 + 4 * hh;
#pragma unroll
    for (int eb = 0; eb < 4; ++eb)
#pragma unroll
      for (int q4 = 0; q4 < 4; ++q4) {
        u32x2 w; w.x = pack2(acc[eb][4 * q4], acc[eb][4 * q4 + 1]); w.y = pack2(acc[eb][4 * q4 + 2], acc[eb][4 * q4 + 3]);
        *(u32x2*)(dst + eb * 32 + 8 * q4) = w;
      }
    if (tid == 0) { p.mml[seq * 66 + c] = blast + umax; p.mbl[seq * 66 + c] = blast; }
    __syncthreads();
  }
}

__device__ __forceinline__ void phase_mlcarry(const Params& p) {
  const int per = 4096 + 32;
  const int total = 16 * per;
  for (int i = bidx() * NTHR + tidx(); i < total; i += gridDim.x * NTHR) {
    const int seq = i / per, j = i % per;
    const int dir = seq >> 3;
    const float* ml = p.mml + seq * 66; const float* bl = p.mbl + seq * 66;
    float m = 0.f;
    float st[4] = {0.f, 0.f, 0.f, 0.f};
    const bool isC = j < 4096;
    bf16_t* cb = p.mcl + (size_t)seq * 66 * 16384 + (isC ? j * 4 : 0);
    float* nb = p.mnl + (size_t)seq * 66 * 128 + (isC ? 0 : (j - 4096) * 4);
#pragma unroll 11
    for (int k = 0; k < 66; ++k) {
      int c = dir == 0 ? (k < 2 ? 64 + k : k - 2) : (65 - k);
      float mlc = ml[c], blc = bl[c];
      float mnew = fmaxf(blc + m, mlc);
      float ap = __expf(blc + m - mnew), al = __expf(mlc - mnew);
      if (isC) {
        u32x2 v = *(const u32x2*)(cb + (size_t)c * 16384);
        u32x2 w; w.x = pack2(st[0], st[1]); w.y = pack2(st[2], st[3]);
        *(u32x2*)(cb + (size_t)c * 16384) = w;
        st[0] = ap * st[0] + al * __uint_as_float(v.x << 16); st[1] = ap * st[1] + al * __uint_as_float(v.x & 0xffff0000u);
        st[2] = ap * st[2] + al * __uint_as_float(v.y << 16); st[3] = ap * st[3] + al * __uint_as_float(v.y & 0xffff0000u);
        if (j == 0) p.mmp[seq * 66 + c] = m;
      } else {
        f32x4 v = *(const f32x4*)(nb + (size_t)c * 128);
        f32x4 w = {st[0], st[1], st[2], st[3]};
        *(f32x4*)(nb + (size_t)c * 128) = w;
        st[0] = ap * st[0] + al * v[0]; st[1] = ap * st[1] + al * v[1]; st[2] = ap * st[2] + al * v[2]; st[3] = ap * st[3] + al * v[3];
      }
      m = mnew;
    }
  }
}

__device__ __forceinline__ void mlC_item(const Params& p, int layer, int item) {
  const int tid = tidx(), wid = tid >> 6, lane = tid & 63, l31 = lane & 31, hh = lane >> 5;
  const int b = item / 264, c = (item / 4) % 66, h = item & 3;
  const int row0 = chunk_row0(b, c);
  float* fl = (float*)smem;
  char* Kt = smem + 8192;
  char* VT = Kt + 128 * ML_TSTR;
  __syncthreads();
  ml_scans(p, layer, row0, h, fl);
  {
#pragma unroll
    for (int i = 0; i < 8; ++i) {
      int id = tid + 256 * i, r = id >> 4, c16 = id & 15;
      *(u32x4*)(Kt + r * ML_TSTR + c16 * 16) = *(const u32x4*)(p.proj + (size_t)(row0 + r) * 4096 + 2560 + h * 128 + c16 * 8);
    }
    const int r_ = tid >> 1, half = tid & 1;
    const bf16_t* vr = p.proj + (size_t)(row0 + r_) * 4096 + 3072 + h * 128 + half * 64;
#pragma unroll
    for (int i = 0; i < 8; ++i) {
      u32x4 vv = *(const u32x4*)(vr + i * 8);
#pragma unroll
      for (int e = 0; e < 4; ++e) {
        int dd = half * 64 + i * 8 + 2 * e;
        *(bf16_t*)(VT + dd * ML_TSTR + r_ * 2) = (bf16_t)(vv[e] & 0xffffu);
        *(bf16_t*)(VT + (dd + 1) * ML_TSTR + r_ * 2) = (bf16_t)(vv[e] >> 16);
      }
    }
    {
      const int dir = tid >> 7, e_ = tid & 127;
      const int seq = (dir * 2 + b) * 4 + h;
      fl[1024 + dir * 128 + e_] = p.mnl[((size_t)seq * 66 + c) * 128 + e_];
    }
  }
  __syncthreads();
  const int s = wid * 32 + l31;
  bf16x8 qf[8];
#pragma unroll
  for (int ks = 0; ks < 8; ++ks) qf[ks] = *(const bf16x8*)(p.proj + (size_t)(row0 + s) * 4096 + 2048 + h * 128 + ks * 16 + hh * 8);
  f32x16 hacc[4];
#pragma unroll
  for (int db = 0; db < 4; ++db)
#pragma unroll
    for (int r = 0; r < 16; ++r) hacc[db][r] = 0.f;
  for (int dir = 0; dir < 2; ++dir) {
    const int seq = (dir * 2 + b) * 4 + h;
    const float mprev = p.mmp[seq * 66 + c];
    const float bcs = fl[dir * 128 + s], pms = fl[512 + dir * 128 + s];
    const float msel = fmaxf(mprev, pms);
    const float ms = bcs + msel;
    const float winter = __expf(mprev - msel);
    const float* uu = fl + 256 + dir * 128;
    float qn = 0.f;
    {
      const float* np = fl + 1024 + dir * 128;
#pragma unroll
      for (int ks = 0; ks < 8; ++ks) {
        u32x4 w = *(u32x4*)&qf[ks];
        const float* npp = np + ks * 16 + hh * 8;
#pragma unroll
        for (int e = 0; e < 4; ++e) qn += __uint_as_float(w[e] << 16) * npp[2 * e] + __uint_as_float(w[e] & 0xffff0000u) * npp[2 * e + 1];
      }
      qn += __shfl_xor(qn, 32);
    }
    float den = 0.f;
    for (int rb = 0; rb < 4; ++rb) {
      if (dir == 0 ? (rb > wid) : (rb < wid)) continue;
      f32x16 st;
#pragma unroll
      for (int r = 0; r < 16; ++r) st[r] = 0.f;
#pragma unroll
      for (int ks = 0; ks < 8; ++ks) {
        bf16x8 a = *(const bf16x8*)(Kt + (rb * 32 + l31) * ML_TSTR + (ks * 16 + hh * 8) * 2);
        st = __builtin_amdgcn_mfma_f32_32x32x16_bf16(a, qf[ks], st, 0, 0, 0);
      }
#pragma unroll
      for (int q4 = 0; q4 < 4; ++q4) {
        int r0 = rb * 32 + 8 * q4 + 4 * hh;
        f32x4 ur = *(const f32x4*)(uu + r0);
#pragma unroll
        for (int e = 0; e < 4; ++e) {
          int r = r0 + e;
          bool keep = dir == 0 ? (r <= s) : (r >= s);
          float arg = fminf(ur[e] - msel, 0.f);
          den += keep ? st[4 * q4 + e] * 0.08838834764831845f * __expf(arg) : 0.f;
        }
      }
    }
    den += __shfl_xor(den, 32);
    den += winter * qn;
    const float inv = 1.f / fmaxf(fabsf(den), __expf(-ms));
    {
      const float qs = winter * inv;
      const bf16_t* cp = p.mcl + ((size_t)seq * 66 + c) * 16384;
#pragma unroll
      for (int ks = 0; ks < 8; ++ks) {
        u32x4 w = *(u32x4*)&qf[ks];
        u32x4 ws;
#pragma unroll
        for (int e = 0; e < 4; ++e) ws[e] = pack2(__uint_as_float(w[e] << 16) * qs, __uint_as_float(w[e] & 0xffff0000u) * qs);
        bf16x8 qsf = *(bf16x8*)&ws;
#pragma unroll
        for (int db = 0; db < 4; ++db) {
          bf16x8 a = *(const bf16x8*)(cp + (db * 32 + l31) * 128 + ks * 16 + hh * 8);
          hacc[db] = __builtin_amdgcn_mfma_f32_32x32x16_bf16(a, qsf, hacc[db], 0, 0, 0);
        }
      }
    }
    for (int rb = 0; rb < 4; ++rb) {
      if (dir == 0 ? (rb > wid) : (rb < wid)) continue;
      f32x16 st;
#pragma unroll
      for (int r = 0; r < 16; ++r) st[r] = 0.f;
#pragma unroll
      for (int ks = 0; ks < 8; ++ks) {
        bf16x8 a = *(const bf16x8*)(Kt + (rb * 32 + l31) * ML_TSTR + (ks * 16 + hh * 8) * 2);
        st = __builtin_amdgcn_mfma_f32_32x32x16_bf16(a, qf[ks], st, 0, 0, 0);
      }
      const float sc = 0.08838834764831845f * inv;
#pragma unroll
      for (int sp = 0; sp < 2; ++sp) {
        u32x4 w;
#pragma unroll
        for (int q2 = 0; q2 < 2; ++q2) {
          int q4 = 2 * sp + q2;
          int r0 = rb * 32 + 8 * q4 + 4 * hh;
          f32x4 ur = *(const f32x4*)(uu + r0);
          float v[4];
#pragma unroll
          for (int e = 0; e < 4; ++e) {
            int r = r0 + e;
            bool keep = dir == 0 ? (r <= s) : (r >= s);
            float arg = fminf(ur[e] - msel, 0.f);
            v[e] = keep ? st[4 * q4 + e] * sc * __expf(arg) : 0.f;
          }
          w[2 * q2] = pack2(v[0], v[1]); w[2 * q2 + 1] = pack2(v[2], v[3]);
        }
        bf16x8 pf = *(bf16x8*)&w;
#pragma unroll
        for (int db = 0; db < 4; ++db) {
          const char* va = VT + (db * 32 + l31) * ML_TSTR + (rb * 32 + 16 * sp + 4 * hh) * 2;
          u32x2 v0 = *(const u32x2*)va, v1 = *(const u32x2*)(va + 16);
          u32x4 vw = {v0[0], v0[1], v1[0], v1[1]};
          hacc[db] = __builtin_amdgcn_mfma_f32_32x32x16_bf16(*(bf16x8*)&vw, pf, hacc[db], 0, 0, 0);
        }
      }
    }
  }
  bf16_t* op = p.hf + (size_t)(row0 + s) * 512 + h * 128;
#pragma unroll
  for (int db = 0; db < 4; ++db)
#pragma unroll
    for (int q4 = 0; q4 < 4; ++q4) {
      u32x2 w; w.x = pack2(hacc[db][4 * q4], hacc[db][4 * q4 + 1]); w.y = pack2(hacc[db][4 * q4 + 2], hacc[db][4 * q4 + 3]);
      *(u32x2*)(op + db * 32 + 8 * q4 + 4 * hh) = w;
    }
}

__device__ __forceinline__ void phase_mlout(const Params& p, int layer, int nrows) {
  const int lane = tidx() & 63, wv = tidx() >> 6;
  const float* ng = p.ml_norm + layer * 512;
  for (int row = bidx() * 4 + wv; row < nrows; row += gridDim.x * 4) {
    int c0 = lane * 8;
    u32x4 a = *(const u32x4*)(p.hf + (size_t)row * 512 + c0);
    u32x4 o = *(const u32x4*)(p.proj + (size_t)row * 4096 + 3584 + c0);
    float y[8]; float ss = 0.f;
#pragma unroll
    for (int e = 0; e < 4; ++e) {
      float y0 = __uint_as_float(a[e] << 16);
      float y1 = __uint_as_float(a[e] & 0xffff0000u);
      y[2 * e] = y0; y[2 * e + 1] = y1; ss += y0 * y0 + y1 * y1;
    }
    ss += __shfl_xor(ss, 1); ss += __shfl_xor(ss, 2); ss += __shfl_xor(ss, 4); ss += __shfl_xor(ss, 8);
    float rs = rsqrtf(ss * (1.f / 128.f) + 1e-6f);
    u32x4 w;
#pragma unroll
    for (int e = 0; e < 4; ++e) {
      float o0 = sigmoidf_(__uint_as_float(o[e] << 16)), o1 = sigmoidf_(__uint_as_float(o[e] & 0xffff0000u));
      w[e] = pack2(y[2 * e] * rs * ng[c0 + 2 * e] * o0, y[2 * e + 1] * rs * ng[c0 + 2 * e + 1] * o1);
    }
    *(u32x4*)(p.br + (size_t)row * 1536 + 1024 + c0) = w;
  }
}

__device__ __forceinline__ void phase_uvconv(const Params& p, int layer) {
  const size_t n4 = (size_t)16384 * 1024 / 4;
  const f32x4* su = (const f32x4*)(p.peer_u + (size_t)layer * 16384 * 1024);
  const f32x4* sv = (const f32x4*)(p.peer_v + (size_t)layer * 16384 * 1024);
  u32x2* du = (u32x2*)p.uv; u32x2* dv = (u32x2*)(p.uv + (size_t)16384 * 1024);
  for (size_t i = (size_t)bidx() * NTHR + tidx(); i < n4; i += (size_t)gridDim.x * NTHR) {
    f32x4 a = su[i], b = sv[i];
    u32x2 w; w.x = pack2(a[0], a[1]); w.y = pack2(a[2], a[3]); du[i] = w;
    u32x2 w2; w2.x = pack2(b[0], b[1]); w2.y = pack2(b[2], b[3]); dv[i] = w2;
  }
}

__device__ __forceinline__ void phase_topk(const Params& p, int layer, int nrows) {
#if DIAG_HP
  float* sks = (float*)smem;
  float* qs = (float*)(smem + 2 * 128 * 129 * 4);
#else
  bf16_t* sks = (bf16_t*)smem;
  float* qs = (float*)(smem + 2 * 128 * 130 * 2);
#endif
  const int tid = tidx(), lane = tid & 63, wv = tid >> 6;
  const int nchunks = nrows / 64;
  int cur_h = -1;
  for (int item = bidx(); item < nchunks * 8; item += gridDim.x) {
    int h = item % 8, chunk = item / 8;
    if (h != cur_h) {
      __syncthreads();
#if DIAG_HP
      const float* src = p.peer_subkeys + ((size_t)layer * 8 + h) * 2 * 128 * 128;
      for (int i = tid; i < 2 * 128 * 128; i += NTHR) { int pk = i >> 7, d = i & 127; sks[pk * 129 + d] = src[i]; }
#else
      const bf16_t* src = p.sk + ((size_t)layer * 8 + h) * 2 * 128 * 128;
      for (int i = tid; i < 2 * 128 * 128; i += NTHR) { int pk = i >> 7, d = i & 127; sks[pk * 130 + d] = src[i]; }
#endif
      __syncthreads();
      cur_h = h;
    }
    float* myq = qs + wv * 256;
    for (int ti = 0; ti < 16; ++ti) {
      int row = chunk * 64 + wv * 16 + ti;
#if DIAG_HP
      const float* qp = p.qf + (size_t)row * 2048 + h * 256;
      myq[lane] = qp[lane]; myq[lane + 64] = qp[lane + 64]; myq[lane + 128] = qp[lane + 128]; myq[lane + 192] = qp[lane + 192];
#else
      const bf16_t* qp = p.q + (size_t)row * 2048 + h * 256;
      myq[lane] = bf2f(qp[lane]); myq[lane + 64] = bf2f(qp[lane + 64]); myq[lane + 128] = bf2f(qp[lane + 128]); myq[lane + 192] = bf2f(qp[lane + 192]);
#endif
      __builtin_amdgcn_wave_barrier();
      float s1v = 0.f, s2v = 0.f; int i1v = 0, i2v = 0;
      for (int pp = 0; pp < 2; ++pp) {
        const float* qq = myq + pp * 128;
        float a0 = 0.f, a1 = 0.f;
#if DIAG_HP
        const float* k0 = sks + (pp * 128 + lane) * 129;
        const float* k1 = sks + (pp * 128 + lane + 64) * 129;
#pragma unroll 8
        for (int d = 0; d < 128; ++d) { a0 += qq[d] * k0[d]; a1 += qq[d] * k1[d]; }
#else
        const bf16_t* k0 = sks + (pp * 128 + lane) * 130;
        const bf16_t* k1 = sks + (pp * 128 + lane + 64) * 130;
#pragma unroll 8
        for (int d = 0; d < 128; d += 2) {
          unsigned w0 = *(const unsigned*)(k0 + d), w1 = *(const unsigned*)(k1 + d);
          float q0 = qq[d], q1 = qq[d + 1];
          a0 += q0 * __uint_as_float(w0 << 16) + q1 * __uint_as_float(w0 & 0xffff0000u);
          a1 += q0 * __uint_as_float(w1 << 16) + q1 * __uint_as_float(w1 & 0xffff0000u);
        }
#endif
        float sv = 0.f; int iv = 0;
        for (int r = 0; r < 16; ++r) {
          float mx = wave_max(fmaxf(a0, a1));
          unsigned long long bal = __ballot(a0 == mx || a1 == mx);
          int wl = __ffsll((long long)bal) - 1;
          int key = 0;
          if (lane == wl) { if (a0 == mx) { key = lane; a0 = -3e38f; } else { key = lane + 64; a1 = -3e38f; } }
          key = __shfl(key, wl);
          if (lane == r) { sv = mx; iv = key; }
        }
        if (pp == 0) { s1v = sv; i1v = iv; } else { s2v = sv; i2v = iv; }
      }
      float cs[4]; int ci[4];
      float s1i = __shfl(s1v, lane >> 2); int i1i = __shfl(i1v, lane >> 2);
#pragma unroll
      for (int r = 0; r < 4; ++r) {
        int j = (lane & 3) * 4 + r;
        float s2j = __shfl(s2v, j); int i2j = __shfl(i2v, j);
        cs[r] = s1i + s2j; ci[r] = i1i * 128 + i2j;
      }
      float selv = 0.f; int seli = 0;
      for (int r = 0; r < 16; ++r) {
        float lm = fmaxf(fmaxf(cs[0], cs[1]), fmaxf(cs[2], cs[3]));
        float mx = wave_max(lm);
        unsigned long long bal = __ballot(lm == mx);
        int wl = __ffsll((long long)bal) - 1;
        int id = 0;
        if (lane == wl) {
          if (cs[0] == mx) { id = ci[0]; cs[0] = -3e38f; }
          else if (cs[1] == mx) { id = ci[1]; cs[1] = -3e38f; }
          else if (cs[2] == mx) { id = ci[2]; cs[2] = -3e38f; }
          else { id = ci[3]; cs[3] = -3e38f; }
        }
        id = __shfl(id, wl);
        if (lane == r) { selv = mx; seli = id; }
      }
      float top = __shfl(selv, 0);
      float e = lane < 16 ? __expf(selv - top) : 0.f;
      float sum = wave_sum(e);
      if (lane < 16) {
        p.idx[(size_t)row * 128 + h * 16 + lane] = seli;
        p.gw[(size_t)row * 128 + h * 16 + lane] = e / sum;
      }
      __builtin_amdgcn_wave_barrier();
    }
  }
}

__device__ __forceinline__ void phase_uvconv8(const Params& p, int layer) {
  const int lane = tidx() & 63, wv = tidx() >> 6;
  for (int row = bidx() * 4 + wv; row < 32768; row += gridDim.x * 4) {
    const float* src = (row < 16384 ? p.peer_u + ((size_t)layer * 16384 + row) * 1024 : p.peer_v + ((size_t)layer * 16384 + (row - 16384)) * 1024) + lane * 16;
    f32x4 a[4]; float amax = 0.f;
#pragma unroll
    for (int i = 0; i < 4; ++i) {
      a[i] = *(const f32x4*)(src + 4 * i);
#pragma unroll
      for (int e = 0; e < 4; ++e) amax = fmaxf(amax, fabsf(a[i][e]));
    }
    amax = wave_max(amax);
    const float scale = amax > 0.f ? amax * (1.f / 127.f) : 1.f;
    const float inv = 1.f / scale;
    u32x4 w;
#pragma unroll
    for (int i = 0; i < 4; ++i) {
      unsigned q = 0;
#pragma unroll
      for (int e = 0; e < 4; ++e) {
        int v = (int)rintf(a[i][e] * inv);
        v = v < -127 ? -127 : (v > 127 ? 127 : v);
        q |= (unsigned)(v & 0xff) << (8 * e);
      }
      w[i] = q;
    }
    if (row < 16384) *(u32x4*)(p.uvq + (size_t)row * 1024 + lane * 16) = w;
    else *(u32x4*)(p.uvq + (size_t)16384 * 1024 + ((size_t)(lane >> 3) * 16384 + (row - 16384)) * 128 + (lane & 7) * 16) = w;
    if (lane == 0) p.uvs[row] = scale;
  }
}


__device__ __forceinline__ void phase_gather8(const Params& p, int layer, int nrows, float oscale, int fuse_norm) {
  const int lane = tidx() & 63, wv = tidx() >> 6;
  const unsigned char* U8 = p.uvq; const unsigned char* V8 = p.uvq + (size_t)16384 * 1024;
  const float* US = p.uvs; const float* VS = p.uvs + 16384;
  const int klane = ((lane >> 5) & 1) * 4 + ((lane >> 4) & 1) * 2 + ((lane >> 3) & 1);
  for (int row = bidx() * 4 + wv; row < nrows; row += gridDim.x * 4) {
    float xv[16], acc[16];
    {
      u32x4 a = *(const u32x4*)(p.h + (size_t)row * DM + lane * 16), b = *(const u32x4*)(p.h + (size_t)row * DM + lane * 16 + 8);
#pragma unroll
      for (int e = 0; e < 4; ++e) {
        xv[2 * e] = __uint_as_float(a[e] << 16); xv[2 * e + 1] = __uint_as_float(a[e] & 0xffff0000u);
        xv[8 + 2 * e] = __uint_as_float(b[e] << 16); xv[8 + 2 * e + 1] = __uint_as_float(b[e] & 0xffff0000u);
      }
    }
    float xs = 0.f;
#pragma unroll
    for (int i = 0; i < 16; ++i) { acc[i] = 0.f; xs += xv[i]; }
    xs = wave_sum(xs) * 128.f;
    const int myidx0 = p.idx[(size_t)row * 128 + lane], myidx1 = p.idx[(size_t)row * 128 + 64 + lane];
    const float myg0 = p.gw[(size_t)row * 128 + lane], myg1 = p.gw[(size_t)row * 128 + 64 + lane];
    float wsum = 0.f;
    for (int k0 = 0; k0 < 128; k0 += 8) {
      const int srcv = k0 < 64 ? myidx0 : myidx1;
      const float srcg = k0 < 64 ? myg0 : myg1;
      const int kb = k0 & 63;
      u32x4 uq[8], vq[8];
#pragma unroll
      for (int j = 0; j < 8; ++j) {
        const int e_ = __builtin_amdgcn_readlane(srcv, kb + j);
        uq[j] = *(const u32x4*)(U8 + (size_t)e_ * 1024 + lane * 16);
        vq[j] = *(const u32x4*)(V8 + (size_t)e_ * 1024 + lane * 16);
      }
      const int el = __shfl(srcv, kb + klane);
      const float gl = __shfl(srcg, kb + klane);
      const float sul = US[el], svl = VS[el];
      float d[8];
#pragma unroll
      for (int j = 0; j < 8; ++j) {
        float s = 0.f;
#pragma unroll
        for (int c = 0; c < 4; ++c) {
          s += xv[4 * c] * ub0(uq[j][c]) + xv[4 * c + 1] * ub1(uq[j][c]) + xv[4 * c + 2] * ub2(uq[j][c]) + xv[4 * c + 3] * ub3(uq[j][c]);
        }
        d[j] = s;
      }
      float r4[4], r2[2], t;
      const bool b5 = lane & 32, b4 = lane & 16, b3 = lane & 8;
#pragma unroll
      for (int j = 0; j < 4; ++j) { float keep = b5 ? d[j + 4] : d[j], send = b5 ? d[j] : d[j + 4]; r4[j] = keep + __shfl_xor(send, 32); }
#pragma unroll
      for (int j = 0; j < 2; ++j) { float keep = b4 ? r4[j + 2] : r4[j], send = b4 ? r4[j] : r4[j + 2]; r2[j] = keep + __shfl_xor(send, 16); }
      { float keep = b3 ? r2[1] : r2[0], send = b3 ? r2[0] : r2[1]; t = keep + __shfl_xor(send, 8); }
      t += __shfl_xor(t, 4); t += __shfl_xor(t, 2); t += __shfl_xor(t, 1);
      const float dot = sul * (t - xs);
      const float wl = PEER_ALPHA * oscale * gl * gelu_tanh(dot) * svl;
#pragma unroll
      for (int j = 0; j < 8; ++j) {
        const float w = __int_as_float(__builtin_amdgcn_readlane(__float_as_int(wl), ((j >> 2) & 1) * 32 + ((j >> 1) & 1) * 16 + (j & 1) * 8));
        wsum += w;
#pragma unroll
        for (int c = 0; c < 4; ++c) {
          acc[4 * c] += w * ub0(vq[j][c]); acc[4 * c + 1] += w * ub1(vq[j][c]); acc[4 * c + 2] += w * ub2(vq[j][c]); acc[4 * c + 3] += w * ub3(vq[j][c]);
        }
      }
    }
    const float off = 128.f * wsum;
    float* xr = xrow(p, row) + lane * 16;
    const float* g2 = p.mod + (size_t)(layer * 3 + modrow(row)) * 6144 + 5 * DM + lane * 16;
    f32x4 xn[4]; float ss = 0.f;
#pragma unroll
    for (int c = 0; c < 4; ++c) {
      f32x4 x0 = *(const f32x4*)(xr + 4 * c), ga = *(const f32x4*)(g2 + 4 * c);
#pragma unroll
      for (int e = 0; e < 4; ++e) { x0[e] += ga[e] * (acc[4 * c + e] - off); ss += x0[e] * x0[e]; }
      *(f32x4*)(xr + 4 * c) = x0;
      xn[c] = x0;
    }
    if (fuse_norm) {
      ss = wave_sum(ss);
      const float rs = rsqrtf(ss * (1.f / DM) + 1e-6f);
      const float* gn = p.norm1_g + (layer + 1) * DM + lane * 16;
      const float* md = p.mod + (size_t)((layer + 1) * 3 + modrow(row)) * 6144 + lane * 16;
      u32x4 w0, w1;
#pragma unroll
      for (int c = 0; c < 4; ++c) {
        f32x4 gg = *(const f32x4*)(gn + 4 * c), sc = *(const f32x4*)(md + DM + 4 * c), sh = *(const f32x4*)(md + 4 * c);
        float o0 = xn[c][0] * rs * gg[0] * (1.f + sc[0]) + sh[0], o1 = xn[c][1] * rs * gg[1] * (1.f + sc[1]) + sh[1];
        float o2 = xn[c][2] * rs * gg[2] * (1.f + sc[2]) + sh[2], o3 = xn[c][3] * rs * gg[3] * (1.f + sc[3]) + sh[3];
        if (c < 2) { w0[2 * c] = pack2(o0, o1); w0[2 * c + 1] = pack2(o2, o3); } else { w1[2 * (c - 2)] = pack2(o0, o1); w1[2 * (c - 2) + 1] = pack2(o2, o3); }
      }
      *(u32x4*)(p.h + (size_t)row * DM + lane * 16) = w0;
      *(u32x4*)(p.h + (size_t)row * DM + lane * 16 + 8) = w1;
    }
  }
}

struct UBatch { u32x4 uq[8]; int ent[8]; int entk; float sul, svl, gl, sxk; };
__device__ __forceinline__ void gu_issue(const Params& p, UBatch& B, const int* list, int b, int cnt, int r0, int lane, int klane) {
  const signed char* U8 = (const signed char*)p.uvq;
#pragma unroll
  for (int j = 0; j < 8; ++j) {
    const int q = b + j < cnt ? b + j : cnt - 1;
    B.ent[j] = __builtin_amdgcn_readfirstlane(list[q]);
    B.uq[j] = *(const u32x4*)(U8 + (size_t)(B.ent[j] & 16383) * 1024 + lane * 16);
  }
  const int qk = b + klane < cnt ? b + klane : cnt - 1;
  B.entk = list[qk];
  const int el = B.entk & 16383;
  B.sul = p.uvs[el]; B.svl = p.uvs[16384 + el];
  B.gl = p.gw[(size_t)(r0 + (B.entk >> 23)) * 128 + ((B.entk >> 16) & 127)];
  B.sxk = p.sxq[r0 + (B.entk >> 23)];
}
__device__ __forceinline__ void gu_compute(const Params& p, const UBatch& B, const u32x4 x0, const u32x4 x1, const u32x4 x2, const u32x4 x3, int b, int cnt, int r0, int lane, int klane) {
  int d[8];
#pragma unroll
  for (int j = 0; j < 8; ++j) {
    const int tg = B.ent[j] >> 23;
    const u32x4 xs = (tg & 2) ? ((tg & 1) ? x3 : x2) : ((tg & 1) ? x1 : x0);
    int a = 0;
#pragma unroll
    for (int c = 0; c < 4; ++c) a = __builtin_amdgcn_sdot4((int)xs[c], (int)B.uq[j][c], a, false);
    d[j] = a;
  }
  int r4[4], r2[2], t;
  const bool b5 = lane & 32, b4 = lane & 16, b3 = lane & 8;
#pragma unroll
  for (int j = 0; j < 4; ++j) { int keep = b5 ? d[j + 4] : d[j], send = b5 ? d[j] : d[j + 4]; r4[j] = keep + __shfl_xor(send, 32); }
#pragma unroll
  for (int j = 0; j < 2; ++j) { int keep = b4 ? r4[j + 2] : r4[j], send = b4 ? r4[j] : r4[j + 2]; r2[j] = keep + __shfl_xor(send, 16); }
  { int keep = b3 ? r2[1] : r2[0], send = b3 ? r2[0] : r2[1]; t = keep + __shfl_xor(send, 8); }
  t += __shfl_xor(t, 4); t += __shfl_xor(t, 2); t += __shfl_xor(t, 1);
  const int tk = B.entk >> 23;
  const float dot = B.sul * B.sxk * (float)t;
  const float wl = PEER_ALPHA * B.gl * gelu_tanh(dot) * B.svl;
  if ((lane & 7) == 0 && b + klane < cnt) p.wbuf[(size_t)(r0 + tk) * 128 + ((B.entk >> 16) & 127)] = wl;
}
__device__ __forceinline__ void phase_gatherU(const Params& p, int layer, int nrows) {
  const int lane = tidx() & 63, wv = tidx() >> 6;
  const int part = bidx() & 7, vb = bidx() >> 3, nvb = (gridDim.x - part + 7) >> 3;
  int* list = (int*)(smem + wv * 2048);
  const int klane = ((lane >> 5) & 1) * 4 + ((lane >> 4) & 1) * 2 + ((lane >> 3) & 1);
  for (int r0 = (vb * 4 + wv) * 4; r0 < nrows; r0 += nvb * 16) {
    int iv[8];
#pragma unroll
    for (int q = 0; q < 8; ++q) iv[q] = p.idx[(size_t)(r0 + (q >> 1)) * 128 + (q & 1) * 64 + lane];
    const u32x4 x0 = *(const u32x4*)(p.xq + (size_t)(r0 + 0) * DM + lane * 16), x1 = *(const u32x4*)(p.xq + (size_t)(r0 + 1) * DM + lane * 16);
    const u32x4 x2 = *(const u32x4*)(p.xq + (size_t)(r0 + 2) * DM + lane * 16), x3 = *(const u32x4*)(p.xq + (size_t)(r0 + 3) * DM + lane * 16);
    int cnt = 0;
    __builtin_amdgcn_wave_barrier();
#pragma unroll
    for (int q = 0; q < 8; ++q) {
      const bool in = (iv[q] >> 11) == part;
      const unsigned long long m = __ballot(in);
      const int rk = cnt + __builtin_amdgcn_mbcnt_hi((unsigned)(m >> 32), __builtin_amdgcn_mbcnt_lo((unsigned)m, 0));
      if (in) list[rk] = ((q >> 1) << 23) | (((q & 1) * 64 + lane) << 16) | iv[q];
      cnt += __popcll(m);
    }
    __builtin_amdgcn_wave_barrier();
    if (cnt == 0) continue;
    UBatch A, Bb;
    gu_issue(p, A, list, 0, cnt, r0, lane, klane);
    for (int b = 0; b < cnt; b += 16) {
      if (b + 8 < cnt) gu_issue(p, Bb, list, b + 8, cnt, r0, lane, klane);
      gu_compute(p, A, x0, x1, x2, x3, b, cnt, r0, lane, klane);
      if (b + 8 < cnt) {
        if (b + 16 < cnt) gu_issue(p, A, list, b + 16, cnt, r0, lane, klane);
        gu_compute(p, Bb, x0, x1, x2, x3, b + 8, cnt, r0, lane, klane);
      }
    }
  }
}

struct VMeta { i32x4 ie[4]; f32x4 we[4]; };
struct VRows { u32x4 vq[16]; int wq4[4]; float sw; f32x2 x0, ga; };
__device__ __forceinline__ void gv_meta(const Params& p, VMeta& M, int row, int g) {
#pragma unroll
  for (int i = 0; i < 4; ++i) {
    M.ie[i] = *(const i32x4*)(p.idx + (size_t)row * 128 + g * 16 + 4 * i);
    M.we[i] = *(const f32x4*)(p.wbuf + (size_t)row * 128 + g * 16 + 4 * i);
  }
}
__device__ __forceinline__ void gv_rows(const Params& p, VRows& R, const VMeta& M, const signed char* V8, int row, int layer, int col) {
#pragma unroll
  for (int j = 0; j < 16; ++j) R.vq[j] = *(const u32x4*)(V8 + (size_t)M.ie[j >> 2][j & 3] * 128);
  R.x0 = *(const f32x2*)(xrow(p, row) + col);
  R.ga = *(const f32x2*)(p.mod + (size_t)(layer * 3 + modrow(row)) * 6144 + 5 * DM + col);
  float mx = 0.f;
#pragma unroll
  for (int i = 0; i < 4; ++i) mx = fmaxf(fmaxf(fmaxf(mx, fabsf(M.we[i][0])), fmaxf(fabsf(M.we[i][1]), fabsf(M.we[i][2]))), fabsf(M.we[i][3]));
  mx = fmaxf(mx, __shfl_xor(mx, 8)); mx = fmaxf(mx, __shfl_xor(mx, 16)); mx = fmaxf(mx, __shfl_xor(mx, 32));
  R.sw = mx > 0.f ? mx * (1.f / 127.f) : 1.f;
  const float inw = 1.f / R.sw;
#pragma unroll
  for (int i = 0; i < 4; ++i) {
    unsigned q = 0;
#pragma unroll
    for (int e = 0; e < 4; ++e) { int t = (int)rintf(M.we[i][e] * inw); t = t < -127 ? -127 : (t > 127 ? 127 : t); q |= (unsigned)(t & 0xff) << (8 * e); }
    R.wq4[i] = (int)q;
  }
}
__device__ __forceinline__ void gv_compute(const Params& p, const VRows& R, int row, int col, int lane, float oscale) {
  const bool b5 = lane & 32, b4 = lane & 16, b3 = lane & 8;
  int acc[16];
#pragma unroll
  for (int i = 0; i < 16; ++i) acc[i] = 0;
#pragma unroll
  for (int grp = 0; grp < 4; ++grp) {
#pragma unroll
    for (int dw = 0; dw < 4; ++dw) {
      const unsigned D0 = R.vq[4 * grp][dw], D1 = R.vq[4 * grp + 1][dw], D2 = R.vq[4 * grp + 2][dw], D3 = R.vq[4 * grp + 3][dw];
      const unsigned P0 = __builtin_amdgcn_perm(D1, D0, 0x05010400u), P1 = __builtin_amdgcn_perm(D1, D0, 0x07030602u);
      const unsigned Q0 = __builtin_amdgcn_perm(D3, D2, 0x05010400u), Q1 = __builtin_amdgcn_perm(D3, D2, 0x07030602u);
      const unsigned T0 = __builtin_amdgcn_perm(Q0, P0, 0x05040100u), T1 = __builtin_amdgcn_perm(Q0, P0, 0x07060302u);
      const unsigned T2 = __builtin_amdgcn_perm(Q1, P1, 0x05040100u), T3 = __builtin_amdgcn_perm(Q1, P1, 0x07060302u);
      acc[4 * dw] = __builtin_amdgcn_sdot4((int)T0, R.wq4[grp], acc[4 * dw], false);
      acc[4 * dw + 1] = __builtin_amdgcn_sdot4((int)T1, R.wq4[grp], acc[4 * dw + 1], false);
      acc[4 * dw + 2] = __builtin_amdgcn_sdot4((int)T2, R.wq4[grp], acc[4 * dw + 2], false);
      acc[4 * dw + 3] = __builtin_amdgcn_sdot4((int)T3, R.wq4[grp], acc[4 * dw + 3], false);
    }
  }
  int r8[8], r4[4], r2[2];
#pragma unroll
  for (int j = 0; j < 8; ++j) { int keep = b5 ? acc[j + 8] : acc[j], send = b5 ? acc[j] : acc[j + 8]; r8[j] = keep + __shfl_xor(send, 32); }
#pragma unroll
  for (int j = 0; j < 4; ++j) { int keep = b4 ? r8[j + 4] : r8[j], send = b4 ? r8[j] : r8[j + 4]; r4[j] = keep + __shfl_xor(send, 16); }
#pragma unroll
  for (int j = 0; j < 2; ++j) { int keep = b3 ? r4[j + 2] : r4[j], send = b3 ? r4[j] : r4[j + 2]; r2[j] = keep + __shfl_xor(send, 8); }
  f32x2 x0 = R.x0;
  x0[0] += oscale * R.ga[0] * R.sw * (float)r2[0]; x0[1] += oscale * R.ga[1] * R.sw * (float)r2[1];
  *(f32x2*)(xrow(p, row) + col) = x0;
}
__device__ __forceinline__ void phase_gatherV(const Params& p, int layer, int nrows, float oscale = 1.f) {
  const int lane = tidx() & 63, wv = tidx() >> 6;
  const int part = bidx() & 7, vb = bidx() >> 3, nvb = (gridDim.x - part + 7) >> 3;
  const signed char* V8 = (const signed char*)p.uvq + (size_t)16384 * 1024 + (size_t)part * 16384 * 128 + (lane & 7) * 16;
  const int g = lane >> 3;
  const int col = part * 128 + (lane & 7) * 16 + ((lane >> 5) & 1) * 8 + ((lane >> 4) & 1) * 4 + ((lane >> 3) & 1) * 2;
  const int rs = nvb * 4, rfirst = vb * 4 + wv;
  if (rfirst >= nrows) return;
  VMeta M; VRows RA, RB;
  gv_meta(p, M, rfirst, g);
  gv_rows(p, RA, M, V8, rfirst, layer, col);
  if (rfirst + rs < nrows) gv_meta(p, M, rfirst + rs, g);
  for (int row = rfirst; row < nrows; row += 2 * rs) {
    const bool h1 = row + rs < nrows, h2 = row + 2 * rs < nrows, h3 = row + 3 * rs < nrows;
    if (h1) gv_rows(p, RB, M, V8, row + rs, layer, col);
    if (h2) gv_meta(p, M, row + 2 * rs, g);
    gv_compute(p, RA, row, col, lane, oscale);
    if (h1) {
      if (h2) gv_rows(p, RA, M, V8, row + 2 * rs, layer, col);
      if (h3) gv_meta(p, M, row + 3 * rs, g);
      gv_compute(p, RB, row + rs, col, lane, oscale);
    }
  }
}

__device__ __forceinline__ unsigned f2key(float f) { unsigned u = __float_as_uint(f); return (u & 0x80000000u) ? ~u : (u | 0x80000000u); }
__device__ __forceinline__ float key2f(unsigned k) { unsigned u = (k & 0x80000000u) ? (k ^ 0x80000000u) : ~k; return __uint_as_float(u); }
#define INS16(L, vv) { unsigned v_ = (vv); _Pragma("unroll") for (int j_ = 0; j_ < 16; ++j_) { unsigned hi_ = max(L[j_], v_); v_ = min(L[j_], v_); L[j_] = hi_; } }
__device__ __forceinline__ unsigned sel16(const unsigned (&a)[16], unsigned i) {
  unsigned t[8], u[4], v[2];
#pragma unroll
  for (int k = 0; k < 8; ++k) t[k] = (i & 1u) ? a[2 * k + 1] : a[2 * k];
#pragma unroll
  for (int k = 0; k < 4; ++k) u[k] = (i & 2u) ? t[2 * k + 1] : t[2 * k];
#pragma unroll
  for (int k = 0; k < 2; ++k) v[k] = (i & 4u) ? u[2 * k + 1] : u[2 * k];
  return (i & 8u) ? v[1] : v[0];
}

__device__ __forceinline__ void sort16_desc(unsigned (&a)[16]) {
#pragma unroll
  for (int k = 2; k <= 16; k <<= 1)
#pragma unroll
    for (int j = k >> 1; j > 0; j >>= 1)
#pragma unroll
      for (int i = 0; i < 16; ++i) {
        const int l = i ^ j;
        if (l > i) {
          const unsigned hi = max(a[i], a[l]), lo = min(a[i], a[l]);
          if ((i & k) == 0) { a[i] = hi; a[l] = lo; } else { a[i] = lo; a[l] = hi; }
        }
      }
}
__device__ __forceinline__ void merge16_desc(unsigned (&L)[16], const unsigned (&g)[16]) {
#pragma unroll
  for (int i = 0; i < 16; ++i) L[i] = max(L[i], g[15 - i]);
#pragma unroll
  for (int j = 8; j > 0; j >>= 1)
#pragma unroll
    for (int i = 0; i < 16; ++i) {
      const int l = i ^ j;
      if (l > i) { const unsigned hi = max(L[i], L[l]), lo = min(L[i], L[l]); L[i] = hi; L[l] = lo; }
    }
}
__device__ __forceinline__ void phase_topk2(const Params& p, int layer, int nrows) {
  char* SK = smem;
  const int tid = tidx(), wid = tid >> 6, lane = tid & 63, l31 = lane & 31, hh = lane >> 5;
  const int ntiles = nrows / 128;
  int cur_h = -1;
  for (int item = bidx(); item < ntiles * 8; item += gridDim.x) {
    const int h = item & 7, tile = item >> 3;
    if (h != cur_h) {
      __syncthreads();
      const bf16_t* src = p.sk + ((size_t)layer * 8 + h) * 2 * 128 * 128;
#pragma unroll
      for (int i = 0; i < 16; ++i) {
        int id = tid + 256 * i, row = id >> 4, c16 = id & 15;
        *(u32x4*)(SK + row * 272 + c16 * 16) = *(const u32x4*)(src + (size_t)row * 128 + c16 * 8);
      }
      __syncthreads();
      cur_h = h;
    }
    const int row = tile * 128 + wid * 32 + l31;
    f32x16 sc[2][4];
#pragma unroll
    for (int pp = 0; pp < 2; ++pp) {
      bf16x8 qf[8];
#pragma unroll
      for (int ks = 0; ks < 8; ++ks) qf[ks] = *(const bf16x8*)(p.q + (size_t)row * 2048 + h * 256 + pp * 128 + ks * 16 + hh * 8);
#pragma unroll
      for (int kb = 0; kb < 4; ++kb) {
#pragma unroll
        for (int r = 0; r < 16; ++r) sc[pp][kb][r] = 0.f;
#pragma unroll
        for (int ks = 0; ks < 8; ++ks) {
          bf16x8 a = *(const bf16x8*)(SK + (pp * 128 + kb * 32 + l31) * 272 + (ks * 16 + hh * 8) * 2);
          sc[pp][kb] = __builtin_amdgcn_mfma_f32_32x32x16_bf16(a, qf[ks], sc[pp][kb], 0, 0, 0);
        }
      }
    }
    unsigned L1[16];
#pragma unroll
    for (int j = 0; j < 16; ++j) L1[j] = 0u;
#pragma unroll
    for (int kb = 0; kb < 4; ++kb)
#pragma unroll
      for (int rh = 0; rh < 2; ++rh) {
        unsigned g[16];
#pragma unroll
        for (int rr = 0; rr < 8; ++rr) {
          const int r = rh * 8 + rr;
          auto sw = __builtin_amdgcn_permlane32_swap(__float_as_uint(sc[0][kb][r]), __float_as_uint(sc[1][kb][r]), false, false);
          const unsigned kidx = kb * 32 + (r & 3) + 8 * (r >> 2);
          g[2 * rr] = (f2key(__uint_as_float(sw[0])) & ~127u) | kidx;
          g[2 * rr + 1] = (f2key(__uint_as_float(sw[1])) & ~127u) | (kidx + 4);
        }
        sort16_desc(g);
        merge16_desc(L1, g);
      }
    float As[16], Bs[16]; unsigned Ai[16], Bi[16];
#pragma unroll
    for (int j = 0; j < 16; ++j) {
      auto sw = __builtin_amdgcn_permlane32_swap(L1[j], L1[j], false, false);
      unsigned other = hh ? sw[0] : sw[1];
      unsigned ka = hh ? other : L1[j], kb_ = hh ? L1[j] : other;
      As[j] = key2f(ka & ~127u); Ai[j] = ka & 127u;
      Bs[j] = key2f(kb_ & ~127u); Bi[j] = kb_ & 127u;
    }
    unsigned L2[16];
#pragma unroll
    for (int j = 0; j < 16; ++j) L2[j] = 0u;
    const float smax = As[0] + Bs[0];
#define CKEY(i, j) (((262143u - min((unsigned)((smax - (As[i] + Bs[j])) * 16384.f), 262143u)) << 14) | (Ai[i] * 128u + Bi[j]))
    {
      unsigned g[16];
      g[0] = CKEY(0, 0);
      g[1] = CKEY(0, 1);
      g[2] = CKEY(0, 2);
      g[3] = CKEY(0, 3);
      g[4] = CKEY(0, 4);
      g[5] = CKEY(0, 5);
      g[6] = CKEY(0, 6);
      g[7] = CKEY(0, 7);
      g[8] = CKEY(0, 8);
      g[9] = CKEY(0, 9);
      g[10] = CKEY(0, 10);
      g[11] = CKEY(0, 11);
      g[12] = CKEY(0, 12);
      g[13] = CKEY(0, 13);
      g[14] = CKEY(0, 14);
      g[15] = CKEY(0, 15);
      sort16_desc(g);
      merge16_desc(L2, g);
    }
    {
      unsigned g[16];
      g[0] = CKEY(1, 0);
      g[1] = CKEY(1, 1);
      g[2] = CKEY(1, 2);
      g[3] = CKEY(1, 3);
      g[4] = CKEY(1, 4);
      g[5] = CKEY(1, 5);
      g[6] = CKEY(1, 6);
      g[7] = CKEY(1, 7);
      g[8] = CKEY(2, 0);
      g[9] = CKEY(2, 1);
      g[10] = CKEY(2, 2);
      g[11] = CKEY(2, 3);
      g[12] = CKEY(2, 4);
      g[13] = CKEY(3, 0);
      g[14] = CKEY(3, 1);
      g[15] = CKEY(3, 2);
      sort16_desc(g);
      merge16_desc(L2, g);
    }
    {
      unsigned g[16];
      g[0] = CKEY(3, 3);
      g[1] = CKEY(4, 0);
      g[2] = CKEY(4, 1);
      g[3] = CKEY(4, 2);
      g[4] = CKEY(5, 0);
      g[5] = CKEY(5, 1);
      g[6] = CKEY(6, 0);
      g[7] = CKEY(6, 1);
      g[8] = CKEY(7, 0);
      g[9] = CKEY(7, 1);
      g[10] = CKEY(8, 0);
      g[11] = CKEY(9, 0);
      g[12] = CKEY(10, 0);
      g[13] = CKEY(11, 0);
      g[14] = CKEY(12, 0);
      g[15] = CKEY(13, 0);
      sort16_desc(g);
      merge16_desc(L2, g);
    }
    {
      unsigned g[16];
      g[0] = CKEY(14, 0);
      g[1] = CKEY(15, 0);
      g[2] = 0u;
      g[3] = 0u;
      g[4] = 0u;
      g[5] = 0u;
      g[6] = 0u;
      g[7] = 0u;
      g[8] = 0u;
      g[9] = 0u;
      g[10] = 0u;
      g[11] = 0u;
      g[12] = 0u;
      g[13] = 0u;
      g[14] = 0u;
      g[15] = 0u;
      sort16_desc(g);
      merge16_desc(L2, g);
    }
#undef CKEY
    float ex[16]; unsigned ev[16]; float sum = 0.f;
#pragma unroll
    for (int t = 0; t < 16; ++t) {
      ev[t] = L2[t] & 16383u;
      float d = (float)(262143u - (L2[t] >> 14)) * (1.f / 16384.f);
      ex[t] = __expf(-d); sum += ex[t];
    }
    const float isum = 1.f / sum;
    if (hh == 0) {
      int* ip = p.idx + (size_t)row * 128 + h * 16;
      float* gp = p.gw + (size_t)row * 128 + h * 16;
#pragma unroll
      for (int t4 = 0; t4 < 4; ++t4) {
        u32x4 e0 = {ev[4 * t4], ev[4 * t4 + 1], ev[4 * t4 + 2], ev[4 * t4 + 3]};
        f32x4 g0 = {ex[4 * t4] * isum, ex[4 * t4 + 1] * isum, ex[4 * t4 + 2] * isum, ex[4 * t4 + 3] * isum};
        *(u32x4*)(ip + 4 * t4) = e0;
        *(f32x4*)(gp + 4 * t4) = g0;
      }
    }
  }
}

__device__ __forceinline__ void phase_gather(const Params& p, int layer, int nrows, float oscale) {
  const int lane = tidx() & 63, wv = tidx() >> 6;
  const bf16_t* U = p.uv; const bf16_t* V = p.uv + (size_t)16384 * 1024;
  for (int row = bidx() * 4 + wv; row < nrows; row += gridDim.x * 4) {
    float xv[16], acc[16];
    {
      u32x4 a = *(const u32x4*)(p.h + (size_t)row * DM + lane * 8), b = *(const u32x4*)(p.h + (size_t)row * DM + 512 + lane * 8);
#pragma unroll
      for (int e = 0; e < 4; ++e) {
        xv[2 * e] = __uint_as_float(a[e] << 16); xv[2 * e + 1] = __uint_as_float(a[e] & 0xffff0000u);
        xv[8 + 2 * e] = __uint_as_float(b[e] << 16); xv[8 + 2 * e + 1] = __uint_as_float(b[e] & 0xffff0000u);
      }
    }
#pragma unroll
    for (int i = 0; i < 16; ++i) acc[i] = 0.f;
    int myidx0 = p.idx[(size_t)row * 128 + lane], myidx1 = p.idx[(size_t)row * 128 + 64 + lane];
    float myg0 = p.gw[(size_t)row * 128 + lane], myg1 = p.gw[(size_t)row * 128 + 64 + lane];
    for (int k = 0; k < 128; ++k) {
      int e_ = k < 64 ? __shfl(myidx0, k) : __shfl(myidx1, k - 64);
      float g_ = k < 64 ? __shfl(myg0, k) : __shfl(myg1, k - 64);
      e_ = __builtin_amdgcn_readfirstlane(e_);
#if DIAG_HP
      const float* ur = p.peer_u + ((size_t)layer * 16384 + e_) * DM; const float* vr = p.peer_v + ((size_t)layer * 16384 + e_) * DM;
      f32x4 u0 = *(const f32x4*)(ur + lane * 8), u1 = *(const f32x4*)(ur + lane * 8 + 4), u2 = *(const f32x4*)(ur + 512 + lane * 8), u3 = *(const f32x4*)(ur + 512 + lane * 8 + 4);
      f32x4 v0 = *(const f32x4*)(vr + lane * 8), v1 = *(const f32x4*)(vr + lane * 8 + 4), v2 = *(const f32x4*)(vr + 512 + lane * 8), v3 = *(const f32x4*)(vr + 512 + lane * 8 + 4);
      float dot = 0.f;
#pragma unroll
      for (int e = 0; e < 4; ++e) dot += xv[e] * u0[e] + xv[4 + e] * u1[e] + xv[8 + e] * u2[e] + xv[12 + e] * u3[e];
      dot = wave_sum(dot);
      float w = g_ * gelu_tanh(dot);
#pragma unroll
      for (int e = 0; e < 4; ++e) { acc[e] += w * v0[e]; acc[4 + e] += w * v1[e]; acc[8 + e] += w * v2[e]; acc[12 + e] += w * v3[e]; }
#else
      const bf16_t* ur = U + (size_t)e_ * DM; const bf16_t* vr = V + (size_t)e_ * DM;
      u32x4 ua = *(const u32x4*)(ur + lane * 8), ub = *(const u32x4*)(ur + 512 + lane * 8);
      u32x4 va = *(const u32x4*)(vr + lane * 8), vb = *(const u32x4*)(vr + 512 + lane * 8);
      float dot = 0.f;
#pragma unroll
      for (int e = 0; e < 4; ++e) {
        dot += xv[2 * e] * __uint_as_float(ua[e] << 16) + xv[2 * e + 1] * __uint_as_float(ua[e] & 0xffff0000u);
        dot += xv[8 + 2 * e] * __uint_as_float(ub[e] << 16) + xv[8 + 2 * e + 1] * __uint_as_float(ub[e] & 0xffff0000u);
      }
      dot = wave_sum(dot);
      float w = PEER_ALPHA * oscale * g_ * gelu_tanh(dot);
#pragma unroll
      for (int e = 0; e < 4; ++e) {
        acc[2 * e] += w * __uint_as_float(va[e] << 16); acc[2 * e + 1] += w * __uint_as_float(va[e] & 0xffff0000u);
        acc[8 + 2 * e] += w * __uint_as_float(vb[e] << 16); acc[8 + 2 * e + 1] += w * __uint_as_float(vb[e] & 0xffff0000u);
      }
#endif
    }
    float* xr = xrow(p, row);
    const float* g2 = p.mod + (size_t)(layer * 3 + modrow(row)) * 6144 + 5 * DM;
#pragma unroll
    for (int hh = 0; hh < 2; ++hh) {
      int c0 = hh * 512 + lane * 8;
      f32x4 x0 = *(const f32x4*)(xr + c0), x1 = *(const f32x4*)(xr + c0 + 4);
      f32x4 ga = *(const f32x4*)(g2 + c0), gb = *(const f32x4*)(g2 + c0 + 4);
#pragma unroll
      for (int e = 0; e < 4; ++e) { x0[e] += ga[e] * acc[hh * 8 + e]; x1[e] += gb[e] * acc[hh * 8 + 4 + e]; }
      *(f32x4*)(xr + c0) = x0; *(f32x4*)(xr + c0 + 4) = x1;
    }
  }
}


__device__ __forceinline__ void phase_mix1(const Params& p, int layer, int with_ctx_queries) {
  const bool fast = attn_logit_bound(p, layer) <= 40.f;
  const int natt = fast ? 512 + (with_ctx_queries ? 16 : 0) : 1024 + (with_ctx_queries ? 32 : 0);
  const int G = gridDim.x, b_ = bidx();
  for (int item = b_; item < natt; item += G) { for (int r = 0; r < REP_ATT; ++r) { if (fast) attn_item64(p, layer, item); else attn_item(p, layer, item); } }
  int b1 = b_ - natt % G; if (b1 < 0) b1 += G;
  for (int it = b1; it < 528; it += G) { for (int r = 0; r < REP_MLA; ++r) mlA_item(p, layer, it); }
  const int nextra = 528 % G;
  const int first = (nextra * 2 < G) ? nextra : 0, span = G - first;
  if (b1 >= first)
    for (int it = b1 - first; it < 1056; it += span) { for (int r = 0; r < REP_SSDA; ++r) ssdA_item(p, layer, it); }
}
__device__ __forceinline__ void phase_mix3(const Params& p, int layer, int last) {
  const int nc = last ? 64 : 66, G = gridDim.x, b_ = bidx();
  const int nml = 2 * nc * 4, nssd = 2 * nc * 8;
  for (int it = b_; it < nml; it += G) {
    const int b = it / (nc * 4), c = (it / 4) % nc, h = it & 3;
    for (int r = 0; r < REP_MLC; ++r) mlC_item(p, layer, (b * 66 + c) * 4 + h);
  }
  const int nextra = nml % G;
  const int first = (nextra * 2 < G) ? nextra : 0, span = G - first;
  if (b_ >= first)
    for (int it = b_ - first; it < nssd; it += span) {
      const int b = it / (nc * 8), c = (it / 8) % nc, h = it & 7;
      for (int r = 0; r < REP_SSDC; ++r) ssdC_item(p, layer, (b * 66 + c) * 8 + h);
    }
}


#define XB_TMO      128
#define XB_XCNT(j)  (256  + 64 * (j))
#define XB_XSUB(j)  (1280 + 64 * (j))
#define XB_XGEN(j)  (2304 + 64 * (j))
#define XB_TOP      3328
#define XB_TOPGEN   3392
#define XCD_BAR_WORDS 3456
#define XB_SPIN_CAP (1u << 18)
#define LAS __attribute__((address_space(3)))
__device__ __forceinline__ unsigned xb_ld(unsigned* p)              { return __hip_atomic_load(p, __ATOMIC_RELAXED, __HIP_MEMORY_SCOPE_AGENT); }
__device__ __forceinline__ unsigned xb_add(unsigned* p, unsigned v) { return __hip_atomic_fetch_add(p, v, __ATOMIC_RELAXED, __HIP_MEMORY_SCOPE_AGENT); }
__device__ __forceinline__ unsigned xb_xcc_id() { return (unsigned)__builtin_amdgcn_s_getreg((3 << 11) | 20) & 0xFu; }
#define XB_SPIN(cond, bar) do { unsigned _sp = 0; while (cond) { __builtin_amdgcn_s_sleep(1); \
    if ((++_sp & 255u) == 0u) { if (xb_ld(&(bar)[XB_TMO])) break; if (_sp > XB_SPIN_CAP) { atomicAdd(&(bar)[XB_TMO], 1u); break; } } } } while (0)
struct XcdBarrier { unsigned* bar; unsigned x; volatile LAS unsigned* st; };
__device__ __forceinline__ XcdBarrier xcd_barrier_post(unsigned* bar, volatile LAS unsigned* st) {
    XcdBarrier b; b.bar = bar; b.x = xb_xcc_id(); b.st = st;
    if (threadIdx.x == 0) (void)xb_add(&bar[XB_XCNT(b.x)], 1u);
    return b;
}
__device__ __forceinline__ void xcd_barrier_complete(unsigned* bar, unsigned x, unsigned& nloc, unsigned& nx) {
    const unsigned G = gridDim.x * gridDim.y * gridDim.z;
    unsigned sum, cnt, mine, sp = 0u;
    for (;;) {
        sum = 0u; cnt = 0u; mine = 0u;
#pragma unroll
        for (unsigned j = 0; j < 16; ++j) { const unsigned c = xb_ld(&bar[XB_XCNT(j)]); sum += c; cnt += (c > 0u) ? 1u : 0u; mine = (j == x) ? c : mine; }
        if (sum == G) break;
        __builtin_amdgcn_s_sleep(1);
        if ((++sp & 255u) == 0u) { if (xb_ld(&bar[XB_TMO])) break; if (sp > XB_SPIN_CAP) { atomicAdd(&bar[XB_TMO], 1u); break; } }
    }
    nloc = mine > 0u ? mine : 1u; nx = cnt > 0u ? cnt : 1u;
}
__device__ __forceinline__ void xcd_barrier(const XcdBarrier& b) {
    asm volatile("s_waitcnt vmcnt(0)" ::: "memory");
    __syncthreads();
    if (threadIdx.x == 0) {
        unsigned* bar = b.bar;
        __builtin_amdgcn_s_waitcnt(0);
        unsigned nloc = b.st[0], nx = b.st[1];
        if (nloc == 0u) { xcd_barrier_complete(bar, b.x, nloc, nx); b.st[0] = nloc; b.st[1] = nx; }
        const unsigned old = xb_add(&bar[XB_XSUB(b.x)], 1u);
        const unsigned gen = old / nloc;
        if (old + 1u == (gen + 1u) * nloc) {
            __builtin_amdgcn_fence(__ATOMIC_RELEASE, "agent");
            asm volatile("s_waitcnt vmcnt(0)" ::: "memory");
            const unsigned og = xb_add(&bar[XB_TOP], 1u);
            const unsigned tg = og / nx;
            if (og + 1u == (tg + 1u) * nx) xb_add(&bar[XB_TOPGEN], 1u);
            else XB_SPIN(xb_ld(&bar[XB_TOPGEN]) == tg, bar);
            __builtin_amdgcn_fence(__ATOMIC_ACQUIRE, "agent");
            xb_add(&bar[XB_XGEN(b.x)], 1u);
            asm volatile("s_waitcnt vmcnt(0)" ::: "memory");
        } else {
            XB_SPIN(xb_ld(&bar[XB_XGEN(b.x)]) == gen, bar);
            __builtin_amdgcn_fence(__ATOMIC_ACQUIRE, "agent");
            asm volatile("s_waitcnt vmcnt(0)" ::: "memory");
        }
    }
    __syncthreads();
}

#ifndef REP_GEMM
#define REP_GEMM 1
#endif

#ifndef REP_MIX
#define REP_MIX 1
#endif
#ifndef REP_PV
#define REP_PV 1
#endif
#ifndef REP_PEER
#define REP_PEER 1
#endif
#ifndef REP_ELEM
#define REP_ELEM 1
#endif
#ifndef REP_SYNC
#define REP_SYNC 1
#endif
#ifndef REP_TOPK
#define REP_TOPK 1
#endif
#define GSYNC() do { for (int r_ = 0; r_ < REP_SYNC; ++r_) xcd_barrier(xb); } while (0)
__global__ void __launch_bounds__(256, 2) k_mega(Params p) {
  cg::grid_group grid = cg::this_grid();
  volatile LAS unsigned* xst = (volatile LAS unsigned*)(smem + LDS_BYTES - 16);
  if (threadIdx.x == 0) { xst[0] = 0u; xst[1] = 0u; }
  __syncthreads();
  XcdBarrier xb = xcd_barrier_post(p.bar, xst);
  for (int r = 0; r < REP_INIT; ++r) phase_init(p);
  if (p.bar == nullptr) grid.sync();
  GSYNC();
  for (int layer = 0; layer < 2; ++layer) {
    const int last = layer == 1;
    const int nrows2 = last ? NLAT : MROWS;
    if (layer == 0 || DIAG_HP) { for (int r = 0; r < REP_NORM; ++r) phase_norm(p, layer, 1, MROWS, layer == 0); GSYNC(); }
    for (int r = 0; r < REP_GEMM * REP_G_IN; ++r) phase_inproj(p, layer, MROWS, DIAG_HP ? 0 : 2);
    GSYNC();
    for (int r = 0; r < REP_SPREP; ++r) { phase_ssdprep(p, layer); phase_vtrans(p); }
    GSYNC();
    for (int r = 0; r < REP_MIX; ++r) phase_mix1(p, layer, !last);
    GSYNC();
    phase_ssdcarry(p); phase_mlcarry(p); GSYNC();
    for (int r = 0; r < REP_MIX; ++r) phase_mix3(p, layer, last);
    GSYNC();
    for (int r = 0; r < REP_SOUT; ++r) { phase_ssdout(p, layer, nrows2); phase_mlout(p, layer, nrows2); }
    GSYNC();
#if DIAG_HP
    for (int r = 0; r < REP_GEMM * REP_G_GATE; ++r) phase_inproj(p, layer, nrows2, 1);
    GSYNC();
#endif
    for (int r = 0; r < REP_GEMM * REP_G_MERGE; ++r) phase_merge(p, layer, nrows2);
    GSYNC();
    for (int r = 0; r < REP_GEMM * REP_G_OUT; ++r) phase_outproj(p, layer, nrows2, r == 0 ? 1.f : 0.f, (layer == 0 && r == 0) ? 1 : 0);
    GSYNC();
    for (int r = 0; r < REP_NORM; ++r) phase_norm(p, layer, 2, nrows2, 0);
    GSYNC();
    for (int r = 0; r < REP_GEMM * REP_G_WQ; ++r) phase_wq(p, layer, nrows2);
#if !DIAG_HP
    for (int r = 0; r < REP_UVC; ++r) phase_uvconv8(p, layer);
#endif
    GSYNC();
    for (int r = 0; r < REP_TOPK; ++r) { if (DIAG_HP) phase_topk(p, layer, nrows2); else phase_topk2(p, layer, nrows2); }
    GSYNC();
#if DIAG_HP
    phase_gather(p, layer, nrows2, 1.f);
    if (!last) { GSYNC(); phase_norm(p, layer + 1, 1, nrows2, 0); GSYNC(); }
#else
    for (int r = 0; r < REP_PEER; ++r) phase_gatherU(p, layer, nrows2);
    GSYNC();
    for (int r = 0; r < REP_PV; ++r) phase_gatherV(p, layer, nrows2, r == 0 ? 1.f : 0.f);
    if (!last) { GSYNC(); phase_norm(p, layer + 1, 1, nrows2, 0); GSYNC(); }
#endif
  }
}

extern "C" void kernel_launch(void* const* d_in, const int* in_sizes, int n_in, void* d_out, int out_size, void* d_ws, size_t ws_size,
                              hipStream_t stream) {
  Params p{};
  const float* const* in = (const float* const*)d_in;
  p.x = in[0]; p.c = in[1]; p.ctx = in[2]; p.c_ctx = in[3]; p.norm1_g = in[4]; p.norm2_g = in[5]; p.w_mod = in[6]; p.b_mod = in[7];
  p.w_in = in[8]; p.att_qnorm = in[9]; p.att_knorm = in[10]; p.ssd_conv_w = in[11]; p.ssd_conv_b = in[12]; p.ssd_dt_bias = in[13];
  p.ssd_a_log = in[14]; p.ssd_d = in[15]; p.ssd_norm = in[16]; p.ml_gate_bias = in[17]; p.ml_norm = in[18]; p.w_branch = in[19];
  p.w_out = in[20]; p.peer_wq = in[21]; p.peer_subkeys = in[22]; p.peer_u = in[23]; p.peer_v = in[24];
  p.out = (float*)d_out;
  char* w = (char*)d_ws; size_t off = 65536;
  p.bar = (unsigned*)d_ws;
  auto take = [&](size_t bytes) { char* r = w + off; off += (bytes + 255) & ~(size_t)255; return r; };
  p.mod = (float*)take((size_t)2 * 3 * 6144 * 4);
  p.xc = (float*)take((size_t)NCTX * DM * 4);
  p.small = (float*)take((size_t)MROWS * 32 * 4);
  p.dtb = (float*)take((size_t)MROWS * 16 * 4);
  p.wt_in = (bf16_t*)take((size_t)2 * INCP * DM * 2);
  p.wt_br = (bf16_t*)take((size_t)2 * 3 * DM * 512 * 2);
  p.wt_out = (bf16_t*)take((size_t)2 * DM * DM * 2);
  p.wt_q = (bf16_t*)take((size_t)2 * 2048 * DM * 2);
  p.sk = (bf16_t*)take((size_t)2 * 8 * 2 * 128 * 128 * 2);
  p.wt_q_lo = (bf16_t*)take(DIAG_HP ? (size_t)2 * 2048 * DM * 2 : 256);
  p.vt = (bf16_t*)take((size_t)4 * 64 * 8448 * 2);
  p.ropec = (float*)take((size_t)8192 * 32 * 4);
  p.ropes = (float*)take((size_t)8192 * 32 * 4);
  p.ssl = (bf16_t*)take((size_t)32 * 66 * 4096 * 2);
  p.sdec = (float*)take((size_t)32 * 66 * 4);
  p.mcl = (bf16_t*)take((size_t)16 * 66 * 16384 * 2);
  p.mnl = (float*)take((size_t)16 * 66 * 128 * 4);
  p.mml = (float*)take((size_t)16 * 66 * 4);
  p.mbl = (float*)take((size_t)16 * 66 * 4);
  p.mmp = (float*)take((size_t)16 * 66 * 4);
  p.h = (bf16_t*)take((size_t)MROWS * DM * 2);
  p.br = (bf16_t*)take((size_t)MROWS * 1536 * 2);
  p.xbc = (bf16_t*)take((size_t)MROWS * 768 * 2);
  p.idx = (int*)p.xbc; p.gw = (float*)((char*)p.xbc + (size_t)MROWS * 128 * 4);
  p.yf = (bf16_t*)take((size_t)MROWS * 512 * 2);
  p.yb = (bf16_t*)take((size_t)MROWS * 512 * 2);
  p.hf = (bf16_t*)take((size_t)MROWS * 512 * 2);
  p.hb = p.hf;
  p.gp8 = (unsigned char*)take((size_t)MROWS * 3072);
  p.mix = p.yf;
  p.proj = (bf16_t*)take((size_t)MROWS * 4096 * 2);
  p.uvs = (float*)take((size_t)2 * 16384 * 4);
  p.gp = p.proj; p.q = p.proj; p.qf = (float*)p.proj; p.h2lo = p.br; p.uv = (bf16_t*)((char*)p.proj + (size_t)MROWS * 2048 * 2); p.uvq = (unsigned char*)p.uv;
  p.xq = (signed char*)p.br; p.sxq = (float*)((char*)p.br + (size_t)MROWS * DM); p.wbuf = (float*)((char*)p.br + (size_t)MROWS * DM + (size_t)MROWS * 4);
  if (off > ws_size) return;

  const int LDS = LDS_BYTES;
  static int grid_blocks = 0;
  if (!grid_blocks) {
    (void)hipFuncSetAttribute((const void*)k_mega, hipFuncAttributeMaxDynamicSharedMemorySize, LDS);
    int dev = 0, cus = 0, per_cu = 0;
    (void)hipGetDevice(&dev);
    (void)hipDeviceGetAttribute(&cus, hipDeviceAttributeMultiprocessorCount, dev);
    (void)hipOccupancyMaxActiveBlocksPerMultiprocessor(&per_cu, (const void*)k_mega, 256, LDS);
    if (per_cu < 1) per_cu = 1;
    if (per_cu > 2) per_cu = 2;
    grid_blocks = cus * per_cu;
  }
  (void)hipMemsetAsync(d_ws, 0, XCD_BAR_WORDS * 4, stream);
  void* args[] = {&p};
  hipError_t e = hipLaunchCooperativeKernel((const void*)k_mega, dim3(grid_blocks), dim3(256), args, LDS, stream);
  if (e != hipSuccess) fprintf(stderr, "cooperative launch failed: %s (grid %d)\n", hipGetErrorString(e), grid_blocks);
}
```

```cpp
#include <hip/hip_runtime.h>
#include <hip/hip_cooperative_groups.h>
#include <stdint.h>
#include <stdio.h>
namespace cg = cooperative_groups;

typedef unsigned short bf16_t;
typedef short bf16x8 __attribute__((ext_vector_type(8)));
typedef float f32x4 __attribute__((ext_vector_type(4)));
typedef unsigned u32x4 __attribute__((ext_vector_type(4)));
typedef unsigned u32x2 __attribute__((ext_vector_type(2)));
typedef float f32x16 __attribute__((ext_vector_type(16)));

constexpr int SEQ = 8192, BATCH = 2, CTXL = 256, DM = 1024;
constexpr int NLAT = BATCH * SEQ;
constexpr int NCTX = BATCH * CTXL;
constexpr int MROWS = NLAT + NCTX;
constexpr int INC = 7200, INCP = 7296;
constexpr int NTHR = 256;

#ifndef DIAG_HP
#define DIAG_HP 0
#endif
#define REP_INIT 1
#define REP_NORM 1
#define REP_SPREP 1
#define REP_SOUT 1
#define REP_UVC 1
#define REP_QK 1
#define REP_KCOMP 1
#define REP_KSTG 1
#define REP_G_IN 1
#define REP_G_GATE 1
#define REP_G_MERGE 1
#define REP_G_OUT 1
#define REP_G_WQ 1
#define REP_STG 1
#define REP_EXP 1
#define REP_MLA 1
#define REP_SSDA 1
#define REP_ATT 1
#define REP_MLC 1
#define REP_SSDC 1
#ifndef ATT_ALPHA
#define ATT_ALPHA 1.f
#endif
#ifndef ATT_NAIVE
#define ATT_NAIVE 0
#endif
#ifndef ATT_TAU
#define ATT_TAU 1.f
#endif
#ifndef PEER_ALPHA
#define PEER_ALPHA 1.f
#endif
#define LDS_BYTES (DIAG_HP ? 140 * 1024 : 78 * 1024)
extern __shared__ __attribute__((aligned(16))) char smem[];

struct Params {
  const float *x, *c, *ctx, *c_ctx, *norm1_g, *norm2_g, *w_mod, *b_mod, *w_in, *att_qnorm, *att_knorm,
      *ssd_conv_w, *ssd_conv_b, *ssd_dt_bias, *ssd_a_log, *ssd_d, *ssd_norm, *ml_gate_bias, *ml_norm,
      *w_branch, *w_out, *peer_wq, *peer_subkeys, *peer_u, *peer_v;
  float* out;
  unsigned* bar;
  float* mod;
  float* xc;
  float* small;
  float* dtb;
  bf16_t *wt_in, *wt_br, *wt_out, *wt_q, *sk;
  bf16_t* h;
  bf16_t* br;
  bf16_t* xbc;
  bf16_t *yf, *yb, *hf, *hb;
  bf16_t* mix;
  bf16_t* proj;
  bf16_t* gp;
  unsigned char* gp8;
  bf16_t* q;
  bf16_t* uv;
  unsigned char* uvq;
  float* uvs;
  signed char* xq;
  float* sxq;
  float* wbuf;
  int* idx;
  float* gw;
  bf16_t* h2lo;
  bf16_t* wt_q_lo;
  float* qf;
  bf16_t* vt;
  float* ropec;
  float* ropes;
  bf16_t* ssl;
  float* sdec;
  bf16_t* mcl;
  float* mnl;
  float* mml;
  float* mbl;
  float* mmp;
};

__device__ __forceinline__ int tidx() { int t = __builtin_amdgcn_workitem_id_x(); asm volatile("" : "+v"(t)); return t; }
__device__ __forceinline__ int bidx() { int t = __builtin_amdgcn_workgroup_id_x(); asm volatile("" : "+s"(t)); return t; }
__device__ __forceinline__ float bf2f(bf16_t v) { return __uint_as_float(((unsigned)v) << 16); }
__device__ __forceinline__ bf16_t f2bf(float f) {
  unsigned u = __float_as_uint(f);
  u += 0x7fffu + ((u >> 16) & 1u);
  return (bf16_t)(u >> 16);
}
typedef float f32x2 __attribute__((ext_vector_type(2)));
typedef int i32x4 __attribute__((ext_vector_type(4)));
typedef __bf16 bf16x2n __attribute__((ext_vector_type(2)));
__device__ __forceinline__ unsigned pack2(float a, float b) {
  f32x2 v = {a, b};
  bf16x2n r = __builtin_convertvector(v, bf16x2n);
  return *(unsigned*)&r;
}
__device__ __forceinline__ float sigmoidf_(float x) { return 1.f / (1.f + __expf(-x)); }
__device__ __forceinline__ float siluf_(float x) { return x / (1.f + __expf(-x)); }
__device__ __forceinline__ float softplusf_(float x) { return x > 20.f ? x : log1pf(__expf(x)); }
__device__ __forceinline__ float logsigmoidf_(float x) { return x < 0.f ? x - log1pf(__expf(x)) : -log1pf(__expf(-x)); }
__device__ __forceinline__ float gelu_tanh(float x) {
  float u = 0.7978845608028654f * (x + 0.044715f * x * x * x);
  float t = 1.f - 2.f / (1.f + __expf(2.f * u));
  return 0.5f * x * (1.f + t);
}
__device__ __forceinline__ float ub0(unsigned v) { return (float)(v & 0xffu); }
__device__ __forceinline__ float ub1(unsigned v) { return (float)((v >> 8) & 0xffu); }
__device__ __forceinline__ float ub2(unsigned v) { return (float)((v >> 16) & 0xffu); }
__device__ __forceinline__ float ub3(unsigned v) { return (float)(v >> 24); }
__device__ __forceinline__ float* xrow(const Params& p, int row) {
  return row < NLAT ? p.out + (size_t)row * DM : p.xc + (size_t)(row - NLAT) * DM;
}
__device__ __forceinline__ const float* xrow_src(const Params& p, int row, int from_input) {
  if (from_input) return row < NLAT ? p.x + (size_t)row * DM : p.ctx + (size_t)(row - NLAT) * DM;
  return row < NLAT ? p.out + (size_t)row * DM : p.xc + (size_t)(row - NLAT) * DM;
}
__device__ __forceinline__ int modrow(int row) { return row < NLAT ? row / SEQ : 2; }
__device__ __forceinline__ float wave_sum(float v) {
#pragma unroll
  for (int o = 32; o > 0; o >>= 1) v += __shfl_xor(v, o);
  return v;
}
__device__ __forceinline__ float wave_max(float v) {
#pragma unroll
  for (int o = 32; o > 0; o >>= 1) v = fmaxf(v, __shfl_xor(v, o));
  return v;
}

__device__ __forceinline__ int win_colmap(int n) {
  if (n < 2048) return n;
  if (n < 4096) return n + 16;
  if (n < 7168) return n + 32;
  if (n < 7184) return n - 5120;
  if (n < 7200) return n - 3072;
  return -1;
}

__device__ __forceinline__ void transpose_tile(const float* src, int Nsrc, int K, bf16_t* dst, int n0, int k0, int mode, bf16_t* dstlo = nullptr) {
  float* tile = (float*)smem;
  const int tid = tidx();
  {
    const int n4 = (tid & 15) * 4;
    int sc = n0 + n4;
    if (mode == 1) sc = win_colmap(sc);
#pragma unroll
    for (int i = 0; i < 4; ++i) {
      const int kk = (tid >> 4) + 16 * i;
      f32x4 v = sc >= 0 ? *(const f32x4*)(src + (size_t)(k0 + kk) * Nsrc + sc) : (f32x4){0.f, 0.f, 0.f, 0.f};
      tile[kk * 65 + n4] = v[0]; tile[kk * 65 + n4 + 1] = v[1]; tile[kk * 65 + n4 + 2] = v[2]; tile[kk * 65 + n4 + 3] = v[3];
    }
  }
  __syncthreads();
  {
    const int n = tid >> 2, kc = (tid & 3) * 16;
    float t[16];
#pragma unroll
    for (int e = 0; e < 16; ++e) t[e] = tile[(kc + e) * 65 + n];
    u32x4 w0, w1;
#pragma unroll
    for (int e = 0; e < 4; ++e) { w0[e] = pack2(t[2 * e], t[2 * e + 1]); w1[e] = pack2(t[8 + 2 * e], t[8 + 2 * e + 1]); }
    bf16_t* d = dst + (size_t)(n0 + n) * K + k0 + kc;
    *(u32x4*)d = w0; *(u32x4*)(d + 8) = w1;
    if (dstlo) {
      u32x4 l0, l1;
#pragma unroll
      for (int e = 0; e < 4; ++e) {
        l0[e] = pack2(t[2 * e] - __uint_as_float(w0[e] << 16), t[2 * e + 1] - __uint_as_float(w0[e] & 0xffff0000u));
        l1[e] = pack2(t[8 + 2 * e] - __uint_as_float(w1[e] << 16), t[8 + 2 * e + 1] - __uint_as_float(w1[e] & 0xffff0000u));
      }
      bf16_t* dl = dstlo + (size_t)(n0 + n) * K + k0 + kc;
      *(u32x4*)dl = l0; *(u32x4*)(dl + 8) = l1;
    }
  }
  __syncthreads();
}

__device__ __forceinline__ void phase_init(const Params& p) {
  const int tid = tidx(), bid = bidx(), nb = gridDim.x;
  for (int i = bid * NTHR + tid; i < 8192 * 32; i += nb * NTHR) {
    int pos = i >> 5, jj = i & 31;
    float inv = powf(10000.f, -(float)(jj & 15) / 16.f);
    float ang = (float)(jj < 16 ? (pos >> 6) : (pos & 63)) * inv;
    float sn, cs_; sincosf(ang, &sn, &cs_);
    p.ropec[i] = cs_; p.ropes[i] = sn;
  }
  for (size_t i = (size_t)bid * NTHR + tid; i < (size_t)2 * 8 * 2 * 128 * 128; i += (size_t)nb * NTHR) p.sk[i] = f2bf(p.peer_subkeys[i]);
  {
    const int per_layer = 1824 + 384 + 256 + 512;
    for (int job = bid; job < 2 * per_layer; job += nb) {
      int l = job / per_layer, j = job % per_layer;
      if (j < 1824) {
        int nt = j / 16, kt = j % 16;
        transpose_tile(p.w_in + (size_t)l * DM * INC, INC, DM, p.wt_in + (size_t)l * INCP * DM, nt * 64, kt * 64, 1);
      } else if (j < 1824 + 384) {
        j -= 1824; int r = j / 128; j %= 128; int nt = j / 8, kt = j % 8;
        transpose_tile(p.w_branch + ((size_t)l * 3 + r) * 512 * DM, DM, 512, p.wt_br + ((size_t)l * 3 + r) * DM * 512, nt * 64, kt * 64, 0);
      } else if (j < 1824 + 384 + 256) {
        j -= 1824 + 384; int nt = j / 16, kt = j % 16;
        transpose_tile(p.w_out + (size_t)l * DM * DM, DM, DM, p.wt_out + (size_t)l * DM * DM, nt * 64, kt * 64, 0);
      } else {
        j -= 1824 + 384 + 256; int nt = j / 16, kt = j % 16;
        transpose_tile(p.peer_wq + (size_t)l * DM * 2048, 2048, DM, p.wt_q + (size_t)l * 2048 * DM, nt * 64, kt * 64, 0, DIAG_HP ? p.wt_q_lo + (size_t)l * 2048 * DM : nullptr);
      }
    }
  }
  {
    float* sl = (float*)smem;
    float* part = sl + 3 * DM;
    bool loaded = false;
    for (int blk = bid; blk < 192; blk += nb) {
      if (!loaded) {
        __syncthreads();
        for (int i = tid; i < 3 * DM; i += NTHR) {
          float v = i < 2 * DM ? p.c[i] : p.c_ctx[i - 2 * DM];
          sl[i] = siluf_(v);
        }
        loaded = true;
      }
      __syncthreads();
      const int wv = tid >> 6, ln = tid & 63;
      const int gi = blk * 64 + ln;
      const int l = gi / 6144, col = gi % 6144;
      const float* w = p.w_mod + (size_t)l * DM * 6144 + col;
      float a0 = 0.f, a1 = 0.f, a2 = 0.f;
#pragma unroll 8
      for (int k = wv * 256; k < wv * 256 + 256; ++k) {
        float wv_ = w[(size_t)k * 6144];
        a0 += sl[k] * wv_; a1 += sl[DM + k] * wv_; a2 += sl[2 * DM + k] * wv_;
      }
      part[(wv * 3 + 0) * 64 + ln] = a0; part[(wv * 3 + 1) * 64 + ln] = a1; part[(wv * 3 + 2) * 64 + ln] = a2;
      __syncthreads();
      if (tid < 192) {
        const int r = tid >> 6;
        float s = part[(0 * 3 + r) * 64 + ln] + part[(1 * 3 + r) * 64 + ln] + part[(2 * 3 + r) * 64 + ln] + part[(3 * 3 + r) * 64 + ln];
        p.mod[(l * 3 + r) * 6144 + col] = s + p.b_mod[l * 6144 + col];
      }
    }
  }
}

__device__ __forceinline__ void phase_norm(const Params& p, int layer, int which, int nrows, int from_input) {
  const int lane = tidx() & 63, wv = tidx() >> 6;
  const float* g = (which == 1 ? p.norm1_g : p.norm2_g) + layer * DM;
  const int sh_off = which == 1 ? 0 : 3 * DM, sc_off = which == 1 ? DM : 4 * DM;
  int curm = -1;
  f32x4 Ar[4], Br[4];
  for (int row = bidx() * 4 + wv; row < nrows; row += gridDim.x * 4) {
    const float* xr = xrow_src(p, row, from_input);
    const int mr = modrow(row);
    if (mr != curm) {
      const float* md = p.mod + (size_t)(layer * 3 + mr) * 6144;
#pragma unroll
      for (int j = 0; j < 4; ++j) {
        int c0 = j * 256 + lane * 4;
        f32x4 gg = *(const f32x4*)(g + c0), sc = *(const f32x4*)(md + sc_off + c0);
        Br[j] = *(const f32x4*)(md + sh_off + c0);
#pragma unroll
        for (int e = 0; e < 4; ++e) Ar[j][e] = gg[e] * (1.f + sc[e]);
      }
      curm = mr;
    }
    f32x4 v[4]; float ss = 0.f;
#pragma unroll
    for (int j = 0; j < 4; ++j) {
      v[j] = *(const f32x4*)(xr + j * 256 + lane * 4);
      ss += v[j][0] * v[j][0] + v[j][1] * v[j][1] + v[j][2] * v[j][2] + v[j][3] * v[j][3];
    }
    ss = wave_sum(ss);
    float rs = rsqrtf(ss * (1.f / DM) + 1e-6f);
#pragma unroll
    for (int j = 0; j < 4; ++j) {
      int c0 = j * 256 + lane * 4;
      float o0 = v[j][0] * rs * Ar[j][0] + Br[j][0];
      float o1 = v[j][1] * rs * Ar[j][1] + Br[j][1];
      float o2 = v[j][2] * rs * Ar[j][2] + Br[j][2];
      float o3 = v[j][3] * rs * Ar[j][3] + Br[j][3];
      u32x2 w; w.x = pack2(o0, o1); w.y = pack2(o2, o3);
      *(u32x2*)(p.h + (size_t)row * DM + c0) = w;
      v[j][0] = o0; v[j][1] = o1; v[j][2] = o2; v[j][3] = o3;
#if DIAG_HP
      if (which == 2) {
        u32x2 wl; wl.x = pack2(o0 - __uint_as_float(w.x << 16), o1 - __uint_as_float(w.x & 0xffff0000u));
        wl.y = pack2(o2 - __uint_as_float(w.y << 16), o3 - __uint_as_float(w.y & 0xffff0000u));
        *(u32x2*)(p.h2lo + (size_t)row * DM + c0) = wl;
      }
#endif
    }
    if (which == 2) {
      float am = 0.f;
#pragma unroll
      for (int j = 0; j < 4; ++j) am = fmaxf(fmaxf(fmaxf(am, fabsf(v[j][0])), fmaxf(fabsf(v[j][1]), fabsf(v[j][2]))), fabsf(v[j][3]));
      am = wave_max(am);
      const float sc8 = am > 0.f ? am * (1.f / 127.f) : 1.f, inv8 = 1.f / sc8;
#pragma unroll
      for (int j = 0; j < 4; ++j) {
        unsigned q = 0;
#pragma unroll
        for (int e = 0; e < 4; ++e) {
          int t = (int)rintf(v[j][e] * inv8);
          t = t < -127 ? -127 : (t > 127 ? 127 : t);
          q |= (unsigned)(t & 0xff) << (8 * e);
        }
        *(unsigned*)(p.xq + (size_t)row * DM + j * 256 + lane * 4) = q;
      }
      if (lane == 0) p.sxq[row] = sc8;
    }
  }
}

__device__ __forceinline__ void gemm_stage(const bf16_t* A, int lda, const bf16_t* Bt, int ldb, int brow, int bcol, int kt, char* buf, int tid) {
#pragma unroll
  for (int i = 0; i < 4; ++i) {
    const int b = (tid + 256 * i) * 16, r = b >> 7, c = ((b >> 4) & 7) ^ ((r >> 1) & 7);
    __builtin_amdgcn_global_load_lds((const unsigned*)(A + (size_t)(brow + r) * lda + kt + c * 8), (__attribute__((address_space(3))) unsigned*)(buf + b), 16, 0, 0);
    __builtin_amdgcn_global_load_lds((const unsigned*)(Bt + (size_t)(bcol + r) * ldb + kt + c * 8), (__attribute__((address_space(3))) unsigned*)(buf + 16384 + b), 16, 0, 0);
  }
}
__device__ __forceinline__ void gemm_compute(f32x4 (&acc)[4][4], const char* buf, int wr, int wc, int fr, int fq) {
#pragma unroll
  for (int ks = 0; ks < 2; ++ks) {
    bf16x8 At[4], Bl[4];
#pragma unroll
    for (int m = 0; m < 4; ++m) { const int row = wr * 64 + m * 16 + fr; At[m] = *(const bf16x8*)(buf + row * 128 + (((ks * 4 + fq) ^ ((row >> 1) & 7)) << 4)); }
#pragma unroll
    for (int n = 0; n < 4; ++n) { const int row = wc * 64 + n * 16 + fr; Bl[n] = *(const bf16x8*)(buf + 16384 + row * 128 + (((ks * 4 + fq) ^ ((row >> 1) & 7)) << 4)); }
    __builtin_amdgcn_s_setprio(1);
#pragma unroll
    for (int m = 0; m < 4; ++m)
#pragma unroll
      for (int n = 0; n < 4; ++n) acc[m][n] = __builtin_amdgcn_mfma_f32_16x16x32_bf16(Bl[n], At[m], acc[m][n], 0, 0, 0);
    __builtin_amdgcn_s_setprio(0);
  }
}
__device__ __forceinline__ void gemm_compute_h(f32x4 (&acc)[4][4], const char* buf, int wr, int wc, int fr, int fq) {
  bf16x8 At[2][4], Bl[2][4];
#pragma unroll
  for (int ks = 0; ks < 2; ++ks) {
#pragma unroll
    for (int m = 0; m < 4; ++m) { const int row = wr * 64 + m * 16 + fr; At[ks][m] = *(const bf16x8*)(buf + row * 128 + (((ks * 4 + fq) ^ ((row >> 1) & 7)) << 4)); }
#pragma unroll
    for (int n = 0; n < 4; ++n) { const int row = wc * 64 + n * 16 + fr; Bl[ks][n] = *(const bf16x8*)(buf + 16384 + row * 128 + (((ks * 4 + fq) ^ ((row >> 1) & 7)) << 4)); }
  }
  __builtin_amdgcn_s_setprio(1);
#pragma unroll
  for (int ks = 0; ks < 2; ++ks)
#pragma unroll
    for (int m = 0; m < 4; ++m)
#pragma unroll
      for (int n = 0; n < 4; ++n) acc[m][n] = __builtin_amdgcn_mfma_f32_16x16x32_bf16(Bl[ks][n], At[ks][m], acc[m][n], 0, 0, 0);
  __builtin_amdgcn_s_setprio(0);
}
template <bool HOIST = true>
__device__ __forceinline__ void gemm_kloop(f32x4 (&acc)[4][4], const bf16_t* A, int lda, const bf16_t* Bt, int ldb, int K, int brow, int bcol) {
  const int tid = tidx(), wid = tid >> 6, lane = tid & 63, wr = wid >> 1, wc = wid & 1, fr = lane & 15, fq = lane >> 4;
  const int nt = K >> 6;
  __syncthreads();
  gemm_stage(A, lda, Bt, ldb, brow, bcol, 0, smem, tid);
  asm volatile("s_waitcnt vmcnt(0)" ::: "memory");
  __syncthreads();
  for (int t = 0; t < nt - 1; ++t) {
    char* cur = smem + (t & 1) * 32768; char* nxt = smem + ((t + 1) & 1) * 32768;
    gemm_stage(A, lda, Bt, ldb, brow, bcol, (t + 1) * 64, nxt, tid);
    if (HOIST) gemm_compute_h(acc, cur, wr, wc, fr, fq); else gemm_compute(acc, cur, wr, wc, fr, fq);
#if REP_KCOMP > 1
    { f32x4 acc2[4][4];
#pragma unroll
      for (int m = 0; m < 4; ++m)
#pragma unroll
        for (int n = 0; n < 4; ++n) acc2[m][n] = (f32x4){0.f, 0.f, 0.f, 0.f};
      gemm_compute(acc2, cur, wr, wc, fr, fq);
      float sink = 0.f;
#pragma unroll
      for (int m = 0; m < 4; ++m)
#pragma unroll
        for (int n = 0; n < 4; ++n) sink += acc2[m][n][0];
      asm volatile("" :: "v"(sink)); }
#endif
    asm volatile("s_waitcnt vmcnt(0)" ::: "memory");
    __syncthreads();
#if REP_KSTG > 1
    gemm_stage(A, lda, Bt, ldb, brow, bcol, (t + 1) * 64, nxt, tid);
    asm volatile("s_waitcnt vmcnt(0)" ::: "memory");
    __syncthreads();
#endif
  }
  if (HOIST) gemm_compute_h(acc, smem + ((nt - 1) & 1) * 32768, wr, wc, fr, fq); else gemm_compute(acc, smem + ((nt - 1) & 1) * 32768, wr, wc, fr, fq);
}

__device__ __forceinline__ void tile_map(int t, int NT, int& mt, int& ni) {
  const int x = t & 7, q = t >> 3, nsub = NT >> 3;
  mt = q / nsub; ni = x + 8 * (q - mt * nsub);
}
__device__ __forceinline__ void tile_map_m(int t, int mtiles, int& mt, int& nt) {
  const int idx = (t & 7) * mtiles + (t >> 3);
  mt = idx >> 3; nt = idx & 7;
}
#define GEMM_IDS const int tid = tidx(), wid = tid >> 6, lane = tid & 63, wr = wid >> 1, wc = wid & 1, fr = lane & 15, fq = lane >> 4; (void)tid;

__device__ __forceinline__ void zero_acc(f32x4 (&acc)[4][4]) {
#pragma unroll
  for (int m = 0; m < 4; ++m)
#pragma unroll
    for (int n = 0; n < 4; ++n) acc[m][n] = (f32x4){0.f, 0.f, 0.f, 0.f};
}


__device__ __forceinline__ void store_slab_bf16(const f32x4 (&v)[4], bf16_t* dst_row0, size_t ld, int wid, int lane) {
  char* slab = smem + 65536 + wid * 2304;
  const int fr = lane & 15, fq = lane >> 4;
#pragma unroll
  for (int n = 0; n < 4; ++n) {
    u32x2 w; w.x = pack2(v[n][0], v[n][1]); w.y = pack2(v[n][2], v[n][3]);
    *(u32x2*)(slab + fr * 144 + (n * 16 + fq * 4) * 2) = w;
  }
  const int r = lane >> 3, c = lane & 7;
  u32x4 a = *(const u32x4*)(slab + r * 144 + c * 16), b = *(const u32x4*)(slab + (r + 8) * 144 + c * 16);
  *(u32x4*)(dst_row0 + (size_t)r * ld + c * 8) = a;
  *(u32x4*)(dst_row0 + (size_t)(r + 8) * ld + c * 8) = b;
}


__device__ __forceinline__ void store_slab_gate8(const f32x4 (&v)[4], unsigned char* dst_row0, int wid, int lane) {
  char* slab = smem + 65536 + wid * 2304;
  const int fr = lane & 15, fq = lane >> 4;
#pragma unroll
  for (int n = 0; n < 4; ++n) {
    unsigned q = 0;
#pragma unroll
    for (int j = 0; j < 4; ++j) { int g = (int)rintf(sigmoidf_(v[n][j]) * 255.f); q |= (unsigned)g << (8 * j); }
    *(unsigned*)(slab + fr * 80 + n * 16 + fq * 4) = q;
  }
  const int r = lane >> 2, c = lane & 3;
  u32x4 a = *(const u32x4*)(slab + r * 80 + c * 16);
  *(u32x4*)(dst_row0 + (size_t)r * 3072 + c * 16) = a;
}
__device__ __forceinline__ void load_slab_gate8(unsigned (&g)[4], const unsigned char* src_row0, int wid, int lane) {
  char* slab = smem + 65536 + wid * 2304;
  const int fr = lane & 15, fq = lane >> 4;
  const int r = lane >> 2, c = lane & 3;
  *(u32x4*)(slab + r * 80 + c * 16) = *(const u32x4*)(src_row0 + (size_t)r * 3072 + c * 16);
#pragma unroll
  for (int n = 0; n < 4; ++n) g[n] = *(const unsigned*)(slab + fr * 80 + n * 16 + fq * 4);
}

__device__ __forceinline__ void phase_inproj(const Params& p, int layer, int nrows, int part) {
  GEMM_IDS
  const int ntl = part == 0 ? 33 : (part == 1 ? 24 : 57);
  const int mtiles = nrows / 128;
  const bf16_t* Bt = p.wt_in + (size_t)layer * INCP * DM;
  for (int t = bidx(); t < mtiles * ntl; t += gridDim.x) {
    int mt, ni, nt;
    if (part == 0) { if (t < mtiles * 32) tile_map(t, 32, mt, ni); else { mt = t - mtiles * 32; ni = 32; } nt = ni < 32 ? ni : 56; }
    else if (part == 1) { tile_map(t, 24, mt, ni); nt = 32 + ni; }
    else { if (t < mtiles * 56) { tile_map(t, 56, mt, ni); nt = ni; } else { mt = t - mtiles * 56; nt = 56; } }
    f32x4 acc[4][4]; zero_acc(acc);
    gemm_kloop(acc, p.h, DM, Bt, DM, DM, mt * 128, nt * 128);
    if (nt >= 32 && nt < 56 && !DIAG_HP) {
#pragma unroll
      for (int m = 0; m < 4; ++m) store_slab_gate8(acc[m], p.gp8 + (size_t)(mt * 128 + wr * 64 + m * 16) * 3072 + (nt * 128 - 4096) + wc * 64, wid, lane);
    } else if (nt >= 5 && nt < 56) {
      bf16_t* dst = nt < 32 ? p.proj + (size_t)(mt * 128 + wr * 64) * 4096 + nt * 128 + wc * 64 : p.gp + (size_t)(mt * 128 + wr * 64) * 3072 + (nt * 128 - 4096) + wc * 64;
      const size_t ld = nt < 32 ? 4096 : 3072;
#pragma unroll
      for (int m = 0; m < 4; ++m) store_slab_bf16(acc[m], dst + (size_t)(m * 16) * ld, ld, wid, lane);
    } else if (nt == 56) {
#pragma unroll
      for (int m = 0; m < 4; ++m)
#pragma unroll
        for (int n = 0; n < 4; ++n) {
          int row = mt * 128 + wr * 64 + m * 16 + fr, cc = wc * 64 + n * 16 + fq * 4;
          if (cc < 32) *(f32x4*)(p.small + (size_t)row * 32 + cc) = acc[m][n];
        }
    }
    if (nt < 5) {
      const float* nw = (nt < 4 ? p.att_qnorm : p.att_knorm) + layer * 64;
      const bool latent = mt < NLAT / 128;
#pragma unroll
      for (int m = 0; m < 4; ++m) {
        const int row = mt * 128 + wr * 64 + m * 16 + fr;
        float ss = 0.f;
#pragma unroll
        for (int n = 0; n < 4; ++n)
#pragma unroll
          for (int j = 0; j < 4; ++j) ss += acc[m][n][j] * acc[m][n][j];
        ss += __shfl_xor(ss, 16); ss += __shfl_xor(ss, 32);
        const float rs = rsqrtf(ss * (1.f / 64.f) + 1e-6f);
        f32x4 v[4];
#pragma unroll
        for (int n = 0; n < 4; ++n) {
          f32x4 w4 = *(const f32x4*)(nw + n * 16 + fq * 4);
#pragma unroll
          for (int j = 0; j < 4; ++j) v[n][j] = acc[m][n][j] * rs * w4[j];
        }
        if (latent) {
          const int pos = row & (SEQ - 1);
#pragma unroll
          for (int n = 0; n < 2; ++n) {
            f32x4 c4 = *(const f32x4*)(p.ropec + pos * 32 + n * 16 + fq * 4), s4 = *(const f32x4*)(p.ropes + pos * 32 + n * 16 + fq * 4);
#pragma unroll
            for (int j = 0; j < 4; ++j) {
              float t1 = v[n][j], t2 = v[n + 2][j];
              v[n][j] = t1 * c4[j] - t2 * s4[j];
              v[n + 2][j] = t1 * s4[j] + t2 * c4[j];
            }
          }
        }
        store_slab_bf16(v, p.proj + (size_t)(mt * 128 + wr * 64 + m * 16) * 4096 + nt * 128 + wc * 64, 4096, wid, lane);
      }
    }
  }
}

__device__ __forceinline__ void phase_merge(const Params& p, int layer, int nrows) {
  GEMM_IDS
  const int mtiles = nrows / 128;
  for (int t = bidx(); t < mtiles * 8; t += gridDim.x) {
    int mt, nt; tile_map_m(t, mtiles, mt, nt);
    f32x4 mixa[4][4]; zero_acc(mixa);
    for (int r = 0; r < 3; ++r) {
      f32x4 acc[4][4]; zero_acc(acc);
      gemm_kloop<false>(acc, p.br + r * 512, 1536, p.wt_br + ((size_t)layer * 3 + r) * DM * 512, 512, 512, mt * 128, nt * 128);
#if DIAG_HP
#pragma unroll
      for (int m = 0; m < 4; ++m)
#pragma unroll
        for (int n = 0; n < 4; ++n) {
          int row = mt * 128 + wr * 64 + m * 16 + fr, col = nt * 128 + wc * 64 + n * 16 + fq * 4;
          u32x2 g = *(const u32x2*)(p.gp + (size_t)row * 3072 + r * 1024 + col);
          mixa[m][n][0] += sigmoidf_(__uint_as_float(g.x << 16)) * acc[m][n][0];
          mixa[m][n][1] += sigmoidf_(__uint_as_float(g.x & 0xffff0000u)) * acc[m][n][1];
          mixa[m][n][2] += sigmoidf_(__uint_as_float(g.y << 16)) * acc[m][n][2];
          mixa[m][n][3] += sigmoidf_(__uint_as_float(g.y & 0xffff0000u)) * acc[m][n][3];
        }
#else
#pragma unroll
      for (int m = 0; m < 4; ++m) {
        unsigned g[4];
        load_slab_gate8(g, p.gp8 + (size_t)(mt * 128 + wr * 64 + m * 16) * 3072 + r * 1024 + nt * 128 + wc * 64, wid, lane);
#pragma unroll
        for (int n = 0; n < 4; ++n) {
          mixa[m][n][0] += ub0(g[n]) * (1.f / 255.f) * acc[m][n][0];
          mixa[m][n][1] += ub1(g[n]) * (1.f / 255.f) * acc[m][n][1];
          mixa[m][n][2] += ub2(g[n]) * (1.f / 255.f) * acc[m][n][2];
          mixa[m][n][3] += ub3(g[n]) * (1.f / 255.f) * acc[m][n][3];
        }
      }
#endif
    }
#pragma unroll
    for (int m = 0; m < 4; ++m) store_slab_bf16(mixa[m], p.mix + (size_t)(mt * 128 + wr * 64 + m * 16) * DM + nt * 128 + wc * 64, DM, wid, lane);
  }
}

__device__ __forceinline__ void phase_outproj(const Params& p, int layer, int nrows, float oscale, int from_input) {
  GEMM_IDS
  const int mtiles = nrows / 128;
  for (int t = bidx(); t < mtiles * 8; t += gridDim.x) {
    int mt, nt; tile_map_m(t, mtiles, mt, nt);
    f32x4 acc[4][4]; zero_acc(acc);
    gemm_kloop(acc, p.mix, DM, p.wt_out + (size_t)layer * DM * DM, DM, DM, mt * 128, nt * 128);
#pragma unroll
    for (int m = 0; m < 4; ++m)
#pragma unroll
      for (int n = 0; n < 4; ++n) {
        int row = mt * 128 + wr * 64 + m * 16 + fr, col = nt * 128 + wc * 64 + n * 16 + fq * 4;
        float* xr = xrow(p, row) + col;
        f32x4 g1 = *(const f32x4*)(p.mod + (size_t)(layer * 3 + modrow(row)) * 6144 + 2 * DM + col);
        g1 = g1 * oscale;
        f32x4 xv = *(const f32x4*)(xrow_src(p, row, from_input) + col);
        xv[0] += g1[0] * acc[m][n][0]; xv[1] += g1[1] * acc[m][n][1]; xv[2] += g1[2] * acc[m][n][2]; xv[3] += g1[3] * acc[m][n][3];
        *(f32x4*)xr = xv;
      }
  }
}

__device__ __forceinline__ void phase_wq(const Params& p, int layer, int nrows) {
  GEMM_IDS
  const int mtiles = nrows / 128;
  for (int t = bidx(); t < mtiles * 16; t += gridDim.x) {
    int mt, nt; { const int idx = (t & 7) * (mtiles * 2) + (t >> 3); mt = idx >> 4; nt = idx & 15; }
    f32x4 acc[4][4]; zero_acc(acc);
    gemm_kloop(acc, p.h, DM, p.wt_q + (size_t)layer * 2048 * DM, DM, DM, mt * 128, nt * 128);
#if DIAG_HP
    gemm_kloop(acc, p.h, DM, p.wt_q_lo + (size_t)layer * 2048 * DM, DM, DM, mt * 128, nt * 128);
    gemm_kloop(acc, p.h2lo, DM, p.wt_q + (size_t)layer * 2048 * DM, DM, DM, mt * 128, nt * 128);
#endif
#if DIAG_HP
#pragma unroll
    for (int m = 0; m < 4; ++m)
#pragma unroll
      for (int n = 0; n < 4; ++n) {
        int row = mt * 128 + wr * 64 + m * 16 + fr, col = nt * 128 + wc * 64 + n * 16 + fq * 4;
        *(f32x4*)(p.qf + (size_t)row * 2048 + col) = acc[m][n];
      }
#else
#pragma unroll
    for (int m = 0; m < 4; ++m) store_slab_bf16(acc[m], p.q + (size_t)(mt * 128 + wr * 64 + m * 16) * 2048 + nt * 128 + wc * 64, 2048, wid, lane);
#endif
  }
}

__device__ __forceinline__ void phase_vtrans(const Params& p) {
  bf16_t* tile = (bf16_t*)smem;
  const int tid = tidx();
  for (int item = bidx(); item < 528; item += gridDim.x) {
    int b = item / 264, r = item % 264, kvh = r / 132, kt = r % 132;
    int krow0 = kt < 128 ? b * SEQ + kt * 64 : NLAT + b * CTXL + (kt - 128) * 64;
    __syncthreads();
    {
      int kr = tid >> 2, c0 = (tid & 3) * 16;
      const bf16_t* vp = p.proj + (size_t)(krow0 + kr) * 4096 + 640 + kvh * 64 + c0;
      u32x4 w0 = *(const u32x4*)vp, w1 = *(const u32x4*)(vp + 8);
      unsigned* tp = (unsigned*)(tile + kr * 66 + c0);
#pragma unroll
      for (int e = 0; e < 4; ++e) { tp[e] = w0[e]; tp[4 + e] = w1[e]; }
    }
    __syncthreads();
    {
      int d = tid >> 2, k0 = (tid & 3) * 16;
      bf16_t* op = p.vt + ((size_t)(b * 2 + kvh) * 64 + d) * 8448 + kt * 64 + k0;
      u32x4 o0, o1;
#pragma unroll
      for (int e = 0; e < 4; ++e) {
        const int ka = e < 2 ? 2 * e : 8 + 2 * (e - 2);
        const int kb2 = e < 2 ? 4 + 2 * e : 12 + 2 * (e - 2);
        o0[e] = (unsigned)tile[(k0 + ka) * 66 + d] | ((unsigned)tile[(k0 + ka + 1) * 66 + d] << 16);
        o1[e] = (unsigned)tile[(k0 + kb2) * 66 + d] | ((unsigned)tile[(k0 + kb2 + 1) * 66 + d] << 16);
      }
      *(u32x4*)op = o0; *(u32x4*)(op + 8) = o1;
    }
  }
}

#define ATT_KSTR 144
#define ATT_VSTR 272
#define ATT_VOFF 18432
#define ATT_BUF 35840
__device__ __forceinline__ void attn_item(const Params& p, int layer, int item) {
  const int tid = tidx(), wid = tid >> 6, lane = tid & 63, l31 = lane & 31, hh = lane >> 5;
  int b, kvh, tok0, kt0, nkt;
  if (item < 1024) { b = item >> 9; kvh = (item >> 8) & 1; tok0 = b * SEQ + (item & 255) * 32; kt0 = 0; nkt = 66; }
  else { int r = item - 1024; b = r >> 4; kvh = (r >> 3) & 1; tok0 = NLAT + b * CTXL + (r & 7) * 32; kt0 = 64; nkt = 2; }
  const int head = kvh * 4 + wid;
  bf16x8 qf[4];
#pragma unroll
  for (int ks = 0; ks < 4; ++ks)
    qf[ks] = *(const bf16x8*)(p.proj + (size_t)(tok0 + l31) * 4096 + head * 64 + ks * 16 + hh * 8);
  f32x16 o[2];
#pragma unroll
  for (int db = 0; db < 2; ++db)
#pragma unroll
    for (int r = 0; r < 16; ++r) o[db][r] = 0.f;
  float mrun = -1e30f, lrun = 0.f;
  const float cs = 0.125f * 1.44269504088896f * ATT_TAU;
  const bf16_t* vtb = p.vt + (size_t)(b * 2 + kvh) * 64 * 8448;
  u32x4 kreg[4], vreg[4];
  auto gload = [&](int kt) {
    int krow0 = kt < 64 ? b * SEQ + kt * 128 : NLAT + b * CTXL + (kt - 64) * 128;
    int ko = kt * 128; asm volatile("" : "+s"(ko));
#pragma unroll
    for (int i = 0; i < 4; ++i) {
      int id = tid + 256 * i;
      kreg[i] = *(const u32x4*)(p.proj + (size_t)(krow0 + (id >> 3)) * 4096 + 512 + kvh * 64 + (id & 7) * 8);
      vreg[i] = *(const u32x4*)(vtb + (size_t)(id >> 4) * 8448 + ko + (id & 15) * 8);
    }
  };
  auto lstore = [&](int buf) {
    char* base = smem + buf * ATT_BUF;
#pragma unroll
    for (int i = 0; i < 4; ++i) {
      int id = tid + 256 * i;
      *(u32x4*)(base + (id >> 3) * ATT_KSTR + (id & 7) * 16) = kreg[i];
      *(u32x4*)(base + ATT_VOFF + (id >> 4) * ATT_VSTR + (id & 15) * 16) = vreg[i];
    }
  };
  auto compute = [&](int buf, int sub) {
    const char* Kb = smem + buf * ATT_BUF + sub * 64 * ATT_KSTR;
    const char* Vb = smem + buf * ATT_BUF + ATT_VOFF + sub * 128;
    f32x16 s[2];
#pragma unroll
    for (int kb = 0; kb < 2; ++kb) {
#pragma unroll
      for (int r = 0; r < 16; ++r) s[kb][r] = 0.f;
#pragma unroll
      for (int ks = 0; ks < 4; ++ks) {
        bf16x8 kf = *(const bf16x8*)(Kb + (kb * 32 + l31) * ATT_KSTR + (ks * 16 + hh * 8) * 2);
        s[kb] = __builtin_amdgcn_mfma_f32_32x32x16_bf16(kf, qf[ks], s[kb], 0, 0, 0);
      }
    }
    bf16x8 pf[4];
    float mx = s[0][0];
#pragma unroll
    for (int r = 1; r < 16; ++r) mx = fmaxf(mx, s[0][r]);
#pragma unroll
    for (int r = 0; r < 16; ++r) mx = fmaxf(mx, s[1][r]);
    mx = fmaxf(mx, __shfl_xor(mx, 32));
    const float mnew = fmaxf(mrun, mx * cs);
    const float alpha = __builtin_amdgcn_exp2f(mrun - mnew);
    const bool grew = mnew > mrun;
    mrun = mnew;
    float ls = 0.f;
#pragma unroll
    for (int kb = 0; kb < 2; ++kb) {
      float pv[16];
#pragma unroll
      for (int r = 0; r < 16; ++r) { pv[r] = __builtin_amdgcn_exp2f(s[kb][r] * cs - mnew); ls += pv[r]; }
#pragma unroll
      for (int sp = 0; sp < 2; ++sp) {
        u32x4 w;
#pragma unroll
        for (int e = 0; e < 4; ++e) w[e] = pack2(pv[8 * sp + 2 * e], pv[8 * sp + 2 * e + 1]);
        pf[kb * 2 + sp] = *(bf16x8*)&w;
      }
    }
    lrun = lrun * alpha + ls;
    if (__any(grew)) {
#pragma unroll
      for (int db = 0; db < 2; ++db)
#pragma unroll
        for (int r = 0; r < 16; ++r) o[db][r] *= alpha;
    }
#pragma unroll
    for (int sp = 0; sp < 4; ++sp) {
#pragma unroll
      for (int db = 0; db < 2; ++db) {
        bf16x8 vf = *(const bf16x8*)(Vb + (db * 32 + l31) * ATT_VSTR + (16 * sp + 8 * hh) * 2);
        o[db] = __builtin_amdgcn_mfma_f32_32x32x16_bf16(vf, pf[sp], o[db], 0, 0, 0);
      }
    }
  };
  float mfix;
  {
    float aq = fabsf(p.att_qnorm[layer * 64 + lane]), ak = fabsf(p.att_knorm[layer * 64 + lane]);
    aq = wave_max(aq); ak = wave_max(ak);
    mfix = 8.f * aq * ak * 1.02f * 1.44269504088896f * ATT_TAU;
  }
  const bool fast = mfix <= 40.f;
  if (fast) {
#pragma unroll
    for (int ks = 0; ks < 4; ++ks) {
      u32x4 w = *(u32x4*)&qf[ks];
#pragma unroll
      for (int e = 0; e < 4; ++e) w[e] = pack2(__uint_as_float(w[e] << 16) * cs, __uint_as_float(w[e] & 0xffff0000u) * cs);
      qf[ks] = *(bf16x8*)&w;
    }
  }
  auto compute_fast = [&](int buf, int sub) {
    const char* Kb = smem + buf * ATT_BUF + sub * 64 * ATT_KSTR;
    const char* Vb = smem + buf * ATT_BUF + ATT_VOFF + sub * 128;
    bf16x8 kf[8], vf[8];
#pragma unroll
    for (int kb = 0; kb < 2; ++kb)
#pragma unroll
      for (int ks = 0; ks < 4; ++ks) kf[kb * 4 + ks] = *(const bf16x8*)(Kb + (kb * 32 + l31) * ATT_KSTR + (ks * 16 + hh * 8) * 2);
#pragma unroll
    for (int sp = 0; sp < 4; ++sp)
#pragma unroll
      for (int db = 0; db < 2; ++db) vf[sp * 2 + db] = *(const bf16x8*)(Vb + (db * 32 + l31) * ATT_VSTR + (16 * sp + 8 * hh) * 2);
    f32x16 s[2];
#pragma unroll
    for (int kb = 0; kb < 2; ++kb) {
#pragma unroll
      for (int r = 0; r < 16; ++r) s[kb][r] = 0.f;
#pragma unroll
      for (int ks = 0; ks < 4; ++ks) s[kb] = __builtin_amdgcn_mfma_f32_32x32x16_bf16(kf[kb * 4 + ks], qf[ks], s[kb], 0, 0, 0);
    }
    bf16x8 pf[4];
    float ls = 0.f;
#pragma unroll
    for (int kb = 0; kb < 2; ++kb) {
      float pv[16];
#pragma unroll
      for (int r = 0; r < 16; ++r) { pv[r] = __builtin_amdgcn_exp2f(s[kb][r]); ls += pv[r]; }
#pragma unroll
      for (int sp = 0; sp < 2; ++sp) {
        u32x4 w;
#pragma unroll
        for (int e = 0; e < 4; ++e) w[e] = pack2(pv[8 * sp + 2 * e], pv[8 * sp + 2 * e + 1]);
        pf[kb * 2 + sp] = *(bf16x8*)&w;
      }
    }
    lrun += ls;
#pragma unroll
    for (int sp = 0; sp < 4; ++sp)
#pragma unroll
      for (int db = 0; db < 2; ++db) o[db] = __builtin_amdgcn_mfma_f32_32x32x16_bf16(vf[sp * 2 + db], pf[sp], o[db], 0, 0, 0);
  };
  __syncthreads();
  gload(kt0);
  lstore(0);
  __syncthreads();
  if (fast) {
    for (int t = 0; t < nkt; ++t) {
      const int buf = t & 1;
      if (t + 1 < nkt) gload(kt0 + t + 1);
      compute_fast(buf, 0);
      compute_fast(buf, 1);
      if (t + 1 < nkt) lstore(buf ^ 1);
      __syncthreads();
    }
  } else {
    for (int t = 0; t < nkt; ++t) {
      const int buf = t & 1;
      if (t + 1 < nkt) gload(kt0 + t + 1);
      compute(buf, 0);
      compute(buf, 1);
      if (t + 1 < nkt) lstore(buf ^ 1);
      __syncthreads();
    }
  }
  {
    float l = lrun + __shfl_xor(lrun, 32);
    float il = ATT_ALPHA / l;
    bf16_t* op = p.br + (size_t)(tok0 + l31) * 1536 + head * 64;
#pragma unroll
    for (int db = 0; db < 2; ++db)
#pragma unroll
      for (int g = 0; g < 4; ++g) {
        u32x2 w; w.x = pack2(o[db][4 * g] * il, o[db][4 * g + 1] * il); w.y = pack2(o[db][4 * g + 2] * il, o[db][4 * g + 3] * il);
        *(u32x2*)(op + db * 32 + 8 * g + 4 * hh) = w;
      }
  }
}

__device__ __forceinline__ void attn_item64(const Params& p, int layer, int item) {
  const int tid = tidx(), wid = tid >> 6, lane = tid & 63, l31 = lane & 31, hh = lane >> 5;
  int b, kvh, tok0, kt0, nkt;
  if (item < 512) { b = item >> 8; kvh = (item >> 7) & 1; tok0 = b * SEQ + (item & 127) * 64; kt0 = 0; nkt = 132; }
  else { int r = item - 512; b = r >> 3; kvh = (r >> 2) & 1; tok0 = NLAT + b * CTXL + (r & 3) * 64; kt0 = 128; nkt = 4; }
  const int head = kvh * 4 + wid;
  const float cs = 0.125f * 1.44269504088896f * ATT_TAU;
  bf16x8 qf[2][4];
#pragma unroll
  for (int qb = 0; qb < 2; ++qb)
#pragma unroll
    for (int ks = 0; ks < 4; ++ks) {
      u32x4 w = *(const u32x4*)(p.proj + (size_t)(tok0 + qb * 32 + l31) * 4096 + head * 64 + ks * 16 + hh * 8);
#pragma unroll
      for (int e = 0; e < 4; ++e) w[e] = pack2(__uint_as_float(w[e] << 16) * cs, __uint_as_float(w[e] & 0xffff0000u) * cs);
      qf[qb][ks] = *(bf16x8*)&w;
    }
  f32x16 o[2][2];
#pragma unroll
  for (int qb = 0; qb < 2; ++qb)
#pragma unroll
    for (int db = 0; db < 2; ++db)
#pragma unroll
      for (int r = 0; r < 16; ++r) o[qb][db][r] = 0.f;
  float lrun[2] = {0.f, 0.f};
  const bf16_t* vtb = p.vt + (size_t)(b * 2 + kvh) * 64 * 8448;
  auto stage = [&](int kt, int buf) {
    const int krow0 = kt < 128 ? b * SEQ + kt * 64 : NLAT + b * CTXL + (kt - 128) * 64;
    int ko = kt * 64; asm volatile("" : "+s"(ko));
    char* base = smem + buf * 16384;
#pragma unroll
    for (int i = 0; i < 2; ++i) {
      const int q = tid + 256 * i, r = q >> 3, c = (q & 7) ^ ((r >> 1) & 7);
      __builtin_amdgcn_global_load_lds((const unsigned*)(p.proj + (size_t)(krow0 + r) * 4096 + 512 + kvh * 64 + c * 8), (__attribute__((address_space(3))) unsigned*)(base + q * 16), 16, 0, 0);
      __builtin_amdgcn_global_load_lds((const unsigned*)(vtb + (size_t)r * 8448 + ko + c * 8), (__attribute__((address_space(3))) unsigned*)(base + 8192 + q * 16), 16, 0, 0);
    }
  };
  auto compute = [&](int buf) {
    const char* Kb = smem + buf * 16384;
    const char* Vb = Kb + 8192;
    bf16x8 pf[2][4];
#pragma unroll
    for (int kb = 0; kb < 2; ++kb) {
      bf16x8 kf[4];
      const int row = kb * 32 + l31;
#pragma unroll
      for (int ks = 0; ks < 4; ++ks) kf[ks] = *(const bf16x8*)(Kb + row * 128 + (((ks * 2 + hh) ^ ((row >> 1) & 7)) << 4));
      f32x16 s[2];
#pragma unroll
      for (int qb = 0; qb < 2; ++qb) {
#pragma unroll
        for (int r = 0; r < 16; ++r) s[qb][r] = 0.f;
#pragma unroll
        for (int ks = 0; ks < 4; ++ks) s[qb] = __builtin_amdgcn_mfma_f32_32x32x16_bf16(kf[ks], qf[qb][ks], s[qb], 0, 0, 0);
      }
#pragma unroll
      for (int qb = 0; qb < 2; ++qb) {
        float pv[16]; float ls = 0.f;
#pragma unroll
        for (int r = 0; r < 16; ++r) { pv[r] = __builtin_amdgcn_exp2f(s[qb][r]); ls += pv[r]; }
        lrun[qb] += ls;
#pragma unroll
        for (int sp = 0; sp < 2; ++sp) {
          u32x4 w;
#pragma unroll
          for (int e = 0; e < 4; ++e) w[e] = pack2(pv[8 * sp + 2 * e], pv[8 * sp + 2 * e + 1]);
          pf[qb][kb * 2 + sp] = *(bf16x8*)&w;
        }
      }
    }
#pragma unroll
    for (int sp = 0; sp < 4; ++sp)
#pragma unroll
      for (int db = 0; db < 2; ++db) {
        const int row = db * 32 + l31;
        bf16x8 vf = *(const bf16x8*)(Vb + row * 128 + (((sp * 2 + hh) ^ ((row >> 1) & 7)) << 4));
        o[0][db] = __builtin_amdgcn_mfma_f32_32x32x16_bf16(vf, pf[0][sp], o[0][db], 0, 0, 0);
        o[1][db] = __builtin_amdgcn_mfma_f32_32x32x16_bf16(vf, pf[1][sp], o[1][db], 0, 0, 0);
      }
  };
  __syncthreads();
  stage(kt0, 0);
  asm volatile("s_waitcnt vmcnt(0)" ::: "memory");
  __syncthreads();
  for (int t = 0; t < nkt; ++t) {
    if (t + 1 < nkt) stage(kt0 + t + 1, (t + 1) & 1);
    compute(t & 1);
    asm volatile("s_waitcnt vmcnt(0)" ::: "memory");
    __syncthreads();
  }
#pragma unroll
  for (int qb = 0; qb < 2; ++qb) {
    float l = lrun[qb] + __shfl_xor(lrun[qb], 32);
    float il = ATT_ALPHA / l;
    bf16_t* op = p.br + (size_t)(tok0 + qb * 32 + l31) * 1536 + head * 64;
#pragma unroll
    for (int db = 0; db < 2; ++db)
#pragma unroll
      for (int g = 0; g < 4; ++g) {
        u32x2 w; w.x = pack2(o[qb][db][4 * g] * il, o[qb][db][4 * g + 1] * il); w.y = pack2(o[qb][db][4 * g + 2] * il, o[qb][db][4 * g + 3] * il);
        *(u32x2*)(op + db * 32 + 8 * g + 4 * hh) = w;
      }
  }
}
__device__ __forceinline__ float attn_logit_bound(const Params& p, int layer) {
  const int lane = tidx() & 63;
  float aq = fabsf(p.att_qnorm[layer * 64 + lane]), ak = fabsf(p.att_knorm[layer * 64 + lane]);
  aq = wave_max(aq); ak = wave_max(ak);
  return 8.f * aq * ak * 1.02f * 1.44269504088896f * ATT_TAU;
}

__device__ __forceinline__ void phase_ssdprep(const Params& p, int layer) {
  const float* cw = p.ssd_conv_w + (size_t)layer * 5 * 768;
  const float* cb = p.ssd_conv_b + layer * 768;
  const int total = (MROWS / 16) * 96;
  for (int i = bidx() * NTHR + tidx(); i < total; i += gridDim.x * NTHR) {
    const int run = i / 96, c0 = (i - run * 96) * 8;
    const int row0 = run * 16;
    int t0, T;
    if (row0 < NLAT) { t0 = row0 & (SEQ - 1); T = SEQ; } else { t0 = (row0 - NLAT) & (CTXL - 1); T = CTXL; }
    float w[5][8], bias[8];
#pragma unroll
    for (int j = 0; j < 5; ++j) {
      f32x4 w0 = *(const f32x4*)(cw + j * 768 + c0), w1 = *(const f32x4*)(cw + j * 768 + c0 + 4);
#pragma unroll
      for (int e = 0; e < 4; ++e) { w[j][e] = w0[e]; w[j][4 + e] = w1[e]; }
    }
    {
      f32x4 b0 = *(const f32x4*)(cb + c0), b1 = *(const f32x4*)(cb + c0 + 4);
#pragma unroll
      for (int e = 0; e < 4; ++e) { bias[e] = b0[e]; bias[4 + e] = b1[e]; }
    }
    const bf16_t* src = p.proj + (size_t)row0 * 4096 + 1280 + c0;
    u32x4 win[5];
    const u32x4 zero4 = {0u, 0u, 0u, 0u};
    win[0] = zero4;
    win[1] = t0 >= 2 ? *(const u32x4*)(src - 2 * 4096) : zero4;
    win[2] = t0 >= 1 ? *(const u32x4*)(src - 1 * 4096) : zero4;
    win[3] = *(const u32x4*)(src);
    win[4] = *(const u32x4*)(src + 4096);
#pragma unroll
    for (int r = 0; r < 16; ++r) {
      win[0] = win[1]; win[1] = win[2]; win[2] = win[3]; win[3] = win[4];
      win[4] = (t0 + r + 2 < T) ? *(const u32x4*)(src + (size_t)(r + 2) * 4096) : zero4;
      float a[8];
#pragma unroll
      for (int e = 0; e < 8; ++e) a[e] = bias[e];
#pragma unroll
      for (int j = 0; j < 5; ++j)
#pragma unroll
        for (int e = 0; e < 4; ++e) {
          a[2 * e] += w[j][2 * e] * __uint_as_float(win[j][e] << 16);
          a[2 * e + 1] += w[j][2 * e + 1] * __uint_as_float(win[j][e] & 0xffff0000u);
        }
      u32x4 o;
#pragma unroll
      for (int e = 0; e < 4; ++e) o[e] = pack2(siluf_(a[2 * e]), siluf_(a[2 * e + 1]));
      *(u32x4*)(p.xbc + (size_t)(row0 + r) * 768 + c0) = o;
    }
  }
  const int total2 = MROWS * 16;
  for (int i = bidx() * NTHR + tidx(); i < total2; i += gridDim.x * NTHR) {
    int row = i >> 4, j = i & 15;
    p.dtb[i] = softplusf_(p.small[(size_t)row * 32 + j] + p.ssd_dt_bias[layer * 16 + j]);
  }
}

__device__ __forceinline__ int chunk_row0(int b, int c) { return c < 64 ? b * SEQ + c * 128 : NLAT + b * CTXL + (c - 64) * 128; }
__device__ __forceinline__ float wave_incl_scan(float v, int lane) {
#pragma unroll
  for (int o = 1; o < 64; o <<= 1) { float t = __shfl_up(v, o); if (lane >= o) v += t; }
  return v;
}
__device__ __forceinline__ void ssd_scans(const Params& p, int layer, int row0, int h, float* fl) {
  const int tid = tidx(), lane = tid & 63, wv = tid >> 6;
  const bool fwd = tid < 128;
  const int s = fwd ? tid : 127 - (tid - 128);
  const float A = -__expf(p.ssd_a_log[layer * 16 + (fwd ? 0 : 8) + h]);
  const float dt = p.dtb[(size_t)(row0 + s) * 16 + (fwd ? 0 : 8) + h];
  float v = wave_incl_scan(dt * A, lane);
  if (lane == 63) fl[512 + wv] = v;
  __syncthreads();
  if (wv & 1) v += fl[512 + wv - 1];
  fl[(fwd ? 0 : 128) + s] = v;
  fl[(fwd ? 256 : 384) + s] = dt;
  __syncthreads();
}

#define SSD_TSTR 272
__device__ __forceinline__ void ssdA_item(const Params& p, int layer, int item) {
  const int tid = tidx(), wid = tid >> 6, lane = tid & 63, l31 = lane & 31, hh = lane >> 5;
  const int b = item / 528, c = (item / 8) % 66, h = item & 7, g = h >> 2;
  const int row0 = chunk_row0(b, c);
  float* fl = (float*)smem;
  char* BT = smem + 4096;
  char* XF = BT + 64 * SSD_TSTR;
  char* XB = XF + 64 * SSD_TSTR;
  __syncthreads();
  ssd_scans(p, layer, row0, h, fl);
  const float cfl = fl[127], cbl = fl[128];
  {
    const int s = tid >> 1, half = tid & 1;
    const float wf = __expf(cfl - fl[s]) * fl[256 + s], wb = __expf(cbl - fl[128 + s]) * fl[384 + s];
    const bf16_t* xr = p.xbc + (size_t)(row0 + s) * 768;
#pragma unroll
    for (int i = 0; i < 4; ++i) {
      u32x4 xv = *(const u32x4*)(xr + h * 64 + half * 32 + i * 8);
      u32x4 bv = *(const u32x4*)(xr + 512 + g * 64 + half * 32 + i * 8);
#pragma unroll
      for (int e = 0; e < 4; ++e) {
        int pp = half * 32 + i * 8 + 2 * e;
        float x0 = __uint_as_float(xv[e] << 16), x1 = __uint_as_float(xv[e] & 0xffff0000u);
        *(bf16_t*)(XF + pp * SSD_TSTR + s * 2) = f2bf(x0 * wf);
        *(bf16_t*)(XF + (pp + 1) * SSD_TSTR + s * 2) = f2bf(x1 * wf);
        *(bf16_t*)(XB + pp * SSD_TSTR + s * 2) = f2bf(x0 * wb);
        *(bf16_t*)(XB + (pp + 1) * SSD_TSTR + s * 2) = f2bf(x1 * wb);
        *(bf16_t*)(BT + pp * SSD_TSTR + s * 2) = (bf16_t)(bv[e] & 0xffffu);
        *(bf16_t*)(BT + (pp + 1) * SSD_TSTR + s * 2) = (bf16_t)(bv[e] >> 16);
      }
    }
  }
  __syncthreads();
  const int nb = wid >> 1, pb = wid & 1;
#pragma unroll
  for (int dir = 0; dir < 2; ++dir) {
    const char* XT = dir == 0 ? XF : XB;
    f32x16 acc;
#pragma unroll
    for (int r = 0; r < 16; ++r) acc[r] = 0.f;
#pragma unroll
    for (int ks = 0; ks < 8; ++ks) {
      bf16x8 a = *(const bf16x8*)(BT + (nb * 32 + l31) * SSD_TSTR + (ks * 16 + hh * 8) * 2);
      bf16x8 bb = *(const bf16x8*)(XT + (pb * 32 + l31) * SSD_TSTR + (ks * 16 + hh * 8) * 2);
      acc = __builtin_amdgcn_mfma_f32_32x32x16_bf16(a, bb, acc, 0, 0, 0);
    }
    bf16_t* dst = p.ssl + ((size_t)(((dir * 2 + b) * 8 + h) * 66 + c) * 64 + pb * 32 + l31) * 64 + nb * 32 + 4 * hh;
#pragma unroll
    for (int q4 = 0; q4 < 4; ++q4) {
      u32x2 w; w.x = pack2(acc[4 * q4], acc[4 * q4 + 1]); w.y = pack2(acc[4 * q4 + 2], acc[4 * q4 + 3]);
      *(u32x2*)(dst + 8 * q4) = w;
    }
  }
  if (tid == 0) {
    p.sdec[((0 * 2 + b) * 8 + h) * 66 + c] = __expf(cfl);
    p.sdec[((1 * 2 + b) * 8 + h) * 66 + c] = __expf(cbl);
  }
}

__device__ __forceinline__ void phase_ssdcarry(const Params& p) {
  const int total = 32 * 1024;
  for (int i = bidx() * NTHR + tidx(); i < total; i += gridDim.x * NTHR) {
    const int seq = i >> 10, el = (i & 1023) * 4;
    const int dir = seq >> 4;
    bf16_t* base = p.ssl + (size_t)seq * 66 * 4096 + el;
    const float* dec = p.sdec + seq * 66;
    float st[4] = {0.f, 0.f, 0.f, 0.f};
#pragma unroll 22
    for (int k = 0; k < 66; ++k) {
      int c = dir == 0 ? (k < 2 ? 64 + k : k - 2) : (65 - k);
      u32x2 v = *(const u32x2*)(base + (size_t)c * 4096);
      float d = dec[c];
      u32x2 w; w.x = pack2(st[0], st[1]); w.y = pack2(st[2], st[3]);
      *(u32x2*)(base + (size_t)c * 4096) = w;
      st[0] = d * st[0] + __uint_as_float(v.x << 16); st[1] = d * st[1] + __uint_as_float(v.x & 0xffff0000u);
      st[2] = d * st[2] + __uint_as_float(v.y << 16); st[3] = d * st[3] + __uint_as_float(v.y & 0xffff0000u);
    }
  }
}

__device__ __forceinline__ void ssdC_item(const Params& p, int layer, int item) {
  const int tid = tidx(), wid = tid >> 6, lane = tid & 63, l31 = lane & 31, hh = lane >> 5;
  const int b = item / 528, c = (item / 8) % 66, h = item & 7, g = h >> 2;
  const int row0 = chunk_row0(b, c);
  float* fl = (float*)smem;
  char* Bt = smem + 4096;
  char* XT = Bt + 128 * 144;
  __syncthreads();
  ssd_scans(p, layer, row0, h, fl);
  {
#pragma unroll
    for (int i = 0; i < 4; ++i) {
      int id = tid + 256 * i, r = id >> 3, c16 = id & 7;
      *(u32x4*)(Bt + r * 144 + c16 * 16) = *(const u32x4*)(p.xbc + (size_t)(row0 + r) * 768 + 512 + g * 64 + c16 * 8);
    }
    const int s = tid >> 1, half = tid & 1;
    const bf16_t* xr = p.xbc + (size_t)(row0 + s) * 768 + h * 64 + half * 32;
#pragma unroll
    for (int i = 0; i < 4; ++i) {
      u32x4 xv = *(const u32x4*)(xr + i * 8);
#pragma unroll
      for (int e = 0; e < 4; ++e) {
        int pp = half * 32 + i * 8 + 2 * e;
        *(bf16_t*)(XT + pp * SSD_TSTR + s * 2) = (bf16_t)(xv[e] & 0xffffu);
        *(bf16_t*)(XT + (pp + 1) * SSD_TSTR + s * 2) = (bf16_t)(xv[e] >> 16);
      }
    }
  }
  __syncthreads();
  const int s = wid * 32 + l31;
  const float cfs = fl[s], cbs = fl[128 + s];
  bf16x8 cf[4];
#pragma unroll
  for (int ks = 0; ks < 4; ++ks) cf[ks] = *(const bf16x8*)(p.xbc + (size_t)(row0 + s) * 768 + 640 + g * 64 + ks * 16 + hh * 8);
  f32x16 Y[2];
  {
    f32x16 aF[2], aB[2];
#pragma unroll
    for (int pb = 0; pb < 2; ++pb)
#pragma unroll
      for (int r = 0; r < 16; ++r) { aF[pb][r] = 0.f; aB[pb][r] = 0.f; }
    const bf16_t* spf = p.ssl + (size_t)(((0 * 2 + b) * 8 + h) * 66 + c) * 4096;
    const bf16_t* spb = p.ssl + (size_t)(((1 * 2 + b) * 8 + h) * 66 + c) * 4096;
#pragma unroll
    for (int pb = 0; pb < 2; ++pb)
#pragma unroll
      for (int ks = 0; ks < 4; ++ks) {
        bf16x8 a0 = *(const bf16x8*)(spf + (pb * 32 + l31) * 64 + ks * 16 + hh * 8);
        bf16x8 a1 = *(const bf16x8*)(spb + (pb * 32 + l31) * 64 + ks * 16 + hh * 8);
        aF[pb] = __builtin_amdgcn_mfma_f32_32x32x16_bf16(a0, cf[ks], aF[pb], 0, 0, 0);
        aB[pb] = __builtin_amdgcn_mfma_f32_32x32x16_bf16(a1, cf[ks], aB[pb], 0, 0, 0);
      }
    const float ef = __expf(cfs), eb = __expf(cbs);
#pragma unroll
    for (int pb = 0; pb < 2; ++pb)
#pragma unroll
      for (int r = 0; r < 16; ++r) Y[pb][r] = aF[pb][r] * ef + aB[pb][r] * eb;
  }
  for (int rb = 0; rb < 4; ++rb) {
    f32x16 gt;
#pragma unroll
    for (int r = 0; r < 16; ++r) gt[r] = 0.f;
#pragma unroll
    for (int ks = 0; ks < 4; ++ks) {
      bf16x8 a = *(const bf16x8*)(Bt + (rb * 32 + l31) * 144 + (ks * 16 + hh * 8) * 2);
      gt = __builtin_amdgcn_mfma_f32_32x32x16_bf16(a, cf[ks], gt, 0, 0, 0);
    }
#pragma unroll
    for (int dir = 0; dir < 2; ++dir) {
      if (dir == 0 ? (rb > wid) : (rb < wid)) continue;
      const float* cum = fl + (dir == 0 ? 0 : 128);
      const float* dta = fl + (dir == 0 ? 256 : 384);
      const float cs = dir == 0 ? cfs : cbs;
      float val[16];
#pragma unroll
      for (int q4 = 0; q4 < 4; ++q4) {
        int r0 = rb * 32 + 8 * q4 + 4 * hh;
        f32x4 cr = *(const f32x4*)(cum + r0), dr = *(const f32x4*)(dta + r0);
#pragma unroll
        for (int e = 0; e < 4; ++e) {
          int r = r0 + e;
          bool keep = dir == 0 ? (r <= s) : (r >= s);
          float arg = fminf(cs - cr[e], 0.f);
          val[4 * q4 + e] = keep ? gt[4 * q4 + e] * __expf(arg) * dr[e] : 0.f;
        }
      }
#pragma unroll
      for (int sp = 0; sp < 2; ++sp) {
        u32x4 w;
#pragma unroll
        for (int e = 0; e < 4; ++e) w[e] = pack2(val[8 * sp + 2 * e], val[8 * sp + 2 * e + 1]);
        bf16x8 pf = *(bf16x8*)&w;
#pragma unroll
        for (int pb = 0; pb < 2; ++pb) {
          const char* xa = XT + (pb * 32 + l31) * SSD_TSTR + (rb * 32 + 16 * sp + 4 * hh) * 2;
          u32x2 v0 = *(const u32x2*)xa, v1 = *(const u32x2*)(xa + 16);
          u32x4 vw = {v0[0], v0[1], v1[0], v1[1]};
          Y[pb] = __builtin_amdgcn_mfma_f32_32x32x16_bf16(*(bf16x8*)&vw, pf, Y[pb], 0, 0, 0);
        }
      }
    }
  }
  bf16_t* op = p.yf + (size_t)(row0 + s) * 512 + h * 64;
#pragma unroll
  for (int pb = 0; pb < 2; ++pb)
#pragma unroll
    for (int q4 = 0; q4 < 4; ++q4) {
      u32x2 w; w.x = pack2(Y[pb][4 * q4], Y[pb][4 * q4 + 1]); w.y = pack2(Y[pb][4 * q4 + 2], Y[pb][4 * q4 + 3]);
      *(u32x2*)(op + pb * 32 + 8 * q4 + 4 * hh) = w;
    }
}

__device__ __forceinline__ void phase_ssdout(const Params& p, int layer, int nrows) {
  const int lane = tidx() & 63, wv = tidx() >> 6;
  const float* ng = p.ssd_norm + layer * 512;
  for (int row = bidx() * 4 + wv; row < nrows; row += gridDim.x * 4) {
    int c0 = lane * 8; int h = c0 >> 6;
    float Dk = p.ssd_d[layer * 8 + h];
    u32x4 a = *(const u32x4*)(p.yf + (size_t)row * 512 + c0);
    u32x4 xs = *(const u32x4*)(p.xbc + (size_t)row * 768 + c0), z = *(const u32x4*)(p.proj + (size_t)row * 4096 + 768 + c0);
    float y[8]; float ss = 0.f;
#pragma unroll
    for (int e = 0; e < 4; ++e) {
      float y0 = __uint_as_float(a[e] << 16) + __uint_as_float(xs[e] << 16) * Dk;
      float y1 = __uint_as_float(a[e] & 0xffff0000u) + __uint_as_float(xs[e] & 0xffff0000u) * Dk;
      y0 *= siluf_(__uint_as_float(z[e] << 16)); y1 *= siluf_(__uint_as_float(z[e] & 0xffff0000u));
      y[2 * e] = y0; y[2 * e + 1] = y1; ss += y0 * y0 + y1 * y1;
    }
    ss = wave_sum(ss);
    float rs = rsqrtf(ss * (1.f / 512.f) + 1e-6f);
    u32x4 w;
#pragma unroll
    for (int e = 0; e < 4; ++e) w[e] = pack2(y[2 * e] * rs * ng[c0 + 2 * e], y[2 * e + 1] * rs * ng[c0 + 2 * e + 1]);
    *(u32x4*)(p.br + (size_t)row * 1536 + 512 + c0) = w;
  }
}

__device__ __forceinline__ float wave_incl_maxscan(float v, int lane) {
#pragma unroll
  for (int o = 1; o < 64; o <<= 1) { float t = __shfl_up(v, o); if (lane >= o) v = fmaxf(v, t); }
  return v;
}
__device__ __forceinline__ void ml_scans(const Params& p, int layer, int row0, int h, float* fl) {
  const int tid = tidx(), lane = tid & 63, wv = tid >> 6;
  const int dir = tid >> 7;
  const int s = dir == 0 ? tid : 127 - (tid - 128);
  const float ip = p.small[(size_t)(row0 + s) * 32 + 16 + dir * 8 + h] + p.ml_gate_bias[layer * 16 + dir * 8 + h];
  const float fp = p.small[(size_t)(row0 + s) * 32 + 16 + dir * 8 + 4 + h] + p.ml_gate_bias[layer * 16 + dir * 8 + 4 + h];
  float bc = wave_incl_scan(logsigmoidf_(fp), lane);
  if (lane == 63) fl[768 + wv] = bc;
  __syncthreads();
  if (wv & 1) bc += fl[768 + wv - 1];
  const float u = ip - bc;
  float pm = wave_incl_maxscan(u, lane);
  if (lane == 63) fl[776 + wv] = pm;
  __syncthreads();
  if (wv & 1) pm = fmaxf(pm, fl[776 + wv - 1]);
  fl[dir * 128 + s] = bc; fl[256 + dir * 128 + s] = u; fl[512 + dir * 128 + s] = pm;
  __syncthreads();
}

#define ML_TSTR 272
__device__ __forceinline__ void mlA_item(const Params& p, int layer, int item) {
  const int tid = tidx(), wid = tid >> 6, lane = tid & 63, l31 = lane & 31, hh = lane >> 5;
  const int b = item / 264, c = (item / 4) % 66, h = item & 3;
  const int row0 = chunk_row0(b, c);
  float* fl = (float*)smem;
  char* KT = smem + 8192;
  char* VW = KT + 128 * ML_TSTR;
  __syncthreads();
  ml_scans(p, layer, row0, h, fl);
  const int r_ = tid >> 1, half = tid & 1;
  {
    const bf16_t* kr = p.proj + (size_t)(row0 + r_) * 4096 + 2560 + h * 128 + half * 64;
#pragma unroll
    for (int i = 0; i < 8; ++i) {
      u32x4 kv = *(const u32x4*)(kr + i * 8);
#pragma unroll
      for (int e = 0; e < 4; ++e) {
        int ee = half * 64 + i * 8 + 2 * e;
        *(bf16_t*)(KT + ee * ML_TSTR + r_ * 2) = (bf16_t)(kv[e] & 0xffffu);
        *(bf16_t*)(KT + (ee + 1) * ML_TSTR + r_ * 2) = (bf16_t)(kv[e] >> 16);
      }
    }
  }
  for (int dir = 0; dir < 2; ++dir) {
    const int seq = (dir * 2 + b) * 4 + h;
    const float blast = fl[dir * 128 + (dir == 0 ? 127 : 0)];
    const float umax = fl[512 + dir * 128 + (dir == 0 ? 127 : 0)];
    {
      const float wgt = __expf(fl[256 + dir * 128 + r_] - umax) * 0.08838834764831845f;
      if (half == 0) fl[1024 + r_] = wgt;
      const bf16_t* vr = p.proj + (size_t)(row0 + r_) * 4096 + 3072 + h * 128 + half * 64;
#pragma unroll
      for (int i = 0; i < 8; ++i) {
        u32x4 vv = *(const u32x4*)(vr + i * 8);
#pragma unroll
        for (int e = 0; e < 4; ++e) {
          int dd = half * 64 + i * 8 + 2 * e;
          *(bf16_t*)(VW + dd * ML_TSTR + r_ * 2) = f2bf(__uint_as_float(vv[e] << 16) * wgt);
          *(bf16_t*)(VW + (dd + 1) * ML_TSTR + r_ * 2) = f2bf(__uint_as_float(vv[e] & 0xffff0000u) * wgt);
        }
      }
    }
    __syncthreads();
    {
      const int e_ = tid & 127, hf = tid >> 7;
      float a = 0.f;
#pragma unroll
      for (int i = 0; i < 8; ++i) {
        u32x4 kv = *(const u32x4*)(KT + e_ * ML_TSTR + (hf * 64 + i * 8) * 2);
        const float* wp = fl + 1024 + hf * 64 + i * 8;
#pragma unroll
        for (int e = 0; e < 4; ++e) a += __uint_as_float(kv[e] << 16) * wp[2 * e] + __uint_as_float(kv[e] & 0xffff0000u) * wp[2 * e + 1];
      }
      if (hf == 1) fl[1280 + e_] = a;
      __syncthreads();
      if (hf == 0) p.mnl[((size_t)seq * 66 + c) * 128 + e_] = a + fl[1280 + e_];
    }
    f32x16 acc[4];
#pragma unroll
    for (int eb = 0; eb < 4; ++eb)
#pragma unroll
      for (int r = 0; r < 16; ++r) acc[eb][r] = 0.f;
#pragma unroll
    for (int ks = 0; ks < 8; ++ks) {
      bf16x8 bv = *(const bf16x8*)(VW + (wid * 32 + l31) * ML_TSTR + (ks * 16 + hh * 8) * 2);
#pragma unroll
      for (int eb = 0; eb < 4; ++eb) {
        bf16x8 av = *(const bf16x8*)(KT + (eb * 32 + l31) * ML_TSTR + (ks * 16 + hh * 8) * 2);
        acc[eb] = __builtin_amdgcn_mfma_f32_32x32x16_bf16(av, bv, acc[eb], 0, 0, 0);
      }
    }
    bf16_t* dst = p.mcl + (((size_t)seq * 66 + c) * 128 + wid * 32 + l31) * 128 + 4 * hh;
#pragma unroll
    for (int eb = 0; eb < 4; ++eb)
#pragma unroll
      for (int q4 = 0; q4 < 4; ++q4) {
        u32x2 w; w.x = pack2(acc[eb][4 * q4], acc[eb][4 * q4 + 1]); w.y = pack2(acc[eb][4 * q4 + 2], acc[eb][4 * q4 + 3]);
        *(u32x2*)(dst + eb * 32 + 8 * q4) = w;
      }
    if (tid == 0) { p.mml[seq * 66 + c] = blast + umax; p.mbl[seq * 66 + c] = blast; }
    __syncthreads();
  }
}

__device__ __forceinline__ void phase_mlcarry(const Params& p) {
  const int per = 4096 + 32;
  const int total = 16 * per;
  for (int i = bidx() * NTHR + tidx(); i < total; i += gridDim.x * NTHR) {
    const int seq = i / per, j = i % per;
    const int dir = seq >> 3;
    const float* ml = p.mml + seq * 66; const float* bl = p.mbl + seq * 66;
    float m = 0.f;
    float st[4] = {0.f, 0.f, 0.f, 0.f};
    const bool isC = j < 4096;
    bf16_t* cb = p.mcl + (size_t)seq * 66 * 16384 + (isC ? j * 4 : 0);
    float* nb = p.mnl + (size_t)seq * 66 * 128 + (isC ? 0 : (j - 4096) * 4);
#pragma unroll 11
    for (int k = 0; k < 66; ++k) {
      int c = dir == 0 ? (k < 2 ? 64 + k : k - 2) : (65 - k);
      float mlc = ml[c], blc = bl[c];
      float mnew = fmaxf(blc + m, mlc);
      float ap = __expf(blc + m - mnew), al = __expf(mlc - mnew);
      if (isC) {
        u32x2 v = *(const u32x2*)(cb + (size_t)c * 16384);
        u32x2 w; w.x = pack2(st[0], st[1]); w.y = pack2(st[2], st[3]);
        *(u32x2*)(cb + (size_t)c * 16384) = w;
        st[0] = ap * st[0] + al * __uint_as_float(v.x << 16); st[1] = ap * st[1] + al * __uint_as_float(v.x & 0xffff0000u);
        st[2] = ap * st[2] + al * __uint_as_float(v.y << 16); st[3] = ap * st[3] + al * __uint_as_float(v.y & 0xffff0000u);
        if (j == 0) p.mmp[seq * 66 + c] = m;
      } else {
        f32x4 v = *(const f32x4*)(nb + (size_t)c * 128);
        f32x4 w = {st[0], st[1], st[2], st[3]};
        *(f32x4*)(nb + (size_t)c * 128) = w;
        st[0] = ap * st[0] + al * v[0]; st[1] = ap * st[1] + al * v[1]; st[2] = ap * st[2] + al * v[2]; st[3] = ap * st[3] + al * v[3];
      }
      m = mnew;
    }
  }
}

__device__ __forceinline__ void mlC_item(const Params& p, int layer, int item) {
  const int tid = tidx(), wid = tid >> 6, lane = tid & 63, l31 = lane & 31, hh = lane >> 5;
  const int b = item / 264, c = (item / 4) % 66, h = item & 3;
  const int row0 = chunk_row0(b, c);
  float* fl = (float*)smem;
  char* Kt = smem + 8192;
  char* VT = Kt + 128 * ML_TSTR;
  __syncthreads();
  ml_scans(p, layer, row0, h, fl);
  {
#pragma unroll
    for (int i = 0; i < 8; ++i) {
      int id = tid + 256 * i, r = id >> 4, c16 = id & 15;
      *(u32x4*)(Kt + r * ML_TSTR + c16 * 16) = *(const u32x4*)(p.proj + (size_t)(row0 + r) * 4096 + 2560 + h * 128 + c16 * 8);
    }
    const int r_ = tid >> 1, half = tid & 1;
    const bf16_t* vr = p.proj + (size_t)(row0 + r_) * 4096 + 3072 + h * 128 + half * 64;
#pragma unroll
    for (int i = 0; i < 8; ++i) {
      u32x4 vv = *(const u32x4*)(vr + i * 8);
#pragma unroll
      for (int e = 0; e < 4; ++e) {
        int dd = half * 64 + i * 8 + 2 * e;
        *(bf16_t*)(VT + dd * ML_TSTR + r_ * 2) = (bf16_t)(vv[e] & 0xffffu);
        *(bf16_t*)(VT + (dd + 1) * ML_TSTR + r_ * 2) = (bf16_t)(vv[e] >> 16);
      }
    }
    {
      const int dir = tid >> 7, e_ = tid & 127;
      const int seq = (dir * 2 + b) * 4 + h;
      fl[1024 + dir * 128 + e_] = p.mnl[((size_t)seq * 66 + c) * 128 + e_];
    }
  }
  __syncthreads();
  const int s = wid * 32 + l31;
  bf16x8 qf[8];
#pragma unroll
  for (int ks = 0; ks < 8; ++ks) qf[ks] = *(const bf16x8*)(p.proj + (size_t)(row0 + s) * 4096 + 2048 + h * 128 + ks * 16 + hh * 8);
  f32x16 hacc[4];
#pragma unroll
  for (int db = 0; db < 4; ++db)
#pragma unroll
    for (int r = 0; r < 16; ++r) hacc[db][r] = 0.f;
  for (int dir = 0; dir < 2; ++dir) {
    const int seq = (dir * 2 + b) * 4 + h;
    const float mprev = p.mmp[seq * 66 + c];
    const float bcs = fl[dir * 128 + s], pms = fl[512 + dir * 128 + s];
    const float msel = fmaxf(mprev, pms);
    const float ms = bcs + msel;
    const float winter = __expf(mprev - msel);
    const float* uu = fl + 256 + dir * 128;
    float qn = 0.f;
    {
      const float* np = fl + 1024 + dir * 128;
#pragma unroll
      for (int ks = 0; ks < 8; ++ks) {
        u32x4 w = *(u32x4*)&qf[ks];
        const float* npp = np + ks * 16 + hh * 8;
#pragma unroll
        for (int e = 0; e < 4; ++e) qn += __uint_as_float(w[e] << 16) * npp[2 * e] + __uint_as_float(w[e] & 0xffff0000u) * npp[2 * e + 1];
      }
      qn += __shfl_xor(qn, 32);
    }
    float den = 0.f;
    for (int rb = 0; rb < 4; ++rb) {
      if (dir == 0 ? (rb > wid) : (rb < wid)) continue;
      f32x16 st;
#pragma unroll
      for (int r = 0; r < 16; ++r) st[r] = 0.f;
#pragma unroll
      for (int ks = 0; ks < 8; ++ks) {
        bf16x8 a = *(const bf16x8*)(Kt + (rb * 32 + l31) * ML_TSTR + (ks * 16 + hh * 8) * 2);
        st = __builtin_amdgcn_mfma_f32_32x32x16_bf16(a, qf[ks], st, 0, 0, 0);
      }
#pragma unroll
      for (int q4 = 0; q4 < 4; ++q4) {
        int r0 = rb * 32 + 8 * q4 + 4 * hh;
        f32x4 ur = *(const f32x4*)(uu + r0);
#pragma unroll
        for (int e = 0; e < 4; ++e) {
          int r = r0 + e;
          bool keep = dir == 0 ? (r <= s) : (r >= s);
          float arg = fminf(ur[e] - msel, 0.f);
          den += keep ? st[4 * q4 + e] * 0.08838834764831845f * __expf(arg) : 0.f;
        }
      }
    }
    den += __shfl_xor(den, 32);
    den += winter * qn;
    const float inv = 1.f / fmaxf(fabsf(den), __expf(-ms));
    {
      const float qs = winter * inv;
      const bf16_t* cp = p.mcl + ((size_t)seq * 66 + c) * 16384;
#pragma unroll
      for (int ks = 0; ks < 8; ++ks) {
        u32x4 w = *(u32x4*)&qf[ks];
        u32x4 ws;
#pragma unroll
        for (int e = 0; e < 4; ++e) ws[e] = pack2(__uint_as_float(w[e] << 16) * qs, __uint_as_float(w[e] & 0xffff0000u) * qs);
        bf16x8 qsf = *(bf16x8*)&ws;
#pragma unroll
        for (int db = 0; db < 4; ++db) {
          bf16x8 a = *(const bf16x8*)(cp + (db * 32 + l31) * 128 + ks * 16 + hh * 8);
          hacc[db] = __builtin_amdgcn_mfma_f32_32x32x16_bf16(a, qsf, hacc[db], 0, 0, 0);
        }
      }
    }
    for (int rb = 0; rb < 4; ++rb) {
      if (dir == 0 ? (rb > wid) : (rb < wid)) continue;
      f32x16 st;
#pragma unroll
      for (int r = 0; r < 16; ++r) st[r] = 0.f;
#pragma unroll
      for (int ks = 0; ks < 8; ++ks) {
        bf16x8 a = *(const bf16x8*)(Kt + (rb * 32 + l31) * ML_TSTR + (ks * 16 + hh * 8) * 2);
        st = __builtin_amdgcn_mfma_f32_32x32x16_bf16(a, qf[ks], st, 0, 0, 0);
      }
      const float sc = 0.08838834764831845f * inv;
#pragma unroll
      for (int sp = 0; sp < 2; ++sp) {
        u32x4 w;
#pragma unroll
        for (int q2 = 0; q2 < 2; ++q2) {
          int q4 = 2 * sp + q2;
          int r0 = rb * 32 + 8 * q4 + 4 * hh;
          f32x4 ur = *(const f32x4*)(uu + r0);
          float v[4];
#pragma unroll
          for (int e = 0; e < 4; ++e) {
            int r = r0 + e;
            bool keep = dir == 0 ? (r <= s) : (r >= s);
            float arg = fminf(ur[e] - msel, 0.f);
            v[e] = keep ? st[4 * q4 + e] * sc * __expf(arg) : 0.f;
          }
          w[2 * q2] = pack2(v[0], v[1]); w[2 * q2 + 1] = pack2(v[2], v[3]);
        }
        bf16x8 pf = *(bf16x8*)&w;
#pragma unroll
        for (int db = 0; db < 4; ++db) {
          const char* va = VT + (db * 32 + l31) * ML_TSTR + (rb * 32 + 16 * sp + 4 * hh) * 2;
          u32x2 v0 = *(const u32x2*)va, v1 = *(const u32x2*)(va + 16);
          u32x4 vw = {v0[0], v0[1], v1[0], v1[1]};
          hacc[db] = __builtin_amdgcn_mfma_f32_32x32x16_bf16(*(bf16x8*)&vw, pf, hacc[db], 0, 0, 0);
        }
      }
    }
  }
  bf16_t* op = p.hf + (size_t)(row0 + s) * 512 + h * 128;
#pragma unroll
  for (int db = 0; db < 4; ++db)
#pragma unroll
    for (int q4 = 0; q4 < 4; ++q4) {
      u32x2 w; w.x = pack2(hacc[db][4 * q4], hacc[db][4 * q4 + 1]); w.y = pack2(hacc[db][4 * q4 + 2], hacc[db][4 * q4 + 3]);
      *(u32x2*)(op + db * 32 + 8 * q4 + 4 * hh) = w;
    }
}

__device__ __forceinline__ void phase_mlout(const Params& p, int layer, int nrows) {
  const int lane = tidx() & 63, wv = tidx() >> 6;
  const float* ng = p.ml_norm + layer * 512;
  for (int row = bidx() * 4 + wv; row < nrows; row += gridDim.x * 4) {
    int c0 = lane * 8;
    u32x4 a = *(const u32x4*)(p.hf + (size_t)row * 512 + c0);
    u32x4 o = *(const u32x4*)(p.proj + (size_t)row * 4096 + 3584 + c0);
    float y[8]; float ss = 0.f;
#pragma unroll
    for (int e = 0; e < 4; ++e) {
      float y0 = __uint_as_float(a[e] << 16);
      float y1 = __uint_as_float(a[e] & 0xffff0000u);
      y[2 * e] = y0; y[2 * e + 1] = y1; ss += y0 * y0 + y1 * y1;
    }
    ss += __shfl_xor(ss, 1); ss += __shfl_xor(ss, 2); ss += __shfl_xor(ss, 4); ss += __shfl_xor(ss, 8);
    float rs = rsqrtf(ss * (1.f / 128.f) + 1e-6f);
    u32x4 w;
#pragma unroll
    for (int e = 0; e < 4; ++e) {
      float o0 = sigmoidf_(__uint_as_float(o[e] << 16)), o1 = sigmoidf_(__uint_as_float(o[e] & 0xffff0000u));
      w[e] = pack2(y[2 * e] * rs * ng[c0 + 2 * e] * o0, y[2 * e + 1] * rs * ng[c0 + 2 * e + 1] * o1);
    }
    *(u32x4*)(p.br + (size_t)row * 1536 + 1024 + c0) = w;
  }
}

__device__ __forceinline__ void phase_uvconv(const Params& p, int layer) {
  const size_t n4 = (size_t)16384 * 1024 / 4;
  const f32x4* su = (const f32x4*)(p.peer_u + (size_t)layer * 16384 * 1024);
  const f32x4* sv = (const f32x4*)(p.peer_v + (size_t)layer * 16384 * 1024);
  u32x2* du = (u32x2*)p.uv; u32x2* dv = (u32x2*)(p.uv + (size_t)16384 * 1024);
  for (size_t i = (size_t)bidx() * NTHR + tidx(); i < n4; i += (size_t)gridDim.x * NTHR) {
    f32x4 a = su[i], b = sv[i];
    u32x2 w; w.x = pack2(a[0], a[1]); w.y = pack2(a[2], a[3]); du[i] = w;
    u32x2 w2; w2.x = pack2(b[0], b[1]); w2.y = pack2(b[2], b[3]); dv[i] = w2;
  }
}

__device__ __forceinline__ void phase_topk(const Params& p, int layer, int nrows) {
#if DIAG_HP
  float* sks = (float*)smem;
  float* qs = (float*)(smem + 2 * 128 * 129 * 4);
#else
  bf16_t* sks = (bf16_t*)smem;
  float* qs = (float*)(smem + 2 * 128 * 130 * 2);
#endif
  const int tid = tidx(), lane = tid & 63, wv = tid >> 6;
  const int nchunks = nrows / 64;
  int cur_h = -1;
  for (int item = bidx(); item < nchunks * 8; item += gridDim.x) {
    int h = item % 8, chunk = item / 8;
    if (h != cur_h) {
      __syncthreads();
#if DIAG_HP
      const float* src = p.peer_subkeys + ((size_t)layer * 8 + h) * 2 * 128 * 128;
      for (int i = tid; i < 2 * 128 * 128; i += NTHR) { int pk = i >> 7, d = i & 127; sks[pk * 129 + d] = src[i]; }
#else
      const bf16_t* src = p.sk + ((size_t)layer * 8 + h) * 2 * 128 * 128;
      for (int i = tid; i < 2 * 128 * 128; i += NTHR) { int pk = i >> 7, d = i & 127; sks[pk * 130 + d] = src[i]; }
#endif
      __syncthreads();
      cur_h = h;
    }
    float* myq = qs + wv * 256;
    for (int ti = 0; ti < 16; ++ti) {
      int row = chunk * 64 + wv * 16 + ti;
#if DIAG_HP
      const float* qp = p.qf + (size_t)row * 2048 + h * 256;
      myq[lane] = qp[lane]; myq[lane + 64] = qp[lane + 64]; myq[lane + 128] = qp[lane + 128]; myq[lane + 192] = qp[lane + 192];
#else
      const bf16_t* qp = p.q + (size_t)row * 2048 + h * 256;
      myq[lane] = bf2f(qp[lane]); myq[lane + 64] = bf2f(qp[lane + 64]); myq[lane + 128] = bf2f(qp[lane + 128]); myq[lane + 192] = bf2f(qp[lane + 192]);
#endif
      __builtin_amdgcn_wave_barrier();
      float s1v = 0.f, s2v = 0.f; int i1v = 0, i2v = 0;
      for (int pp = 0; pp < 2; ++pp) {
        const float* qq = myq + pp * 128;
        float a0 = 0.f, a1 = 0.f;
#if DIAG_HP
        const float* k0 = sks + (pp * 128 + lane) * 129;
        const float* k1 = sks + (pp * 128 + lane + 64) * 129;
#pragma unroll 8
        for (int d = 0; d < 128; ++d) { a0 += qq[d] * k0[d]; a1 += qq[d] * k1[d]; }
#else
        const bf16_t* k0 = sks + (pp * 128 + lane) * 130;
        const bf16_t* k1 = sks + (pp * 128 + lane + 64) * 130;
#pragma unroll 8
        for (int d = 0; d < 128; d += 2) {
          unsigned w0 = *(const unsigned*)(k0 + d), w1 = *(const unsigned*)(k1 + d);
          float q0 = qq[d], q1 = qq[d + 1];
          a0 += q0 * __uint_as_float(w0 << 16) + q1 * __uint_as_float(w0 & 0xffff0000u);
          a1 += q0 * __uint_as_float(w1 << 16) + q1 * __uint_as_float(w1 & 0xffff0000u);
        }
#endif
        float sv = 0.f; int iv = 0;
        for (int r = 0; r < 16; ++r) {
          float mx = wave_max(fmaxf(a0, a1));
          unsigned long long bal = __ballot(a0 == mx || a1 == mx);
          int wl = __ffsll((long long)bal) - 1;
          int key = 0;
          if (lane == wl) { if (a0 == mx) { key = lane; a0 = -3e38f; } else { key = lane + 64; a1 = -3e38f; } }
          key = __shfl(key, wl);
          if (lane == r) { sv = mx; iv = key; }
        }
        if (pp == 0) { s1v = sv; i1v = iv; } else { s2v = sv; i2v = iv; }
      }
      float cs[4]; int ci[4];
      float s1i = __shfl(s1v, lane >> 2); int i1i = __shfl(i1v, lane >> 2);
#pragma unroll
      for (int r = 0; r < 4; ++r) {
        int j = (lane & 3) * 4 + r;
        float s2j = __shfl(s2v, j); int i2j = __shfl(i2v, j);
        cs[r] = s1i + s2j; ci[r] = i1i * 128 + i2j;
      }
      float selv = 0.f; int seli = 0;
      for (int r = 0; r < 16; ++r) {
        float lm = fmaxf(fmaxf(cs[0], cs[1]), fmaxf(cs[2], cs[3]));
        float mx = wave_max(lm);
        unsigned long long bal = __ballot(lm == mx);
        int wl = __ffsll((long long)bal) - 1;
        int id = 0;
        if (lane == wl) {
          if (cs[0] == mx) { id = ci[0]; cs[0] = -3e38f; }
          else if (cs[1] == mx) { id = ci[1]; cs[1] = -3e38f; }
          else if (cs[2] == mx) { id = ci[2]; cs[2] = -3e38f; }
          else { id = ci[3]; cs[3] = -3e38f; }
        }
        id = __shfl(id, wl);
        if (lane == r) { selv = mx; seli = id; }
      }
      float top = __shfl(selv, 0);
      float e = lane < 16 ? __expf(selv - top) : 0.f;
      float sum = wave_sum(e);
      if (lane < 16) {
        p.idx[(size_t)row * 128 + h * 16 + lane] = seli;
        p.gw[(size_t)row * 128 + h * 16 + lane] = e / sum;
      }
      __builtin_amdgcn_wave_barrier();
    }
  }
}

__device__ __forceinline__ void phase_uvconv8(const Params& p, int layer) {
  const int lane = tidx() & 63, wv = tidx() >> 6;
  for (int row = bidx() * 4 + wv; row < 32768; row += gridDim.x * 4) {
    const float* src = (row < 16384 ? p.peer_u + ((size_t)layer * 16384 + row) * 1024 : p.peer_v + ((size_t)layer * 16384 + (row - 16384)) * 1024) + lane * 16;
    f32x4 a[4]; float amax = 0.f;
#pragma unroll
    for (int i = 0; i < 4; ++i) {
      a[i] = *(const f32x4*)(src + 4 * i);
#pragma unroll
      for (int e = 0; e < 4; ++e) amax = fmaxf(amax, fabsf(a[i][e]));
    }
    amax = wave_max(amax);
    const float scale = amax > 0.f ? amax * (1.f / 127.f) : 1.f;
    const float inv = 1.f / scale;
    u32x4 w;
#pragma unroll
    for (int i = 0; i < 4; ++i) {
      unsigned q = 0;
#pragma unroll
      for (int e = 0; e < 4; ++e) {
        int v = (int)rintf(a[i][e] * inv);
        v = v < -127 ? -127 : (v > 127 ? 127 : v);
        q |= (unsigned)(v & 0xff) << (8 * e);
      }
      w[i] = q;
    }
    if (row < 16384) *(u32x4*)(p.uvq + (size_t)row * 1024 + lane * 16) = w;
    else *(u32x4*)(p.uvq + (size_t)16384 * 1024 + ((size_t)(lane >> 3) * 16384 + (row - 16384)) * 128 + (lane & 7) * 16) = w;
    if (lane == 0) p.uvs[row] = scale;
  }
}


__device__ __forceinline__ void phase_gather8(const Params& p, int layer, int nrows, float oscale, int fuse_norm) {
  const int lane = tidx() & 63, wv = tidx() >> 6;
  const unsigned char* U8 = p.uvq; const unsigned char* V8 = p.uvq + (size_t)16384 * 1024;
  const float* US = p.uvs; const float* VS = p.uvs + 16384;
  const int klane = ((lane >> 5) & 1) * 4 + ((lane >> 4) & 1) * 2 + ((lane >> 3) & 1);
  for (int row = bidx() * 4 + wv; row < nrows; row += gridDim.x * 4) {
    float xv[16], acc[16];
    {
      u32x4 a = *(const u32x4*)(p.h + (size_t)row * DM + lane * 16), b = *(const u32x4*)(p.h + (size_t)row * DM + lane * 16 + 8);
#pragma unroll
      for (int e = 0; e < 4; ++e) {
        xv[2 * e] = __uint_as_float(a[e] << 16); xv[2 * e + 1] = __uint_as_float(a[e] & 0xffff0000u);
        xv[8 + 2 * e] = __uint_as_float(b[e] << 16); xv[8 + 2 * e + 1] = __uint_as_float(b[e] & 0xffff0000u);
      }
    }
    float xs = 0.f;
#pragma unroll
    for (int i = 0; i < 16; ++i) { acc[i] = 0.f; xs += xv[i]; }
    xs = wave_sum(xs) * 128.f;
    const int myidx0 = p.idx[(size_t)row * 128 + lane], myidx1 = p.idx[(size_t)row * 128 + 64 + lane];
    const float myg0 = p.gw[(size_t)row * 128 + lane], myg1 = p.gw[(size_t)row * 128 + 64 + lane];
    float wsum = 0.f;
    for (int k0 = 0; k0 < 128; k0 += 8) {
      const int srcv = k0 < 64 ? myidx0 : myidx1;
      const float srcg = k0 < 64 ? myg0 : myg1;
      const int kb = k0 & 63;
      u32x4 uq[8], vq[8];
#pragma unroll
      for (int j = 0; j < 8; ++j) {
        const int e_ = __builtin_amdgcn_readlane(srcv, kb + j);
        uq[j] = *(const u32x4*)(U8 + (size_t)e_ * 1024 + lane * 16);
        vq[j] = *(const u32x4*)(V8 + (size_t)e_ * 1024 + lane * 16);
      }
      const int el = __shfl(srcv, kb + klane);
      const float gl = __shfl(srcg, kb + klane);
      const float sul = US[el], svl = VS[el];
      float d[8];
#pragma unroll
      for (int j = 0; j < 8; ++j) {
        float s = 0.f;
#pragma unroll
        for (int c = 0; c < 4; ++c) {
          s += xv[4 * c] * ub0(uq[j][c]) + xv[4 * c + 1] * ub1(uq[j][c]) + xv[4 * c + 2] * ub2(uq[j][c]) + xv[4 * c + 3] * ub3(uq[j][c]);
        }
        d[j] = s;
      }
      float r4[4], r2[2], t;
      const bool b5 = lane & 32, b4 = lane & 16, b3 = lane & 8;
#pragma unroll
      for (int j = 0; j < 4; ++j) { float keep = b5 ? d[j + 4] : d[j], send = b5 ? d[j] : d[j + 4]; r4[j] = keep + __shfl_xor(send, 32); }
#pragma unroll
      for (int j = 0; j < 2; ++j) { float keep = b4 ? r4[j + 2] : r4[j], send = b4 ? r4[j] : r4[j + 2]; r2[j] = keep + __shfl_xor(send, 16); }
      { float keep = b3 ? r2[1] : r2[0], send = b3 ? r2[0] : r2[1]; t = keep + __shfl_xor(send, 8); }
      t += __shfl_xor(t, 4); t += __shfl_xor(t, 2); t += __shfl_xor(t, 1);
      const float dot = sul * (t - xs);
      const float wl = PEER_ALPHA * oscale * gl * gelu_tanh(dot) * svl;
#pragma unroll
      for (int j = 0; j < 8; ++j) {
        const float w = __int_as_float(__builtin_amdgcn_readlane(__float_as_int(wl), ((j >> 2) & 1) * 32 + ((j >> 1) & 1) * 16 + (j & 1) * 8));
        wsum += w;
#pragma unroll
        for (int c = 0; c < 4; ++c) {
          acc[4 * c] += w * ub0(vq[j][c]); acc[4 * c + 1] += w * ub1(vq[j][c]); acc[4 * c + 2] += w * ub2(vq[j][c]); acc[4 * c + 3] += w * ub3(vq[j][c]);
        }
      }
    }
    const float off = 128.f * wsum;
    float* xr = xrow(p, row) + lane * 16;
    const float* g2 = p.mod + (size_t)(layer * 3 + modrow(row)) * 6144 + 5 * DM + lane * 16;
    f32x4 xn[4]; float ss = 0.f;
#pragma unroll
    for (int c = 0; c < 4; ++c) {
      f32x4 x0 = *(const f32x4*)(xr + 4 * c), ga = *(const f32x4*)(g2 + 4 * c);
#pragma unroll
      for (int e = 0; e < 4; ++e) { x0[e] += ga[e] * (acc[4 * c + e] - off); ss += x0[e] * x0[e]; }
      *(f32x4*)(xr + 4 * c) = x0;
      xn[c] = x0;
    }
    if (fuse_norm) {
      ss = wave_sum(ss);
      const float rs = rsqrtf(ss * (1.f / DM) + 1e-6f);
      const float* gn = p.norm1_g + (layer + 1) * DM + lane * 16;
      const float* md = p.mod + (size_t)((layer + 1) * 3 + modrow(row)) * 6144 + lane * 16;
      u32x4 w0, w1;
#pragma unroll
      for (int c = 0; c < 4; ++c) {
        f32x4 gg = *(const f32x4*)(gn + 4 * c), sc = *(const f32x4*)(md + DM + 4 * c), sh = *(const f32x4*)(md + 4 * c);
        float o0 = xn[c][0] * rs * gg[0] * (1.f + sc[0]) + sh[0], o1 = xn[c][1] * rs * gg[1] * (1.f + sc[1]) + sh[1];
        float o2 = xn[c][2] * rs * gg[2] * (1.f + sc[2]) + sh[2], o3 = xn[c][3] * rs * gg[3] * (1.f + sc[3]) + sh[3];
        if (c < 2) { w0[2 * c] = pack2(o0, o1); w0[2 * c + 1] = pack2(o2, o3); } else { w1[2 * (c - 2)] = pack2(o0, o1); w1[2 * (c - 2) + 1] = pack2(o2, o3); }
      }
      *(u32x4*)(p.h + (size_t)row * DM + lane * 16) = w0;
      *(u32x4*)(p.h + (size_t)row * DM + lane * 16 + 8) = w1;
    }
  }
}

typedef short s16x2 __attribute__((ext_vector_type(2)));
__device__ __forceinline__ int swap32_add(int a, int b) { auto s = __builtin_amdgcn_permlane32_swap((unsigned)a, (unsigned)b, false, false); return (int)s[0] + (int)s[1]; }
__device__ __forceinline__ int swap16_add(int a, int b) { auto s = __builtin_amdgcn_permlane16_swap((unsigned)a, (unsigned)b, false, false); return (int)s[0] + (int)s[1]; }
template <int CTRL> __device__ __forceinline__ int dpp_i(int v) { return __builtin_amdgcn_update_dpp(0, v, CTRL, 0xf, 0xf, true); }
template <int CTRL> __device__ __forceinline__ float dpp_f(float v) { return __int_as_float(__builtin_amdgcn_update_dpp(0, __float_as_int(v), CTRL, 0xf, 0xf, true)); }

struct UBatch { u32x4 uq[8]; int ent[8]; int entk; float sul, svl, gl, sxk; };
__device__ __forceinline__ void gu_issue(const Params& p, UBatch& B, const int* list, int b, int r0, int lane) {
  const signed char* U8 = (const signed char*)p.uvq;
  const i32x4 e0 = *(const i32x4*)(list + b), e1 = *(const i32x4*)(list + b + 4);
#pragma unroll
  for (int j = 0; j < 8; ++j) {
    B.ent[j] = __builtin_amdgcn_readfirstlane(j < 4 ? e0[j & 3] : e1[j & 3]);
    B.uq[j] = *(const u32x4*)(U8 + (size_t)(B.ent[j] & 16383) * 1024 + lane * 16);
  }
  B.entk = list[b + (lane >> 3)];
  const int el = B.entk & 16383;
  B.sul = p.uvs[el]; B.svl = p.uvs[16384 + el];
  B.gl = p.gw[(size_t)(r0 + (B.entk >> 23)) * 128 + ((B.entk >> 16) & 127)];
  B.sxk = p.sxq[r0 + (B.entk >> 23)];
}
__device__ __forceinline__ void gu_compute(const Params& p, const UBatch& B, const char* xl, int b, int cnt, int r0, int lane) {
  u32x4 xs[8];
#pragma unroll
  for (int j = 0; j < 8; ++j) xs[j] = *(const u32x4*)(xl + ((B.ent[j] >> 23) << 10));
  int d[8];
#pragma unroll
  for (int j = 0; j < 8; ++j) {
    int a = 0;
#pragma unroll
    for (int c = 0; c < 4; ++c) a = __builtin_amdgcn_sdot4((int)xs[j][c], (int)B.uq[j][c], a, false);
    d[j] = a;
  }
  int r4[4], r2[2];
#pragma unroll
  for (int j = 0; j < 4; ++j) r4[j] = swap32_add(d[j], d[j + 4]);
#pragma unroll
  for (int j = 0; j < 2; ++j) r2[j] = swap16_add(r4[j], r4[j + 2]);
#pragma unroll
  for (int j = 0; j < 2; ++j) { r2[j] += dpp_i<0x128>(r2[j]); r2[j] += dpp_i<0x124>(r2[j]); r2[j] += dpp_i<0x122>(r2[j]); r2[j] += dpp_i<0x121>(r2[j]); }
  const int t = (lane & 8) ? r2[1] : r2[0];
  const int tk = B.entk >> 23;
  const float dot = B.sul * B.sxk * (float)t;
  const float wl = PEER_ALPHA * B.gl * gelu_tanh(dot) * B.svl;
  if ((lane & 7) == 0 && b + (lane >> 3) < cnt) p.wbuf[(size_t)(r0 + tk) * 128 + ((B.entk >> 16) & 127)] = wl;
}
__device__ __forceinline__ void phase_gatherU(const Params& p, int layer, int nrows) {
  const int lane = tidx() & 63, wv = __builtin_amdgcn_readfirstlane(tidx() >> 6);
  const int part = bidx() & 7, vb = bidx() >> 3, nvb = (gridDim.x - part + 7) >> 3;
  int* list = (int*)(smem + wv * 6400);
  char* xlw = smem + wv * 6400 + 2304;
  const char* xl = xlw + lane * 16;
  for (int r0 = (vb * 4 + wv) * 4; r0 < nrows; r0 += nvb * 16) {
    int iv[8];
#pragma unroll
    for (int q = 0; q < 8; ++q) iv[q] = p.idx[(size_t)(r0 + (q >> 1)) * 128 + (q & 1) * 64 + lane];
    u32x4 x4[4];
#pragma unroll
    for (int t = 0; t < 4; ++t) x4[t] = *(const u32x4*)(p.xq + (size_t)(r0 + t) * DM + lane * 16);
    int cnt = 0;
    __builtin_amdgcn_wave_barrier();
#pragma unroll
    for (int q = 0; q < 8; ++q) {
      const bool in = (iv[q] >> 11) == part;
      const unsigned long long m = __ballot(in);
      const int rk = cnt + __builtin_amdgcn_mbcnt_hi((unsigned)(m >> 32), __builtin_amdgcn_mbcnt_lo((unsigned)m, 0));
      if (in) list[rk] = ((q >> 1) << 23) | (((q & 1) * 64 + lane) << 16) | iv[q];
      cnt += __popcll(m);
    }
    if (lane < 8) list[cnt + lane] = part << 11;
#pragma unroll
    for (int t = 0; t < 4; ++t) *(u32x4*)(xlw + t * 1024 + lane * 16) = x4[t];
    __builtin_amdgcn_wave_barrier();
    if (cnt == 0) continue;
    UBatch A, Bb;
    gu_issue(p, A, list, 0, r0, lane);
    for (int b = 0; b < cnt; b += 16) {
      if (b + 8 < cnt) gu_issue(p, Bb, list, b + 8, r0, lane);
      gu_compute(p, A, xl, b, cnt, r0, lane);
      if (b + 8 < cnt) {
        if (b + 16 < cnt) gu_issue(p, A, list, b + 16, r0, lane);
        gu_compute(p, Bb, xl, b + 8, cnt, r0, lane);
      }
    }
  }
}

struct VMeta { i32x4 ie[4]; f32x4 we[4]; };
struct VRows { u32x4 vq[16]; int wq4[4]; float sw; f32x2 x0, ga; };
__device__ __forceinline__ void gv_meta(const Params& p, VMeta& M, int row, int goff) {
  const int* ip = p.idx + (size_t)row * 128; const float* wp = p.wbuf + (size_t)row * 128;
#pragma unroll
  for (int i = 0; i < 4; ++i) {
    M.ie[i] = *(const i32x4*)((const char*)ip + (unsigned)(goff + 16 * i));
    M.we[i] = *(const f32x4*)((const char*)wp + (unsigned)(goff + 16 * i));
  }
}
__device__ __forceinline__ void gv_rows(const Params& p, VRows& R, const VMeta& M, const signed char* V8, int loff, int row, int layer, int coff) {
#pragma unroll
  for (int j = 0; j < 16; ++j) R.vq[j] = *(const u32x4*)(V8 + (unsigned)((M.ie[j >> 2][j & 3] << 7) + loff));
  R.x0 = *(const f32x2*)((const char*)xrow(p, row) + (unsigned)coff);
  R.ga = *(const f32x2*)((const char*)(p.mod + (size_t)(layer * 3 + modrow(row)) * 6144 + 5 * DM) + (unsigned)coff);
  float mx = fmaxf(fmaxf(fabsf(M.we[0][0]), fabsf(M.we[0][1])), fmaxf(fabsf(M.we[0][2]), fabsf(M.we[0][3])));
#pragma unroll
  for (int i = 1; i < 4; ++i) mx = fmaxf(fmaxf(fmaxf(mx, fabsf(M.we[i][0])), fmaxf(fabsf(M.we[i][1]), fabsf(M.we[i][2]))), fabsf(M.we[i][3]));
  mx = fmaxf(mx, dpp_f<0x128>(mx));
  { auto s = __builtin_amdgcn_permlane16_swap(__float_as_uint(mx), __float_as_uint(mx), false, false); mx = fmaxf(__uint_as_float(s[0]), __uint_as_float(s[1])); }
  { auto s = __builtin_amdgcn_permlane32_swap(__float_as_uint(mx), __float_as_uint(mx), false, false); mx = fmaxf(__uint_as_float(s[0]), __uint_as_float(s[1])); }
  R.sw = mx > 0.f ? mx * (1.f / 127.f) : 1.f;
  const float k = (mx > 0.f ? 127.f / mx : 1.f) * (256.f / 32767.f);
#pragma unroll
  for (int i = 0; i < 4; ++i) {
    auto c0 = __builtin_amdgcn_cvt_pknorm_i16(M.we[i][0] * k, M.we[i][1] * k), c1 = __builtin_amdgcn_cvt_pknorm_i16(M.we[i][2] * k, M.we[i][3] * k);
    s16x2 a = {c0[0], c0[1]}, bq = {c1[0], c1[1]};
    a = a + (s16x2){128, 128}; bq = bq + (s16x2){128, 128};
    const unsigned ua = ((unsigned)(unsigned short)a[1] << 16) | (unsigned short)a[0], ub = ((unsigned)(unsigned short)bq[1] << 16) | (unsigned short)bq[0];
    R.wq4[i] = (int)__builtin_amdgcn_perm(ub, ua, 0x07050301u);
  }
}
__device__ __forceinline__ void gv_compute(const Params& p, const VRows& R, int row, int coff, int lane, float oscale) {
  int acc[16];
#pragma unroll
  for (int i = 0; i < 16; ++i) acc[i] = 0;
#pragma unroll
  for (int grp = 0; grp < 4; ++grp) {
#pragma unroll
    for (int dw = 0; dw < 4; ++dw) {
      const unsigned D0 = R.vq[4 * grp][dw], D1 = R.vq[4 * grp + 1][dw], D2 = R.vq[4 * grp + 2][dw], D3 = R.vq[4 * grp + 3][dw];
      const unsigned P0 = __builtin_amdgcn_perm(D1, D0, 0x05010400u), P1 = __builtin_amdgcn_perm(D1, D0, 0x07030602u);
      const unsigned Q0 = __builtin_amdgcn_perm(D3, D2, 0x05010400u), Q1 = __builtin_amdgcn_perm(D3, D2, 0x07030602u);
      const unsigned T0 = __builtin_amdgcn_perm(Q0, P0, 0x05040100u), T1 = __builtin_amdgcn_perm(Q0, P0, 0x07060302u);
      const unsigned T2 = __builtin_amdgcn_perm(Q1, P1, 0x05040100u), T3 = __builtin_amdgcn_perm(Q1, P1, 0x07060302u);
      acc[4 * dw] = __builtin_amdgcn_sdot4((int)T0, R.wq4[grp], acc[4 * dw], false);
      acc[4 * dw + 1] = __builtin_amdgcn_sdot4((int)T1, R.wq4[grp], acc[4 * dw + 1], false);
      acc[4 * dw + 2] = __builtin_amdgcn_sdot4((int)T2, R.wq4[grp], acc[4 * dw + 2], false);
      acc[4 * dw + 3] = __builtin_amdgcn_sdot4((int)T3, R.wq4[grp], acc[4 * dw + 3], false);
    }
  }
  int r8[8], r4[4], r2[2];
#pragma unroll
  for (int j = 0; j < 8; ++j) r8[j] = swap32_add(acc[j], acc[j + 8]);
#pragma unroll
  for (int j = 0; j < 4; ++j) r4[j] = swap16_add(r8[j], r8[j + 4]);
#pragma unroll
  for (int j = 0; j < 4; ++j) r4[j] += dpp_i<0x128>(r4[j]);
  const bool b3 = lane & 8;
  r2[0] = b3 ? r4[2] : r4[0]; r2[1] = b3 ? r4[3] : r4[1];
  f32x2 x0 = R.x0;
  x0[0] += oscale * R.ga[0] * R.sw * (float)r2[0]; x0[1] += oscale * R.ga[1] * R.sw * (float)r2[1];
  *(f32x2*)((char*)xrow(p, row) + (unsigned)coff) = x0;
}
__device__ __forceinline__ void phase_gatherV(const Params& p, int layer, int nrows, float oscale = 1.f) {
  const int lane = tidx() & 63, wv = __builtin_amdgcn_readfirstlane(tidx() >> 6);
  const int part = bidx() & 7, vb = bidx() >> 3, nvb = (gridDim.x - part + 7) >> 3;
  const signed char* V8 = (const signed char*)p.uvq + (size_t)16384 * 1024 + (size_t)part * 16384 * 128;
  const int loff = (lane & 7) * 16, goff = (lane >> 3) * 64;
  const int coff = 4 * (part * 128 + (lane & 7) * 16 + ((lane >> 5) & 1) * 8 + ((lane >> 4) & 1) * 4 + ((lane >> 3) & 1) * 2);
  const int rs = nvb * 4, rfirst = vb * 4 + wv;
  if (rfirst >= nrows) return;
  VMeta M; VRows RA, RB;
  gv_meta(p, M, rfirst, goff);
  gv_rows(p, RA, M, V8, loff, rfirst, layer, coff);
  if (rfirst + rs < nrows) gv_meta(p, M, rfirst + rs, goff);
  for (int row = rfirst; row < nrows; row += 2 * rs) {
    const bool h1 = row + rs < nrows, h2 = row + 2 * rs < nrows, h3 = row + 3 * rs < nrows;
    if (h1) gv_rows(p, RB, M, V8, loff, row + rs, layer, coff);
    if (h2) gv_meta(p, M, row + 2 * rs, goff);
    gv_compute(p, RA, row, coff, lane, oscale);
    if (h1) {
      if (h2) gv_rows(p, RA, M, V8, loff, row + 2 * rs, layer, coff);
      if (h3) gv_meta(p, M, row + 3 * rs, goff);
      gv_compute(p, RB, row + rs, coff, lane, oscale);
    }
  }
}

__device__ __forceinline__ unsigned f2key(float f) { unsigned u = __float_as_uint(f); return (u & 0x80000000u) ? ~u : (u | 0x80000000u); }
__device__ __forceinline__ float key2f(unsigned k) { unsigned u = (k & 0x80000000u) ? (k ^ 0x80000000u) : ~k; return __uint_as_float(u); }
#define INS16(L, vv) { unsigned v_ = (vv); _Pragma("unroll") for (int j_ = 0; j_ < 16; ++j_) { unsigned hi_ = max(L[j_], v_); v_ = min(L[j_], v_); L[j_] = hi_; } }
__device__ __forceinline__ unsigned sel16(const unsigned (&a)[16], unsigned i) {
  unsigned t[8], u[4], v[2];
#pragma unroll
  for (int k = 0; k < 8; ++k) t[k] = (i & 1u) ? a[2 * k + 1] : a[2 * k];
#pragma unroll
  for (int k = 0; k < 4; ++k) u[k] = (i & 2u) ? t[2 * k + 1] : t[2 * k];
#pragma unroll
  for (int k = 0; k < 2; ++k) v[k] = (i & 4u) ? u[2 * k + 1] : u[2 * k];
  return (i & 8u) ? v[1] : v[0];
}

__device__ __forceinline__ void sort16_desc(unsigned (&a)[16]) {
#pragma unroll
  for (int k = 2; k <= 16; k <<= 1)
#pragma unroll
    for (int j = k >> 1; j > 0; j >>= 1)
#pragma unroll
      for (int i = 0; i < 16; ++i) {
        const int l = i ^ j;
        if (l > i) {
          const unsigned hi = max(a[i], a[l]), lo = min(a[i], a[l]);
          if ((i & k) == 0) { a[i] = hi; a[l] = lo; } else { a[i] = lo; a[l] = hi; }
        }
      }
}
__device__ __forceinline__ void merge16_desc(unsigned (&L)[16], const unsigned (&g)[16]) {
#pragma unroll
  for (int i = 0; i < 16; ++i) L[i] = max(L[i], g[15 - i]);
#pragma unroll
  for (int j = 8; j > 0; j >>= 1)
#pragma unroll
    for (int i = 0; i < 16; ++i) {
      const int l = i ^ j;
      if (l > i) { const unsigned hi = max(L[i], L[l]), lo = min(L[i], L[l]); L[i] = hi; L[l] = lo; }
    }
}
__device__ __forceinline__ void phase_topk2(const Params& p, int layer, int nrows) {
  char* SK = smem;
  const int tid = tidx(), wid = tid >> 6, lane = tid & 63, l31 = lane & 31, hh = lane >> 5;
  const int ntiles = nrows / 128;
  int cur_h = -1;
  for (int item = bidx(); item < ntiles * 8; item += gridDim.x) {
    const int h = item & 7, tile = item >> 3;
    if (h != cur_h) {
      __syncthreads();
      const bf16_t* src = p.sk + ((size_t)layer * 8 + h) * 2 * 128 * 128;
#pragma unroll
      for (int i = 0; i < 16; ++i) {
        int id = tid + 256 * i, row = id >> 4, c16 = id & 15;
        *(u32x4*)(SK + row * 272 + c16 * 16) = *(const u32x4*)(src + (size_t)row * 128 + c16 * 8);
      }
      __syncthreads();
      cur_h = h;
    }
    const int row = tile * 128 + wid * 32 + l31;
    f32x16 sc[2][4];
#pragma unroll
    for (int pp = 0; pp < 2; ++pp) {
      bf16x8 qf[8];
#pragma unroll
      for (int ks = 0; ks < 8; ++ks) qf[ks] = *(const bf16x8*)(p.q + (size_t)row * 2048 + h * 256 + pp * 128 + ks * 16 + hh * 8);
#pragma unroll
      for (int kb = 0; kb < 4; ++kb) {
#pragma unroll
        for (int r = 0; r < 16; ++r) sc[pp][kb][r] = 0.f;
#pragma unroll
        for (int ks = 0; ks < 8; ++ks) {
          bf16x8 a = *(const bf16x8*)(SK + (pp * 128 + kb * 32 + l31) * 272 + (ks * 16 + hh * 8) * 2);
          sc[pp][kb] = __builtin_amdgcn_mfma_f32_32x32x16_bf16(a, qf[ks], sc[pp][kb], 0, 0, 0);
        }
      }
    }
    unsigned L1[16];
#pragma unroll
    for (int j = 0; j < 16; ++j) L1[j] = 0u;
#pragma unroll
    for (int kb = 0; kb < 4; ++kb)
#pragma unroll
      for (int rh = 0; rh < 2; ++rh) {
        unsigned g[16];
#pragma unroll
        for (int rr = 0; rr < 8; ++rr) {
          const int r = rh * 8 + rr;
          auto sw = __builtin_amdgcn_permlane32_swap(__float_as_uint(sc[0][kb][r]), __float_as_uint(sc[1][kb][r]), false, false);
          const unsigned kidx = kb * 32 + (r & 3) + 8 * (r >> 2);
          g[2 * rr] = (f2key(__uint_as_float(sw[0])) & ~127u) | kidx;
          g[2 * rr + 1] = (f2key(__uint_as_float(sw[1])) & ~127u) | (kidx + 4);
        }
        sort16_desc(g);
        merge16_desc(L1, g);
      }
    float As[16], Bs[16]; unsigned Ai[16], Bi[16];
#pragma unroll
    for (int j = 0; j < 16; ++j) {
      auto sw = __builtin_amdgcn_permlane32_swap(L1[j], L1[j], false, false);
      unsigned other = hh ? sw[0] : sw[1];
      unsigned ka = hh ? other : L1[j], kb_ = hh ? L1[j] : other;
      As[j] = key2f(ka & ~127u); Ai[j] = ka & 127u;
      Bs[j] = key2f(kb_ & ~127u); Bi[j] = kb_ & 127u;
    }
    unsigned L2[16];
#pragma unroll
    for (int j = 0; j < 16; ++j) L2[j] = 0u;
    const float smax = As[0] + Bs[0];
#define CKEY(i, j) (((262143u - min((unsigned)((smax - (As[i] + Bs[j])) * 16384.f), 262143u)) << 14) | (Ai[i] * 128u + Bi[j]))
    {
      unsigned g[16];
      g[0] = CKEY(0, 0);
      g[1] = CKEY(0, 1);
      g[2] = CKEY(0, 2);
      g[3] = CKEY(0, 3);
      g[4] = CKEY(0, 4);
      g[5] = CKEY(0, 5);
      g[6] = CKEY(0, 6);
      g[7] = CKEY(0, 7);
      g[8] = CKEY(0, 8);
      g[9] = CKEY(0, 9);
      g[10] = CKEY(0, 10);
      g[11] = CKEY(0, 11);
      g[12] = CKEY(0, 12);
      g[13] = CKEY(0, 13);
      g[14] = CKEY(0, 14);
      g[15] = CKEY(0, 15);
      sort16_desc(g);
      merge16_desc(L2, g);
    }
    {
      unsigned g[16];
      g[0] = CKEY(1, 0);
      g[1] = CKEY(1, 1);
      g[2] = CKEY(1, 2);
      g[3] = CKEY(1, 3);
      g[4] = CKEY(1, 4);
      g[5] = CKEY(1, 5);
      g[6] = CKEY(1, 6);
      g[7] = CKEY(1, 7);
      g[8] = CKEY(2, 0);
      g[9] = CKEY(2, 1);
      g[10] = CKEY(2, 2);
      g[11] = CKEY(2, 3);
      g[12] = CKEY(2, 4);
      g[13] = CKEY(3, 0);
      g[14] = CKEY(3, 1);
      g[15] = CKEY(3, 2);
      sort16_desc(g);
      merge16_desc(L2, g);
    }
    {
      unsigned g[16];
      g[0] = CKEY(3, 3);
      g[1] = CKEY(4, 0);
      g[2] = CKEY(4, 1);
      g[3] = CKEY(4, 2);
      g[4] = CKEY(5, 0);
      g[5] = CKEY(5, 1);
      g[6] = CKEY(6, 0);
      g[7] = CKEY(6, 1);
      g[8] = CKEY(7, 0);
      g[9] = CKEY(7, 1);
      g[10] = CKEY(8, 0);
      g[11] = CKEY(9, 0);
      g[12] = CKEY(10, 0);
      g[13] = CKEY(11, 0);
      g[14] = CKEY(12, 0);
      g[15] = CKEY(13, 0);
      sort16_desc(g);
      merge16_desc(L2, g);
    }
    {
      unsigned g[16];
      g[0] = CKEY(14, 0);
      g[1] = CKEY(15, 0);
      g[2] = 0u;
      g[3] = 0u;
      g[4] = 0u;
      g[5] = 0u;
      g[6] = 0u;
      g[7] = 0u;
      g[8] = 0u;
      g[9] = 0u;
      g[10] = 0u;
      g[11] = 0u;
      g[12] = 0u;
      g[13] = 0u;
      g[14] = 0u;
      g[15] = 0u;
      sort16_desc(g);
      merge16_desc(L2, g);
    }
#undef CKEY
    float ex[16]; unsigned ev[16]; float sum = 0.f;
#pragma unroll
    for (int t = 0; t < 16; ++t) {
      ev[t] = L2[t] & 16383u;
      float d = (float)(262143u - (L2[t] >> 14)) * (1.f / 16384.f);
      ex[t] = __expf(-d); sum += ex[t];
    }
    const float isum = 1.f / sum;
    if (hh == 0) {
      int* ip = p.idx + (size_t)row * 128 + h * 16;
      float* gp = p.gw + (size_t)row * 128 + h * 16;
#pragma unroll
      for (int t4 = 0; t4 < 4; ++t4) {
        u32x4 e0 = {ev[4 * t4], ev[4 * t4 + 1], ev[4 * t4 + 2], ev[4 * t4 + 3]};
        f32x4 g0 = {ex[4 * t4] * isum, ex[4 * t4 + 1] * isum, ex[4 * t4 + 2] * isum, ex[4 * t4 + 3] * isum};
        *(u32x4*)(ip + 4 * t4) = e0;
        *(f32x4*)(gp + 4 * t4) = g0;
      }
    }
  }
}

__device__ __forceinline__ void phase_gather(const Params& p, int layer, int nrows, float oscale) {
  const int lane = tidx() & 63, wv = tidx() >> 6;
  const bf16_t* U = p.uv; const bf16_t* V = p.uv + (size_t)16384 * 1024;
  for (int row = bidx() * 4 + wv; row < nrows; row += gridDim.x * 4) {
    float xv[16], acc[16];
    {
      u32x4 a = *(const u32x4*)(p.h + (size_t)row * DM + lane * 8), b = *(const u32x4*)(p.h + (size_t)row * DM + 512 + lane * 8);
#pragma unroll
      for (int e = 0; e < 4; ++e) {
        xv[2 * e] = __uint_as_float(a[e] << 16); xv[2 * e + 1] = __uint_as_float(a[e] & 0xffff0000u);
        xv[8 + 2 * e] = __uint_as_float(b[e] << 16); xv[8 + 2 * e + 1] = __uint_as_float(b[e] & 0xffff0000u);
      }
    }
#pragma unroll
    for (int i = 0; i < 16; ++i) acc[i] = 0.f;
    int myidx0 = p.idx[(size_t)row * 128 + lane], myidx1 = p.idx[(size_t)row * 128 + 64 + lane];
    float myg0 = p.gw[(size_t)row * 128 + lane], myg1 = p.gw[(size_t)row * 128 + 64 + lane];
    for (int k = 0; k < 128; ++k) {
      int e_ = k < 64 ? __shfl(myidx0, k) : __shfl(myidx1, k - 64);
      float g_ = k < 64 ? __shfl(myg0, k) : __shfl(myg1, k - 64);
      e_ = __builtin_amdgcn_readfirstlane(e_);
#if DIAG_HP
      const float* ur = p.peer_u + ((size_t)layer * 16384 + e_) * DM; const float* vr = p.peer_v + ((size_t)layer * 16384 + e_) * DM;
      f32x4 u0 = *(const f32x4*)(ur + lane * 8), u1 = *(const f32x4*)(ur + lane * 8 + 4), u2 = *(const f32x4*)(ur + 512 + lane * 8), u3 = *(const f32x4*)(ur + 512 + lane * 8 + 4);
      f32x4 v0 = *(const f32x4*)(vr + lane * 8), v1 = *(const f32x4*)(vr + lane * 8 + 4), v2 = *(const f32x4*)(vr + 512 + lane * 8), v3 = *(const f32x4*)(vr + 512 + lane * 8 + 4);
      float dot = 0.f;
#pragma unroll
      for (int e = 0; e < 4; ++e) dot += xv[e] * u0[e] + xv[4 + e] * u1[e] + xv[8 + e] * u2[e] + xv[12 + e] * u3[e];
      dot = wave_sum(dot);
      float w = g_ * gelu_tanh(dot);
#pragma unroll
      for (int e = 0; e < 4; ++e) { acc[e] += w * v0[e]; acc[4 + e] += w * v1[e]; acc[8 + e] += w * v2[e]; acc[12 + e] += w * v3[e]; }
#else
      const bf16_t* ur = U + (size_t)e_ * DM; const bf16_t* vr = V + (size_t)e_ * DM;
      u32x4 ua = *(const u32x4*)(ur + lane * 8), ub = *(const u32x4*)(ur + 512 + lane * 8);
      u32x4 va = *(const u32x4*)(vr + lane * 8), vb = *(const u32x4*)(vr + 512 + lane * 8);
      float dot = 0.f;
#pragma unroll
      for (int e = 0; e < 4; ++e) {
        dot += xv[2 * e] * __uint_as_float(ua[e] << 16) + xv[2 * e + 1] * __uint_as_float(ua[e] & 0xffff0000u);
        dot += xv[8 + 2 * e] * __uint_as_float(ub[e] << 16) + xv[8 + 2 * e + 1] * __uint_as_float(ub[e] & 0xffff0000u);
      }
      dot = wave_sum(dot);
      float w = PEER_ALPHA * oscale * g_ * gelu_tanh(dot);
#pragma unroll
      for (int e = 0; e < 4; ++e) {
        acc[2 * e] += w * __uint_as_float(va[e] << 16); acc[2 * e + 1] += w * __uint_as_float(va[e] & 0xffff0000u);
        acc[8 + 2 * e] += w * __uint_as_float(vb[e] << 16); acc[8 + 2 * e + 1] += w * __uint_as_float(vb[e] & 0xffff0000u);
      }
#endif
    }
    float* xr = xrow(p, row);
    const float* g2 = p.mod + (size_t)(layer * 3 + modrow(row)) * 6144 + 5 * DM;
#pragma unroll
    for (int hh = 0; hh < 2; ++hh) {
      int c0 = hh * 512 + lane * 8;
      f32x4 x0 = *(const f32x4*)(xr + c0), x1 = *(const f32x4*)(xr + c0 + 4);
      f32x4 ga = *(const f32x4*)(g2 + c0), gb = *(const f32x4*)(g2 + c0 + 4);
#pragma unroll
      for (int e = 0; e < 4; ++e) { x0[e] += ga[e] * acc[hh * 8 + e]; x1[e] += gb[e] * acc[hh * 8 + 4 + e]; }
      *(f32x4*)(xr + c0) = x0; *(f32x4*)(xr + c0 + 4) = x1;
    }
  }
}


__device__ __forceinline__ void phase_mix1(const Params& p, int layer, int with_ctx_queries) {
  const bool fast = attn_logit_bound(p, layer) <= 40.f;
  const int natt = fast ? 512 + (with_ctx_queries ? 16 : 0) : 1024 + (with_ctx_queries ? 32 : 0);
  const int G = gridDim.x, b_ = bidx();
  for (int item = b_; item < natt; item += G) { for (int r = 0; r < REP_ATT; ++r) { if (fast) attn_item64(p, layer, item); else attn_item(p, layer, item); } }
  int b1 = b_ - natt % G; if (b1 < 0) b1 += G;
  for (int it = b1; it < 528; it += G) { for (int r = 0; r < REP_MLA; ++r) mlA_item(p, layer, it); }
  const int nextra = 528 % G;
  const int first = (nextra * 2 < G) ? nextra : 0, span = G - first;
  if (b1 >= first)
    for (int it = b1 - first; it < 1056; it += span) { for (int r = 0; r < REP_SSDA; ++r) ssdA_item(p, layer, it); }
}
__device__ __forceinline__ void phase_mix3(const Params& p, int layer, int last) {
  const int nc = last ? 64 : 66, G = gridDim.x, b_ = bidx();
  const int nml = 2 * nc * 4, nssd = 2 * nc * 8;
  for (int it = b_; it < nml; it += G) {
    const int b = it / (nc * 4), c = (it / 4) % nc, h = it & 3;
    for (int r = 0; r < REP_MLC; ++r) mlC_item(p, layer, (b * 66 + c) * 4 + h);
  }
  const int nextra = nml % G;
  const int first = (nextra * 2 < G) ? nextra : 0, span = G - first;
  if (b_ >= first)
    for (int it = b_ - first; it < nssd; it += span) {
      const int b = it / (nc * 8), c = (it / 8) % nc, h = it & 7;
      for (int r = 0; r < REP_SSDC; ++r) ssdC_item(p, layer, (b * 66 + c) * 8 + h);
    }
}


#define XB_TMO      128
#define XB_XCNT(j)  (256  + 64 * (j))
#define XB_XSUB(j)  (1280 + 64 * (j))
#define XB_XGEN(j)  (2304 + 64 * (j))
#define XB_TOP      3328
#define XB_TOPGEN   3392
#define XCD_BAR_WORDS 3456
#define XB_SPIN_CAP (1u << 18)
#define LAS __attribute__((address_space(3)))
__device__ __forceinline__ unsigned xb_ld(unsigned* p)              { return __hip_atomic_load(p, __ATOMIC_RELAXED, __HIP_MEMORY_SCOPE_AGENT); }
__device__ __forceinline__ unsigned xb_add(unsigned* p, unsigned v) { return __hip_atomic_fetch_add(p, v, __ATOMIC_RELAXED, __HIP_MEMORY_SCOPE_AGENT); }
__device__ __forceinline__ unsigned xb_xcc_id() { return (unsigned)__builtin_amdgcn_s_getreg((3 << 11) | 20) & 0xFu; }
#define XB_SPIN(cond, bar) do { unsigned _sp = 0; while (cond) { __builtin_amdgcn_s_sleep(1); \
    if ((++_sp & 255u) == 0u) { if (xb_ld(&(bar)[XB_TMO])) break; if (_sp > XB_SPIN_CAP) { atomicAdd(&(bar)[XB_TMO], 1u); break; } } } } while (0)
struct XcdBarrier { unsigned* bar; unsigned x; volatile LAS unsigned* st; };
__device__ __forceinline__ XcdBarrier xcd_barrier_post(unsigned* bar, volatile LAS unsigned* st) {
    XcdBarrier b; b.bar = bar; b.x = xb_xcc_id(); b.st = st;
    if (threadIdx.x == 0) (void)xb_add(&bar[XB_XCNT(b.x)], 1u);
    return b;
}
__device__ __forceinline__ void xcd_barrier_complete(unsigned* bar, unsigned x, unsigned& nloc, unsigned& nx) {
    const unsigned G = gridDim.x * gridDim.y * gridDim.z;
    unsigned sum, cnt, mine, sp = 0u;
    for (;;) {
        sum = 0u; cnt = 0u; mine = 0u;
#pragma unroll
        for (unsigned j = 0; j < 16; ++j) { const unsigned c = xb_ld(&bar[XB_XCNT(j)]); sum += c; cnt += (c > 0u) ? 1u : 0u; mine = (j == x) ? c : mine; }
        if (sum == G) break;
        __builtin_amdgcn_s_sleep(1);
        if ((++sp & 255u) == 0u) { if (xb_ld(&bar[XB_TMO])) break; if (sp > XB_SPIN_CAP) { atomicAdd(&bar[XB_TMO], 1u); break; } }
    }
    nloc = mine > 0u ? mine : 1u; nx = cnt > 0u ? cnt : 1u;
}
__device__ __forceinline__ void xcd_barrier(const XcdBarrier& b) {
    asm volatile("s_waitcnt vmcnt(0)" ::: "memory");
    __syncthreads();
    if (threadIdx.x == 0) {
        unsigned* bar = b.bar;
        __builtin_amdgcn_s_waitcnt(0);
        unsigned nloc = b.st[0], nx = b.st[1];
        if (nloc == 0u) { xcd_barrier_complete(bar, b.x, nloc, nx); b.st[0] = nloc; b.st[1] = nx; }
        const unsigned old = xb_add(&bar[XB_XSUB(b.x)], 1u);
        const unsigned gen = old / nloc;
        if (old + 1u == (gen + 1u) * nloc) {
            __builtin_amdgcn_fence(__ATOMIC_RELEASE, "agent");
            asm volatile("s_waitcnt vmcnt(0)" ::: "memory");
            const unsigned og = xb_add(&bar[XB_TOP], 1u);
            const unsigned tg = og / nx;
            if (og + 1u == (tg + 1u) * nx) xb_add(&bar[XB_TOPGEN], 1u);
            else XB_SPIN(xb_ld(&bar[XB_TOPGEN]) == tg, bar);
            __builtin_amdgcn_fence(__ATOMIC_ACQUIRE, "agent");
            xb_add(&bar[XB_XGEN(b.x)], 1u);
            asm volatile("s_waitcnt vmcnt(0)" ::: "memory");
        } else {
            XB_SPIN(xb_ld(&bar[XB_XGEN(b.x)]) == gen, bar);
            __builtin_amdgcn_fence(__ATOMIC_ACQUIRE, "agent");
            asm volatile("s_waitcnt vmcnt(0)" ::: "memory");
        }
    }
    __syncthreads();
}

#ifndef REP_GEMM
#define REP_GEMM 1
#endif

#ifndef REP_MIX
#define REP_MIX 1
#endif
#ifndef REP_PV
#define REP_PV 1
#endif
#ifndef REP_PEER
#define REP_PEER 1
#endif
#ifndef REP_ELEM
#define REP_ELEM 1
#endif
#ifndef REP_SYNC
#define REP_SYNC 1
#endif
#ifndef REP_TOPK
#define REP_TOPK 1
#endif
#define GSYNC() do { for (int r_ = 0; r_ < REP_SYNC; ++r_) xcd_barrier(xb); } while (0)
__global__ void __launch_bounds__(256, 2) k_mega(Params p) {
  cg::grid_group grid = cg::this_grid();
  volatile LAS unsigned* xst = (volatile LAS unsigned*)(smem + LDS_BYTES - 16);
  if (threadIdx.x == 0) { xst[0] = 0u; xst[1] = 0u; }
  __syncthreads();
  XcdBarrier xb = xcd_barrier_post(p.bar, xst);
  for (int r = 0; r < REP_INIT; ++r) phase_init(p);
  if (p.bar == nullptr) grid.sync();
  GSYNC();
  for (int layer = 0; layer < 2; ++layer) {
    const int last = layer == 1;
    const int nrows2 = last ? NLAT : MROWS;
    if (layer == 0 || DIAG_HP) { for (int r = 0; r < REP_NORM; ++r) phase_norm(p, layer, 1, MROWS, layer == 0); GSYNC(); }
    for (int r = 0; r < REP_GEMM * REP_G_IN; ++r) phase_inproj(p, layer, MROWS, DIAG_HP ? 0 : 2);
    GSYNC();
    for (int r = 0; r < REP_SPREP; ++r) { phase_ssdprep(p, layer); phase_vtrans(p); }
    GSYNC();
    for (int r = 0; r < REP_MIX; ++r) phase_mix1(p, layer, !last);
    GSYNC();
    phase_ssdcarry(p); phase_mlcarry(p); GSYNC();
    for (int r = 0; r < REP_MIX; ++r) phase_mix3(p, layer, last);
    GSYNC();
    for (int r = 0; r < REP_SOUT; ++r) { phase_ssdout(p, layer, nrows2); phase_mlout(p, layer, nrows2); }
    GSYNC();
#if DIAG_HP
    for (int r = 0; r < REP_GEMM * REP_G_GATE; ++r) phase_inproj(p, layer, nrows2, 1);
    GSYNC();
#endif
    for (int r = 0; r < REP_GEMM * REP_G_MERGE; ++r) phase_merge(p, layer, nrows2);
    GSYNC();
    for (int r = 0; r < REP_GEMM * REP_G_OUT; ++r) phase_outproj(p, layer, nrows2, r == 0 ? 1.f : 0.f, (layer == 0 && r == 0) ? 1 : 0);
    GSYNC();
    for (int r = 0; r < REP_NORM; ++r) phase_norm(p, layer, 2, nrows2, 0);
    GSYNC();
    for (int r = 0; r < REP_GEMM * REP_G_WQ; ++r) phase_wq(p, layer, nrows2);
#if !DIAG_HP
    for (int r = 0; r < REP_UVC; ++r) phase_uvconv8(p, layer);
#endif
    GSYNC();
    for (int r = 0; r < REP_TOPK; ++r) { if (DIAG_HP) phase_topk(p, layer, nrows2); else phase_topk2(p, layer, nrows2); }
    GSYNC();
#if DIAG_HP
    phase_gather(p, layer, nrows2, 1.f);
    if (!last) { GSYNC(); phase_norm(p, layer + 1, 1, nrows2, 0); GSYNC(); }
#else
    for (int r = 0; r < REP_PEER; ++r) phase_gatherU(p, layer, nrows2);
    GSYNC();
    for (int r = 0; r < REP_PV; ++r) phase_gatherV(p, layer, nrows2, r == 0 ? 1.f : 0.f);
    if (!last) { GSYNC(); phase_norm(p, layer + 1, 1, nrows2, 0); GSYNC(); }
#endif
  }
}

extern "C" void kernel_launch(void* const* d_in, const int* in_sizes, int n_in, void* d_out, int out_size, void* d_ws, size_t ws_size,
                              hipStream_t stream) {
  Params p{};
  const float* const* in = (const float* const*)d_in;
  p.x = in[0]; p.c = in[1]; p.ctx = in[2]; p.c_ctx = in[3]; p.norm1_g = in[4]; p.norm2_g = in[5]; p.w_mod = in[6]; p.b_mod = in[7];
  p.w_in = in[8]; p.att_qnorm = in[9]; p.att_knorm = in[10]; p.ssd_conv_w = in[11]; p.ssd_conv_b = in[12]; p.ssd_dt_bias = in[13];
  p.ssd_a_log = in[14]; p.ssd_d = in[15]; p.ssd_norm = in[16]; p.ml_gate_bias = in[17]; p.ml_norm = in[18]; p.w_branch = in[19];
  p.w_out = in[20]; p.peer_wq = in[21]; p.peer_subkeys = in[22]; p.peer_u = in[23]; p.peer_v = in[24];
  p.out = (float*)d_out;
  char* w = (char*)d_ws; size_t off = 65536;
  p.bar = (unsigned*)d_ws;
  auto take = [&](size_t bytes) { char* r = w + off; off += (bytes + 255) & ~(size_t)255; return r; };
  p.mod = (float*)take((size_t)2 * 3 * 6144 * 4);
  p.xc = (float*)take((size_t)NCTX * DM * 4);
  p.small = (float*)take((size_t)MROWS * 32 * 4);
  p.dtb = (float*)take((size_t)MROWS * 16 * 4);
  p.wt_in = (bf16_t*)take((size_t)2 * INCP * DM * 2);
  p.wt_br = (bf16_t*)take((size_t)2 * 3 * DM * 512 * 2);
  p.wt_out = (bf16_t*)take((size_t)2 * DM * DM * 2);
  p.wt_q = (bf16_t*)take((size_t)2 * 2048 * DM * 2);
  p.sk = (bf16_t*)take((size_t)2 * 8 * 2 * 128 * 128 * 2);
  p.wt_q_lo = (bf16_t*)take(DIAG_HP ? (size_t)2 * 2048 * DM * 2 : 256);
  p.vt = (bf16_t*)take((size_t)4 * 64 * 8448 * 2);
  p.ropec = (float*)take((size_t)8192 * 32 * 4);
  p.ropes = (float*)take((size_t)8192 * 32 * 4);
  p.ssl = (bf16_t*)take((size_t)32 * 66 * 4096 * 2);
  p.sdec = (float*)take((size_t)32 * 66 * 4);
  p.mcl = (bf16_t*)take((size_t)16 * 66 * 16384 * 2);
  p.mnl = (float*)take((size_t)16 * 66 * 128 * 4);
  p.mml = (float*)take((size_t)16 * 66 * 4);
  p.mbl = (float*)take((size_t)16 * 66 * 4);
  p.mmp = (float*)take((size_t)16 * 66 * 4);
  p.h = (bf16_t*)take((size_t)MROWS * DM * 2);
  p.br = (bf16_t*)take((size_t)MROWS * 1536 * 2);
  p.xbc = (bf16_t*)take((size_t)MROWS * 768 * 2);
  p.idx = (int*)p.xbc; p.gw = (float*)((char*)p.xbc + (size_t)MROWS * 128 * 4);
  p.yf = (bf16_t*)take((size_t)MROWS * 512 * 2);
  p.yb = (bf16_t*)take((size_t)MROWS * 512 * 2);
  p.hf = (bf16_t*)take((size_t)MROWS * 512 * 2);
  p.hb = p.hf;
  p.gp8 = (unsigned char*)take((size_t)MROWS * 3072);
  p.mix = p.yf;
  p.proj = (bf16_t*)take((size_t)MROWS * 4096 * 2);
  p.uvs = (float*)take((size_t)2 * 16384 * 4);
  p.gp = p.proj; p.q = p.proj; p.qf = (float*)p.proj; p.h2lo = p.br; p.uv = (bf16_t*)((char*)p.proj + (size_t)MROWS * 2048 * 2); p.uvq = (unsigned char*)p.uv;
  p.xq = (signed char*)p.br; p.sxq = (float*)((char*)p.br + (size_t)MROWS * DM); p.wbuf = (float*)((char*)p.br + (size_t)MROWS * DM + (size_t)MROWS * 4);
  if (off > ws_size) return;

  const int LDS = LDS_BYTES;
  static int grid_blocks = 0;
  if (!grid_blocks) {
    (void)hipFuncSetAttribute((const void*)k_mega, hipFuncAttributeMaxDynamicSharedMemorySize, LDS);
    int dev = 0, cus = 0, per_cu = 0;
    (void)hipGetDevice(&dev);
    (void)hipDeviceGetAttribute(&cus, hipDeviceAttributeMultiprocessorCount, dev);
    (void)hipOccupancyMaxActiveBlocksPerMultiprocessor(&per_cu, (const void*)k_mega, 256, LDS);
    if (per_cu < 1) per_cu = 1;
    if (per_cu > 2) per_cu = 2;
    grid_blocks = cus * per_cu;
  }
  (void)hipMemsetAsync(d_ws, 0, XCD_BAR_WORDS * 4, stream);
  void* args[] = {&p};
  hipError_t e = hipLaunchCooperativeKernel((const void*)k_mega, dim3(grid_blocks), dim3(256), args, LDS, stream);
  if (e != hipSuccess) fprintf(stderr, "cooperative launch failed: %s (grid %d)\n", hipGetErrorString(e), grid_blocks);
}
```

```cpp
#include <hip/hip_runtime.h>
#include <hip/hip_cooperative_groups.h>
#include <stdint.h>
#include <stdio.h>
namespace cg = cooperative_groups;

typedef unsigned short bf16_t;
typedef short bf16x8 __attribute__((ext_vector_type(8)));
typedef float f32x4 __attribute__((ext_vector_type(4)));
typedef unsigned u32x4 __attribute__((ext_vector_type(4)));
typedef unsigned u32x2 __attribute__((ext_vector_type(2)));
typedef float f32x16 __attribute__((ext_vector_type(16)));

constexpr int SEQ = 8192, BATCH = 2, CTXL = 256, DM = 1024;
constexpr int NLAT = BATCH * SEQ;
constexpr int NCTX = BATCH * CTXL;
constexpr int MROWS = NLAT + NCTX;
constexpr int INC = 7200, INCP = 7296;
constexpr int NTHR = 256;

#ifndef DIAG_HP
#define DIAG_HP 0
#endif
#define REP_INIT 1
#define REP_NORM 1
#define REP_SPREP 1
#define REP_SOUT 1
#define REP_UVC 1
#define REP_QK 1
#define REP_KCOMP 1
#define REP_KSTG 1
#define REP_G_IN 1
#define REP_G_GATE 1
#define REP_G_MERGE 1
#define REP_G_OUT 1
#define REP_G_WQ 1
#define REP_STG 1
#define REP_EXP 1
#define REP_MLA 1
#define REP_SSDA 1
#define REP_ATT 1
#define REP_MLC 1
#define REP_SSDC 1
#ifndef ATT_ALPHA
#define ATT_ALPHA 1.f
#endif
#ifndef ATT_NAIVE
#define ATT_NAIVE 0
#endif
#ifndef ATT_TAU
#define ATT_TAU 1.f
#endif
#ifndef PEER_ALPHA
#define PEER_ALPHA 1.f
#endif
#define LDS_BYTES (DIAG_HP ? 140 * 1024 : 78 * 1024)
extern __shared__ __attribute__((aligned(16))) char smem[];

struct Params {
  const float *x, *c, *ctx, *c_ctx, *norm1_g, *norm2_g, *w_mod, *b_mod, *w_in, *att_qnorm, *att_knorm,
      *ssd_conv_w, *ssd_conv_b, *ssd_dt_bias, *ssd_a_log, *ssd_d, *ssd_norm, *ml_gate_bias, *ml_norm,
      *w_branch, *w_out, *peer_wq, *peer_subkeys, *peer_u, *peer_v;
  float* out;
  unsigned* bar;
  float* mod;
  float* xc;
  float* small;
  float* dtb;
  bf16_t *wt_in, *wt_br, *wt_out, *wt_q, *sk;
  bf16_t* h;
  bf16_t* br;
  bf16_t* xbc;
  bf16_t *yf, *yb, *hf, *hb;
  bf16_t* mix;
  bf16_t* proj;
  bf16_t* gp;
  unsigned char* gp8;
  bf16_t* q;
  bf16_t* uv;
  unsigned char* uvq;
  float* uvs;
  signed char* xq;
  float* sxq;
  float* wbuf;
  int* idx;
  float* gw;
  bf16_t* h2lo;
  bf16_t* wt_q_lo;
  float* qf;
  bf16_t* vt;
  float* ropec;
  float* ropes;
  bf16_t* ssl;
  float* sdec;
  bf16_t* mcl;
  float* mnl;
  float* mml;
  float* mbl;
  float* mmp;
};

__device__ __forceinline__ int tidx() { int t = __builtin_amdgcn_workitem_id_x(); asm volatile("" : "+v"(t)); return t; }
__device__ __forceinline__ int bidx() { int t = __builtin_amdgcn_workgroup_id_x(); asm volatile("" : "+s"(t)); return t; }
__device__ __forceinline__ float bf2f(bf16_t v) { return __uint_as_float(((unsigned)v) << 16); }
__device__ __forceinline__ bf16_t f2bf(float f) {
  unsigned u = __float_as_uint(f);
  u += 0x7fffu + ((u >> 16) & 1u);
  return (bf16_t)(u >> 16);
}
typedef float f32x2 __attribute__((ext_vector_type(2)));
typedef int i32x4 __attribute__((ext_vector_type(4)));
typedef __bf16 bf16x2n __attribute__((ext_vector_type(2)));
__device__ __forceinline__ unsigned pack2(float a, float b) {
  f32x2 v = {a, b};
  bf16x2n r = __builtin_convertvector(v, bf16x2n);
  return *(unsigned*)&r;
}
__device__ __forceinline__ float sigmoidf_(float x) { return 1.f / (1.f + __expf(-x)); }
__device__ __forceinline__ float siluf_(float x) { return x / (1.f + __expf(-x)); }
__device__ __forceinline__ float softplusf_(float x) { return x > 20.f ? x : log1pf(__expf(x)); }
__device__ __forceinline__ float logsigmoidf_(float x) { return x < 0.f ? x - log1pf(__expf(x)) : -log1pf(__expf(-x)); }
__device__ __forceinline__ float gelu_tanh(float x) {
  float u = 0.7978845608028654f * (x + 0.044715f * x * x * x);
  float t = 1.f - 2.f / (1.f + __expf(2.f * u));
  return 0.5f * x * (1.f + t);
}
__device__ __forceinline__ float ub0(unsigned v) { return (float)(v & 0xffu); }
__device__ __forceinline__ float ub1(unsigned v) { return (float)((v >> 8) & 0xffu); }
__device__ __forceinline__ float ub2(unsigned v) { return (float)((v >> 16) & 0xffu); }
__device__ __forceinline__ float ub3(unsigned v) { return (float)(v >> 24); }
__device__ __forceinline__ float* xrow(const Params& p, int row) {
  return row < NLAT ? p.out + (size_t)row * DM : p.xc + (size_t)(row - NLAT) * DM;
}
__device__ __forceinline__ const float* xrow_src(const Params& p, int row, int from_input) {
  if (from_input) return row < NLAT ? p.x + (size_t)row * DM : p.ctx + (size_t)(row - NLAT) * DM;
  return row < NLAT ? p.out + (size_t)row * DM : p.xc + (size_t)(row - NLAT) * DM;
}
__device__ __forceinline__ int modrow(int row) { return row < NLAT ? row / SEQ : 2; }
__device__ __forceinline__ float wave_sum(float v) {
#pragma unroll
  for (int o = 32; o > 0; o >>= 1) v += __shfl_xor(v, o);
  return v;
}
__device__ __forceinline__ float wave_max(float v) {
#pragma unroll
  for (int o = 32; o > 0; o >>= 1) v = fmaxf(v, __shfl_xor(v, o));
  return v;
}

__device__ __forceinline__ int win_colmap(int n) {
  if (n < 2048) return n;
  if (n < 4096) return n + 16;
  if (n < 7168) return n + 32;
  if (n < 7184) return n - 5120;
  if (n < 7200) return n - 3072;
  return -1;
}

__device__ __forceinline__ void transpose_tile(const float* src, int Nsrc, int K, bf16_t* dst, int n0, int k0, int mode, bf16_t* dstlo = nullptr) {
  float* tile = (float*)smem;
  const int tid = tidx();
  {
    const int n4 = (tid & 15) * 4;
    int sc = n0 + n4;
    if (mode == 1) sc = win_colmap(sc);
#pragma unroll
    for (int i = 0; i < 4; ++i) {
      const int kk = (tid >> 4) + 16 * i;
      f32x4 v = sc >= 0 ? *(const f32x4*)(src + (size_t)(k0 + kk) * Nsrc + sc) : (f32x4){0.f, 0.f, 0.f, 0.f};
      tile[kk * 65 + n4] = v[0]; tile[kk * 65 + n4 + 1] = v[1]; tile[kk * 65 + n4 + 2] = v[2]; tile[kk * 65 + n4 + 3] = v[3];
    }
  }
  __syncthreads();
  {
    const int n = tid >> 2, kc = (tid & 3) * 16;
    float t[16];
#pragma unroll
    for (int e = 0; e < 16; ++e) t[e] = tile[(kc + e) * 65 + n];
    u32x4 w0, w1;
#pragma unroll
    for (int e = 0; e < 4; ++e) { w0[e] = pack2(t[2 * e], t[2 * e + 1]); w1[e] = pack2(t[8 + 2 * e], t[8 + 2 * e + 1]); }
    bf16_t* d = dst + (size_t)(n0 + n) * K + k0 + kc;
    *(u32x4*)d = w0; *(u32x4*)(d + 8) = w1;
    if (dstlo) {
      u32x4 l0, l1;
#pragma unroll
      for (int e = 0; e < 4; ++e) {
        l0[e] = pack2(t[2 * e] - __uint_as_float(w0[e] << 16), t[2 * e + 1] - __uint_as_float(w0[e] & 0xffff0000u));
        l1[e] = pack2(t[8 + 2 * e] - __uint_as_float(w1[e] << 16), t[8 + 2 * e + 1] - __uint_as_float(w1[e] & 0xffff0000u));
      }
      bf16_t* dl = dstlo + (size_t)(n0 + n) * K + k0 + kc;
      *(u32x4*)dl = l0; *(u32x4*)(dl + 8) = l1;
    }
  }
  __syncthreads();
}

__device__ __forceinline__ void phase_init(const Params& p) {
  const int tid = tidx(), bid = bidx(), nb = gridDim.x;
  for (int i = bid * NTHR + tid; i < 8192 * 32; i += nb * NTHR) {
    int pos = i >> 5, jj = i & 31;
    float inv = powf(10000.f, -(float)(jj & 15) / 16.f);
    float ang = (float)(jj < 16 ? (pos >> 6) : (pos & 63)) * inv;
    float sn, cs_; sincosf(ang, &sn, &cs_);
    p.ropec[i] = cs_; p.ropes[i] = sn;
  }
  for (size_t i = (size_t)bid * NTHR + tid; i < (size_t)2 * 8 * 2 * 128 * 128; i += (size_t)nb * NTHR) p.sk[i] = f2bf(p.peer_subkeys[i]);
  {
    const int per_layer = 1824 + 384 + 256 + 512;
    for (int job = bid; job < 2 * per_layer; job += nb) {
      int l = job / per_layer, j = job % per_layer;
      if (j < 1824) {
        int nt = j / 16, kt = j % 16;
        transpose_tile(p.w_in + (size_t)l * DM * INC, INC, DM, p.wt_in + (size_t)l * INCP * DM, nt * 64, kt * 64, 1);
      } else if (j < 1824 + 384) {
        j -= 1824; int r = j / 128; j %= 128; int nt = j / 8, kt = j % 8;
        transpose_tile(p.w_branch + ((size_t)l * 3 + r) * 512 * DM, DM, 512, p.wt_br + ((size_t)l * 3 + r) * DM * 512, nt * 64, kt * 64, 0);
      } else if (j < 1824 + 384 + 256) {
        j -= 1824 + 384; int nt = j / 16, kt = j % 16;
        transpose_tile(p.w_out + (size_t)l * DM * DM, DM, DM, p.wt_out + (size_t)l * DM * DM, nt * 64, kt * 64, 0);
      } else {
        j -= 1824 + 384 + 256; int nt = j / 16, kt = j % 16;
        transpose_tile(p.peer_wq + (size_t)l * DM * 2048, 2048, DM, p.wt_q + (size_t)l * 2048 * DM, nt * 64, kt * 64, 0, DIAG_HP ? p.wt_q_lo + (size_t)l * 2048 * DM : nullptr);
      }
    }
  }
  {
    float* sl = (float*)smem;
    float* part = sl + 3 * DM;
    bool loaded = false;
    for (int blk = bid; blk < 192; blk += nb) {
      if (!loaded) {
        __syncthreads();
        for (int i = tid; i < 3 * DM; i += NTHR) {
          float v = i < 2 * DM ? p.c[i] : p.c_ctx[i - 2 * DM];
          sl[i] = siluf_(v);
        }
        loaded = true;
      }
      __syncthreads();
      const int wv = tid >> 6, ln = tid & 63;
      const int gi = blk * 64 + ln;
      const int l = gi / 6144, col = gi % 6144;
      const float* w = p.w_mod + (size_t)l * DM * 6144 + col;
      float a0 = 0.f, a1 = 0.f, a2 = 0.f;
#pragma unroll 8
      for (int k = wv * 256; k < wv * 256 + 256; ++k) {
        float wv_ = w[(size_t)k * 6144];
        a0 += sl[k] * wv_; a1 += sl[DM + k] * wv_; a2 += sl[2 * DM + k] * wv_;
      }
      part[(wv * 3 + 0) * 64 + ln] = a0; part[(wv * 3 + 1) * 64 + ln] = a1; part[(wv * 3 + 2) * 64 + ln] = a2;
      __syncthreads();
      if (tid < 192) {
        const int r = tid >> 6;
        float s = part[(0 * 3 + r) * 64 + ln] + part[(1 * 3 + r) * 64 + ln] + part[(2 * 3 + r) * 64 + ln] + part[(3 * 3 + r) * 64 + ln];
        p.mod[(l * 3 + r) * 6144 + col] = s + p.b_mod[l * 6144 + col];
      }
    }
  }
}

__device__ __forceinline__ void phase_norm(const Params& p, int layer, int which, int nrows, int from_input) {
  const int lane = tidx() & 63, wv = tidx() >> 6;
  const float* g = (which == 1 ? p.norm1_g : p.norm2_g) + layer * DM;
  const int sh_off = which == 1 ? 0 : 3 * DM, sc_off = which == 1 ? DM : 4 * DM;
  int curm = -1;
  f32x4 Ar[4], Br[4];
  for (int row = bidx() * 4 + wv; row < nrows; row += gridDim.x * 4) {
    const float* xr = xrow_src(p, row, from_input);
    const int mr = modrow(row);
    if (mr != curm) {
      const float* md = p.mod + (size_t)(layer * 3 + mr) * 6144;
#pragma unroll
      for (int j = 0; j < 4; ++j) {
        int c0 = j * 256 + lane * 4;
        f32x4 gg = *(const f32x4*)(g + c0), sc = *(const f32x4*)(md + sc_off + c0);
        Br[j] = *(const f32x4*)(md + sh_off + c0);
#pragma unroll
        for (int e = 0; e < 4; ++e) Ar[j][e] = gg[e] * (1.f + sc[e]);
      }
      curm = mr;
    }
    f32x4 v[4]; float ss = 0.f;
#pragma unroll
    for (int j = 0; j < 4; ++j) {
      v[j] = *(const f32x4*)(xr + j * 256 + lane * 4);
      ss += v[j][0] * v[j][0] + v[j][1] * v[j][1] + v[j][2] * v[j][2] + v[j][3] * v[j][3];
    }
    ss = wave_sum(ss);
    float rs = rsqrtf(ss * (1.f / DM) + 1e-6f);
#pragma unroll
    for (int j = 0; j < 4; ++j) {
      int c0 = j * 256 + lane * 4;
      float o0 = v[j][0] * rs * Ar[j][0] + Br[j][0];
      float o1 = v[j][1] * rs * Ar[j][1] + Br[j][1];
      float o2 = v[j][2] * rs * Ar[j][2] + Br[j][2];
      float o3 = v[j][3] * rs * Ar[j][3] + Br[j][3];
      u32x2 w; w.x = pack2(o0, o1); w.y = pack2(o2, o3);
      *(u32x2*)(p.h + (size_t)row * DM + c0) = w;
      v[j][0] = o0; v[j][1] = o1; v[j][2] = o2; v[j][3] = o3;
#if DIAG_HP
      if (which == 2) {
        u32x2 wl; wl.x = pack2(o0 - __uint_as_float(w.x << 16), o1 - __uint_as_float(w.x & 0xffff0000u));
        wl.y = pack2(o2 - __uint_as_float(w.y << 16), o3 - __uint_as_float(w.y & 0xffff0000u));
        *(u32x2*)(p.h2lo + (size_t)row * DM + c0) = wl;
      }
#endif
    }
    if (which == 2) {
      float am = 0.f;
#pragma unroll
      for (int j = 0; j < 4; ++j) am = fmaxf(fmaxf(fmaxf(am, fabsf(v[j][0])), fmaxf(fabsf(v[j][1]), fabsf(v[j][2]))), fabsf(v[j][3]));
      am = wave_max(am);
      const float sc8 = am > 0.f ? am * (1.f / 127.f) : 1.f, inv8 = 1.f / sc8;
#pragma unroll
      for (int j = 0; j < 4; ++j) {
        unsigned q = 0;
#pragma unroll
        for (int e = 0; e < 4; ++e) {
          int t = (int)rintf(v[j][e] * inv8);
          t = t < -127 ? -127 : (t > 127 ? 127 : t);
          q |= (unsigned)(t & 0xff) << (8 * e);
        }
        *(unsigned*)(p.xq + (size_t)row * DM + j * 256 + lane * 4) = q;
      }
      if (lane == 0) p.sxq[row] = sc8;
    }
  }
}

__device__ __forceinline__ void gemm_stage(const bf16_t* A, int lda, const bf16_t* Bt, int ldb, int brow, int bcol, int kt, char* buf, int tid) {
#pragma unroll
  for (int i = 0; i < 4; ++i) {
    const int b = (tid + 256 * i) * 16, r = b >> 7, c = ((b >> 4) & 7) ^ ((r >> 1) & 7);
    __builtin_amdgcn_global_load_lds((const unsigned*)(A + (size_t)(brow + r) * lda + kt + c * 8), (__attribute__((address_space(3))) unsigned*)(buf + b), 16, 0, 0);
    __builtin_amdgcn_global_load_lds((const unsigned*)(Bt + (size_t)(bcol + r) * ldb + kt + c * 8), (__attribute__((address_space(3))) unsigned*)(buf + 16384 + b), 16, 0, 0);
  }
}
__device__ __forceinline__ void gemm_compute(f32x4 (&acc)[4][4], const char* buf, int wr, int wc, int fr, int fq) {
#pragma unroll
  for (int ks = 0; ks < 2; ++ks) {
    bf16x8 At[4], Bl[4];
#pragma unroll
    for (int m = 0; m < 4; ++m) { const int row = wr * 64 + m * 16 + fr; At[m] = *(const bf16x8*)(buf + row * 128 + (((ks * 4 + fq) ^ ((row >> 1) & 7)) << 4)); }
#pragma unroll
    for (int n = 0; n < 4; ++n) { const int row = wc * 64 + n * 16 + fr; Bl[n] = *(const bf16x8*)(buf + 16384 + row * 128 + (((ks * 4 + fq) ^ ((row >> 1) & 7)) << 4)); }
    __builtin_amdgcn_s_setprio(1);
#pragma unroll
    for (int m = 0; m < 4; ++m)
#pragma unroll
      for (int n = 0; n < 4; ++n) acc[m][n] = __builtin_amdgcn_mfma_f32_16x16x32_bf16(Bl[n], At[m], acc[m][n], 0, 0, 0);
    __builtin_amdgcn_s_setprio(0);
  }
}
__device__ __forceinline__ void gemm_compute_h(f32x4 (&acc)[4][4], const char* buf, int wr, int wc, int fr, int fq) {
  bf16x8 At[2][4], Bl[2][4];
#pragma unroll
  for (int ks = 0; ks < 2; ++ks) {
#pragma unroll
    for (int m = 0; m < 4; ++m) { const int row = wr * 64 + m * 16 + fr; At[ks][m] = *(const bf16x8*)(buf + row * 128 + (((ks * 4 + fq) ^ ((row >> 1) & 7)) << 4)); }
#pragma unroll
    for (int n = 0; n < 4; ++n) { const int row = wc * 64 + n * 16 + fr; Bl[ks][n] = *(const bf16x8*)(buf + 16384 + row * 128 + (((ks * 4 + fq) ^ ((row >> 1) & 7)) << 4)); }
  }
  __builtin_amdgcn_s_setprio(1);
#pragma unroll
  for (int ks = 0; ks < 2; ++ks)
#pragma unroll
    for (int m = 0; m < 4; ++m)
#pragma unroll
      for (int n = 0; n < 4; ++n) acc[m][n] = __builtin_amdgcn_mfma_f32_16x16x32_bf16(Bl[ks][n], At[ks][m], acc[m][n], 0, 0, 0);
  __builtin_amdgcn_s_setprio(0);
}
template <bool HOIST = true>
__device__ __forceinline__ void gemm_kloop(f32x4 (&acc)[4][4], const bf16_t* A, int lda, const bf16_t* Bt, int ldb, int K, int brow, int bcol) {
  const int tid = tidx(), wid = tid >> 6, lane = tid & 63, wr = wid >> 1, wc = wid & 1, fr = lane & 15, fq = lane >> 4;
  const int nt = K >> 6;
  __syncthreads();
  gemm_stage(A, lda, Bt, ldb, brow, bcol, 0, smem, tid);
  asm volatile("s_waitcnt vmcnt(0)" ::: "memory");
  __syncthreads();
  for (int t = 0; t < nt - 1; ++t) {
    char* cur = smem + (t & 1) * 32768; char* nxt = smem + ((t + 1) & 1) * 32768;
    gemm_stage(A, lda, Bt, ldb, brow, bcol, (t + 1) * 64, nxt, tid);
    if (HOIST) gemm_compute_h(acc, cur, wr, wc, fr, fq); else gemm_compute(acc, cur, wr, wc, fr, fq);
#if REP_KCOMP > 1
    { f32x4 acc2[4][4];
#pragma unroll
      for (int m = 0; m < 4; ++m)
#pragma unroll
        for (int n = 0; n < 4; ++n) acc2[m][n] = (f32x4){0.f, 0.f, 0.f, 0.f};
      gemm_compute(acc2, cur, wr, wc, fr, fq);
      float sink = 0.f;
#pragma unroll
      for (int m = 0; m < 4; ++m)
#pragma unroll
        for (int n = 0; n < 4; ++n) sink += acc2[m][n][0];
      asm volatile("" :: "v"(sink)); }
#endif
    asm volatile("s_waitcnt vmcnt(0)" ::: "memory");
    __syncthreads();
#if REP_KSTG > 1
    gemm_stage(A, lda, Bt, ldb, brow, bcol, (t + 1) * 64, nxt, tid);
    asm volatile("s_waitcnt vmcnt(0)" ::: "memory");
    __syncthreads();
#endif
  }
  if (HOIST) gemm_compute_h(acc, smem + ((nt - 1) & 1) * 32768, wr, wc, fr, fq); else gemm_compute(acc, smem + ((nt - 1) & 1) * 32768, wr, wc, fr, fq);
}

__device__ __forceinline__ void tile_map(int t, int NT, int& mt, int& ni) {
  const int x = t & 7, q = t >> 3, nsub = NT >> 3;
  mt = q / nsub; ni = x + 8 * (q - mt * nsub);
}
__device__ __forceinline__ void tile_map_m(int t, int mtiles, int& mt, int& nt) {
  const int idx = (t & 7) * mtiles + (t >> 3);
  mt = idx >> 3; nt = idx & 7;
}
#define GEMM_IDS const int tid = tidx(), wid = tid >> 6, lane = tid & 63, wr = wid >> 1, wc = wid & 1, fr = lane & 15, fq = lane >> 4; (void)tid;

__device__ __forceinline__ void zero_acc(f32x4 (&acc)[4][4]) {
#pragma unroll
  for (int m = 0; m < 4; ++m)
#pragma unroll
    for (int n = 0; n < 4; ++n) acc[m][n] = (f32x4){0.f, 0.f, 0.f, 0.f};
}


__device__ __forceinline__ void store_slab_bf16(const f32x4 (&v)[4], bf16_t* dst_row0, size_t ld, int wid, int lane) {
  char* slab = smem + 65536 + wid * 2304;
  const int fr = lane & 15, fq = lane >> 4;
#pragma unroll
  for (int n = 0; n < 4; ++n) {
    u32x2 w; w.x = pack2(v[n][0], v[n][1]); w.y = pack2(v[n][2], v[n][3]);
    *(u32x2*)(slab + fr * 144 + (n * 16 + fq * 4) * 2) = w;
  }
  const int r = lane >> 3, c = lane & 7;
  u32x4 a = *(const u32x4*)(slab + r * 144 + c * 16), b = *(const u32x4*)(slab + (r + 8) * 144 + c * 16);
  *(u32x4*)(dst_row0 + (size_t)r * ld + c * 8) = a;
  *(u32x4*)(dst_row0 + (size_t)(r + 8) * ld + c * 8) = b;
}


__device__ __forceinline__ void store_slab_gate8(const f32x4 (&v)[4], unsigned char* dst_row0, int wid, int lane) {
  char* slab = smem + 65536 + wid * 2304;
  const int fr = lane & 15, fq = lane >> 4;
#pragma unroll
  for (int n = 0; n < 4; ++n) {
    unsigned q = 0;
#pragma unroll
    for (int j = 0; j < 4; ++j) { int g = (int)rintf(sigmoidf_(v[n][j]) * 255.f); q |= (unsigned)g << (8 * j); }
    *(unsigned*)(slab + fr * 80 + n * 16 + fq * 4) = q;
  }
  const int r = lane >> 2, c = lane & 3;
  u32x4 a = *(const u32x4*)(slab + r * 80 + c * 16);
  *(u32x4*)(dst_row0 + (size_t)r * 3072 + c * 16) = a;
}
__device__ __forceinline__ void load_slab_gate8(unsigned (&g)[4], const unsigned char* src_row0, int wid, int lane) {
  char* slab = smem + 65536 + wid * 2304;
  const int fr = lane & 15, fq = lane >> 4;
  const int r = lane >> 2, c = lane & 3;
  *(u32x4*)(slab + r * 80 + c * 16) = *(const u32x4*)(src_row0 + (size_t)r * 3072 + c * 16);
#pragma unroll
  for (int n = 0; n < 4; ++n) g[n] = *(const unsigned*)(slab + fr * 80 + n * 16 + fq * 4);
}

__device__ __forceinline__ void phase_inproj(const Params& p, int layer, int nrows, int part) {
  GEMM_IDS
  const int ntl = part == 0 ? 33 : (part == 1 ? 24 : 57);
  const int mtiles = nrows / 128;
  const bf16_t* Bt = p.wt_in + (size_t)layer * INCP * DM;
  for (int t = bidx(); t < mtiles * ntl; t += gridDim.x) {
    int mt, ni, nt;
    if (part == 0) { if (t < mtiles * 32) tile_map(t, 32, mt, ni); else { mt = t - mtiles * 32; ni = 32; } nt = ni < 32 ? ni : 56; }
    else if (part == 1) { tile_map(t, 24, mt, ni); nt = 32 + ni; }
    else { if (t < mtiles * 56) { tile_map(t, 56, mt, ni); nt = ni; } else { mt = t - mtiles * 56; nt = 56; } }
    f32x4 acc[4][4]; zero_acc(acc);
    gemm_kloop(acc, p.h, DM, Bt, DM, DM, mt * 128, nt * 128);
    if (nt >= 32 && nt < 56 && !DIAG_HP) {
#pragma unroll
      for (int m = 0; m < 4; ++m) store_slab_gate8(acc[m], p.gp8 + (size_t)(mt * 128 + wr * 64 + m * 16) * 3072 + (nt * 128 - 4096) + wc * 64, wid, lane);
    } else if (nt >= 5 && nt < 56) {
      bf16_t* dst = nt < 32 ? p.proj + (size_t)(mt * 128 + wr * 64) * 4096 + nt * 128 + wc * 64 : p.gp + (size_t)(mt * 128 + wr * 64) * 3072 + (nt * 128 - 4096) + wc * 64;
      const size_t ld = nt < 32 ? 4096 : 3072;
#pragma unroll
      for (int m = 0; m < 4; ++m) store_slab_bf16(acc[m], dst + (size_t)(m * 16) * ld, ld, wid, lane);
    } else if (nt == 56) {
#pragma unroll
      for (int m = 0; m < 4; ++m)
#pragma unroll
        for (int n = 0; n < 4; ++n) {
          int row = mt * 128 + wr * 64 + m * 16 + fr, cc = wc * 64 + n * 16 + fq * 4;
          if (cc < 32) *(f32x4*)(p.small + (size_t)row * 32 + cc) = acc[m][n];
        }
    }
    if (nt < 5) {
      const float* nw = (nt < 4 ? p.att_qnorm : p.att_knorm) + layer * 64;
      const bool latent = mt < NLAT / 128;
#pragma unroll
      for (int m = 0; m < 4; ++m) {
        const int row = mt * 128 + wr * 64 + m * 16 + fr;
        float ss = 0.f;
#pragma unroll
        for (int n = 0; n < 4; ++n)
#pragma unroll
          for (int j = 0; j < 4; ++j) ss += acc[m][n][j] * acc[m][n][j];
        ss += __shfl_xor(ss, 16); ss += __shfl_xor(ss, 32);
        const float rs = rsqrtf(ss * (1.f / 64.f) + 1e-6f);
        f32x4 v[4];
#pragma unroll
        for (int n = 0; n < 4; ++n) {
          f32x4 w4 = *(const f32x4*)(nw + n * 16 + fq * 4);
#pragma unroll
          for (int j = 0; j < 4; ++j) v[n][j] = acc[m][n][j] * rs * w4[j];
        }
        if (latent) {
          const int pos = row & (SEQ - 1);
#pragma unroll
          for (int n = 0; n < 2; ++n) {
            f32x4 c4 = *(const f32x4*)(p.ropec + pos * 32 + n * 16 + fq * 4), s4 = *(const f32x4*)(p.ropes + pos * 32 + n * 16 + fq * 4);
#pragma unroll
            for (int j = 0; j < 4; ++j) {
              float t1 = v[n][j], t2 = v[n + 2][j];
              v[n][j] = t1 * c4[j] - t2 * s4[j];
              v[n + 2][j] = t1 * s4[j] + t2 * c4[j];
            }
          }
        }
        store_slab_bf16(v, p.proj + (size_t)(mt * 128 + wr * 64 + m * 16) * 4096 + nt * 128 + wc * 64, 4096, wid, lane);
      }
    }
  }
}

__device__ __forceinline__ void phase_merge(const Params& p, int layer, int nrows) {
  GEMM_IDS
  const int mtiles = nrows / 128;
  for (int t = bidx(); t < mtiles * 8; t += gridDim.x) {
    int mt, nt; tile_map_m(t, mtiles, mt, nt);
    f32x4 mixa[4][4]; zero_acc(mixa);
    for (int r = 0; r < 3; ++r) {
      f32x4 acc[4][4]; zero_acc(acc);
      gemm_kloop<false>(acc, p.br + r * 512, 1536, p.wt_br + ((size_t)layer * 3 + r) * DM * 512, 512, 512, mt * 128, nt * 128);
#if DIAG_HP
#pragma unroll
      for (int m = 0; m < 4; ++m)
#pragma unroll
        for (int n = 0; n < 4; ++n) {
          int row = mt * 128 + wr * 64 + m * 16 + fr, col = nt * 128 + wc * 64 + n * 16 + fq * 4;
          u32x2 g = *(const u32x2*)(p.gp + (size_t)row * 3072 + r * 1024 + col);
          mixa[m][n][0] += sigmoidf_(__uint_as_float(g.x << 16)) * acc[m][n][0];
          mixa[m][n][1] += sigmoidf_(__uint_as_float(g.x & 0xffff0000u)) * acc[m][n][1];
          mixa[m][n][2] += sigmoidf_(__uint_as_float(g.y << 16)) * acc[m][n][2];
          mixa[m][n][3] += sigmoidf_(__uint_as_float(g.y & 0xffff0000u)) * acc[m][n][3];
        }
#else
#pragma unroll
      for (int m = 0; m < 4; ++m) {
        unsigned g[4];
        load_slab_gate8(g, p.gp8 + (size_t)(mt * 128 + wr * 64 + m * 16) * 3072 + r * 1024 + nt * 128 + wc * 64, wid, lane);
#pragma unroll
        for (int n = 0; n < 4; ++n) {
          mixa[m][n][0] += ub0(g[n]) * (1.f / 255.f) * acc[m][n][0];
          mixa[m][n][1] += ub1(g[n]) * (1.f / 255.f) * acc[m][n][1];
          mixa[m][n][2] += ub2(g[n]) * (1.f / 255.f) * acc[m][n][2];
          mixa[m][n][3] += ub3(g[n]) * (1.f / 255.f) * acc[m][n][3];
        }
      }
#endif
    }
#pragma unroll
    for (int m = 0; m < 4; ++m) store_slab_bf16(mixa[m], p.mix + (size_t)(mt * 128 + wr * 64 + m * 16) * DM + nt * 128 + wc * 64, DM, wid, lane);
  }
}

__device__ __forceinline__ void phase_outproj(const Params& p, int layer, int nrows, float oscale, int from_input) {
  GEMM_IDS
  const int mtiles = nrows / 128;
  for (int t = bidx(); t < mtiles * 8; t += gridDim.x) {
    int mt, nt; tile_map_m(t, mtiles, mt, nt);
    f32x4 acc[4][4]; zero_acc(acc);
    gemm_kloop(acc, p.mix, DM, p.wt_out + (size_t)layer * DM * DM, DM, DM, mt * 128, nt * 128);
#pragma unroll
    for (int m = 0; m < 4; ++m)
#pragma unroll
      for (int n = 0; n < 4; ++n) {
        int row = mt * 128 + wr * 64 + m * 16 + fr, col = nt * 128 + wc * 64 + n * 16 + fq * 4;
        float* xr = xrow(p, row) + col;
        f32x4 g1 = *(const f32x4*)(p.mod + (size_t)(layer * 3 + modrow(row)) * 6144 + 2 * DM + col);
        g1 = g1 * oscale;
        f32x4 xv = *(const f32x4*)(xrow_src(p, row, from_input) + col);
        xv[0] += g1[0] * acc[m][n][0]; xv[1] += g1[1] * acc[m][n][1]; xv[2] += g1[2] * acc[m][n][2]; xv[3] += g1[3] * acc[m][n][3];
        *(f32x4*)xr = xv;
      }
  }
}

__device__ __forceinline__ void phase_wq(const Params& p, int layer, int nrows) {
  GEMM_IDS
  const int mtiles = nrows / 128;
  for (int t = bidx(); t < mtiles * 16; t += gridDim.x) {
    int mt, nt; { const int idx = (t & 7) * (mtiles * 2) + (t >> 3); mt = idx >> 4; nt = idx & 15; }
    f32x4 acc[4][4]; zero_acc(acc);
    gemm_kloop(acc, p.h, DM, p.wt_q + (size_t)layer * 2048 * DM, DM, DM, mt * 128, nt * 128);
#if DIAG_HP
    gemm_kloop(acc, p.h, DM, p.wt_q_lo + (size_t)layer * 2048 * DM, DM, DM, mt * 128, nt * 128);
    gemm_kloop(acc, p.h2lo, DM, p.wt_q + (size_t)layer * 2048 * DM, DM, DM, mt * 128, nt * 128);
#endif
#if DIAG_HP
#pragma unroll
    for (int m = 0; m < 4; ++m)
#pragma unroll
      for (int n = 0; n < 4; ++n) {
        int row = mt * 128 + wr * 64 + m * 16 + fr, col = nt * 128 + wc * 64 + n * 16 + fq * 4;
        *(f32x4*)(p.qf + (size_t)row * 2048 + col) = acc[m][n];
      }
#else
#pragma unroll
    for (int m = 0; m < 4; ++m) store_slab_bf16(acc[m], p.q + (size_t)(mt * 128 + wr * 64 + m * 16) * 2048 + nt * 128 + wc * 64, 2048, wid, lane);
#endif
  }
}

__device__ __forceinline__ void phase_vtrans(const Params& p) {
  bf16_t* tile = (bf16_t*)smem;
  const int tid = tidx();
  for (int item = bidx(); item < 528; item += gridDim.x) {
    int b = item / 264, r = item % 264, kvh = r / 132, kt = r % 132;
    int krow0 = kt < 128 ? b * SEQ + kt * 64 : NLAT + b * CTXL + (kt - 128) * 64;
    __syncthreads();
    {
      int kr = tid >> 2, c0 = (tid & 3) * 16;
      const bf16_t* vp = p.proj + (size_t)(krow0 + kr) * 4096 + 640 + kvh * 64 + c0;
      u32x4 w0 = *(const u32x4*)vp, w1 = *(const u32x4*)(vp + 8);
      unsigned* tp = (unsigned*)(tile + kr * 66 + c0);
#pragma unroll
      for (int e = 0; e < 4; ++e) { tp[e] = w0[e]; tp[4 + e] = w1[e]; }
    }
    __syncthreads();
    {
      int d = tid >> 2, k0 = (tid & 3) * 16;
      bf16_t* op = p.vt + ((size_t)(b * 2 + kvh) * 64 + d) * 8448 + kt * 64 + k0;
      u32x4 o0, o1;
#pragma unroll
      for (int e = 0; e < 4; ++e) {
        const int ka = e < 2 ? 2 * e : 8 + 2 * (e - 2);
        const int kb2 = e < 2 ? 4 + 2 * e : 12 + 2 * (e - 2);
        o0[e] = (unsigned)tile[(k0 + ka) * 66 + d] | ((unsigned)tile[(k0 + ka + 1) * 66 + d] << 16);
        o1[e] = (unsigned)tile[(k0 + kb2) * 66 + d] | ((unsigned)tile[(k0 + kb2 + 1) * 66 + d] << 16);
      }
      *(u32x4*)op = o0; *(u32x4*)(op + 8) = o1;
    }
  }
}

#define ATT_KSTR 144
#define ATT_VSTR 272
#define ATT_VOFF 18432
#define ATT_BUF 35840
__device__ __forceinline__ void attn_item(const Params& p, int layer, int item) {
  const int tid = tidx(), wid = tid >> 6, lane = tid & 63, l31 = lane & 31, hh = lane >> 5;
  int b, kvh, tok0, kt0, nkt;
  if (item < 1024) { b = item >> 9; kvh = (item >> 8) & 1; tok0 = b * SEQ + (item & 255) * 32; kt0 = 0; nkt = 66; }
  else { int r = item - 1024; b = r >> 4; kvh = (r >> 3) & 1; tok0 = NLAT + b * CTXL + (r & 7) * 32; kt0 = 64; nkt = 2; }
  const int head = kvh * 4 + wid;
  bf16x8 qf[4];
#pragma unroll
  for (int ks = 0; ks < 4; ++ks)
    qf[ks] = *(const bf16x8*)(p.proj + (size_t)(tok0 + l31) * 4096 + head * 64 + ks * 16 + hh * 8);
  f32x16 o[2];
#pragma unroll
  for (int db = 0; db < 2; ++db)
#pragma unroll
    for (int r = 0; r < 16; ++r) o[db][r] = 0.f;
  float mrun = -1e30f, lrun = 0.f;
  const float cs = 0.125f * 1.44269504088896f * ATT_TAU;
  const bf16_t* vtb = p.vt + (size_t)(b * 2 + kvh) * 64 * 8448;
  u32x4 kreg[4], vreg[4];
  auto gload = [&](int kt) {
    int krow0 = kt < 64 ? b * SEQ + kt * 128 : NLAT + b * CTXL + (kt - 64) * 128;
    int ko = kt * 128; asm volatile("" : "+s"(ko));
#pragma unroll
    for (int i = 0; i < 4; ++i) {
      int id = tid + 256 * i;
      kreg[i] = *(const u32x4*)(p.proj + (size_t)(krow0 + (id >> 3)) * 4096 + 512 + kvh * 64 + (id & 7) * 8);
      vreg[i] = *(const u32x4*)(vtb + (size_t)(id >> 4) * 8448 + ko + (id & 15) * 8);
    }
  };
  auto lstore = [&](int buf) {
    char* base = smem + buf * ATT_BUF;
#pragma unroll
    for (int i = 0; i < 4; ++i) {
      int id = tid + 256 * i;
      *(u32x4*)(base + (id >> 3) * ATT_KSTR + (id & 7) * 16) = kreg[i];
      *(u32x4*)(base + ATT_VOFF + (id >> 4) * ATT_VSTR + (id & 15) * 16) = vreg[i];
    }
  };
  auto compute = [&](int buf, int sub) {
    const char* Kb = smem + buf * ATT_BUF + sub * 64 * ATT_KSTR;
    const char* Vb = smem + buf * ATT_BUF + ATT_VOFF + sub * 128;
    f32x16 s[2];
#pragma unroll
    for (int kb = 0; kb < 2; ++kb) {
#pragma unroll
      for (int r = 0; r < 16; ++r) s[kb][r] = 0.f;
#pragma unroll
      for (int ks = 0; ks < 4; ++ks) {
        bf16x8 kf = *(const bf16x8*)(Kb + (kb * 32 + l31) * ATT_KSTR + (ks * 16 + hh * 8) * 2);
        s[kb] = __builtin_amdgcn_mfma_f32_32x32x16_bf16(kf, qf[ks], s[kb], 0, 0, 0);
      }
    }
    bf16x8 pf[4];
    float mx = s[0][0];
#pragma unroll
    for (int r = 1; r < 16; ++r) mx = fmaxf(mx, s[0][r]);
#pragma unroll
    for (int r = 0; r < 16; ++r) mx = fmaxf(mx, s[1][r]);
    mx = fmaxf(mx, __shfl_xor(mx, 32));
    const float mnew = fmaxf(mrun, mx * cs);
    const float alpha = __builtin_amdgcn_exp2f(mrun - mnew);
    const bool grew = mnew > mrun;
    mrun = mnew;
    float ls = 0.f;
#pragma unroll
    for (int kb = 0; kb < 2; ++kb) {
      float pv[16];
#pragma unroll
      for (int r = 0; r < 16; ++r) { pv[r] = __builtin_amdgcn_exp2f(s[kb][r] * cs - mnew); ls += pv[r]; }
#pragma unroll
      for (int sp = 0; sp < 2; ++sp) {
        u32x4 w;
#pragma unroll
        for (int e = 0; e < 4; ++e) w[e] = pack2(pv[8 * sp + 2 * e], pv[8 * sp + 2 * e + 1]);
        pf[kb * 2 + sp] = *(bf16x8*)&w;
      }
    }
    lrun = lrun * alpha + ls;
    if (__any(grew)) {
#pragma unroll
      for (int db = 0; db < 2; ++db)
#pragma unroll
        for (int r = 0; r < 16; ++r) o[db][r] *= alpha;
    }
#pragma unroll
    for (int sp = 0; sp < 4; ++sp) {
#pragma unroll
      for (int db = 0; db < 2; ++db) {
        bf16x8 vf = *(const bf16x8*)(Vb + (db * 32 + l31) * ATT_VSTR + (16 * sp + 8 * hh) * 2);
        o[db] = __builtin_amdgcn_mfma_f32_32x32x16_bf16(vf, pf[sp], o[db], 0, 0, 0);
      }
    }
  };
  float mfix;
  {
    float aq = fabsf(p.att_qnorm[layer * 64 + lane]), ak = fabsf(p.att_knorm[layer * 64 + lane]);
    aq = wave_max(aq); ak = wave_max(ak);
    mfix = 8.f * aq * ak * 1.02f * 1.44269504088896f * ATT_TAU;
  }
  const bool fast = mfix <= 40.f;
  if (fast) {
#pragma unroll
    for (int ks = 0; ks < 4; ++ks) {
      u32x4 w = *(u32x4*)&qf[ks];
#pragma unroll
      for (int e = 0; e < 4; ++e) w[e] = pack2(__uint_as_float(w[e] << 16) * cs, __uint_as_float(w[e] & 0xffff0000u) * cs);
      qf[ks] = *(bf16x8*)&w;
    }
  }
  auto compute_fast = [&](int buf, int sub) {
    const char* Kb = smem + buf * ATT_BUF + sub * 64 * ATT_KSTR;
    const char* Vb = smem + buf * ATT_BUF + ATT_VOFF + sub * 128;
    bf16x8 kf[8], vf[8];
#pragma unroll
    for (int kb = 0; kb < 2; ++kb)
#pragma unroll
      for (int ks = 0; ks < 4; ++ks) kf[kb * 4 + ks] = *(const bf16x8*)(Kb + (kb * 32 + l31) * ATT_KSTR + (ks * 16 + hh * 8) * 2);
#pragma unroll
    for (int sp = 0; sp < 4; ++sp)
#pragma unroll
      for (int db = 0; db < 2; ++db) vf[sp * 2 + db] = *(const bf16x8*)(Vb + (db * 32 + l31) * ATT_VSTR + (16 * sp + 8 * hh) * 2);
    f32x16 s[2];
#pragma unroll
    for (int kb = 0; kb < 2; ++kb) {
#pragma unroll
      for (int r = 0; r < 16; ++r) s[kb][r] = 0.f;
#pragma unroll
      for (int ks = 0; ks < 4; ++ks) s[kb] = __builtin_amdgcn_mfma_f32_32x32x16_bf16(kf[kb * 4 + ks], qf[ks], s[kb], 0, 0, 0);
    }
    bf16x8 pf[4];
    float ls = 0.f;
#pragma unroll
    for (int kb = 0; kb < 2; ++kb) {
      float pv[16];
#pragma unroll
      for (int r = 0; r < 16; ++r) { pv[r] = __builtin_amdgcn_exp2f(s[kb][r]); ls += pv[r]; }
#pragma unroll
      for (int sp = 0; sp < 2; ++sp) {
        u32x4 w;
#pragma unroll
        for (int e = 0; e < 4; ++e) w[e] = pack2(pv[8 * sp + 2 * e], pv[8 * sp + 2 * e + 1]);
        pf[kb * 2 + sp] = *(bf16x8*)&w;
      }
    }
    lrun += ls;
#pragma unroll
    for (int sp = 0; sp < 4; ++sp)
#pragma unroll
      for (int db = 0; db < 2; ++db) o[db] = __builtin_amdgcn_mfma_f32_32x32x16_bf16(vf[sp * 2 + db], pf[sp], o[db], 0, 0, 0);
  };
  __syncthreads();
  gload(kt0);
  lstore(0);
  __syncthreads();
  if (fast) {
    for (int t = 0; t < nkt; ++t) {
      const int buf = t & 1;
      if (t + 1 < nkt) gload(kt0 + t + 1);
      compute_fast(buf, 0);
      compute_fast(buf, 1);
      if (t + 1 < nkt) lstore(buf ^ 1);
      __syncthreads();
    }
  } else {
    for (int t = 0; t < nkt; ++t) {
      const int buf = t & 1;
      if (t + 1 < nkt) gload(kt0 + t + 1);
      compute(buf, 0);
      compute(buf, 1);
      if (t + 1 < nkt) lstore(buf ^ 1);
      __syncthreads();
    }
  }
  {
    float l = lrun + __shfl_xor(lrun, 32);
    float il = ATT_ALPHA / l;
    bf16_t* op = p.br + (size_t)(tok0 + l31) * 1536 + head * 64;
#pragma unroll
    for (int db = 0; db < 2; ++db)
#pragma unroll
      for (int g = 0; g < 4; ++g) {
        u32x2 w; w.x = pack2(o[db][4 * g] * il, o[db][4 * g + 1] * il); w.y = pack2(o[db][4 * g + 2] * il, o[db][4 * g + 3] * il);
        *(u32x2*)(op + db * 32 + 8 * g + 4 * hh) = w;
      }
  }
}

__device__ __forceinline__ void attn_item64(const Params& p, int layer, int item) {
  const int tid = tidx(), wid = tid >> 6, lane = tid & 63, l31 = lane & 31, hh = lane >> 5;
  int b, kvh, tok0, kt0, nkt;
  if (item < 512) { b = item >> 8; kvh = (item >> 7) & 1; tok0 = b * SEQ + (item & 127) * 64; kt0 = 0; nkt = 132; }
  else { int r = item - 512; b = r >> 3; kvh = (r >> 2) & 1; tok0 = NLAT + b * CTXL + (r & 3) * 64; kt0 = 128; nkt = 4; }
  const int head = kvh * 4 + wid;
  const float cs = 0.125f * 1.44269504088896f * ATT_TAU;
  bf16x8 qf[2][4];
#pragma unroll
  for (int qb = 0; qb < 2; ++qb)
#pragma unroll
    for (int ks = 0; ks < 4; ++ks) {
      u32x4 w = *(const u32x4*)(p.proj + (size_t)(tok0 + qb * 32 + l31) * 4096 + head * 64 + ks * 16 + hh * 8);
#pragma unroll
      for (int e = 0; e < 4; ++e) w[e] = pack2(__uint_as_float(w[e] << 16) * cs, __uint_as_float(w[e] & 0xffff0000u) * cs);
      qf[qb][ks] = *(bf16x8*)&w;
    }
  f32x16 o[2][2];
#pragma unroll
  for (int qb = 0; qb < 2; ++qb)
#pragma unroll
    for (int db = 0; db < 2; ++db)
#pragma unroll
      for (int r = 0; r < 16; ++r) o[qb][db][r] = 0.f;
  float lrun[2] = {0.f, 0.f};
  const bf16_t* vtb = p.vt + (size_t)(b * 2 + kvh) * 64 * 8448;
  auto stage = [&](int kt, int buf) {
    const int krow0 = kt < 128 ? b * SEQ + kt * 64 : NLAT + b * CTXL + (kt - 128) * 64;
    int ko = kt * 64; asm volatile("" : "+s"(ko));
    char* base = smem + buf * 16384;
#pragma unroll
    for (int i = 0; i < 2; ++i) {
      const int q = tid + 256 * i, r = q >> 3, c = (q & 7) ^ ((r >> 1) & 7);
      __builtin_amdgcn_global_load_lds((const unsigned*)(p.proj + (size_t)(krow0 + r) * 4096 + 512 + kvh * 64 + c * 8), (__attribute__((address_space(3))) unsigned*)(base + q * 16), 16, 0, 0);
      __builtin_amdgcn_global_load_lds((const unsigned*)(vtb + (size_t)r * 8448 + ko + c * 8), (__attribute__((address_space(3))) unsigned*)(base + 8192 + q * 16), 16, 0, 0);
    }
  };
  auto compute = [&](int buf) {
    const char* Kb = smem + buf * 16384;
    const char* Vb = Kb + 8192;
    bf16x8 pf[2][4];
#pragma unroll
    for (int kb = 0; kb < 2; ++kb) {
      bf16x8 kf[4];
      const int row = kb * 32 + l31;
#pragma unroll
      for (int ks = 0; ks < 4; ++ks) kf[ks] = *(const bf16x8*)(Kb + row * 128 + (((ks * 2 + hh) ^ ((row >> 1) & 7)) << 4));
      f32x16 s[2];
#pragma unroll
      for (int qb = 0; qb < 2; ++qb) {
#pragma unroll
        for (int r = 0; r < 16; ++r) s[qb][r] = 0.f;
#pragma unroll
        for (int ks = 0; ks < 4; ++ks) s[qb] = __builtin_amdgcn_mfma_f32_32x32x16_bf16(kf[ks], qf[qb][ks], s[qb], 0, 0, 0);
      }
#pragma unroll
      for (int qb = 0; qb < 2; ++qb) {
        float pv[16]; float ls = 0.f;
#pragma unroll
        for (int r = 0; r < 16; ++r) { pv[r] = __builtin_amdgcn_exp2f(s[qb][r]); ls += pv[r]; }
        lrun[qb] += ls;
#pragma unroll
        for (int sp = 0; sp < 2; ++sp) {
          u32x4 w;
#pragma unroll
          for (int e = 0; e < 4; ++e) w[e] = pack2(pv[8 * sp + 2 * e], pv[8 * sp + 2 * e + 1]);
          pf[qb][kb * 2 + sp] = *(bf16x8*)&w;
        }
      }
    }
#pragma unroll
    for (int sp = 0; sp < 4; ++sp)
#pragma unroll
      for (int db = 0; db < 2; ++db) {
        const int row = db * 32 + l31;
        bf16x8 vf = *(const bf16x8*)(Vb + row * 128 + (((sp * 2 + hh) ^ ((row >> 1) & 7)) << 4));
        o[0][db] = __builtin_amdgcn_mfma_f32_32x32x16_bf16(vf, pf[0][sp], o[0][db], 0, 0, 0);
        o[1][db] = __builtin_amdgcn_mfma_f32_32x32x16_bf16(vf, pf[1][sp], o[1][db], 0, 0, 0);
      }
  };
  __syncthreads();
  stage(kt0, 0);
  asm volatile("s_waitcnt vmcnt(0)" ::: "memory");
  __syncthreads();
  for (int t = 0; t < nkt; ++t) {
    if (t + 1 < nkt) stage(kt0 + t + 1, (t + 1) & 1);
    compute(t & 1);
    asm volatile("s_waitcnt vmcnt(0)" ::: "memory");
    __syncthreads();
  }
#pragma unroll
  for (int qb = 0; qb < 2; ++qb) {
    float l = lrun[qb] + __shfl_xor(lrun[qb], 32);
    float il = ATT_ALPHA / l;
    bf16_t* op = p.br + (size_t)(tok0 + qb * 32 + l31) * 1536 + head * 64;
#pragma unroll
    for (int db = 0; db < 2; ++db)
#pragma unroll
      for (int g = 0; g < 4; ++g) {
        u32x2 w; w.x = pack2(o[qb][db][4 * g] * il, o[qb][db][4 * g + 1] * il); w.y = pack2(o[qb][db][4 * g + 2] * il, o[qb][db][4 * g + 3] * il);
        *(u32x2*)(op + db * 32 + 8 * g + 4 * hh) = w;
      }
  }
}
__device__ __forceinline__ float attn_logit_bound(const Params& p, int layer) {
  const int lane = tidx() & 63;
  float aq = fabsf(p.att_qnorm[layer * 64 + lane]), ak = fabsf(p.att_knorm[layer * 64 + lane]);
  aq = wave_max(aq); ak = wave_max(ak);
  return 8.f * aq * ak * 1.02f * 1.44269504088896f * ATT_TAU;
}

__device__ __forceinline__ void phase_ssdprep(const Params& p, int layer) {
  const float* cw = p.ssd_conv_w + (size_t)layer * 5 * 768;
  const float* cb = p.ssd_conv_b + layer * 768;
  const int total = (MROWS / 16) * 96;
  for (int i = bidx() * NTHR + tidx(); i < total; i += gridDim.x * NTHR) {
    const int run = i / 96, c0 = (i - run * 96) * 8;
    const int row0 = run * 16;
    int t0, T;
    if (row0 < NLAT) { t0 = row0 & (SEQ - 1); T = SEQ; } else { t0 = (row0 - NLAT) & (CTXL - 1); T = CTXL; }
    float w[5][8], bias[8];
#pragma unroll
    for (int j = 0; j < 5; ++j) {
      f32x4 w0 = *(const f32x4*)(cw + j * 768 + c0), w1 = *(const f32x4*)(cw + j * 768 + c0 + 4);
#pragma unroll
      for (int e = 0; e < 4; ++e) { w[j][e] = w0[e]; w[j][4 + e] = w1[e]; }
    }
    {
      f32x4 b0 = *(const f32x4*)(cb + c0), b1 = *(const f32x4*)(cb + c0 + 4);
#pragma unroll
      for (int e = 0; e < 4; ++e) { bias[e] = b0[e]; bias[4 + e] = b1[e]; }
    }
    const bf16_t* src = p.proj + (size_t)row0 * 4096 + 1280 + c0;
    u32x4 win[5];
    const u32x4 zero4 = {0u, 0u, 0u, 0u};
    win[0] = zero4;
    win[1] = t0 >= 2 ? *(const u32x4*)(src - 2 * 4096) : zero4;
    win[2] = t0 >= 1 ? *(const u32x4*)(src - 1 * 4096) : zero4;
    win[3] = *(const u32x4*)(src);
    win[4] = *(const u32x4*)(src + 4096);
#pragma unroll
    for (int r = 0; r < 16; ++r) {
      win[0] = win[1]; win[1] = win[2]; win[2] = win[3]; win[3] = win[4];
      win[4] = (t0 + r + 2 < T) ? *(const u32x4*)(src + (size_t)(r + 2) * 4096) : zero4;
      float a[8];
#pragma unroll
      for (int e = 0; e < 8; ++e) a[e] = bias[e];
#pragma unroll
      for (int j = 0; j < 5; ++j)
#pragma unroll
        for (int e = 0; e < 4; ++e) {
          a[2 * e] += w[j][2 * e] * __uint_as_float(win[j][e] << 16);
          a[2 * e + 1] += w[j][2 * e + 1] * __uint_as_float(win[j][e] & 0xffff0000u);
        }
      u32x4 o;
#pragma unroll
      for (int e = 0; e < 4; ++e) o[e] = pack2(siluf_(a[2 * e]), siluf_(a[2 * e + 1]));
      *(u32x4*)(p.xbc + (size_t)(row0 + r) * 768 + c0) = o;
    }
  }
  const int total2 = MROWS * 16;
  for (int i = bidx() * NTHR + tidx(); i < total2; i += gridDim.x * NTHR) {
    int row = i >> 4, j = i & 15;
    p.dtb[i] = softplusf_(p.small[(size_t)row * 32 + j] + p.ssd_dt_bias[layer * 16 + j]);
  }
}

__device__ __forceinline__ int chunk_row0(int b, int c) { return c < 64 ? b * SEQ + c * 128 : NLAT + b * CTXL + (c - 64) * 128; }
__device__ __forceinline__ float wave_incl_scan(float v, int lane) {
#pragma unroll
  for (int o = 1; o < 64; o <<= 1) { float t = __shfl_up(v, o); if (lane >= o) v += t; }
  return v;
}
__device__ __forceinline__ void ssd_scans(const Params& p, int layer, int row0, int h, float* fl) {
  const int tid = tidx(), lane = tid & 63, wv = tid >> 6;
  const bool fwd = tid < 128;
  const int s = fwd ? tid : 127 - (tid - 128);
  const float A = -__expf(p.ssd_a_log[layer * 16 + (fwd ? 0 : 8) + h]);
  const float dt = p.dtb[(size_t)(row0 + s) * 16 + (fwd ? 0 : 8) + h];
  float v = wave_incl_scan(dt * A, lane);
  if (lane == 63) fl[512 + wv] = v;
  __syncthreads();
  if (wv & 1) v += fl[512 + wv - 1];
  fl[(fwd ? 0 : 128) + s] = v;
  fl[(fwd ? 256 : 384) + s] = dt;
  __syncthreads();
}

#define SSD_TSTR 272
__device__ __forceinline__ void ssdA_item(const Params& p, int layer, int item) {
  const int tid = tidx(), wid = tid >> 6, lane = tid & 63, l31 = lane & 31, hh = lane >> 5;
  const int b = item / 528, c = (item / 8) % 66, h = item & 7, g = h >> 2;
  const int row0 = chunk_row0(b, c);
  float* fl = (float*)smem;
  char* BT = smem + 4096;
  char* XF = BT + 64 * SSD_TSTR;
  char* XB = XF + 64 * SSD_TSTR;
  __syncthreads();
  ssd_scans(p, layer, row0, h, fl);
  const float cfl = fl[127], cbl = fl[128];
  {
    const int s = tid >> 1, half = tid & 1;
    const float wf = __expf(cfl - fl[s]) * fl[256 + s], wb = __expf(cbl - fl[128 + s]) * fl[384 + s];
    const bf16_t* xr = p.xbc + (size_t)(row0 + s) * 768;
#pragma unroll
    for (int i = 0; i < 4; ++i) {
      u32x4 xv = *(const u32x4*)(xr + h * 64 + half * 32 + i * 8);
      u32x4 bv = *(const u32x4*)(xr + 512 + g * 64 + half * 32 + i * 8);
#pragma unroll
      for (int e = 0; e < 4; ++e) {
        int pp = half * 32 + i * 8 + 2 * e;
        float x0 = __uint_as_float(xv[e] << 16), x1 = __uint_as_float(xv[e] & 0xffff0000u);
        *(bf16_t*)(XF + pp * SSD_TSTR + s * 2) = f2bf(x0 * wf);
        *(bf16_t*)(XF + (pp + 1) * SSD_TSTR + s * 2) = f2bf(x1 * wf);
        *(bf16_t*)(XB + pp * SSD_TSTR + s * 2) = f2bf(x0 * wb);
        *(bf16_t*)(XB + (pp + 1) * SSD_TSTR + s * 2) = f2bf(x1 * wb);
        *(bf16_t*)(BT + pp * SSD_TSTR + s * 2) = (bf16_t)(bv[e] & 0xffffu);
        *(bf16_t*)(BT + (pp + 1) * SSD_TSTR + s * 2) = (bf16_t)(bv[e] >> 16);
      }
    }
  }
  __syncthreads();
  const int nb = wid >> 1, pb = wid & 1;
#pragma unroll
  for (int dir = 0; dir < 2; ++dir) {
    const char* XT = dir == 0 ? XF : XB;
    f32x16 acc;
#pragma unroll
    for (int r = 0; r < 16; ++r) acc[r] = 0.f;
#pragma unroll
    for (int ks = 0; ks < 8; ++ks) {
      bf16x8 a = *(const bf16x8*)(BT + (nb * 32 + l31) * SSD_TSTR + (ks * 16 + hh * 8) * 2);
      bf16x8 bb = *(const bf16x8*)(XT + (pb * 32 + l31) * SSD_TSTR + (ks * 16 + hh * 8) * 2);
      acc = __builtin_amdgcn_mfma_f32_32x32x16_bf16(a, bb, acc, 0, 0, 0);
    }
    bf16_t* dst = p.ssl + ((size_t)(((dir * 2 + b) * 8 + h) * 66 + c) * 64 + pb * 32 + l31) * 64 + nb * 32 + 4 * hh;
#pragma unroll
    for (int q4 = 0; q4 < 4; ++q4) {
      u32x2 w; w.x = pack2(acc[4 * q4], acc[4 * q4 + 1]); w.y = pack2(acc[4 * q4 + 2], acc[4 * q4 + 3]);
      *(u32x2*)(dst + 8 * q4) = w;
    }
  }
  if (tid == 0) {
    p.sdec[((0 * 2 + b) * 8 + h) * 66 + c] = __expf(cfl);
    p.sdec[((1 * 2 + b) * 8 + h) * 66 + c] = __expf(cbl);
  }
}

__device__ __forceinline__ void phase_ssdcarry(const Params& p) {
  const int total = 32 * 1024;
  for (int i = bidx() * NTHR + tidx(); i < total; i += gridDim.x * NTHR) {
    const int seq = i >> 10, el = (i & 1023) * 4;
    const int dir = seq >> 4;
    bf16_t* base = p.ssl + (size_t)seq * 66 * 4096 + el;
    const float* dec = p.sdec + seq * 66;
    float st[4] = {0.f, 0.f, 0.f, 0.f};
#pragma unroll 22
    for (int k = 0; k < 66; ++k) {
      int c = dir == 0 ? (k < 2 ? 64 + k : k - 2) : (65 - k);
      u32x2 v = *(const u32x2*)(base + (size_t)c * 4096);
      float d = dec[c];
      u32x2 w; w.x = pack2(st[0], st[1]); w.y = pack2(st[2], st[3]);
      *(u32x2*)(base + (size_t)c * 4096) = w;
      st[0] = d * st[0] + __uint_as_float(v.x << 16); st[1] = d * st[1] + __uint_as_float(v.x & 0xffff0000u);
      st[2] = d * st[2] + __uint_as_float(v.y << 16); st[3] = d * st[3] + __uint_as_float(v.y & 0xffff0000u);
    }
  }
}

__device__ __forceinline__ void ssdC_item(const Params& p, int layer, int item) {
  const int tid = tidx(), wid = tid >> 6, lane = tid & 63, l31 = lane & 31, hh = lane >> 5;
  const int b = item / 528, c = (item / 8) % 66, h = item & 7, g = h >> 2;
  const int row0 = chunk_row0(b, c);
  float* fl = (float*)smem;
  char* Bt = smem + 4096;
  char* XT = Bt + 128 * 144;
  __syncthreads();
  ssd_scans(p, layer, row0, h, fl);
  {
#pragma unroll
    for (int i = 0; i < 4; ++i) {
      int id = tid + 256 * i, r = id >> 3, c16 = id & 7;
      *(u32x4*)(Bt + r * 144 + c16 * 16) = *(const u32x4*)(p.xbc + (size_t)(row0 + r) * 768 + 512 + g * 64 + c16 * 8);
    }
    const int s = tid >> 1, half = tid & 1;
    const bf16_t* xr = p.xbc + (size_t)(row0 + s) * 768 + h * 64 + half * 32;
#pragma unroll
    for (int i = 0; i < 4; ++i) {
      u32x4 xv = *(const u32x4*)(xr + i * 8);
#pragma unroll
      for (int e = 0; e < 4; ++e) {
        int pp = half * 32 + i * 8 + 2 * e;
        *(bf16_t*)(XT + pp * SSD_TSTR + s * 2) = (bf16_t)(xv[e] & 0xffffu);
        *(bf16_t*)(XT + (pp + 1) * SSD_TSTR + s * 2) = (bf16_t)(xv[e] >> 16);
      }
    }
  }
  __syncthreads();
  const int s = wid * 32 + l31;
  const float cfs = fl[s], cbs = fl[128 + s];
  bf16x8 cf[4];
#pragma unroll
  for (int ks = 0; ks < 4; ++ks) cf[ks] = *(const bf16x8*)(p.xbc + (size_t)(row0 + s) * 768 + 640 + g * 64 + ks * 16 + hh * 8);
  f32x16 Y[2];
  {
    f32x16 aF[2], aB[2];
#pragma unroll
    for (int pb = 0; pb < 2; ++pb)
#pragma unroll
      for (int r = 0; r < 16; ++r) { aF[pb][r] = 0.f; aB[pb][r] = 0.f; }
    const bf16_t* spf = p.ssl + (size_t)(((0 * 2 + b) * 8 + h) * 66 + c) * 4096;
    const bf16_t* spb = p.ssl + (size_t)(((1 * 2 + b) * 8 + h) * 66 + c) * 4096;
#pragma unroll
    for (int pb = 0; pb < 2; ++pb)
#pragma unroll
      for (int ks = 0; ks < 4; ++ks) {
        bf16x8 a0 = *(const bf16x8*)(spf + (pb * 32 + l31) * 64 + ks * 16 + hh * 8);
        bf16x8 a1 = *(const bf16x8*)(spb + (pb * 32 + l31) * 64 + ks * 16 + hh * 8);
        aF[pb] = __builtin_amdgcn_mfma_f32_32x32x16_bf16(a0, cf[ks], aF[pb], 0, 0, 0);
        aB[pb] = __builtin_amdgcn_mfma_f32_32x32x16_bf16(a1, cf[ks], aB[pb], 0, 0, 0);
      }
    const float ef = __expf(cfs), eb = __expf(cbs);
#pragma unroll
    for (int pb = 0; pb < 2; ++pb)
#pragma unroll
      for (int r = 0; r < 16; ++r) Y[pb][r] = aF[pb][r] * ef + aB[pb][r] * eb;
  }
  for (int rb = 0; rb < 4; ++rb) {
    f32x16 gt;
#pragma unroll
    for (int r = 0; r < 16; ++r) gt[r] = 0.f;
#pragma unroll
    for (int ks = 0; ks < 4; ++ks) {
      bf16x8 a = *(const bf16x8*)(Bt + (rb * 32 + l31) * 144 + (ks * 16 + hh * 8) * 2);
      gt = __builtin_amdgcn_mfma_f32_32x32x16_bf16(a, cf[ks], gt, 0, 0, 0);
    }
#pragma unroll
    for (int dir = 0; dir < 2; ++dir) {
      if (dir == 0 ? (rb > wid) : (rb < wid)) continue;
      const float* cum = fl + (dir == 0 ? 0 : 128);
      const float* dta = fl + (dir == 0 ? 256 : 384);
      const float cs = dir == 0 ? cfs : cbs;
      float val[16];
#pragma unroll
      for (int q4 = 0; q4 < 4; ++q4) {
        int r0 = rb * 32 + 8 * q4 + 4 * hh;
        f32x4 cr = *(const f32x4*)(cum + r0), dr = *(const f32x4*)(dta + r0);
#pragma unroll
        for (int e = 0; e < 4; ++e) {
          int r = r0 + e;
          bool keep = dir == 0 ? (r <= s) : (r >= s);
          float arg = fminf(cs - cr[e], 0.f);
          val[4 * q4 + e] = keep ? gt[4 * q4 + e] * __expf(arg) * dr[e] : 0.f;
        }
      }
#pragma unroll
      for (int sp = 0; sp < 2; ++sp) {
        u32x4 w;
#pragma unroll
        for (int e = 0; e < 4; ++e) w[e] = pack2(val[8 * sp + 2 * e], val[8 * sp + 2 * e + 1]);
        bf16x8 pf = *(bf16x8*)&w;
#pragma unroll
        for (int pb = 0; pb < 2; ++pb) {
          const char* xa = XT + (pb * 32 + l31) * SSD_TSTR + (rb * 32 + 16 * sp + 4 * hh) * 2;
          u32x2 v0 = *(const u32x2*)xa, v1 = *(const u32x2*)(xa + 16);
          u32x4 vw = {v0[0], v0[1], v1[0], v1[1]};
          Y[pb] = __builtin_amdgcn_mfma_f32_32x32x16_bf16(*(bf16x8*)&vw, pf, Y[pb], 0, 0, 0);
        }
      }
    }
  }
  bf16_t* op = p.yf + (size_t)(row0 + s) * 512 + h * 64;
#pragma unroll
  for (int pb = 0; pb < 2; ++pb)
#pragma unroll
    for (int q4 = 0; q4 < 4; ++q4) {
      u32x2 w; w.x = pack2(Y[pb][4 * q4], Y[pb][4 * q4 + 1]); w.y = pack2(Y[pb][4 * q4 + 2], Y[pb][4 * q4 + 3]);
      *(u32x2*)(op + pb * 32 + 8 * q4 + 4 * hh) = w;
    }
}

__device__ __forceinline__ void phase_ssdout(const Params& p, int layer, int nrows) {
  const int lane = tidx() & 63, wv = tidx() >> 6;
  const float* ng = p.ssd_norm + layer * 512;
  for (int row = bidx() * 4 + wv; row < nrows; row += gridDim.x * 4) {
    int c0 = lane * 8; int h = c0 >> 6;
    float Dk = p.ssd_d[layer * 8 + h];
    u32x4 a = *(const u32x4*)(p.yf + (size_t)row * 512 + c0);
    u32x4 xs = *(const u32x4*)(p.xbc + (size_t)row * 768 + c0), z = *(const u32x4*)(p.proj + (size_t)row * 4096 + 768 + c0);
    float y[8]; float ss = 0.f;
#pragma unroll
    for (int e = 0; e < 4; ++e) {
      float y0 = __uint_as_float(a[e] << 16) + __uint_as_float(xs[e] << 16) * Dk;
      float y1 = __uint_as_float(a[e] & 0xffff0000u) + __uint_as_float(xs[e] & 0xffff0000u) * Dk;
      y0 *= siluf_(__uint_as_float(z[e] << 16)); y1 *= siluf_(__uint_as_float(z[e] & 0xffff0000u));
      y[2 * e] = y0; y[2 * e + 1] = y1; ss += y0 * y0 + y1 * y1;
    }
    ss = wave_sum(ss);
    float rs = rsqrtf(ss * (1.f / 512.f) + 1e-6f);
    u32x4 w;
#pragma unroll
    for (int e = 0; e < 4; ++e) w[e] = pack2(y[2 * e] * rs * ng[c0 + 2 * e], y[2 * e + 1] * rs * ng[c0 + 2 * e + 1]);
    *(u32x4*)(p.br + (size_t)row * 1536 + 512 + c0) = w;
  }
}

__device__ __forceinline__ float wave_incl_maxscan(float v, int lane) {
#pragma unroll
  for (int o = 1; o < 64; o <<= 1) { float t = __shfl_up(v, o); if (lane >= o) v = fmaxf(v, t); }
  return v;
}
__device__ __forceinline__ void ml_scans(const Params& p, int layer, int row0, int h, float* fl) {
  const int tid = tidx(), lane = tid & 63, wv = tid >> 6;
  const int dir = tid >> 7;
  const int s = dir == 0 ? tid : 127 - (tid - 128);
  const float ip = p.small[(size_t)(row0 + s) * 32 + 16 + dir * 8 + h] + p.ml_gate_bias[layer * 16 + dir * 8 + h];
  const float fp = p.small[(size_t)(row0 + s) * 32 + 16 + dir * 8 + 4 + h] + p.ml_gate_bias[layer * 16 + dir * 8 + 4 + h];
  float bc = wave_incl_scan(logsigmoidf_(fp), lane);
  if (lane == 63) fl[768 + wv] = bc;
  __syncthreads();
  if (wv & 1) bc += fl[768 + wv - 1];
  const float u = ip - bc;
  float pm = wave_incl_maxscan(u, lane);
  if (lane == 63) fl[776 + wv] = pm;
  __syncthreads();
  if (wv & 1) pm = fmaxf(pm, fl[776 + wv - 1]);
  fl[dir * 128 + s] = bc; fl[256 + dir * 128 + s] = u; fl[512 + dir * 128 + s] = pm;
  __syncthreads();
}

#define ML_TSTR 272
__device__ __forceinline__ void mlA_item(const Params& p, int layer, int item) {
  const int tid = tidx(), wid = tid >> 6, lane = tid & 63, l31 = lane & 31, hh = lane >> 5;
  const int b = item / 264, c = (item / 4) % 66, h = item & 3;
  const int row0 = chunk_row0(b, c);
  float* fl = (float*)smem;
  char* KT = smem + 8192;
  char* VW = KT + 128 * ML_TSTR;
  __syncthreads();
  ml_scans(p, layer, row0, h, fl);
  const int r_ = tid >> 1, half = tid & 1;
  {
    const bf16_t* kr = p.proj + (size_t)(row0 + r_) * 4096 + 2560 + h * 128 + half * 64;
#pragma unroll
    for (int i = 0; i < 8; ++i) {
      u32x4 kv = *(const u32x4*)(kr + i * 8);
#pragma unroll
      for (int e = 0; e < 4; ++e) {
        int ee = half * 64 + i * 8 + 2 * e;
        *(bf16_t*)(KT + ee * ML_TSTR + r_ * 2) = (bf16_t)(kv[e] & 0xffffu);
        *(bf16_t*)(KT + (ee + 1) * ML_TSTR + r_ * 2) = (bf16_t)(kv[e] >> 16);
      }
    }
  }
  for (int dir = 0; dir < 2; ++dir) {
    const int seq = (dir * 2 + b) * 4 + h;
    const float blast = fl[dir * 128 + (dir == 0 ? 127 : 0)];
    const float umax = fl[512 + dir * 128 + (dir == 0 ? 127 : 0)];
    {
      const float wgt = __expf(fl[256 + dir * 128 + r_] - umax) * 0.08838834764831845f;
      if (half == 0) fl[1024 + r_] = wgt;
      const bf16_t* vr = p.proj + (size_t)(row0 + r_) * 4096 + 3072 + h * 128 + half * 64;
#pragma unroll
      for (int i = 0; i < 8; ++i) {
        u32x4 vv = *(const u32x4*)(vr + i * 8);
#pragma unroll
        for (int e = 0; e < 4; ++e) {
          int dd = half * 64 + i * 8 + 2 * e;
          *(bf16_t*)(VW + dd * ML_TSTR + r_ * 2) = f2bf(__uint_as_float(vv[e] << 16) * wgt);
          *(bf16_t*)(VW + (dd + 1) * ML_TSTR + r_ * 2) = f2bf(__uint_as_float(vv[e] & 0xffff0000u) * wgt);
        }
      }
    }
    __syncthreads();
    {
      const int e_ = tid & 127, hf = tid >> 7;
      float a = 0.f;
#pragma unroll
      for (int i = 0; i < 8; ++i) {
        u32x4 kv = *(const u32x4*)(KT + e_ * ML_TSTR + (hf * 64 + i * 8) * 2);
        const float* wp = fl + 1024 + hf * 64 + i * 8;
#pragma unroll
        for (int e = 0; e < 4; ++e) a += __uint_as_float(kv[e] << 16) * wp[2 * e] + __uint_as_float(kv[e] & 0xffff0000u) * wp[2 * e + 1];
      }
      if (hf == 1) fl[1280 + e_] = a;
      __syncthreads();
      if (hf == 0) p.mnl[((size_t)seq * 66 + c) * 128 + e_] = a + fl[1280 + e_];
    }
    f32x16 acc[4];
#pragma unroll
    for (int eb = 0; eb < 4; ++eb)
#pragma unroll
      for (int r = 0; r < 16; ++r) acc[eb][r] = 0.f;
#pragma unroll
    for (int ks = 0; ks < 8; ++ks) {
      bf16x8 bv = *(const bf16x8*)(VW + (wid * 32 + l31) * ML_TSTR + (ks * 16 + hh * 8) * 2);
#pragma unroll
      for (int eb = 0; eb < 4; ++eb) {
        bf16x8 av = *(const bf16x8*)(KT + (eb * 32 + l31) * ML_TSTR + (ks * 16 + hh * 8) * 2);
        acc[eb] = __builtin_amdgcn_mfma_f32_32x32x16_bf16(av, bv, acc[eb], 0, 0, 0);
      }
    }
    bf16_t* dst = p.mcl + (((size_t)seq * 66 + c) * 128 + wid * 32 + l31) * 128 + 4 * hh;
#pragma unroll
    for (int eb = 0; eb < 4; ++eb)
#pragma unroll
      for (int q4 = 0; q4 < 4; ++q4) {
        u32x2 w; w.x = pack2(acc[eb][4 * q4], acc[eb][4 * q4 + 1]); w.y = pack2(acc[eb][4 * q4 + 2], acc[eb][4 * q4 + 3]);
        *(u32x2*)(dst + eb * 32 + 8 * q4) = w;
      }
    if (tid == 0) { p.mml[seq * 66 + c] = blast + umax; p.mbl[seq * 66 + c] = blast; }
    __syncthreads();
  }
}

__device__ __forceinline__ void phase_mlcarry(const Params& p) {
  const int per = 4096 + 32;
  const int total = 16 * per;
  for (int i = bidx() * NTHR + tidx(); i < total; i += gridDim.x * NTHR) {
    const int seq = i / per, j = i % per;
    const int dir = seq >> 3;
    const float* ml = p.mml + seq * 66; const float* bl = p.mbl + seq * 66;
    float m = 0.f;
    float st[4] = {0.f, 0.f, 0.f, 0.f};
    const bool isC = j < 4096;
    bf16_t* cb = p.mcl + (size_t)seq * 66 * 16384 + (isC ? j * 4 : 0);
    float* nb = p.mnl + (size_t)seq * 66 * 128 + (isC ? 0 : (j - 4096) * 4);
#pragma unroll 11
    for (int k = 0; k < 66; ++k) {
      int c = dir == 0 ? (k < 2 ? 64 + k : k - 2) : (65 - k);
      float mlc = ml[c], blc = bl[c];
      float mnew = fmaxf(blc + m, mlc);
      float ap = __expf(blc + m - mnew), al = __expf(mlc - mnew);
      if (isC) {
        u32x2 v = *(const u32x2*)(cb + (size_t)c * 16384);
        u32x2 w; w.x = pack2(st[0], st[1]); w.y = pack2(st[2], st[3]);
        *(u32x2*)(cb + (size_t)c * 16384) = w;
        st[0] = ap * st[0] + al * __uint_as_float(v.x << 16); st[1] = ap * st[1] + al * __uint_as_float(v.x & 0xffff0000u);
        st[2] = ap * st[2] + al * __uint_as_float(v.y << 16); st[3] = ap * st[3] + al * __uint_as_float(v.y & 0xffff0000u);
        if (j == 0) p.mmp[seq * 66 + c] = m;
      } else {
        f32x4 v = *(const f32x4*)(nb + (size_t)c * 128);
        f32x4 w = {st[0], st[1], st[2], st[3]};
        *(f32x4*)(nb + (size_t)c * 128) = w;
        st[0] = ap * st[0] + al * v[0]; st[1] = ap * st[1] + al * v[1]; st[2] = ap * st[2] + al * v[2]; st[3] = ap * st[3] + al * v[3];
      }
      m = mnew;
    }
  }
}

__device__ __forceinline__ void mlC_item(const Params& p, int layer, int item) {
  const int tid = tidx(), wid = tid >> 6, lane = tid & 63, l31 = lane & 31, hh = lane >> 5;
  const int b = item / 264, c = (item / 4) % 66, h = item & 3;
  const int row0 = chunk_row0(b, c);
  float* fl = (float*)smem;
  char* Kt = smem + 8192;
  char* VT = Kt + 128 * ML_TSTR;
  __syncthreads();
  ml_scans(p, layer, row0, h, fl);
  {
#pragma unroll
    for (int i = 0; i < 8; ++i) {
      int id = tid + 256 * i, r = id >> 4, c16 = id & 15;
      *(u32x4*)(Kt + r * ML_TSTR + c16 * 16) = *(const u32x4*)(p.proj + (size_t)(row0 + r) * 4096 + 2560 + h * 128 + c16 * 8);
    }
    const int r_ = tid >> 1, half = tid & 1;
    const bf16_t* vr = p.proj + (size_t)(row0 + r_) * 4096 + 3072 + h * 128 + half * 64;
#pragma unroll
    for (int i = 0; i < 8; ++i) {
      u32x4 vv = *(const u32x4*)(vr + i * 8);
#pragma unroll
      for (int e = 0; e < 4; ++e) {
        int dd = half * 64 + i * 8 + 2 * e;
        *(bf16_t*)(VT + dd * ML_TSTR + r_ * 2) = (bf16_t)(vv[e] & 0xffffu);
        *(bf16_t*)(VT + (dd + 1) * ML_TSTR + r_ * 2) = (bf16_t)(vv[e] >> 16);
      }
    }
    {
      const int dir = tid >> 7, e_ = tid & 127;
      const int seq = (dir * 2 + b) * 4 + h;
      fl[1024 + dir * 128 + e_] = p.mnl[((size_t)seq * 66 + c) * 128 + e_];
    }
  }
  __syncthreads();
  const int s = wid * 32 + l31;
  bf16x8 qf[8];
#pragma unroll
  for (int ks = 0; ks < 8; ++ks) qf[ks] = *(const bf16x8*)(p.proj + (size_t)(row0 + s) * 4096 + 2048 + h * 128 + ks * 16 + hh * 8);
  f32x16 hacc[4];
#pragma unroll
  for (int db = 0; db < 4; ++db)
#pragma unroll
    for (int r = 0; r < 16; ++r) hacc[db][r] = 0.f;
  for (int dir = 0; dir < 2; ++dir) {
    const int seq = (dir * 2 + b) * 4 + h;
    const float mprev = p.mmp[seq * 66 + c];
    const float bcs = fl[dir * 128 + s], pms = fl[512 + dir * 128 + s];
    const float msel = fmaxf(mprev, pms);
    const float ms = bcs + msel;
    const float winter = __expf(mprev - msel);
    const float* uu = fl + 256 + dir * 128;
    float qn = 0.f;
    {
      const float* np = fl + 1024 + dir * 128;
#pragma unroll
      for (int ks = 0; ks < 8; ++ks) {
        u32x4 w = *(u32x4*)&qf[ks];
        const float* npp = np + ks * 16 + hh * 8;
#pragma unroll
        for (int e = 0; e < 4; ++e) qn += __uint_as_float(w[e] << 16) * npp[2 * e] + __uint_as_float(w[e] & 0xffff0000u) * npp[2 * e + 1];
      }
      qn += __shfl_xor(qn, 32);
    }
    float den = 0.f;
    for (int rb = 0; rb < 4; ++rb) {
      if (dir == 0 ? (rb > wid) : (rb < wid)) continue;
      f32x16 st;
#pragma unroll
      for (int r = 0; r < 16; ++r) st[r] = 0.f;
#pragma unroll
      for (int ks = 0; ks < 8; ++ks) {
        bf16x8 a = *(const bf16x8*)(Kt + (rb * 32 + l31) * ML_TSTR + (ks * 16 + hh * 8) * 2);
        st = __builtin_amdgcn_mfma_f32_32x32x16_bf16(a, qf[ks], st, 0, 0, 0);
      }
#pragma unroll
      for (int q4 = 0; q4 < 4; ++q4) {
        int r0 = rb * 32 + 8 * q4 + 4 * hh;
        f32x4 ur = *(const f32x4*)(uu + r0);
#pragma unroll
        for (int e = 0; e < 4; ++e) {
          int r = r0 + e;
          bool keep = dir == 0 ? (r <= s) : (r >= s);
          float arg = fminf(ur[e] - msel, 0.f);
          den += keep ? st[4 * q4 + e] * 0.08838834764831845f * __expf(arg) : 0.f;
        }
      }
    }
    den += __shfl_xor(den, 32);
    den += winter * qn;
    const float inv = 1.f / fmaxf(fabsf(den), __expf(-ms));
    {
      const float qs = winter * inv;
      const bf16_t* cp = p.mcl + ((size_t)seq * 66 + c) * 16384;
#pragma unroll
      for (int ks = 0; ks < 8; ++ks) {
        u32x4 w = *(u32x4*)&qf[ks];
        u32x4 ws;
#pragma unroll
        for (int e = 0; e < 4; ++e) ws[e] = pack2(__uint_as_float(w[e] << 16) * qs, __uint_as_float(w[e] & 0xffff0000u) * qs);
        bf16x8 qsf = *(bf16x8*)&ws;
#pragma unroll
        for (int db = 0; db < 4; ++db) {
          bf16x8 a = *(const bf16x8*)(cp + (db * 32 + l31) * 128 + ks * 16 + hh * 8);
          hacc[db] = __builtin_amdgcn_mfma_f32_32x32x16_bf16(a, qsf, hacc[db], 0, 0, 0);
        }
      }
    }
    for (int rb = 0; rb < 4; ++rb) {
      if (dir == 0 ? (rb > wid) : (rb < wid)) continue;
      f32x16 st;
#pragma unroll
      for (int r = 0; r < 16; ++r) st[r] = 0.f;
#pragma unroll
      for (int ks = 0; ks < 8; ++ks) {
        bf16x8 a = *(const bf16x8*)(Kt + (rb * 32 + l31) * ML_TSTR + (ks * 16 + hh * 8) * 2);
        st = __builtin_amdgcn_mfma_f32_32x32x16_bf16(a, qf[ks], st, 0, 0, 0);
      }
      const float sc = 0.08838834764831845f * inv;
#pragma unroll
      for (int sp = 0; sp < 2; ++sp) {
        u32x4 w;
#pragma unroll
        for (int q2 = 0; q2 < 2; ++q2) {
          int q4 = 2 * sp + q2;
          int r0 = rb * 32 + 8 * q4 + 4 * hh;
          f32x4 ur = *(const f32x4*)(uu + r0);
          float v[4];
#pragma unroll
          for (int e = 0; e < 4; ++e) {
            int r = r0 + e;
            bool keep = dir == 0 ? (r <= s) : (r >= s);
            float arg = fminf(ur[e] - msel, 0.f);
            v[e] = keep ? st[4 * q4 + e] * sc * __expf(arg) : 0.f;
          }
          w[2 * q2] = pack2(v[0], v[1]); w[2 * q2 + 1] = pack2(v[2], v[3]);
        }
        bf16x8 pf = *(bf16x8*)&w;
#pragma unroll
        for (int db = 0; db < 4; ++db) {
          const char* va = VT + (db * 32 + l31) * ML_TSTR + (rb * 32 + 16 * sp + 4 * hh) * 2;
          u32x2 v0 = *(const u32x2*)va, v1 = *(const u32x2*)(va + 16);
          u32x4 vw = {v0[0], v0[1], v1[0], v1[1]};
          hacc[db] = __builtin_amdgcn_mfma_f32_32x32x16_bf16(*(bf16x8*)&vw, pf, hacc[db], 0, 0, 0);
        }
      }
    }
  }
  bf16_t* op = p.hf + (size_t)(row0 + s) * 512 + h * 128;
#pragma unroll
  for (int db = 0; db < 4; ++db)
#pragma unroll
    for (int q4 = 0; q4 < 4; ++q4) {
      u32x2 w; w.x = pack2(hacc[db][4 * q4], hacc[db][4 * q4 + 1]); w.y = pack2(hacc[db][4 * q4 + 2], hacc[db][4 * q4 + 3]);
      *(u32x2*)(op + db * 32 + 8 * q4 + 4 * hh) = w;
    }
}

__device__ __forceinline__ void phase_mlout(const Params& p, int layer, int nrows) {
  const int lane = tidx() & 63, wv = tidx() >> 6;
  const float* ng = p.ml_norm + layer * 512;
  for (int row = bidx() * 4 + wv; row < nrows; row += gridDim.x * 4) {
    int c0 = lane * 8;
    u32x4 a = *(const u32x4*)(p.hf + (size_t)row * 512 + c0);
    u32x4 o = *(const u32x4*)(p.proj + (size_t)row * 4096 + 3584 + c0);
    float y[8]; float ss = 0.f;
#pragma unroll
    for (int e = 0; e < 4; ++e) {
      float y0 = __uint_as_float(a[e] << 16);
      float y1 = __uint_as_float(a[e] & 0xffff0000u);
      y[2 * e] = y0; y[2 * e + 1] = y1; ss += y0 * y0 + y1 * y1;
    }
    ss += __shfl_xor(ss, 1); ss += __shfl_xor(ss, 2); ss += __shfl_xor(ss, 4); ss += __shfl_xor(ss, 8);
    float rs = rsqrtf(ss * (1.f / 128.f) + 1e-6f);
    u32x4 w;
#pragma unroll
    for (int e = 0; e < 4; ++e) {
      float o0 = sigmoidf_(__uint_as_float(o[e] << 16)), o1 = sigmoidf_(__uint_as_float(o[e] & 0xffff0000u));
      w[e] = pack2(y[2 * e] * rs * ng[c0 + 2 * e] * o0, y[2 * e + 1] * rs * ng[c0 + 2 * e + 1] * o1);
    }
    *(u32x4*)(p.br + (size_t)row * 1536 + 1024 + c0) = w;
  }
}

__device__ __forceinline__ void phase_uvconv(const Params& p, int layer) {
  const size_t n4 = (size_t)16384 * 1024 / 4;
  const f32x4* su = (const f32x4*)(p.peer_u + (size_t)layer * 16384 * 1024);
  const f32x4* sv = (const f32x4*)(p.peer_v + (size_t)layer * 16384 * 1024);
  u32x2* du = (u32x2*)p.uv; u32x2* dv = (u32x2*)(p.uv + (size_t)16384 * 1024);
  for (size_t i = (size_t)bidx() * NTHR + tidx(); i < n4; i += (size_t)gridDim.x * NTHR) {
    f32x4 a = su[i], b = sv[i];
    u32x2 w; w.x = pack2(a[0], a[1]); w.y = pack2(a[2], a[3]); du[i] = w;
    u32x2 w2; w2.x = pack2(b[0], b[1]); w2.y = pack2(b[2], b[3]); dv[i] = w2;
  }
}

__device__ __forceinline__ void phase_topk(const Params& p, int layer, int nrows) {
#if DIAG_HP
  float* sks = (float*)smem;
  float* qs = (float*)(smem + 2 * 128 * 129 * 4);
#else
  bf16_t* sks = (bf16_t*)smem;
  float* qs = (float*)(smem + 2 * 128 * 130 * 2);
#endif
  const int tid = tidx(), lane = tid & 63, wv = tid >> 6;
  const int nchunks = nrows / 64;
  int cur_h = -1;
  for (int item = bidx(); item < nchunks * 8; item += gridDim.x) {
    int h = item % 8, chunk = item / 8;
    if (h != cur_h) {
      __syncthreads();
#if DIAG_HP
      const float* src = p.peer_subkeys + ((size_t)layer * 8 + h) * 2 * 128 * 128;
      for (int i = tid; i < 2 * 128 * 128; i += NTHR) { int pk = i >> 7, d = i & 127; sks[pk * 129 + d] = src[i]; }
#else
      const bf16_t* src = p.sk + ((size_t)layer * 8 + h) * 2 * 128 * 128;
      for (int i = tid; i < 2 * 128 * 128; i += NTHR) { int pk = i >> 7, d = i & 127; sks[pk * 130 + d] = src[i]; }
#endif
      __syncthreads();
      cur_h = h;
    }
    float* myq = qs + wv * 256;
    for (int ti = 0; ti < 16; ++ti) {
      int row = chunk * 64 + wv * 16 + ti;
#if DIAG_HP
      const float* qp = p.qf + (size_t)row * 2048 + h * 256;
      myq[lane] = qp[lane]; myq[lane + 64] = qp[lane + 64]; myq[lane + 128] = qp[lane + 128]; myq[lane + 192] = qp[lane + 192];
#else
      const bf16_t* qp = p.q + (size_t)row * 2048 + h * 256;
      myq[lane] = bf2f(qp[lane]); myq[lane + 64] = bf2f(qp[lane + 64]); myq[lane + 128] = bf2f(qp[lane + 128]); myq[lane + 192] = bf2f(qp[lane + 192]);
#endif
      __builtin_amdgcn_wave_barrier();
      float s1v = 0.f, s2v = 0.f; int i1v = 0, i2v = 0;
      for (int pp = 0; pp < 2; ++pp) {
        const float* qq = myq + pp * 128;
        float a0 = 0.f, a1 = 0.f;
#if DIAG_HP
        const float* k0 = sks + (pp * 128 + lane) * 129;
        const float* k1 = sks + (pp * 128 + lane + 64) * 129;
#pragma unroll 8
        for (int d = 0; d < 128; ++d) { a0 += qq[d] * k0[d]; a1 += qq[d] * k1[d]; }
#else
        const bf16_t* k0 = sks + (pp * 128 + lane) * 130;
        const bf16_t* k1 = sks + (pp * 128 + lane + 64) * 130;
#pragma unroll 8
        for (int d = 0; d < 128; d += 2) {
          unsigned w0 = *(const unsigned*)(k0 + d), w1 = *(const unsigned*)(k1 + d);
          float q0 = qq[d], q1 = qq[d + 1];
          a0 += q0 * __uint_as_float(w0 << 16) + q1 * __uint_as_float(w0 & 0xffff0000u);
          a1 += q0 * __uint_as_float(w1 << 16) + q1 * __uint_as_float(w1 & 0xffff0000u);
        }
#endif
        float sv = 0.f; int iv = 0;
        for (int r = 0; r < 16; ++r) {
          float mx = wave_max(fmaxf(a0, a1));
          unsigned long long bal = __ballot(a0 == mx || a1 == mx);
          int wl = __ffsll((long long)bal) - 1;
          int key = 0;
          if (lane == wl) { if (a0 == mx) { key = lane; a0 = -3e38f; } else { key = lane + 64; a1 = -3e38f; } }
          key = __shfl(key, wl);
          if (lane == r) { sv = mx; iv = key; }
        }
        if (pp == 0) { s1v = sv; i1v = iv; } else { s2v = sv; i2v = iv; }
      }
      float cs[4]; int ci[4];
      float s1i = __shfl(s1v, lane >> 2); int i1i = __shfl(i1v, lane >> 2);
#pragma unroll
      for (int r = 0; r < 4; ++r) {
        int j = (lane & 3) * 4 + r;
        float s2j = __shfl(s2v, j); int i2j = __shfl(i2v, j);
        cs[r] = s1i + s2j; ci[r] = i1i * 128 + i2j;
      }
      float selv = 0.f; int seli = 0;
      for (int r = 0; r < 16; ++r) {
        float lm = fmaxf(fmaxf(cs[0], cs[1]), fmaxf(cs[2], cs[3]));
        float mx = wave_max(lm);
        unsigned long long bal = __ballot(lm == mx);
        int wl = __ffsll((long long)bal) - 1;
        int id = 0;
        if (lane == wl) {
          if (cs[0] == mx) { id = ci[0]; cs[0] = -3e38f; }
          else if (cs[1] == mx) { id = ci[1]; cs[1] = -3e38f; }
          else if (cs[2] == mx) { id = ci[2]; cs[2] = -3e38f; }
          else { id = ci[3]; cs[3] = -3e38f; }
        }
        id = __shfl(id, wl);
        if (lane == r) { selv = mx; seli = id; }
      }
      float top = __shfl(selv, 0);
      float e = lane < 16 ? __expf(selv - top) : 0.f;
      float sum = wave_sum(e);
      if (lane < 16) {
        p.idx[(size_t)row * 128 + h * 16 + lane] = seli;
        p.gw[(size_t)row * 128 + h * 16 + lane] = e / sum;
      }
      __builtin_amdgcn_wave_barrier();
    }
  }
}

__device__ __forceinline__ void phase_uvconv8(const Params& p, int layer) {
  const int lane = tidx() & 63, wv = tidx() >> 6;
  for (int row = bidx() * 4 + wv; row < 32768; row += gridDim.x * 4) {
    const float* src = (row < 16384 ? p.peer_u + ((size_t)layer * 16384 + row) * 1024 : p.peer_v + ((size_t)layer * 16384 + (row - 16384)) * 1024) + lane * 16;
    f32x4 a[4]; float amax = 0.f;
#pragma unroll
    for (int i = 0; i < 4; ++i) {
      a[i] = *(const f32x4*)(src + 4 * i);
#pragma unroll
      for (int e = 0; e < 4; ++e) amax = fmaxf(amax, fabsf(a[i][e]));
    }
    amax = wave_max(amax);
    const float scale = amax > 0.f ? amax * (1.f / 127.f) : 1.f;
    const float inv = 1.f / scale;
    u32x4 w;
#pragma unroll
    for (int i = 0; i < 4; ++i) {
      unsigned q = 0;
#pragma unroll
      for (int e = 0; e < 4; ++e) {
        int v = (int)rintf(a[i][e] * inv);
        v = v < -127 ? -127 : (v > 127 ? 127 : v);
        q |= (unsigned)(v & 0xff) << (8 * e);
      }
      w[i] = q;
    }
    if (row < 16384) *(u32x4*)(p.uvq + (size_t)row * 1024 + lane * 16) = w;
    else *(u32x4*)(p.uvq + (size_t)16384 * 1024 + ((size_t)(lane >> 3) * 16384 + (row - 16384)) * 128 + (lane & 7) * 16) = w;
    if (lane == 0) p.uvs[row] = scale;
  }
}


__device__ __forceinline__ void phase_gather8(const Params& p, int layer, int nrows, float oscale, int fuse_norm) {
  const int lane = tidx() & 63, wv = tidx() >> 6;
  const unsigned char* U8 = p.uvq; const unsigned char* V8 = p.uvq + (size_t)16384 * 1024;
  const float* US = p.uvs; const float* VS = p.uvs + 16384;
  const int klane = ((lane >> 5) & 1) * 4 + ((lane >> 4) & 1) * 2 + ((lane >> 3) & 1);
  for (int row = bidx() * 4 + wv; row < nrows; row += gridDim.x * 4) {
    float xv[16], acc[16];
    {
      u32x4 a = *(const u32x4*)(p.h + (size_t)row * DM + lane * 16), b = *(const u32x4*)(p.h + (size_t)row * DM + lane * 16 + 8);
#pragma unroll
      for (int e = 0; e < 4; ++e) {
        xv[2 * e] = __uint_as_float(a[e] << 16); xv[2 * e + 1] = __uint_as_float(a[e] & 0xffff0000u);
        xv[8 + 2 * e] = __uint_as_float(b[e] << 16); xv[8 + 2 * e + 1] = __uint_as_float(b[e] & 0xffff0000u);
      }
    }
    float xs = 0.f;
#pragma unroll
    for (int i = 0; i < 16; ++i) { acc[i] = 0.f; xs += xv[i]; }
    xs = wave_sum(xs) * 128.f;
    const int myidx0 = p.idx[(size_t)row * 128 + lane], myidx1 = p.idx[(size_t)row * 128 + 64 + lane];
    const float myg0 = p.gw[(size_t)row * 128 + lane], myg1 = p.gw[(size_t)row * 128 + 64 + lane];
    float wsum = 0.f;
    for (int k0 = 0; k0 < 128; k0 += 8) {
      const int srcv = k0 < 64 ? myidx0 : myidx1;
      const float srcg = k0 < 64 ? myg0 : myg1;
      const int kb = k0 & 63;
      u32x4 uq[8], vq[8];
#pragma unroll
      for (int j = 0; j < 8; ++j) {
        const int e_ = __builtin_amdgcn_readlane(srcv, kb + j);
        uq[j] = *(const u32x4*)(U8 + (size_t)e_ * 1024 + lane * 16);
        vq[j] = *(const u32x4*)(V8 + (size_t)e_ * 1024 + lane * 16);
      }
      const int el = __shfl(srcv, kb + klane);
      const float gl = __shfl(srcg, kb + klane);
      const float sul = US[el], svl = VS[el];
      float d[8];
#pragma unroll
      for (int j = 0; j < 8; ++j) {
        float s = 0.f;
#pragma unroll
        for (int c = 0; c < 4; ++c) {
          s += xv[4 * c] * ub0(uq[j][c]) + xv[4 * c + 1] * ub1(uq[j][c]) + xv[4 * c + 2] * ub2(uq[j][c]) + xv[4 * c + 3] * ub3(uq[j][c]);
        }
        d[j] = s;
      }
      float r4[4], r2[2], t;
      const bool b5 = lane & 32, b4 = lane & 16, b3 = lane & 8;
#pragma unroll
      for (int j = 0; j < 4; ++j) { float keep = b5 ? d[j + 4] : d[j], send = b5 ? d[j] : d[j + 4]; r4[j] = keep + __shfl_xor(send, 32); }
#pragma unroll
      for (int j = 0; j < 2; ++j) { float keep = b4 ? r4[j + 2] : r4[j], send = b4 ? r4[j] : r4[j + 2]; r2[j] = keep + __shfl_xor(send, 16); }
      { float keep = b3 ? r2[1] : r2[0], send = b3 ? r2[0] : r2[1]; t = keep + __shfl_xor(send, 8); }
      t += __shfl_xor(t, 4); t += __shfl_xor(t, 2); t += __shfl_xor(t, 1);
      const float dot = sul * (t - xs);
      const float wl = PEER_ALPHA * oscale * gl * gelu_tanh(dot) * svl;
#pragma unroll
      for (int j = 0; j < 8; ++j) {
        const float w = __int_as_float(__builtin_amdgcn_readlane(__float_as_int(wl), ((j >> 2) & 1) * 32 + ((j >> 1) & 1) * 16 + (j & 1) * 8));
        wsum += w;
#pragma unroll
        for (int c = 0; c < 4; ++c) {
          acc[4 * c] += w * ub0(vq[j][c]); acc[4 * c + 1] += w * ub1(vq[j][c]); acc[4 * c + 2] += w * ub2(vq[j][c]); acc[4 * c + 3] += w * ub3(vq[j][c]);
        }
      }
    }
    const float off = 128.f * wsum;
    float* xr = xrow(p, row) + lane * 16;
    const float* g2 = p.mod + (size_t)(layer * 3 + modrow(row)) * 6144 + 5 * DM + lane * 16;
    f32x4 xn[4]; float ss = 0.f;
#pragma unroll
    for (int c = 0; c < 4; ++c) {
      f32x4 x0 = *(const f32x4*)(xr + 4 * c), ga = *(const f32x4*)(g2 + 4 * c);
#pragma unroll
      for (int e = 0; e < 4; ++e) { x0[e] += ga[e] * (acc[4 * c + e] - off); ss += x0[e] * x0[e]; }
      *(f32x4*)(xr + 4 * c) = x0;
      xn[c] = x0;
    }
    if (fuse_norm) {
      ss = wave_sum(ss);
      const float rs = rsqrtf(ss * (1.f / DM) + 1e-6f);
      const float* gn = p.norm1_g + (layer + 1) * DM + lane * 16;
      const float* md = p.mod + (size_t)((layer + 1) * 3 + modrow(row)) * 6144 + lane * 16;
      u32x4 w0, w1;
#pragma unroll
      for (int c = 0; c < 4; ++c) {
        f32x4 gg = *(const f32x4*)(gn + 4 * c), sc = *(const f32x4*)(md + DM + 4 * c), sh = *(const f32x4*)(md + 4 * c);
        float o0 = xn[c][0] * rs * gg[0] * (1.f + sc[0]) + sh[0], o1 = xn[c][1] * rs * gg[1] * (1.f + sc[1]) + sh[1];
        float o2 = xn[c][2] * rs * gg[2] * (1.f + sc[2]) + sh[2], o3 = xn[c][3] * rs * gg[3] * (1.f + sc[3]) + sh[3];
        if (c < 2) { w0[2 * c] = pack2(o0, o1); w0[2 * c + 1] = pack2(o2, o3); } else { w1[2 * (c - 2)] = pack2(o0, o1); w1[2 * (c - 2) + 1] = pack2(o2, o3); }
      }
      *(u32x4*)(p.h + (size_t)row * DM + lane * 16) = w0;
      *(u32x4*)(p.h + (size_t)row * DM + lane * 16 + 8) = w1;
    }
  }
}

typedef short s16x2 __attribute__((ext_vector_type(2)));
__device__ __forceinline__ int swap32_add(int a, int b) { auto s = __builtin_amdgcn_permlane32_swap((unsigned)a, (unsigned)b, false, false); return (int)s[0] + (int)s[1]; }
__device__ __forceinline__ int swap16_add(int a, int b) { auto s = __builtin_amdgcn_permlane16_swap((unsigned)a, (unsigned)b, false, false); return (int)s[0] + (int)s[1]; }
template <int CTRL> __device__ __forceinline__ int dpp_i(int v) { return __builtin_amdgcn_update_dpp(0, v, CTRL, 0xf, 0xf, true); }
template <int CTRL> __device__ __forceinline__ float dpp_f(float v) { return __int_as_float(__builtin_amdgcn_update_dpp(0, __float_as_int(v), CTRL, 0xf, 0xf, true)); }

struct UBatch { u32x4 uq[8]; int ent[8]; int entk; float sul, svl, gl, sxk; };
__device__ __forceinline__ void gu_issue(const Params& p, UBatch& B, const int* list, int b, int r0, int lane) {
  const signed char* U8 = (const signed char*)p.uvq;
  const i32x4 e0 = *(const i32x4*)(list + b), e1 = *(const i32x4*)(list + b + 4);
#pragma unroll
  for (int j = 0; j < 8; ++j) {
    B.ent[j] = __builtin_amdgcn_readfirstlane(j < 4 ? e0[j & 3] : e1[j & 3]);
    B.uq[j] = *(const u32x4*)(U8 + (unsigned)(((B.ent[j] & 16383) << 10) + lane * 16));
  }
  B.entk = list[b + (lane >> 3)];
  const int el = B.entk & 16383;
  B.sul = p.uvs[el]; B.svl = p.uvs[16384 + el];
  B.gl = p.gw[(size_t)(r0 + (B.entk >> 23)) * 128 + ((B.entk >> 16) & 127)];
  B.sxk = p.sxq[r0 + (B.entk >> 23)];
}
__device__ __forceinline__ void gu_compute(const Params& p, const UBatch& B, const char* xl, int b, int cnt, int r0, int lane) {
  u32x4 xs[8];
#pragma unroll
  for (int j = 0; j < 8; ++j) xs[j] = *(const u32x4*)(xl + ((B.ent[j] >> 23) << 10));
  int d[8];
#pragma unroll
  for (int j = 0; j < 8; ++j) {
    int a = 0;
#pragma unroll
    for (int c = 0; c < 4; ++c) a = __builtin_amdgcn_sdot4((int)xs[j][c], (int)B.uq[j][c], a, false);
    d[j] = a;
  }
  int r4[4], r2[2];
#pragma unroll
  for (int j = 0; j < 4; ++j) r4[j] = swap32_add(d[j], d[j + 4]);
#pragma unroll
  for (int j = 0; j < 2; ++j) r2[j] = swap16_add(r4[j], r4[j + 2]);
#pragma unroll
  for (int j = 0; j < 2; ++j) { r2[j] += dpp_i<0x128>(r2[j]); r2[j] += dpp_i<0x124>(r2[j]); r2[j] += dpp_i<0x122>(r2[j]); r2[j] += dpp_i<0x121>(r2[j]); }
  const int t = (lane & 8) ? r2[1] : r2[0];
  const int tk = B.entk >> 23;
  const float dot = B.sul * B.sxk * (float)t;
  const float wl = PEER_ALPHA * B.gl * gelu_tanh(dot) * B.svl;
  if ((lane & 7) == 0 && b + (lane >> 3) < cnt) p.wbuf[(size_t)(r0 + tk) * 128 + ((B.entk >> 16) & 127)] = wl;
}
__device__ __forceinline__ void phase_gatherU(const Params& p, int layer, int nrows) {
  const int lane = tidx() & 63, wv = __builtin_amdgcn_readfirstlane(tidx() >> 6);
  const int part = bidx() & 7, vb = bidx() >> 3, nvb = (gridDim.x - part + 7) >> 3;
  int* list = (int*)(smem + wv * 6400);
  char* xlw = smem + wv * 6400 + 2304;
  const char* xl = xlw + lane * 16;
  for (int r0 = (vb * 4 + wv) * 4; r0 < nrows; r0 += nvb * 16) {
    int iv[8];
#pragma unroll
    for (int q = 0; q < 8; ++q) iv[q] = p.idx[(size_t)(r0 + (q >> 1)) * 128 + (q & 1) * 64 + lane];
    u32x4 x4[4];
#pragma unroll
    for (int t = 0; t < 4; ++t) x4[t] = *(const u32x4*)(p.xq + (size_t)(r0 + t) * DM + lane * 16);
    int cnt = 0;
    __builtin_amdgcn_wave_barrier();
#pragma unroll
    for (int q = 0; q < 8; ++q) {
      const bool in = (iv[q] >> 11) == part;
      const unsigned long long m = __ballot(in);
      const int rk = cnt + __builtin_amdgcn_mbcnt_hi((unsigned)(m >> 32), __builtin_amdgcn_mbcnt_lo((unsigned)m, 0));
      if (in) list[rk] = ((q >> 1) << 23) | (((q & 1) * 64 + lane) << 16) | iv[q];
      cnt += __popcll(m);
    }
    if (lane < 8) list[cnt + lane] = part << 11;
#pragma unroll
    for (int t = 0; t < 4; ++t) *(u32x4*)(xlw + t * 1024 + lane * 16) = x4[t];
    __builtin_amdgcn_wave_barrier();
    if (cnt == 0) continue;
    UBatch A, Bb;
    const int lastb = (cnt - 1) & ~7;
    gu_issue(p, A, list, 0, r0, lane);
    for (int b = 0; b < cnt; b += 16) {
      gu_issue(p, Bb, list, b + 8 < lastb ? b + 8 : lastb, r0, lane);
      gu_compute(p, A, xl, b, cnt, r0, lane);
      gu_issue(p, A, list, b + 16 < lastb ? b + 16 : lastb, r0, lane);
      if (b + 8 < cnt) gu_compute(p, Bb, xl, b + 8, cnt, r0, lane);
    }
  }
}

struct VMeta { i32x4 ie[4]; f32x4 we[4]; };
struct VRows { u32x4 vq[16]; int wq4[4]; float sw; f32x2 x0, ga; };
__device__ __forceinline__ void gv_meta(const Params& p, VMeta& M, int row, int goff) {
  const int* ip = p.idx + (size_t)row * 128; const float* wp = p.wbuf + (size_t)row * 128;
#pragma unroll
  for (int i = 0; i < 4; ++i) {
    M.ie[i] = *(const i32x4*)((const char*)ip + (unsigned)(goff + 16 * i));
    M.we[i] = *(const f32x4*)((const char*)wp + (unsigned)(goff + 16 * i));
  }
}
__device__ __forceinline__ void gv_rows(const Params& p, VRows& R, const VMeta& M, const signed char* V8, int loff, int row, int layer, int coff) {
#pragma unroll
  for (int j = 0; j < 16; ++j) R.vq[j] = *(const u32x4*)(V8 + (unsigned)((M.ie[j >> 2][j & 3] << 7) + loff));
  R.x0 = *(const f32x2*)((const char*)xrow(p, row) + (unsigned)coff);
  R.ga = *(const f32x2*)((const char*)(p.mod + (size_t)(layer * 3 + modrow(row)) * 6144 + 5 * DM) + (unsigned)coff);
  float mx = fmaxf(fmaxf(fabsf(M.we[0][0]), fabsf(M.we[0][1])), fmaxf(fabsf(M.we[0][2]), fabsf(M.we[0][3])));
#pragma unroll
  for (int i = 1; i < 4; ++i) mx = fmaxf(fmaxf(fmaxf(mx, fabsf(M.we[i][0])), fmaxf(fabsf(M.we[i][1]), fabsf(M.we[i][2]))), fabsf(M.we[i][3]));
  mx = fmaxf(mx, dpp_f<0x128>(mx));
  { auto s = __builtin_amdgcn_permlane16_swap(__float_as_uint(mx), __float_as_uint(mx), false, false); mx = fmaxf(__uint_as_float(s[0]), __uint_as_float(s[1])); }
  { auto s = __builtin_amdgcn_permlane32_swap(__float_as_uint(mx), __float_as_uint(mx), false, false); mx = fmaxf(__uint_as_float(s[0]), __uint_as_float(s[1])); }
  R.sw = mx > 0.f ? mx * (1.f / 127.f) : 1.f;
  const float k = (mx > 0.f ? 127.f / mx : 1.f) * (256.f / 32767.f);
#pragma unroll
  for (int i = 0; i < 4; ++i) {
    auto c0 = __builtin_amdgcn_cvt_pknorm_i16(M.we[i][0] * k, M.we[i][1] * k), c1 = __builtin_amdgcn_cvt_pknorm_i16(M.we[i][2] * k, M.we[i][3] * k);
    s16x2 a = {c0[0], c0[1]}, bq = {c1[0], c1[1]};
    a = a + (s16x2){128, 128}; bq = bq + (s16x2){128, 128};
    const unsigned ua = ((unsigned)(unsigned short)a[1] << 16) | (unsigned short)a[0], ub = ((unsigned)(unsigned short)bq[1] << 16) | (unsigned short)bq[0];
    R.wq4[i] = (int)__builtin_amdgcn_perm(ub, ua, 0x07050301u);
  }
}
__device__ __forceinline__ void gv_compute(const Params& p, const VRows& R, int row, int coff, int lane, float oscale, bool valid = true) {
  int acc[16];
#pragma unroll
  for (int grp = 0; grp < 4; ++grp) {
#pragma unroll
    for (int dw = 0; dw < 4; ++dw) {
      if (grp == 0) { acc[4 * dw] = 0; acc[4 * dw + 1] = 0; acc[4 * dw + 2] = 0; acc[4 * dw + 3] = 0; }
      const unsigned D0 = R.vq[4 * grp][dw], D1 = R.vq[4 * grp + 1][dw], D2 = R.vq[4 * grp + 2][dw], D3 = R.vq[4 * grp + 3][dw];
      const unsigned P0 = __builtin_amdgcn_perm(D1, D0, 0x05010400u), P1 = __builtin_amdgcn_perm(D1, D0, 0x07030602u);
      const unsigned Q0 = __builtin_amdgcn_perm(D3, D2, 0x05010400u), Q1 = __builtin_amdgcn_perm(D3, D2, 0x07030602u);
      const unsigned T0 = __builtin_amdgcn_perm(Q0, P0, 0x05040100u), T1 = __builtin_amdgcn_perm(Q0, P0, 0x07060302u);
      const unsigned T2 = __builtin_amdgcn_perm(Q1, P1, 0x05040100u), T3 = __builtin_amdgcn_perm(Q1, P1, 0x07060302u);
      acc[4 * dw] = __builtin_amdgcn_sdot4((int)T0, R.wq4[grp], acc[4 * dw], false);
      acc[4 * dw + 1] = __builtin_amdgcn_sdot4((int)T1, R.wq4[grp], acc[4 * dw + 1], false);
      acc[4 * dw + 2] = __builtin_amdgcn_sdot4((int)T2, R.wq4[grp], acc[4 * dw + 2], false);
      acc[4 * dw + 3] = __builtin_amdgcn_sdot4((int)T3, R.wq4[grp], acc[4 * dw + 3], false);
    }
  }
  int r8[8], r4[4], r2[2];
#pragma unroll
  for (int j = 0; j < 8; ++j) r8[j] = swap32_add(acc[j], acc[j + 8]);
#pragma unroll
  for (int j = 0; j < 4; ++j) r4[j] = swap16_add(r8[j], r8[j + 4]);
#pragma unroll
  for (int j = 0; j < 4; ++j) r4[j] += dpp_i<0x128>(r4[j]);
  const bool b3 = lane & 8;
  r2[0] = b3 ? r4[2] : r4[0]; r2[1] = b3 ? r4[3] : r4[1];
  f32x2 x0 = R.x0;
  x0[0] += oscale * R.ga[0] * R.sw * (float)r2[0]; x0[1] += oscale * R.ga[1] * R.sw * (float)r2[1];
  if (valid) *(f32x2*)((char*)xrow(p, row) + (unsigned)coff) = x0;
}
__device__ __forceinline__ void phase_gatherV(const Params& p, int layer, int nrows, float oscale = 1.f) {
  const int lane = tidx() & 63, wv = __builtin_amdgcn_readfirstlane(tidx() >> 6);
  const int part = bidx() & 7, vb = bidx() >> 3, nvb = (gridDim.x - part + 7) >> 3;
  const signed char* V8 = (const signed char*)p.uvq + (size_t)16384 * 1024 + (size_t)part * 16384 * 128;
  const int loff = (lane & 7) * 16, goff = (lane >> 3) * 64;
  const int coff = 4 * (part * 128 + (lane & 7) * 16 + ((lane >> 5) & 1) * 8 + ((lane >> 4) & 1) * 4 + ((lane >> 3) & 1) * 2);
  const int rs = nvb * 4, rfirst = vb * 4 + wv;
  if (rfirst >= nrows) return;
  const int n = (nrows - rfirst + rs - 1) / rs;
  VMeta M; VRows RA, RB;
#define ROWK(k) (rfirst + ((k) < n - 1 ? (k) : n - 1) * rs)
  gv_meta(p, M, ROWK(0), goff);
  gv_rows(p, RA, M, V8, loff, ROWK(0), layer, coff);
  gv_meta(p, M, ROWK(1), goff);
  for (int k = 0; k < n; k += 2) {
    gv_rows(p, RB, M, V8, loff, ROWK(k + 1), layer, coff);
    gv_meta(p, M, ROWK(k + 2), goff);
    gv_compute(p, RA, ROWK(k), coff, lane, oscale);
    gv_rows(p, RA, M, V8, loff, ROWK(k + 2), layer, coff);
    gv_meta(p, M, ROWK(k + 3), goff);
    gv_compute(p, RB, ROWK(k + 1), coff, lane, oscale, k + 1 < n);
  }
#undef ROWK
}

__device__ __forceinline__ unsigned f2key(float f) { unsigned u = __float_as_uint(f); return (u & 0x80000000u) ? ~u : (u | 0x80000000u); }
__device__ __forceinline__ float key2f(unsigned k) { unsigned u = (k & 0x80000000u) ? (k ^ 0x80000000u) : ~k; return __uint_as_float(u); }
#define INS16(L, vv) { unsigned v_ = (vv); _Pragma("unroll") for (int j_ = 0; j_ < 16; ++j_) { unsigned hi_ = max(L[j_], v_); v_ = min(L[j_], v_); L[j_] = hi_; } }
__device__ __forceinline__ unsigned sel16(const unsigned (&a)[16], unsigned i) {
  unsigned t[8], u[4], v[2];
#pragma unroll
  for (int k = 0; k < 8; ++k) t[k] = (i & 1u) ? a[2 * k + 1] : a[2 * k];
#pragma unroll
  for (int k = 0; k < 4; ++k) u[k] = (i & 2u) ? t[2 * k + 1] : t[2 * k];
#pragma unroll
  for (int k = 0; k < 2; ++k) v[k] = (i & 4u) ? u[2 * k + 1] : u[2 * k];
  return (i & 8u) ? v[1] : v[0];
}

__device__ __forceinline__ void sort16_desc(unsigned (&a)[16]) {
#pragma unroll
  for (int k = 2; k <= 16; k <<= 1)
#pragma unroll
    for (int j = k >> 1; j > 0; j >>= 1)
#pragma unroll
      for (int i = 0; i < 16; ++i) {
        const int l = i ^ j;
        if (l > i) {
          const unsigned hi = max(a[i], a[l]), lo = min(a[i], a[l]);
          if ((i & k) == 0) { a[i] = hi; a[l] = lo; } else { a[i] = lo; a[l] = hi; }
        }
      }
}
__device__ __forceinline__ void merge16_desc(unsigned (&L)[16], const unsigned (&g)[16]) {
#pragma unroll
  for (int i = 0; i < 16; ++i) L[i] = max(L[i], g[15 - i]);
#pragma unroll
  for (int j = 8; j > 0; j >>= 1)
#pragma unroll
    for (int i = 0; i < 16; ++i) {
      const int l = i ^ j;
      if (l > i) { const unsigned hi = max(L[i], L[l]), lo = min(L[i], L[l]); L[i] = hi; L[l] = lo; }
    }
}
__device__ __forceinline__ void phase_topk2(const Params& p, int layer, int nrows) {
  char* SK = smem;
  const int tid = tidx(), wid = tid >> 6, lane = tid & 63, l31 = lane & 31, hh = lane >> 5;
  const int ntiles = nrows / 128;
  int cur_h = -1;
  for (int item = bidx(); item < ntiles * 8; item += gridDim.x) {
    const int h = item & 7, tile = item >> 3;
    if (h != cur_h) {
      __syncthreads();
      const bf16_t* src = p.sk + ((size_t)layer * 8 + h) * 2 * 128 * 128;
#pragma unroll
      for (int i = 0; i < 16; ++i) {
        int id = tid + 256 * i, row = id >> 4, c16 = id & 15;
        *(u32x4*)(SK + row * 272 + c16 * 16) = *(const u32x4*)(src + (size_t)row * 128 + c16 * 8);
      }
      __syncthreads();
      cur_h = h;
    }
    const int row = tile * 128 + wid * 32 + l31;
    f32x16 sc[2][4];
#pragma unroll
    for (int pp = 0; pp < 2; ++pp) {
      bf16x8 qf[8];
#pragma unroll
      for (int ks = 0; ks < 8; ++ks) qf[ks] = *(const bf16x8*)(p.q + (size_t)row * 2048 + h * 256 + pp * 128 + ks * 16 + hh * 8);
#pragma unroll
      for (int kb = 0; kb < 4; ++kb) {
#pragma unroll
        for (int r = 0; r < 16; ++r) sc[pp][kb][r] = 0.f;
#pragma unroll
        for (int ks = 0; ks < 8; ++ks) {
          bf16x8 a = *(const bf16x8*)(SK + (pp * 128 + kb * 32 + l31) * 272 + (ks * 16 + hh * 8) * 2);
          sc[pp][kb] = __builtin_amdgcn_mfma_f32_32x32x16_bf16(a, qf[ks], sc[pp][kb], 0, 0, 0);
        }
      }
    }
    unsigned L1[16];
#pragma unroll
    for (int j = 0; j < 16; ++j) L1[j] = 0u;
#pragma unroll
    for (int kb = 0; kb < 4; ++kb)
#pragma unroll
      for (int rh = 0; rh < 2; ++rh) {
        unsigned g[16];
#pragma unroll
        for (int rr = 0; rr < 8; ++rr) {
          const int r = rh * 8 + rr;
          auto sw = __builtin_amdgcn_permlane32_swap(__float_as_uint(sc[0][kb][r]), __float_as_uint(sc[1][kb][r]), false, false);
          const unsigned kidx = kb * 32 + (r & 3) + 8 * (r >> 2);
          g[2 * rr] = (f2key(__uint_as_float(sw[0])) & ~127u) | kidx;
          g[2 * rr + 1] = (f2key(__uint_as_float(sw[1])) & ~127u) | (kidx + 4);
        }
        sort16_desc(g);
        merge16_desc(L1, g);
      }
    float As[16], Bs[16]; unsigned Ai[16], Bi[16];
#pragma unroll
    for (int j = 0; j < 16; ++j) {
      auto sw = __builtin_amdgcn_permlane32_swap(L1[j], L1[j], false, false);
      unsigned other = hh ? sw[0] : sw[1];
      unsigned ka = hh ? other : L1[j], kb_ = hh ? L1[j] : other;
      As[j] = key2f(ka & ~127u); Ai[j] = ka & 127u;
      Bs[j] = key2f(kb_ & ~127u); Bi[j] = kb_ & 127u;
    }
    unsigned L2[16];
#pragma unroll
    for (int j = 0; j < 16; ++j) L2[j] = 0u;
    const float smax = As[0] + Bs[0];
#define CKEY(i, j) (((262143u - min((unsigned)((smax - (As[i] + Bs[j])) * 16384.f), 262143u)) << 14) | (Ai[i] * 128u + Bi[j]))
    {
      unsigned g[16];
      g[0] = CKEY(0, 0);
      g[1] = CKEY(0, 1);
      g[2] = CKEY(0, 2);
      g[3] = CKEY(0, 3);
      g[4] = CKEY(0, 4);
      g[5] = CKEY(0, 5);
      g[6] = CKEY(0, 6);
      g[7] = CKEY(0, 7);
      g[8] = CKEY(0, 8);
      g[9] = CKEY(0, 9);
      g[10] = CKEY(0, 10);
      g[11] = CKEY(0, 11);
      g[12] = CKEY(0, 12);
      g[13] = CKEY(0, 13);
      g[14] = CKEY(0, 14);
      g[15] = CKEY(0, 15);
      sort16_desc(g);
      merge16_desc(L2, g);
    }
    {
      unsigned g[16];
      g[0] = CKEY(1, 0);
      g[1] = CKEY(1, 1);
      g[2] = CKEY(1, 2);
      g[3] = CKEY(1, 3);
      g[4] = CKEY(1, 4);
      g[5] = CKEY(1, 5);
      g[6] = CKEY(1, 6);
      g[7] = CKEY(1, 7);
      g[8] = CKEY(2, 0);
      g[9] = CKEY(2, 1);
      g[10] = CKEY(2, 2);
      g[11] = CKEY(2, 3);
      g[12] = CKEY(2, 4);
      g[13] = CKEY(3, 0);
      g[14] = CKEY(3, 1);
      g[15] = CKEY(3, 2);
      sort16_desc(g);
      merge16_desc(L2, g);
    }
    {
      unsigned g[16];
      g[0] = CKEY(3, 3);
      g[1] = CKEY(4, 0);
      g[2] = CKEY(4, 1);
      g[3] = CKEY(4, 2);
      g[4] = CKEY(5, 0);
      g[5] = CKEY(5, 1);
      g[6] = CKEY(6, 0);
      g[7] = CKEY(6, 1);
      g[8] = CKEY(7, 0);
      g[9] = CKEY(7, 1);
      g[10] = CKEY(8, 0);
      g[11] = CKEY(9, 0);
      g[12] = CKEY(10, 0);
      g[13] = CKEY(11, 0);
      g[14] = CKEY(12, 0);
      g[15] = CKEY(13, 0);
      sort16_desc(g);
      merge16_desc(L2, g);
    }
    {
      unsigned g[16];
      g[0] = CKEY(14, 0);
      g[1] = CKEY(15, 0);
      g[2] = 0u;
      g[3] = 0u;
      g[4] = 0u;
      g[5] = 0u;
      g[6] = 0u;
      g[7] = 0u;
      g[8] = 0u;
      g[9] = 0u;
      g[10] = 0u;
      g[11] = 0u;
      g[12] = 0u;
      g[13] = 0u;
      g[14] = 0u;
      g[15] = 0u;
      sort16_desc(g);
      merge16_desc(L2, g);
    }
#undef CKEY
    float ex[16]; unsigned ev[16]; float sum = 0.f;
#pragma unroll
    for (int t = 0; t < 16; ++t) {
      ev[t] = L2[t] & 16383u;
      float d = (float)(262143u - (L2[t] >> 14)) * (1.f / 16384.f);
      ex[t] = __expf(-d); sum += ex[t];
    }
    const float isum = 1.f / sum;
    if (hh == 0) {
      int* ip = p.idx + (size_t)row * 128 + h * 16;
      float* gp = p.gw + (size_t)row * 128 + h * 16;
#pragma unroll
      for (int t4 = 0; t4 < 4; ++t4) {
        u32x4 e0 = {ev[4 * t4], ev[4 * t4 + 1], ev[4 * t4 + 2], ev[4 * t4 + 3]};
        f32x4 g0 = {ex[4 * t4] * isum, ex[4 * t4 + 1] * isum, ex[4 * t4 + 2] * isum, ex[4 * t4 + 3] * isum};
        *(u32x4*)(ip + 4 * t4) = e0;
        *(f32x4*)(gp + 4 * t4) = g0;
      }
    }
  }
}

__device__ __forceinline__ void phase_gather(const Params& p, int layer, int nrows, float oscale) {
  const int lane = tidx() & 63, wv = tidx() >> 6;
  const bf16_t* U = p.uv; const bf16_t* V = p.uv + (size_t)16384 * 1024;
  for (int row = bidx() * 4 + wv; row < nrows; row += gridDim.x * 4) {
    float xv[16], acc[16];
    {
      u32x4 a = *(const u32x4*)(p.h + (size_t)row * DM + lane * 8), b = *(const u32x4*)(p.h + (size_t)row * DM + 512 + lane * 8);
#pragma unroll
      for (int e = 0; e < 4; ++e) {
        xv[2 * e] = __uint_as_float(a[e] << 16); xv[2 * e + 1] = __uint_as_float(a[e] & 0xffff0000u);
        xv[8 + 2 * e] = __uint_as_float(b[e] << 16); xv[8 + 2 * e + 1] = __uint_as_float(b[e] & 0xffff0000u);
      }
    }
#pragma unroll
    for (int i = 0; i < 16; ++i) acc[i] = 0.f;
    int myidx0 = p.idx[(size_t)row * 128 + lane], myidx1 = p.idx[(size_t)row * 128 + 64 + lane];
    float myg0 = p.gw[(size_t)row * 128 + lane], myg1 = p.gw[(size_t)row * 128 + 64 + lane];
    for (int k = 0; k < 128; ++k) {
      int e_ = k < 64 ? __shfl(myidx0, k) : __shfl(myidx1, k - 64);
      float g_ = k < 64 ? __shfl(myg0, k) : __shfl(myg1, k - 64);
      e_ = __builtin_amdgcn_readfirstlane(e_);
#if DIAG_HP
      const float* ur = p.peer_u + ((size_t)layer * 16384 + e_) * DM; const float* vr = p.peer_v + ((size_t)layer * 16384 + e_) * DM;
      f32x4 u0 = *(const f32x4*)(ur + lane * 8), u1 = *(const f32x4*)(ur + lane * 8 + 4), u2 = *(const f32x4*)(ur + 512 + lane * 8), u3 = *(const f32x4*)(ur + 512 + lane * 8 + 4);
      f32x4 v0 = *(const f32x4*)(vr + lane * 8), v1 = *(const f32x4*)(vr + lane * 8 + 4), v2 = *(const f32x4*)(vr + 512 + lane * 8), v3 = *(const f32x4*)(vr + 512 + lane * 8 + 4);
      float dot = 0.f;
#pragma unroll
      for (int e = 0; e < 4; ++e) dot += xv[e] * u0[e] + xv[4 + e] * u1[e] + xv[8 + e] * u2[e] + xv[12 + e] * u3[e];
      dot = wave_sum(dot);
      float w = g_ * gelu_tanh(dot);
#pragma unroll
      for (int e = 0; e < 4; ++e) { acc[e] += w * v0[e]; acc[4 + e] += w * v1[e]; acc[8 + e] += w * v2[e]; acc[12 + e] += w * v3[e]; }
#else
      const bf16_t* ur = U + (size_t)e_ * DM; const bf16_t* vr = V + (size_t)e_ * DM;
      u32x4 ua = *(const u32x4*)(ur + lane * 8), ub = *(const u32x4*)(ur + 512 + lane * 8);
      u32x4 va = *(const u32x4*)(vr + lane * 8), vb = *(const u32x4*)(vr + 512 + lane * 8);
      float dot = 0.f;
#pragma unroll
      for (int e = 0; e < 4; ++e) {
        dot += xv[2 * e] * __uint_as_float(ua[e] << 16) + xv[2 * e + 1] * __uint_as_float(ua[e] & 0xffff0000u);
        dot += xv[8 + 2 * e] * __uint_as_float(ub[e] << 16) + xv[8 + 2 * e + 1] * __uint_as_float(ub[e] & 0xffff0000u);
      }
      dot = wave_sum(dot);
      float w = PEER_ALPHA * oscale * g_ * gelu_tanh(dot);
#pragma unroll
      for (int e = 0; e < 4; ++e) {
        acc[2 * e] += w * __uint_as_float(va[e] << 16); acc[2 * e + 1] += w * __uint_as_float(va[e] & 0xffff0000u);
        acc[8 + 2 * e] += w * __uint_as_float(vb[e] << 16); acc[8 + 2 * e + 1] += w * __uint_as_float(vb[e] & 0xffff0000u);
      }
#endif
    }
    float* xr = xrow(p, row);
    const float* g2 = p.mod + (size_t)(layer * 3 + modrow(row)) * 6144 + 5 * DM;
#pragma unroll
    for (int hh = 0; hh < 2; ++hh) {
      int c0 = hh * 512 + lane * 8;
      f32x4 x0 = *(const f32x4*)(xr + c0), x1 = *(const f32x4*)(xr + c0 + 4);
      f32x4 ga = *(const f32x4*)(g2 + c0), gb = *(const f32x4*)(g2 + c0 + 4);
#pragma unroll
      for (int e = 0; e < 4; ++e) { x0[e] += ga[e] * acc[hh * 8 + e]; x1[e] += gb[e] * acc[hh * 8 + 4 + e]; }
      *(f32x4*)(xr + c0) = x0; *(f32x4*)(xr + c0 + 4) = x1;
    }
  }
}


__device__ __forceinline__ void phase_mix1(const Params& p, int layer, int with_ctx_queries) {
  const bool fast = attn_logit_bound(p, layer) <= 40.f;
  const int natt = fast ? 512 + (with_ctx_queries ? 16 : 0) : 1024 + (with_ctx_queries ? 32 : 0);
  const int G = gridDim.x, b_ = bidx();
  for (int item = b_; item < natt; item += G) { for (int r = 0; r < REP_ATT; ++r) { if (fast) attn_item64(p, layer, item); else attn_item(p, layer, item); } }
  int b1 = b_ - natt % G; if (b1 < 0) b1 += G;
  for (int it = b1; it < 528; it += G) { for (int r = 0; r < REP_MLA; ++r) mlA_item(p, layer, it); }
  const int nextra = 528 % G;
  const int first = (nextra * 2 < G) ? nextra : 0, span = G - first;
  if (b1 >= first)
    for (int it = b1 - first; it < 1056; it += span) { for (int r = 0; r < REP_SSDA; ++r) ssdA_item(p, layer, it); }
}
__device__ __forceinline__ void phase_mix3(const Params& p, int layer, int last) {
  const int nc = last ? 64 : 66, G = gridDim.x, b_ = bidx();
  const int nml = 2 * nc * 4, nssd = 2 * nc * 8;
  for (int it = b_; it < nml; it += G) {
    const int b = it / (nc * 4), c = (it / 4) % nc, h = it & 3;
    for (int r = 0; r < REP_MLC; ++r) mlC_item(p, layer, (b * 66 + c) * 4 + h);
  }
  const int nextra = nml % G;
  const int first = (nextra * 2 < G) ? nextra : 0, span = G - first;
  if (b_ >= first)
    for (int it = b_ - first; it < nssd; it += span) {
      const int b = it / (nc * 8), c = (it / 8) % nc, h = it & 7;
      for (int r = 0; r < REP_SSDC; ++r) ssdC_item(p, layer, (b * 66 + c) * 8 + h);
    }
}


#define XB_TMO      128
#define XB_XCNT(j)  (256  + 64 * (j))
#define XB_XSUB(j)  (1280 + 64 * (j))
#define XB_XGEN(j)  (2304 + 64 * (j))
#define XB_TOP      3328
#define XB_TOPGEN   3392
#define XCD_BAR_WORDS 3456
#define XB_SPIN_CAP (1u << 18)
#define LAS __attribute__((address_space(3)))
__device__ __forceinline__ unsigned xb_ld(unsigned* p)              { return __hip_atomic_load(p, __ATOMIC_RELAXED, __HIP_MEMORY_SCOPE_AGENT); }
__device__ __forceinline__ unsigned xb_add(unsigned* p, unsigned v) { return __hip_atomic_fetch_add(p, v, __ATOMIC_RELAXED, __HIP_MEMORY_SCOPE_AGENT); }
__device__ __forceinline__ unsigned xb_xcc_id() { return (unsigned)__builtin_amdgcn_s_getreg((3 << 11) | 20) & 0xFu; }
#define XB_SPIN(cond, bar) do { unsigned _sp = 0; while (cond) { __builtin_amdgcn_s_sleep(1); \
    if ((++_sp & 255u) == 0u) { if (xb_ld(&(bar)[XB_TMO])) break; if (_sp > XB_SPIN_CAP) { atomicAdd(&(bar)[XB_TMO], 1u); break; } } } } while (0)
struct XcdBarrier { unsigned* bar; unsigned x; volatile LAS unsigned* st; };
__device__ __forceinline__ XcdBarrier xcd_barrier_post(unsigned* bar, volatile LAS unsigned* st) {
    XcdBarrier b; b.bar = bar; b.x = xb_xcc_id(); b.st = st;
    if (threadIdx.x == 0) (void)xb_add(&bar[XB_XCNT(b.x)], 1u);
    return b;
}
__device__ __forceinline__ void xcd_barrier_complete(unsigned* bar, unsigned x, unsigned& nloc, unsigned& nx) {
    const unsigned G = gridDim.x * gridDim.y * gridDim.z;
    unsigned sum, cnt, mine, sp = 0u;
    for (;;) {
        sum = 0u; cnt = 0u; mine = 0u;
#pragma unroll
        for (unsigned j = 0; j < 16; ++j) { const unsigned c = xb_ld(&bar[XB_XCNT(j)]); sum += c; cnt += (c > 0u) ? 1u : 0u; mine = (j == x) ? c : mine; }
        if (sum == G) break;
        __builtin_amdgcn_s_sleep(1);
        if ((++sp & 255u) == 0u) { if (xb_ld(&bar[XB_TMO])) break; if (sp > XB_SPIN_CAP) { atomicAdd(&bar[XB_TMO], 1u); break; } }
    }
    nloc = mine > 0u ? mine : 1u; nx = cnt > 0u ? cnt : 1u;
}
__device__ __forceinline__ void xcd_barrier(const XcdBarrier& b) {
    asm volatile("s_waitcnt vmcnt(0)" ::: "memory");
    __syncthreads();
    if (threadIdx.x == 0) {
        unsigned* bar = b.bar;
        __builtin_amdgcn_s_waitcnt(0);
        unsigned nloc = b.st[0], nx = b.st[1];
        if (nloc == 0u) { xcd_barrier_complete(bar, b.x, nloc, nx); b.st[0] = nloc; b.st[1] = nx; }
        const unsigned old = xb_add(&bar[XB_XSUB(b.x)], 1u);
        const unsigned gen = old / nloc;
        if (old + 1u == (gen + 1u) * nloc) {
            __builtin_amdgcn_fence(__ATOMIC_RELEASE, "agent");
            asm volatile("s_waitcnt vmcnt(0)" ::: "memory");
            const unsigned og = xb_add(&bar[XB_TOP], 1u);
            const unsigned tg = og / nx;
            if (og + 1u == (tg + 1u) * nx) xb_add(&bar[XB_TOPGEN], 1u);
            else XB_SPIN(xb_ld(&bar[XB_TOPGEN]) == tg, bar);
            __builtin_amdgcn_fence(__ATOMIC_ACQUIRE, "agent");
            xb_add(&bar[XB_XGEN(b.x)], 1u);
            asm volatile("s_waitcnt vmcnt(0)" ::: "memory");
        } else {
            XB_SPIN(xb_ld(&bar[XB_XGEN(b.x)]) == gen, bar);
            __builtin_amdgcn_fence(__ATOMIC_ACQUIRE, "agent");
            asm volatile("s_waitcnt vmcnt(0)" ::: "memory");
        }
    }
    __syncthreads();
}

#ifndef REP_GEMM
#define REP_GEMM 1
#endif

#ifndef REP_MIX
#define REP_MIX 1
#endif
#ifndef REP_PV
#define REP_PV 1
#endif
#ifndef REP_PEER
#define REP_PEER 1
#endif
#ifndef REP_ELEM
#define REP_ELEM 1
#endif
#ifndef REP_SYNC
#define REP_SYNC 1
#endif
#ifndef REP_TOPK
#define REP_TOPK 1
#endif
#define GSYNC() do { for (int r_ = 0; r_ < REP_SYNC; ++r_) xcd_barrier(xb); } while (0)
__global__ void __launch_bounds__(256, 2) k_mega(Params p) {
  cg::grid_group grid = cg::this_grid();
  volatile LAS unsigned* xst = (volatile LAS unsigned*)(smem + LDS_BYTES - 16);
  if (threadIdx.x == 0) { xst[0] = 0u; xst[1] = 0u; }
  __syncthreads();
  XcdBarrier xb = xcd_barrier_post(p.bar, xst);
  for (int r = 0; r < REP_INIT; ++r) phase_init(p);
  if (p.bar == nullptr) grid.sync();
  GSYNC();
  for (int layer = 0; layer < 2; ++layer) {
    const int last = layer == 1;
    const int nrows2 = last ? NLAT : MROWS;
    if (layer == 0 || DIAG_HP) { for (int r = 0; r < REP_NORM; ++r) phase_norm(p, layer, 1, MROWS, layer == 0); GSYNC(); }
    for (int r = 0; r < REP_GEMM * REP_G_IN; ++r) phase_inproj(p, layer, MROWS, DIAG_HP ? 0 : 2);
    GSYNC();
    for (int r = 0; r < REP_SPREP; ++r) { phase_ssdprep(p, layer); phase_vtrans(p); }
    GSYNC();
    for (int r = 0; r < REP_MIX; ++r) phase_mix1(p, layer, !last);
    GSYNC();
    phase_ssdcarry(p); phase_mlcarry(p); GSYNC();
    for (int r = 0; r < REP_MIX; ++r) phase_mix3(p, layer, last);
    GSYNC();
    for (int r = 0; r < REP_SOUT; ++r) { phase_ssdout(p, layer, nrows2); phase_mlout(p, layer, nrows2); }
    GSYNC();
#if DIAG_HP
    for (int r = 0; r < REP_GEMM * REP_G_GATE; ++r) phase_inproj(p, layer, nrows2, 1);
    GSYNC();
#endif
    for (int r = 0; r < REP_GEMM * REP_G_MERGE; ++r) phase_merge(p, layer, nrows2);
    GSYNC();
    for (int r = 0; r < REP_GEMM * REP_G_OUT; ++r) phase_outproj(p, layer, nrows2, r == 0 ? 1.f : 0.f, (layer == 0 && r == 0) ? 1 : 0);
    GSYNC();
    for (int r = 0; r < REP_NORM; ++r) phase_norm(p, layer, 2, nrows2, 0);
    GSYNC();
    for (int r = 0; r < REP_GEMM * REP_G_WQ; ++r) phase_wq(p, layer, nrows2);
#if !DIAG_HP
    for (int r = 0; r < REP_UVC; ++r) phase_uvconv8(p, layer);
#endif
    GSYNC();
    for (int r = 0; r < REP_TOPK; ++r) { if (DIAG_HP) phase_topk(p, layer, nrows2); else phase_topk2(p, layer, nrows2); }
    GSYNC();
#if DIAG_HP
    phase_gather(p, layer, nrows2, 1.f);
    if (!last) { GSYNC(); phase_norm(p, layer + 1, 1, nrows2, 0); GSYNC(); }
#else
    for (int r = 0; r < REP_PEER; ++r) phase_gatherU(p, layer, nrows2);
    GSYNC();
    for (int r = 0; r < REP_PV; ++r) phase_gatherV(p, layer, nrows2, r == 0 ? 1.f : 0.f);
    if (!last) { GSYNC(); phase_norm(p, layer + 1, 1, nrows2, 0); GSYNC(); }
#endif
  }
}

extern "C" void kernel_launch(void* const* d_in, const int* in_sizes, int n_in, void* d_out, int out_size, void* d_ws, size_t ws_size,
                              hipStream_t stream) {
  Params p{};
  const float* const* in = (const float* const*)d_in;
  p.x = in[0]; p.c = in[1]; p.ctx = in[2]; p.c_ctx = in[3]; p.norm1_g = in[4]; p.norm2_g = in[5]; p.w_mod = in[6]; p.b_mod = in[7];
  p.w_in = in[8]; p.att_qnorm = in[9]; p.att_knorm = in[10]; p.ssd_conv_w = in[11]; p.ssd_conv_b = in[12]; p.ssd_dt_bias = in[13];
  p.ssd_a_log = in[14]; p.ssd_d = in[15]; p.ssd_norm = in[16]; p.ml_gate_bias = in[17]; p.ml_norm = in[18]; p.w_branch = in[19];
  p.w_out = in[20]; p.peer_wq = in[21]; p.peer_subkeys = in[22]; p.peer_u = in[23]; p.peer_v = in[24];
  p.out = (float*)d_out;
  char* w = (char*)d_ws; size_t off = 65536;
  p.bar = (unsigned*)d_ws;
  auto take = [&](size_t bytes) { char* r = w + off; off += (bytes + 255) & ~(size_t)255; return r; };
  p.mod = (float*)take((size_t)2 * 3 * 6144 * 4);
  p.xc = (float*)take((size_t)NCTX * DM * 4);
  p.small = (float*)take((size_t)MROWS * 32 * 4);
  p.dtb = (float*)take((size_t)MROWS * 16 * 4);
  p.wt_in = (bf16_t*)take((size_t)2 * INCP * DM * 2);
  p.wt_br = (bf16_t*)take((size_t)2 * 3 * DM * 512 * 2);
  p.wt_out = (bf16_t*)take((size_t)2 * DM * DM * 2);
  p.wt_q = (bf16_t*)take((size_t)2 * 2048 * DM * 2);
  p.sk = (bf16_t*)take((size_t)2 * 8 * 2 * 128 * 128 * 2);
  p.wt_q_lo = (bf16_t*)take(DIAG_HP ? (size_t)2 * 2048 * DM * 2 : 256);
  p.vt = (bf16_t*)take((size_t)4 * 64 * 8448 * 2);
  p.ropec = (float*)take((size_t)8192 * 32 * 4);
  p.ropes = (float*)take((size_t)8192 * 32 * 4);
  p.ssl = (bf16_t*)take((size_t)32 * 66 * 4096 * 2);
  p.sdec = (float*)take((size_t)32 * 66 * 4);
  p.mcl = (bf16_t*)take((size_t)16 * 66 * 16384 * 2);
  p.mnl = (float*)take((size_t)16 * 66 * 128 * 4);
  p.mml = (float*)take((size_t)16 * 66 * 4);
  p.mbl = (float*)take((size_t)16 * 66 * 4);
  p.mmp = (float*)take((size_t)16 * 66 * 4);
  p.h = (bf16_t*)take((size_t)MROWS * DM * 2);
  p.br = (bf16_t*)take((size_t)MROWS * 1536 * 2);
  p.xbc = (bf16_t*)take((size_t)MROWS * 768 * 2);
  p.idx = (int*)p.xbc; p.gw = (float*)((char*)p.xbc + (size_t)MROWS * 128 * 4);
  p.yf = (bf16_t*)take((size_t)MROWS * 512 * 2);
  p.yb = (bf16_t*)take((size_t)MROWS * 512 * 2);
  p.hf = (bf16_t*)take((size_t)MROWS * 512 * 2);
  p.hb = p.hf;
  p.gp8 = (unsigned char*)take((size_t)MROWS * 3072);
  p.mix = p.yf;
  p.proj = (bf16_t*)take((size_t)MROWS * 4096 * 2);
  p.uvs = (float*)take((size_t)2 * 16384 * 4);
  p.gp = p.proj; p.q = p.proj; p.qf = (float*)p.proj; p.h2lo = p.br; p.uv = (bf16_t*)((char*)p.proj + (size_t)MROWS * 2048 * 2); p.uvq = (unsigned char*)p.uv;
  p.xq = (signed char*)p.br; p.sxq = (float*)((char*)p.br + (size_t)MROWS * DM); p.wbuf = (float*)((char*)p.br + (size_t)MROWS * DM + (size_t)MROWS * 4);
  if (off > ws_size) return;

  const int LDS = LDS_BYTES;
  static int grid_blocks = 0;
  if (!grid_blocks) {
    (void)hipFuncSetAttribute((const void*)k_mega, hipFuncAttributeMaxDynamicSharedMemorySize, LDS);
    int dev = 0, cus = 0, per_cu = 0;
    (void)hipGetDevice(&dev);
    (void)hipDeviceGetAttribute(&cus, hipDeviceAttributeMultiprocessorCount, dev);
    (void)hipOccupancyMaxActiveBlocksPerMultiprocessor(&per_cu, (const void*)k_mega, 256, LDS);
    if (per_cu < 1) per_cu = 1;
    if (per_cu > 2) per_cu = 2;
    grid_blocks = cus * per_cu;
  }
  (void)hipMemsetAsync(d_ws, 0, XCD_BAR_WORDS * 4, stream);
  void* args[] = {&p};
  hipError_t e = hipLaunchCooperativeKernel((const void*)k_mega, dim3(grid_blocks), dim3(256), args, LDS, stream);
  if (e != hipSuccess) fprintf(stderr, "cooperative launch failed: %s (grid %d)\n", hipGetErrorString(e), grid_blocks);
}
```

```cpp
#include <hip/hip_runtime.h>
#include <hip/hip_cooperative_groups.h>
#include <stdint.h>
#include <stdio.h>
namespace cg = cooperative_groups;

typedef unsigned short bf16_t;
typedef short bf16x8 __attribute__((ext_vector_type(8)));
typedef float f32x4 __attribute__((ext_vector_type(4)));
typedef unsigned u32x4 __attribute__((ext_vector_type(4)));
typedef unsigned u32x2 __attribute__((ext_vector_type(2)));
typedef float f32x16 __attribute__((ext_vector_type(16)));

constexpr int SEQ = 8192, BATCH = 2, CTXL = 256, DM = 1024;
constexpr int NLAT = BATCH * SEQ;
constexpr int NCTX = BATCH * CTXL;
constexpr int MROWS = NLAT + NCTX;
constexpr int INC = 7200, INCP = 7296;
constexpr int NTHR = 256;

#ifndef DIAG_HP
#define DIAG_HP 0
#endif
#define REP_INIT 1
#define REP_NORM 1
#define REP_SPREP 1
#define REP_SOUT 1
#define REP_UVC 1
#define REP_QK 1
#define REP_KCOMP 1
#define REP_KSTG 1
#define REP_G_IN 1
#define REP_G_GATE 1
#define REP_G_MERGE 1
#define REP_G_OUT 1
#define REP_G_WQ 1
#define REP_STG 1
#define REP_EXP 1
#define REP_MLA 1
#define REP_SSDA 1
#define REP_ATT 1
#define REP_MLC 1
#define REP_SSDC 1
#ifndef ATT_ALPHA
#define ATT_ALPHA 1.f
#endif
#ifndef ATT_NAIVE
#define ATT_NAIVE 0
#endif
#ifndef ATT_TAU
#define ATT_TAU 1.f
#endif
#ifndef PEER_ALPHA
#define PEER_ALPHA 1.f
#endif
#define LDS_BYTES (DIAG_HP ? 140 * 1024 : 78 * 1024)
extern __shared__ __attribute__((aligned(16))) char smem[];

struct Params {
  const float *x, *c, *ctx, *c_ctx, *norm1_g, *norm2_g, *w_mod, *b_mod, *w_in, *att_qnorm, *att_knorm,
      *ssd_conv_w, *ssd_conv_b, *ssd_dt_bias, *ssd_a_log, *ssd_d, *ssd_norm, *ml_gate_bias, *ml_norm,
      *w_branch, *w_out, *peer_wq, *peer_subkeys, *peer_u, *peer_v;
  float* out;
  unsigned* bar;
  float* mod;
  float* xc;
  float* small;
  float* dtb;
  bf16_t *wt_in, *wt_br, *wt_out, *wt_q, *sk;
  bf16_t* h;
  bf16_t* br;
  bf16_t* xbc;
  bf16_t *yf, *yb, *hf, *hb;
  bf16_t* mix;
  bf16_t* proj;
  bf16_t* gp;
  unsigned char* gp8;
  bf16_t* q;
  bf16_t* uv;
  unsigned char* uvq;
  float* uvs;
  signed char* xq;
  float* sxq;
  float* wbuf;
  int* idx;
  float* gw;
  bf16_t* h2lo;
  bf16_t* wt_q_lo;
  float* qf;
  bf16_t* vt;
  float* ropec;
  float* ropes;
  bf16_t* ssl;
  float* sdec;
  bf16_t* mcl;
  float* mnl;
  float* mml;
  float* mbl;
  float* mmp;
};
#define VT8(p) ((unsigned char*)((p).vt + (size_t)4 * 64 * 8448))
#define KT8(p) (VT8(p) + (size_t)4 * 132 * 4096)


__device__ __forceinline__ int tidx() { int t = __builtin_amdgcn_workitem_id_x(); asm volatile("" : "+v"(t)); return t; }
__device__ __forceinline__ int bidx() { int t = __builtin_amdgcn_workgroup_id_x(); asm volatile("" : "+s"(t)); return t; }
__device__ __forceinline__ float bf2f(bf16_t v) { return __uint_as_float(((unsigned)v) << 16); }
__device__ __forceinline__ bf16_t f2bf(float f) {
  unsigned u = __float_as_uint(f);
  u += 0x7fffu + ((u >> 16) & 1u);
  return (bf16_t)(u >> 16);
}
typedef float f32x2 __attribute__((ext_vector_type(2)));
typedef int i32x4 __attribute__((ext_vector_type(4)));
typedef int i32x8 __attribute__((ext_vector_type(8)));
typedef __bf16 bf16x2n __attribute__((ext_vector_type(2)));
__device__ __forceinline__ unsigned pack2(float a, float b) {
  f32x2 v = {a, b};
  bf16x2n r = __builtin_convertvector(v, bf16x2n);
  return *(unsigned*)&r;
}
__device__ __forceinline__ float sigmoidf_(float x) { return 1.f / (1.f + __expf(-x)); }
__device__ __forceinline__ float siluf_(float x) { return x / (1.f + __expf(-x)); }
__device__ __forceinline__ float softplusf_(float x) { return x > 20.f ? x : log1pf(__expf(x)); }
__device__ __forceinline__ float logsigmoidf_(float x) { return x < 0.f ? x - log1pf(__expf(x)) : -log1pf(__expf(-x)); }
__device__ __forceinline__ float gelu_tanh(float x) {
  float u = 0.7978845608028654f * (x + 0.044715f * x * x * x);
  float t = 1.f - 2.f / (1.f + __expf(2.f * u));
  return 0.5f * x * (1.f + t);
}
__device__ __forceinline__ float ub0(unsigned v) { return (float)(v & 0xffu); }
__device__ __forceinline__ float ub1(unsigned v) { return (float)((v >> 8) & 0xffu); }
__device__ __forceinline__ float ub2(unsigned v) { return (float)((v >> 16) & 0xffu); }
__device__ __forceinline__ float ub3(unsigned v) { return (float)(v >> 24); }
__device__ __forceinline__ float* xrow(const Params& p, int row) {
  return row < NLAT ? p.out + (size_t)row * DM : p.xc + (size_t)(row - NLAT) * DM;
}
__device__ __forceinline__ const float* xrow_src(const Params& p, int row, int from_input) {
  if (from_input) return row < NLAT ? p.x + (size_t)row * DM : p.ctx + (size_t)(row - NLAT) * DM;
  return row < NLAT ? p.out + (size_t)row * DM : p.xc + (size_t)(row - NLAT) * DM;
}
__device__ __forceinline__ int modrow(int row) { return row < NLAT ? row / SEQ : 2; }
template <int CTRL> __device__ __forceinline__ float wr_dpp(float v) { return __int_as_float(__builtin_amdgcn_update_dpp(0, __float_as_int(v), CTRL, 0xf, 0xf, true)); }
__device__ __forceinline__ float wave_sum(float v) {
  v += wr_dpp<0xB1>(v);
  v += wr_dpp<0x4E>(v);
  v += wr_dpp<0x141>(v);
  v += wr_dpp<0x140>(v);
  { auto t = __builtin_amdgcn_permlane16_swap(__float_as_uint(v), __float_as_uint(v), false, false); v = __uint_as_float(t[0]) + __uint_as_float(t[1]); }
  { auto t = __builtin_amdgcn_permlane32_swap(__float_as_uint(v), __float_as_uint(v), false, false); v = __uint_as_float(t[0]) + __uint_as_float(t[1]); }
  return v;
}
__device__ __forceinline__ float wave_max(float v) {
  v = fmaxf(v, wr_dpp<0xB1>(v));
  v = fmaxf(v, wr_dpp<0x4E>(v));
  v = fmaxf(v, wr_dpp<0x141>(v));
  v = fmaxf(v, wr_dpp<0x140>(v));
  { auto t = __builtin_amdgcn_permlane16_swap(__float_as_uint(v), __float_as_uint(v), false, false); v = fmaxf(__uint_as_float(t[0]), __uint_as_float(t[1])); }
  { auto t = __builtin_amdgcn_permlane32_swap(__float_as_uint(v), __float_as_uint(v), false, false); v = fmaxf(__uint_as_float(t[0]), __uint_as_float(t[1])); }
  return v;
}

__device__ __forceinline__ int win_colmap(int n) {
  if (n < 2048) return n;
  if (n < 4096) return n + 16;
  if (n < 7168) return n + 32;
  if (n < 7184) return n - 5120;
  if (n < 7200) return n - 3072;
  return -1;
}

__device__ __forceinline__ void transpose_tile(const float* src, int Nsrc, int K, bf16_t* dst, int n0, int k0, int mode, bf16_t* dstlo = nullptr) {
  float* tile = (float*)smem;
  const int tid = tidx();
  {
    const int n4 = (tid & 15) * 4;
    int sc = n0 + n4;
    if (mode == 1) sc = win_colmap(sc);
#pragma unroll
    for (int i = 0; i < 4; ++i) {
      const int kk = (tid >> 4) + 16 * i;
      const f32x4 ld = *(const f32x4*)(src + (size_t)(k0 + kk) * Nsrc + (sc >= 0 ? sc : 0));
      f32x4 v = sc >= 0 ? ld : (f32x4){0.f, 0.f, 0.f, 0.f};
      tile[kk * 65 + n4] = v[0]; tile[kk * 65 + n4 + 1] = v[1]; tile[kk * 65 + n4 + 2] = v[2]; tile[kk * 65 + n4 + 3] = v[3];
    }
  }
  __syncthreads();
  {
    const int n = tid >> 2, kc = (tid & 3) * 16;
    float t[16];
#pragma unroll
    for (int e = 0; e < 16; ++e) t[e] = tile[(kc + e) * 65 + n];
    u32x4 w0, w1;
#pragma unroll
    for (int e = 0; e < 4; ++e) { w0[e] = pack2(t[2 * e], t[2 * e + 1]); w1[e] = pack2(t[8 + 2 * e], t[8 + 2 * e + 1]); }
    bf16_t* d = dst + (size_t)(n0 + n) * K + k0 + kc;
    *(u32x4*)d = w0; *(u32x4*)(d + 8) = w1;
    if (dstlo) {
      u32x4 l0, l1;
#pragma unroll
      for (int e = 0; e < 4; ++e) {
        l0[e] = pack2(t[2 * e] - __uint_as_float(w0[e] << 16), t[2 * e + 1] - __uint_as_float(w0[e] & 0xffff0000u));
        l1[e] = pack2(t[8 + 2 * e] - __uint_as_float(w1[e] << 16), t[8 + 2 * e + 1] - __uint_as_float(w1[e] & 0xffff0000u));
      }
      bf16_t* dl = dstlo + (size_t)(n0 + n) * K + k0 + kc;
      *(u32x4*)dl = l0; *(u32x4*)(dl + 8) = l1;
    }
  }
  __syncthreads();
}

__device__ __forceinline__ void phase_init(const Params& p) {
  const int tid = tidx(), bid = bidx(), nb = gridDim.x;
  for (int i = bid * NTHR + tid; i < 8192 * 32; i += nb * NTHR) {
    int pos = i >> 5, jj = i & 31;
    float inv = powf(10000.f, -(float)(jj & 15) / 16.f);
    float ang = (float)(jj < 16 ? (pos >> 6) : (pos & 63)) * inv;
    float sn, cs_; sincosf(ang, &sn, &cs_);
    p.ropec[i] = cs_; p.ropes[i] = sn;
  }
  for (int i = bid * NTHR + tid; i < 2 * 8 * 2 * 128 * 128 / 8; i += nb * NTHR) {
    const f32x4 a = *(const f32x4*)(p.peer_subkeys + (size_t)i * 8), b = *(const f32x4*)(p.peer_subkeys + (size_t)i * 8 + 4);
    u32x4 w; w[0] = pack2(a[0], a[1]); w[1] = pack2(a[2], a[3]); w[2] = pack2(b[0], b[1]); w[3] = pack2(b[2], b[3]);
    *(u32x4*)(p.sk + (size_t)i * 8) = w;
  }
  {
    const int per_layer = 1824 + 384 + 256 + 512;
    for (int job = nb - 1 - bid; job < 2 * per_layer; job += nb) {
      int l = job / per_layer, j = job % per_layer;
      if (j < 1824) {
        int nt = j / 16, kt = j % 16;
        transpose_tile(p.w_in + (size_t)l * DM * INC, INC, DM, p.wt_in + (size_t)l * INCP * DM, nt * 64, kt * 64, 1);
      } else if (j < 1824 + 384) {
        j -= 1824; int r = j / 128; j %= 128; int nt = j / 8, kt = j % 8;
        transpose_tile(p.w_branch + ((size_t)l * 3 + r) * 512 * DM, DM, 512, p.wt_br + ((size_t)l * 3 + r) * DM * 512, nt * 64, kt * 64, 0);
      } else if (j < 1824 + 384 + 256) {
        j -= 1824 + 384; int nt = j / 16, kt = j % 16;
        transpose_tile(p.w_out + (size_t)l * DM * DM, DM, DM, p.wt_out + (size_t)l * DM * DM, nt * 64, kt * 64, 0);
      } else {
        j -= 1824 + 384 + 256; int nt = j / 16, kt = j % 16;
        transpose_tile(p.peer_wq + (size_t)l * DM * 2048, 2048, DM, p.wt_q + (size_t)l * 2048 * DM, nt * 64, kt * 64, 0, DIAG_HP ? p.wt_q_lo + (size_t)l * 2048 * DM : nullptr);
      }
    }
  }
  {
    float* sl = (float*)smem;
    float* part = sl + 3 * DM;
    bool loaded = false;
    for (int blk = bid; blk < 192; blk += nb) {
      if (!loaded) {
        __syncthreads();
        for (int i = tid; i < 3 * DM; i += NTHR) {
          float v = i < 2 * DM ? p.c[i] : p.c_ctx[i - 2 * DM];
          sl[i] = siluf_(v);
        }
        loaded = true;
      }
      __syncthreads();
      const int wv = tid >> 6, ln = tid & 63;
      const int gi = blk * 64 + ln;
      const int l = gi / 6144, col = gi % 6144;
      const float* w = p.w_mod + (size_t)l * DM * 6144 + col;
      float a0 = 0.f, a1 = 0.f, a2 = 0.f;
#pragma unroll 8
      for (int k = wv * 256; k < wv * 256 + 256; ++k) {
        float wv_ = w[(size_t)k * 6144];
        a0 += sl[k] * wv_; a1 += sl[DM + k] * wv_; a2 += sl[2 * DM + k] * wv_;
      }
      part[(wv * 3 + 0) * 64 + ln] = a0; part[(wv * 3 + 1) * 64 + ln] = a1; part[(wv * 3 + 2) * 64 + ln] = a2;
      __syncthreads();
      if (tid < 192) {
        const int r = tid >> 6;
        float s = part[(0 * 3 + r) * 64 + ln] + part[(1 * 3 + r) * 64 + ln] + part[(2 * 3 + r) * 64 + ln] + part[(3 * 3 + r) * 64 + ln];
        p.mod[(l * 3 + r) * 6144 + col] = s + p.b_mod[l * 6144 + col];
      }
    }
  }
}

__device__ __forceinline__ void phase_norm(const Params& p, int layer, int which, int nrows, int from_input) {
  const int lane = tidx() & 63, wv = tidx() >> 6;
  const float* g = (which == 1 ? p.norm1_g : p.norm2_g) + layer * DM;
  const int sh_off = which == 1 ? 0 : 3 * DM, sc_off = which == 1 ? DM : 4 * DM;
  int curm = -1;
  f32x4 Ar[4], Br[4];
  for (int row = bidx() * 4 + wv; row < nrows; row += gridDim.x * 4) {
    const float* xr = xrow_src(p, row, from_input);
    const int mr = modrow(row);
    if (mr != curm) {
      const float* md = p.mod + (size_t)(layer * 3 + mr) * 6144;
#pragma unroll
      for (int j = 0; j < 4; ++j) {
        int c0 = j * 256 + lane * 4;
        f32x4 gg = *(const f32x4*)(g + c0), sc = *(const f32x4*)(md + sc_off + c0);
        Br[j] = *(const f32x4*)(md + sh_off + c0);
#pragma unroll
        for (int e = 0; e < 4; ++e) Ar[j][e] = gg[e] * (1.f + sc[e]);
      }
      curm = mr;
    }
    f32x4 v[4]; float ss = 0.f;
#pragma unroll
    for (int j = 0; j < 4; ++j) {
      v[j] = *(const f32x4*)(xr + j * 256 + lane * 4);
      ss += v[j][0] * v[j][0] + v[j][1] * v[j][1] + v[j][2] * v[j][2] + v[j][3] * v[j][3];
    }
    ss = wave_sum(ss);
    float rs = rsqrtf(ss * (1.f / DM) + 1e-6f);
#pragma unroll
    for (int j = 0; j < 4; ++j) {
      int c0 = j * 256 + lane * 4;
      float o0 = v[j][0] * rs * Ar[j][0] + Br[j][0];
      float o1 = v[j][1] * rs * Ar[j][1] + Br[j][1];
      float o2 = v[j][2] * rs * Ar[j][2] + Br[j][2];
      float o3 = v[j][3] * rs * Ar[j][3] + Br[j][3];
      u32x2 w; w.x = pack2(o0, o1); w.y = pack2(o2, o3);
      *(u32x2*)(p.h + (size_t)row * DM + c0) = w;
      v[j][0] = o0; v[j][1] = o1; v[j][2] = o2; v[j][3] = o3;
#if DIAG_HP
      if (which == 2) {
        u32x2 wl; wl.x = pack2(o0 - __uint_as_float(w.x << 16), o1 - __uint_as_float(w.x & 0xffff0000u));
        wl.y = pack2(o2 - __uint_as_float(w.y << 16), o3 - __uint_as_float(w.y & 0xffff0000u));
        *(u32x2*)(p.h2lo + (size_t)row * DM + c0) = wl;
      }
#endif
    }
    if (which == 2) {
      float am = 0.f;
#pragma unroll
      for (int j = 0; j < 4; ++j) am = fmaxf(fmaxf(fmaxf(am, fabsf(v[j][0])), fmaxf(fabsf(v[j][1]), fabsf(v[j][2]))), fabsf(v[j][3]));
      am = wave_max(am);
      const float sc8 = am > 0.f ? am * (1.f / 127.f) : 1.f, inv8 = 1.f / sc8;
#pragma unroll
      for (int j = 0; j < 4; ++j) {
        unsigned q = 0;
#pragma unroll
        for (int e = 0; e < 4; ++e) {
          int t = (int)rintf(v[j][e] * inv8);
          t = t < -127 ? -127 : (t > 127 ? 127 : t);
          q |= (unsigned)(t & 0xff) << (8 * e);
        }
        *(unsigned*)(p.xq + (size_t)row * DM + j * 256 + lane * 4) = q;
      }
      if (lane == 0) p.sxq[row] = sc8;
    }
  }
}

__device__ __forceinline__ void gemm_stage(const bf16_t* A, int lda, const bf16_t* Bt, int ldb, int brow, int bcol, int kt, char* buf, int tid) {
  const int wv = __builtin_amdgcn_readfirstlane(tid >> 6);
  const char* Ak = (const char*)(A + kt);
  const char* Bk = (const char*)(Bt + kt);
#pragma unroll
  for (int i = 0; i < 4; ++i) {
    const int b = (tid + 256 * i) * 16, r = b >> 7, c = ((b >> 4) & 7) ^ ((r >> 1) & 7);
    const unsigned offa = (unsigned)(((brow + r) * lda + c * 8) * 2), offb = (unsigned)(((bcol + r) * ldb + c * 8) * 2);
    char* dst = buf + (wv * 64 + 256 * i) * 16;
    __builtin_amdgcn_global_load_lds((const unsigned*)(Ak + offa), (__attribute__((address_space(3))) unsigned*)dst, 16, 0, 0);
    __builtin_amdgcn_global_load_lds((const unsigned*)(Bk + offb), (__attribute__((address_space(3))) unsigned*)(dst + 16384), 16, 0, 0);
  }
}
__device__ __forceinline__ void gemm_compute(f32x4 (&acc)[4][4], const char* buf, int wr, int wc, int fr, int fq) {
#pragma unroll
  for (int ks = 0; ks < 2; ++ks) {
    bf16x8 At[4], Bl[4];
#pragma unroll
    for (int m = 0; m < 4; ++m) { const int row = wr * 64 + m * 16 + fr; At[m] = *(const bf16x8*)(buf + row * 128 + (((ks * 4 + fq) ^ ((row >> 1) & 7)) << 4)); }
#pragma unroll
    for (int n = 0; n < 4; ++n) { const int row = wc * 64 + n * 16 + fr; Bl[n] = *(const bf16x8*)(buf + 16384 + row * 128 + (((ks * 4 + fq) ^ ((row >> 1) & 7)) << 4)); }
    __builtin_amdgcn_s_setprio(1);
#pragma unroll
    for (int m = 0; m < 4; ++m)
#pragma unroll
      for (int n = 0; n < 4; ++n) acc[m][n] = __builtin_amdgcn_mfma_f32_16x16x32_bf16(Bl[n], At[m], acc[m][n], 0, 0, 0);
    __builtin_amdgcn_s_setprio(0);
  }
}
__device__ __forceinline__ void gemm_compute_h(f32x4 (&acc)[4][4], const char* buf, int wr, int wc, int fr, int fq) {
  bf16x8 At[2][4], Bl[2][4];
#pragma unroll
  for (int ks = 0; ks < 2; ++ks) {
#pragma unroll
    for (int m = 0; m < 4; ++m) { const int row = wr * 64 + m * 16 + fr; At[ks][m] = *(const bf16x8*)(buf + row * 128 + (((ks * 4 + fq) ^ ((row >> 1) & 7)) << 4)); }
#pragma unroll
    for (int n = 0; n < 4; ++n) { const int row = wc * 64 + n * 16 + fr; Bl[ks][n] = *(const bf16x8*)(buf + 16384 + row * 128 + (((ks * 4 + fq) ^ ((row >> 1) & 7)) << 4)); }
  }
  __builtin_amdgcn_s_setprio(1);
#pragma unroll
  for (int ks = 0; ks < 2; ++ks)
#pragma unroll
    for (int m = 0; m < 4; ++m)
#pragma unroll
      for (int n = 0; n < 4; ++n) acc[m][n] = __builtin_amdgcn_mfma_f32_16x16x32_bf16(Bl[ks][n], At[ks][m], acc[m][n], 0, 0, 0);
  __builtin_amdgcn_s_setprio(0);
}
template <bool HOIST = true>
__device__ __forceinline__ void gemm_kloop(f32x4 (&acc)[4][4], const bf16_t* A, int lda, const bf16_t* Bt, int ldb, int K, int brow, int bcol) {
  const int tid = tidx(), wid = tid >> 6, lane = tid & 63, wr = wid >> 1, wc = wid & 1, fr = lane & 15, fq = lane >> 4;
  const int nt = K >> 6;
  __syncthreads();
  gemm_stage(A, lda, Bt, ldb, brow, bcol, 0, smem, tid);
  asm volatile("s_waitcnt vmcnt(0)" ::: "memory");
  __syncthreads();
  for (int t = 0; t < nt - 1; ++t) {
    char* cur = smem + (t & 1) * 32768; char* nxt = smem + ((t + 1) & 1) * 32768;
    gemm_stage(A, lda, Bt, ldb, brow, bcol, (t + 1) * 64, nxt, tid);
    if (HOIST) gemm_compute_h(acc, cur, wr, wc, fr, fq); else gemm_compute(acc, cur, wr, wc, fr, fq);
#if REP_KCOMP > 1
    { f32x4 acc2[4][4];
#pragma unroll
      for (int m = 0; m < 4; ++m)
#pragma unroll
        for (int n = 0; n < 4; ++n) acc2[m][n] = (f32x4){0.f, 0.f, 0.f, 0.f};
      gemm_compute(acc2, cur, wr, wc, fr, fq);
      float sink = 0.f;
#pragma unroll
      for (int m = 0; m < 4; ++m)
#pragma unroll
        for (int n = 0; n < 4; ++n) sink += acc2[m][n][0];
      asm volatile("" :: "v"(sink)); }
#endif
    asm volatile("s_waitcnt vmcnt(0)" ::: "memory");
    __syncthreads();
#if REP_KSTG > 1
    gemm_stage(A, lda, Bt, ldb, brow, bcol, (t + 1) * 64, nxt, tid);
    asm volatile("s_waitcnt vmcnt(0)" ::: "memory");
    __syncthreads();
#endif
  }
  if (HOIST) gemm_compute_h(acc, smem + ((nt - 1) & 1) * 32768, wr, wc, fr, fq); else gemm_compute(acc, smem + ((nt - 1) & 1) * 32768, wr, wc, fr, fq);
}

__device__ __forceinline__ void tile_map(int t, int NT, int& mt, int& ni) {
  const int x = t & 7, q = t >> 3, nsub = NT >> 3;
  mt = q / nsub; ni = x + 8 * (q - mt * nsub);
}
__device__ __forceinline__ void tile_map_m(int t, int mtiles, int& mt, int& nt) {
  const int idx = (t & 7) * mtiles + (t >> 3);
  mt = idx >> 3; nt = idx & 7;
}
#define GEMM_IDS const int tid = tidx(), wid = tid >> 6, lane = tid & 63, wr = wid >> 1, wc = wid & 1, fr = lane & 15, fq = lane >> 4; (void)tid;

__device__ __forceinline__ void zero_acc(f32x4 (&acc)[4][4]) {
#pragma unroll
  for (int m = 0; m < 4; ++m)
#pragma unroll
    for (int n = 0; n < 4; ++n) acc[m][n] = (f32x4){0.f, 0.f, 0.f, 0.f};
}


__device__ __forceinline__ void store_slab_bf16(const f32x4 (&v)[4], bf16_t* dst_row0, size_t ld, int wid, int lane) {
  char* slab = smem + 65536 + wid * 2304;
  const int fr = lane & 15, fq = lane >> 4;
#pragma unroll
  for (int n = 0; n < 4; ++n) {
    u32x2 w; w.x = pack2(v[n][0], v[n][1]); w.y = pack2(v[n][2], v[n][3]);
    *(u32x2*)(slab + fr * 144 + (n * 16 + fq * 4) * 2) = w;
  }
  const int r = lane >> 3, c = lane & 7;
  u32x4 a = *(const u32x4*)(slab + r * 144 + c * 16), b = *(const u32x4*)(slab + (r + 8) * 144 + c * 16);
  *(u32x4*)(dst_row0 + (size_t)r * ld + c * 8) = a;
  *(u32x4*)(dst_row0 + (size_t)(r + 8) * ld + c * 8) = b;
}


__device__ __forceinline__ void store_slab_gate8(const f32x4 (&v)[4], unsigned char* dst_row0, int wid, int lane) {
  char* slab = smem + 65536 + wid * 2304;
  const int fr = lane & 15, fq = lane >> 4;
#pragma unroll
  for (int n = 0; n < 4; ++n) {
    unsigned q = 0;
#pragma unroll
    for (int j = 0; j < 4; ++j) { int g = (int)rintf(sigmoidf_(v[n][j]) * 255.f); q |= (unsigned)g << (8 * j); }
    *(unsigned*)(slab + fr * 80 + n * 16 + fq * 4) = q;
  }
  const int r = lane >> 2, c = lane & 3;
  u32x4 a = *(const u32x4*)(slab + r * 80 + c * 16);
  *(u32x4*)(dst_row0 + (size_t)r * 3072 + c * 16) = a;
}
__device__ __forceinline__ u32x4 gate8_fetch(const unsigned char* src_row0, int lane) {
  const int r = lane >> 2, c = lane & 3;
  return *(const u32x4*)(src_row0 + (size_t)r * 3072 + c * 16);
}
__device__ __forceinline__ void gate8_slab(unsigned (&g)[4], const u32x4 v, int wid, int lane) {
  char* slab = smem + 65536 + wid * 2304;
  const int fr = lane & 15, fq = lane >> 4;
  const int r = lane >> 2, c = lane & 3;
  *(u32x4*)(slab + r * 80 + c * 16) = v;
#pragma unroll
  for (int n = 0; n < 4; ++n) g[n] = *(const unsigned*)(slab + fr * 80 + n * 16 + fq * 4);
}
__device__ __forceinline__ void load_slab_gate8(unsigned (&g)[4], const unsigned char* src_row0, int wid, int lane) {
  char* slab = smem + 65536 + wid * 2304;
  const int fr = lane & 15, fq = lane >> 4;
  const int r = lane >> 2, c = lane & 3;
  *(u32x4*)(slab + r * 80 + c * 16) = *(const u32x4*)(src_row0 + (size_t)r * 3072 + c * 16);
#pragma unroll
  for (int n = 0; n < 4; ++n) g[n] = *(const unsigned*)(slab + fr * 80 + n * 16 + fq * 4);
}

__device__ __forceinline__ void phase_inproj(const Params& p, int layer, int nrows, int part) {
  GEMM_IDS
  const int ntl = part == 0 ? 33 : (part == 1 ? 24 : 57);
  const int mtiles = nrows / 128;
  const bf16_t* Bt = p.wt_in + (size_t)layer * INCP * DM;
  for (int t = bidx(); t < mtiles * ntl; t += gridDim.x) {
    int mt, ni, nt;
    if (part == 0) { if (t < mtiles * 32) tile_map(t, 32, mt, ni); else { mt = t - mtiles * 32; ni = 32; } nt = ni < 32 ? ni : 56; }
    else if (part == 1) { tile_map(t, 24, mt, ni); nt = 32 + ni; }
    else { if (t < mtiles * 56) { tile_map(t, 56, mt, ni); nt = ni; } else { mt = t - mtiles * 56; nt = 56; } }
    f32x4 acc[4][4]; zero_acc(acc);
    gemm_kloop(acc, p.h, DM, Bt, DM, DM, mt * 128, nt * 128);
    if (nt >= 32 && nt < 56 && !DIAG_HP) {
#pragma unroll
      for (int m = 0; m < 4; ++m) store_slab_gate8(acc[m], p.gp8 + (size_t)(mt * 128 + wr * 64 + m * 16) * 3072 + (nt * 128 - 4096) + wc * 64, wid, lane);
    } else if (nt >= 5 && nt < 56) {
      bf16_t* dst = nt < 32 ? p.proj + (size_t)(mt * 128 + wr * 64) * 4096 + nt * 128 + wc * 64 : p.gp + (size_t)(mt * 128 + wr * 64) * 3072 + (nt * 128 - 4096) + wc * 64;
      const size_t ld = nt < 32 ? 4096 : 3072;
#pragma unroll
      for (int m = 0; m < 4; ++m) store_slab_bf16(acc[m], dst + (size_t)(m * 16) * ld, ld, wid, lane);
    } else if (nt == 56) {
#pragma unroll
      for (int m = 0; m < 4; ++m)
#pragma unroll
        for (int n = 0; n < 4; ++n) {
          int row = mt * 128 + wr * 64 + m * 16 + fr, cc = wc * 64 + n * 16 + fq * 4;
          if (cc < 32) *(f32x4*)(p.small + (size_t)row * 32 + cc) = acc[m][n];
        }
    }
    if (nt < 5) {
      const float* nw = (nt < 4 ? p.att_qnorm : p.att_knorm) + layer * 64;
      const bool latent = mt < NLAT / 128;
#pragma unroll
      for (int m = 0; m < 4; ++m) {
        const int row = mt * 128 + wr * 64 + m * 16 + fr;
        float ss = 0.f;
#pragma unroll
        for (int n = 0; n < 4; ++n)
#pragma unroll
          for (int j = 0; j < 4; ++j) ss += acc[m][n][j] * acc[m][n][j];
        ss += __shfl_xor(ss, 16); ss += __shfl_xor(ss, 32);
        const float rs = rsqrtf(ss * (1.f / 64.f) + 1e-6f);
        f32x4 v[4];
#pragma unroll
        for (int n = 0; n < 4; ++n) {
          f32x4 w4 = *(const f32x4*)(nw + n * 16 + fq * 4);
#pragma unroll
          for (int j = 0; j < 4; ++j) v[n][j] = acc[m][n][j] * rs * w4[j];
        }
        if (latent) {
          const int pos = row & (SEQ - 1);
#pragma unroll
          for (int n = 0; n < 2; ++n) {
            f32x4 c4 = *(const f32x4*)(p.ropec + pos * 32 + n * 16 + fq * 4), s4 = *(const f32x4*)(p.ropes + pos * 32 + n * 16 + fq * 4);
#pragma unroll
            for (int j = 0; j < 4; ++j) {
              float t1 = v[n][j], t2 = v[n + 2][j];
              v[n][j] = t1 * c4[j] - t2 * s4[j];
              v[n + 2][j] = t1 * s4[j] + t2 * c4[j];
            }
          }
        }
        store_slab_bf16(v, p.proj + (size_t)(mt * 128 + wr * 64 + m * 16) * 4096 + nt * 128 + wc * 64, 4096, wid, lane);
      }
    }
  }
}

__device__ __forceinline__ void phase_merge(const Params& p, int layer, int nrows) {
  GEMM_IDS
  const int mtiles = nrows / 128;
  for (int t = bidx(); t < mtiles * 8; t += gridDim.x) {
    int mt, nt; tile_map_m(t, mtiles, mt, nt);
    f32x4 mixa[4][4]; zero_acc(mixa);
    for (int r = 0; r < 3; ++r) {
      u32x4 gv[4];
#pragma unroll
      for (int m = 0; m < 4; ++m) gv[m] = gate8_fetch(p.gp8 + (size_t)(mt * 128 + wr * 64 + m * 16) * 3072 + r * 1024 + nt * 128 + wc * 64, lane);
      f32x4 acc[4][4]; zero_acc(acc);
      gemm_kloop<false>(acc, p.br + r * 512, 1536, p.wt_br + ((size_t)layer * 3 + r) * DM * 512, 512, 512, mt * 128, nt * 128);
#if DIAG_HP
#pragma unroll
      for (int m = 0; m < 4; ++m)
#pragma unroll
        for (int n = 0; n < 4; ++n) {
          int row = mt * 128 + wr * 64 + m * 16 + fr, col = nt * 128 + wc * 64 + n * 16 + fq * 4;
          u32x2 g = *(const u32x2*)(p.gp + (size_t)row * 3072 + r * 1024 + col);
          mixa[m][n][0] += sigmoidf_(__uint_as_float(g.x << 16)) * acc[m][n][0];
          mixa[m][n][1] += sigmoidf_(__uint_as_float(g.x & 0xffff0000u)) * acc[m][n][1];
          mixa[m][n][2] += sigmoidf_(__uint_as_float(g.y << 16)) * acc[m][n][2];
          mixa[m][n][3] += sigmoidf_(__uint_as_float(g.y & 0xffff0000u)) * acc[m][n][3];
        }
#else
#pragma unroll
      for (int m = 0; m < 4; ++m) {
        unsigned g[4];
        gate8_slab(g, gv[m], wid, lane);
#pragma unroll
        for (int n = 0; n < 4; ++n) {
          mixa[m][n][0] += ub0(g[n]) * (1.f / 255.f) * acc[m][n][0];
          mixa[m][n][1] += ub1(g[n]) * (1.f / 255.f) * acc[m][n][1];
          mixa[m][n][2] += ub2(g[n]) * (1.f / 255.f) * acc[m][n][2];
          mixa[m][n][3] += ub3(g[n]) * (1.f / 255.f) * acc[m][n][3];
        }
      }
#endif
    }
#pragma unroll
    for (int m = 0; m < 4; ++m) store_slab_bf16(mixa[m], p.mix + (size_t)(mt * 128 + wr * 64 + m * 16) * DM + nt * 128 + wc * 64, DM, wid, lane);
  }
}

__device__ __forceinline__ void phase_outproj(const Params& p, int layer, int nrows, float oscale, int from_input) {
  GEMM_IDS
  const int mtiles = nrows / 128;
  for (int t = bidx(); t < mtiles * 8; t += gridDim.x) {
    int mt, nt; tile_map_m(t, mtiles, mt, nt);
    f32x4 acc[4][4]; zero_acc(acc);
    gemm_kloop(acc, p.mix, DM, p.wt_out + (size_t)layer * DM * DM, DM, DM, mt * 128, nt * 128);
    f32x4 xv[4][4], g1[4][4];
#pragma unroll
    for (int m = 0; m < 4; ++m)
#pragma unroll
      for (int n = 0; n < 4; ++n) {
        const int row = mt * 128 + wr * 64 + m * 16 + fr, col = nt * 128 + wc * 64 + n * 16 + fq * 4;
        g1[m][n] = *(const f32x4*)(p.mod + (size_t)(layer * 3 + modrow(row)) * 6144 + 2 * DM + col);
        xv[m][n] = *(const f32x4*)(xrow_src(p, row, from_input) + col);
      }
#pragma unroll
    for (int m = 0; m < 4; ++m)
#pragma unroll
      for (int n = 0; n < 4; ++n) {
        const int row = mt * 128 + wr * 64 + m * 16 + fr, col = nt * 128 + wc * 64 + n * 16 + fq * 4;
        f32x4 x = xv[m][n]; const f32x4 g = g1[m][n] * oscale;
        x[0] += g[0] * acc[m][n][0]; x[1] += g[1] * acc[m][n][1]; x[2] += g[2] * acc[m][n][2]; x[3] += g[3] * acc[m][n][3];
        *(f32x4*)(xrow(p, row) + col) = x;
      }
  }
}

__device__ __forceinline__ void phase_wq(const Params& p, int layer, int nrows) {
  GEMM_IDS
  const int mtiles = nrows / 128;
  for (int t = bidx(); t < mtiles * 16; t += gridDim.x) {
    int mt, nt; { const int idx = (t & 7) * (mtiles * 2) + (t >> 3); mt = idx >> 4; nt = idx & 15; }
    f32x4 acc[4][4]; zero_acc(acc);
    gemm_kloop(acc, p.h, DM, p.wt_q + (size_t)layer * 2048 * DM, DM, DM, mt * 128, nt * 128);
#if DIAG_HP
    gemm_kloop(acc, p.h, DM, p.wt_q_lo + (size_t)layer * 2048 * DM, DM, DM, mt * 128, nt * 128);
    gemm_kloop(acc, p.h2lo, DM, p.wt_q + (size_t)layer * 2048 * DM, DM, DM, mt * 128, nt * 128);
#endif
#if DIAG_HP
#pragma unroll
    for (int m = 0; m < 4; ++m)
#pragma unroll
      for (int n = 0; n < 4; ++n) {
        int row = mt * 128 + wr * 64 + m * 16 + fr, col = nt * 128 + wc * 64 + n * 16 + fq * 4;
        *(f32x4*)(p.qf + (size_t)row * 2048 + col) = acc[m][n];
      }
#else
#pragma unroll
    for (int m = 0; m < 4; ++m) store_slab_bf16(acc[m], p.q + (size_t)(mt * 128 + wr * 64 + m * 16) * 2048 + nt * 128 + wc * 64, 2048, wid, lane);
#endif
  }
}

__device__ __forceinline__ void phase_vtrans(const Params& p) {
  bf16_t* tile = (bf16_t*)smem;
  const int tid = tidx();
  for (int item = (int)gridDim.x - 1 - bidx(); item < 528; item += gridDim.x) {
    int b = item / 264, r = item % 264, kvh = r / 132, kt = r % 132;
    int krow0 = kt < 128 ? b * SEQ + kt * 64 : NLAT + b * CTXL + (kt - 128) * 64;
    __syncthreads();
    {
      int kr = tid >> 2, c0 = (tid & 3) * 16;
      const bf16_t* vp = p.proj + (size_t)(krow0 + kr) * 4096 + 640 + kvh * 64 + c0;
      u32x4 w0 = *(const u32x4*)vp, w1 = *(const u32x4*)(vp + 8);
      unsigned* tp = (unsigned*)(tile + kr * 66 + c0);
#pragma unroll
      for (int e = 0; e < 4; ++e) { tp[e] = w0[e]; tp[4 + e] = w1[e]; }
    }
    __syncthreads();
    {
      int d = tid >> 2, k0 = (tid & 3) * 16;
      bf16_t* op = p.vt + ((size_t)(b * 2 + kvh) * 64 + d) * 8448 + kt * 64 + k0;
      u32x4 o0, o1;
#pragma unroll
      for (int e = 0; e < 4; ++e) {
        const int ka = e < 2 ? 2 * e : 8 + 2 * (e - 2);
        const int kb2 = e < 2 ? 4 + 2 * e : 12 + 2 * (e - 2);
        o0[e] = (unsigned)tile[(k0 + ka) * 66 + d] | ((unsigned)tile[(k0 + ka + 1) * 66 + d] << 16);
        o1[e] = (unsigned)tile[(k0 + kb2) * 66 + d] | ((unsigned)tile[(k0 + kb2 + 1) * 66 + d] << 16);
      }
      *(u32x4*)op = o0; *(u32x4*)(op + 8) = o1;
    }
    {
      const int d = tid >> 2, hh = (tid >> 1) & 1, kb = tid & 1;
      u32x4 q;
#pragma unroll
      for (int e = 0; e < 4; ++e) {
        float f[4];
#pragma unroll
        for (int jj = 0; jj < 4; ++jj) { const int r = 4 * e + jj, key = kb * 32 + (r & 3) + 8 * (r >> 2) + 4 * hh; f[jj] = __uint_as_float((unsigned)tile[key * 66 + d] << 16); }
        int w = 0;
        w = __builtin_amdgcn_cvt_pk_fp8_f32(f[0], f[1], w, false);
        w = __builtin_amdgcn_cvt_pk_fp8_f32(f[2], f[3], w, true);
        q[e] = (unsigned)w;
      }
      *(u32x4*)(VT8(p) + ((((size_t)(b * 2 + kvh) * 132 + kt) * 64 + d) * 64) + hh * 32 + kb * 16) = q;
    }
    {
      const int key = tid >> 2, c0 = (tid & 3) * 16;
      const bf16_t* kp = p.proj + (size_t)(krow0 + key) * 4096 + 512 + kvh * 64 + c0;
      const u32x4 w0 = *(const u32x4*)kp, w1 = *(const u32x4*)(kp + 8);
      u32x4 q;
#pragma unroll
      for (int e = 0; e < 4; ++e) {
        const unsigned a = e < 2 ? w0[2 * e] : w1[2 * (e - 2)], b2 = e < 2 ? w0[2 * e + 1] : w1[2 * (e - 2) + 1];
        int w = 0;
        w = __builtin_amdgcn_cvt_pk_fp8_f32(__uint_as_float(a << 16), __uint_as_float(a & 0xffff0000u), w, false);
        w = __builtin_amdgcn_cvt_pk_fp8_f32(__uint_as_float(b2 << 16), __uint_as_float(b2 & 0xffff0000u), w, true);
        q[e] = (unsigned)w;
      }
      *(u32x4*)(KT8(p) + (((size_t)(b * 2 + kvh) * 132 + kt) * 64 + key) * 64 + c0) = q;
    }
  }
}

#define ATT_KSTR 144
#define ATT_VSTR 272
#define ATT_VOFF 18432
#define ATT_BUF 35840
__device__ __forceinline__ void attn_item(const Params& p, int layer, int item) {
  const int tid = tidx(), wid = tid >> 6, lane = tid & 63, l31 = lane & 31, hh = lane >> 5;
  int b, kvh, tok0, kt0, nkt;
  if (item < 1024) { b = item >> 9; kvh = (item >> 8) & 1; tok0 = b * SEQ + (item & 255) * 32; kt0 = 0; nkt = 66; }
  else { int r = item - 1024; b = r >> 4; kvh = (r >> 3) & 1; tok0 = NLAT + b * CTXL + (r & 7) * 32; kt0 = 64; nkt = 2; }
  const int head = kvh * 4 + wid;
  bf16x8 qf[4];
#pragma unroll
  for (int ks = 0; ks < 4; ++ks)
    qf[ks] = *(const bf16x8*)(p.proj + (size_t)(tok0 + l31) * 4096 + head * 64 + ks * 16 + hh * 8);
  f32x16 o[2];
#pragma unroll
  for (int db = 0; db < 2; ++db)
#pragma unroll
    for (int r = 0; r < 16; ++r) o[db][r] = 0.f;
  float mrun = -1e30f, lrun = 0.f;
  const float cs = 0.125f * 1.44269504088896f * ATT_TAU;
  const bf16_t* vtb = p.vt + (size_t)(b * 2 + kvh) * 64 * 8448;
  u32x4 kreg[4], vreg[4];
  auto gload = [&](int kt) {
    int krow0 = kt < 64 ? b * SEQ + kt * 128 : NLAT + b * CTXL + (kt - 64) * 128;
    int ko = kt * 128; asm volatile("" : "+s"(ko));
#pragma unroll
    for (int i = 0; i < 4; ++i) {
      int id = tid + 256 * i;
      kreg[i] = *(const u32x4*)(p.proj + (size_t)(krow0 + (id >> 3)) * 4096 + 512 + kvh * 64 + (id & 7) * 8);
      vreg[i] = *(const u32x4*)(vtb + (size_t)(id >> 4) * 8448 + ko + (id & 15) * 8);
    }
  };
  auto lstore = [&](int buf) {
    char* base = smem + buf * ATT_BUF;
#pragma unroll
    for (int i = 0; i < 4; ++i) {
      int id = tid + 256 * i;
      *(u32x4*)(base + (id >> 3) * ATT_KSTR + (id & 7) * 16) = kreg[i];
      *(u32x4*)(base + ATT_VOFF + (id >> 4) * ATT_VSTR + (id & 15) * 16) = vreg[i];
    }
  };
  auto compute = [&](int buf, int sub) {
    const char* Kb = smem + buf * ATT_BUF + sub * 64 * ATT_KSTR;
    const char* Vb = smem + buf * ATT_BUF + ATT_VOFF + sub * 128;
    f32x16 s[2];
#pragma unroll
    for (int kb = 0; kb < 2; ++kb) {
#pragma unroll
      for (int r = 0; r < 16; ++r) s[kb][r] = 0.f;
#pragma unroll
      for (int ks = 0; ks < 4; ++ks) {
        bf16x8 kf = *(const bf16x8*)(Kb + (kb * 32 + l31) * ATT_KSTR + (ks * 16 + hh * 8) * 2);
        s[kb] = __builtin_amdgcn_mfma_f32_32x32x16_bf16(kf, qf[ks], s[kb], 0, 0, 0);
      }
    }
    bf16x8 pf[4];
    float mx = s[0][0];
#pragma unroll
    for (int r = 1; r < 16; ++r) mx = fmaxf(mx, s[0][r]);
#pragma unroll
    for (int r = 0; r < 16; ++r) mx = fmaxf(mx, s[1][r]);
    mx = fmaxf(mx, __shfl_xor(mx, 32));
    const float mnew = fmaxf(mrun, mx * cs);
    const float alpha = __builtin_amdgcn_exp2f(mrun - mnew);
    const bool grew = mnew > mrun;
    mrun = mnew;
    float ls = 0.f;
#pragma unroll
    for (int kb = 0; kb < 2; ++kb) {
      float pv[16];
#pragma unroll
      for (int r = 0; r < 16; ++r) { pv[r] = __builtin_amdgcn_exp2f(s[kb][r] * cs - mnew); ls += pv[r]; }
#pragma unroll
      for (int sp = 0; sp < 2; ++sp) {
        u32x4 w;
#pragma unroll
        for (int e = 0; e < 4; ++e) w[e] = pack2(pv[8 * sp + 2 * e], pv[8 * sp + 2 * e + 1]);
        pf[kb * 2 + sp] = *(bf16x8*)&w;
      }
    }
    lrun = lrun * alpha + ls;
    if (__any(grew)) {
#pragma unroll
      for (int db = 0; db < 2; ++db)
#pragma unroll
        for (int r = 0; r < 16; ++r) o[db][r] *= alpha;
    }
#pragma unroll
    for (int sp = 0; sp < 4; ++sp) {
#pragma unroll
      for (int db = 0; db < 2; ++db) {
        bf16x8 vf = *(const bf16x8*)(Vb + (db * 32 + l31) * ATT_VSTR + (16 * sp + 8 * hh) * 2);
        o[db] = __builtin_amdgcn_mfma_f32_32x32x16_bf16(vf, pf[sp], o[db], 0, 0, 0);
      }
    }
  };
  float mfix;
  {
    float aq = fabsf(p.att_qnorm[layer * 64 + lane]), ak = fabsf(p.att_knorm[layer * 64 + lane]);
    aq = wave_max(aq); ak = wave_max(ak);
    mfix = 8.f * aq * ak * 1.02f * 1.44269504088896f * ATT_TAU;
  }
  const bool fast = mfix <= 40.f;
  if (fast) {
#pragma unroll
    for (int ks = 0; ks < 4; ++ks) {
      u32x4 w = *(u32x4*)&qf[ks];
#pragma unroll
      for (int e = 0; e < 4; ++e) w[e] = pack2(__uint_as_float(w[e] << 16) * cs, __uint_as_float(w[e] & 0xffff0000u) * cs);
      qf[ks] = *(bf16x8*)&w;
    }
  }
  auto compute_fast = [&](int buf, int sub) {
    const char* Kb = smem + buf * ATT_BUF + sub * 64 * ATT_KSTR;
    const char* Vb = smem + buf * ATT_BUF + ATT_VOFF + sub * 128;
    bf16x8 kf[8], vf[8];
#pragma unroll
    for (int kb = 0; kb < 2; ++kb)
#pragma unroll
      for (int ks = 0; ks < 4; ++ks) kf[kb * 4 + ks] = *(const bf16x8*)(Kb + (kb * 32 + l31) * ATT_KSTR + (ks * 16 + hh * 8) * 2);
#pragma unroll
    for (int sp = 0; sp < 4; ++sp)
#pragma unroll
      for (int db = 0; db < 2; ++db) vf[sp * 2 + db] = *(const bf16x8*)(Vb + (db * 32 + l31) * ATT_VSTR + (16 * sp + 8 * hh) * 2);
    f32x16 s[2];
#pragma unroll
    for (int kb = 0; kb < 2; ++kb) {
#pragma unroll
      for (int r = 0; r < 16; ++r) s[kb][r] = 0.f;
#pragma unroll
      for (int ks = 0; ks < 4; ++ks) s[kb] = __builtin_amdgcn_mfma_f32_32x32x16_bf16(kf[kb * 4 + ks], qf[ks], s[kb], 0, 0, 0);
    }
    bf16x8 pf[4];
    float ls = 0.f;
#pragma unroll
    for (int kb = 0; kb < 2; ++kb) {
      float pv[16];
#pragma unroll
      for (int r = 0; r < 16; ++r) { pv[r] = __builtin_amdgcn_exp2f(s[kb][r]); ls += pv[r]; }
#pragma unroll
      for (int sp = 0; sp < 2; ++sp) {
        u32x4 w;
#pragma unroll
        for (int e = 0; e < 4; ++e) w[e] = pack2(pv[8 * sp + 2 * e], pv[8 * sp + 2 * e + 1]);
        pf[kb * 2 + sp] = *(bf16x8*)&w;
      }
    }
    lrun += ls;
#pragma unroll
    for (int sp = 0; sp < 4; ++sp)
#pragma unroll
      for (int db = 0; db < 2; ++db) o[db] = __builtin_amdgcn_mfma_f32_32x32x16_bf16(vf[sp * 2 + db], pf[sp], o[db], 0, 0, 0);
  };
  __syncthreads();
  gload(kt0);
  lstore(0);
  __syncthreads();
  if (fast) {
    for (int t = 0; t < nkt; ++t) {
      const int buf = t & 1;
      if (t + 1 < nkt) gload(kt0 + t + 1);
      compute_fast(buf, 0);
      compute_fast(buf, 1);
      if (t + 1 < nkt) lstore(buf ^ 1);
      __syncthreads();
    }
  } else {
    for (int t = 0; t < nkt; ++t) {
      const int buf = t & 1;
      if (t + 1 < nkt) gload(kt0 + t + 1);
      compute(buf, 0);
      compute(buf, 1);
      if (t + 1 < nkt) lstore(buf ^ 1);
      __syncthreads();
    }
  }
  {
    float l = lrun + __shfl_xor(lrun, 32);
    float il = ATT_ALPHA / l;
    bf16_t* op = p.br + (size_t)(tok0 + l31) * 1536 + head * 64;
#pragma unroll
    for (int db = 0; db < 2; ++db)
#pragma unroll
      for (int g = 0; g < 4; ++g) {
        u32x2 w; w.x = pack2(o[db][4 * g] * il, o[db][4 * g + 1] * il); w.y = pack2(o[db][4 * g + 2] * il, o[db][4 * g + 3] * il);
        *(u32x2*)(op + db * 32 + 8 * g + 4 * hh) = w;
      }
  }
}

__device__ __forceinline__ void attn_item64(const Params& p, int layer, int item) {
  const int tid = tidx(), wid = tid >> 6, lane = tid & 63, l31 = lane & 31, hh = lane >> 5;
  int b, kvh, tok0, kt0, nkt;
  if (item < 512) { b = item >> 8; kvh = (item >> 7) & 1; tok0 = b * SEQ + (item & 127) * 64; kt0 = 0; nkt = 132; }
  else { int r = item - 512; b = r >> 3; kvh = (r >> 2) & 1; tok0 = NLAT + b * CTXL + (r & 3) * 64; kt0 = 128; nkt = 4; }
  const int head = kvh * 4 + wid;
  const float cs = 0.125f * 1.44269504088896f * ATT_TAU;
  i32x8 qf[2];
#pragma unroll
  for (int qb = 0; qb < 2; ++qb)
#pragma unroll
    for (int i = 0; i < 4; ++i) {
      const u32x4 w = *(const u32x4*)(p.proj + (size_t)(tok0 + qb * 32 + l31) * 4096 + head * 64 + hh * 32 + i * 8);
#pragma unroll
      for (int e = 0; e < 2; ++e) {
        int q8 = 0;
        q8 = __builtin_amdgcn_cvt_pk_fp8_f32(__uint_as_float(w[2 * e] << 16) * cs, __uint_as_float(w[2 * e] & 0xffff0000u) * cs, q8, false);
        q8 = __builtin_amdgcn_cvt_pk_fp8_f32(__uint_as_float(w[2 * e + 1] << 16) * cs, __uint_as_float(w[2 * e + 1] & 0xffff0000u) * cs, q8, true);
        qf[qb][i * 2 + e] = q8;
      }
    }
  f32x16 o[2][2];
#pragma unroll
  for (int qb = 0; qb < 2; ++qb)
#pragma unroll
    for (int db = 0; db < 2; ++db)
#pragma unroll
      for (int r = 0; r < 16; ++r) o[qb][db][r] = 0.f;
  float lrun[2] = {0.f, 0.f};
  const bf16_t* vtb = p.vt + (size_t)(b * 2 + kvh) * 64 * 8448;
  const unsigned char* vt8b = VT8(p) + (size_t)(b * 2 + kvh) * 132 * 4096;
  const unsigned char* kt8b = KT8(p) + (size_t)(b * 2 + kvh) * 132 * 4096;
  auto stage = [&](int kt, int buf) {
    int ko = kt * 4096; asm volatile("" : "+s"(ko));
    char* base = smem + buf * 16384;
    const int r = tid >> 2, c = (tid & 3) ^ ((r >> 2) & 3);
    __builtin_amdgcn_global_load_lds((const unsigned*)(kt8b + ko + r * 64 + c * 16), (__attribute__((address_space(3))) unsigned*)(base + tid * 16), 16, 0, 0);
    __builtin_amdgcn_global_load_lds((const unsigned*)(vt8b + ko + r * 64 + c * 16), (__attribute__((address_space(3))) unsigned*)(base + 8192 + tid * 16), 16, 0, 0);
  };
  auto compute = [&](int buf) {
    const char* Kb = smem + buf * 16384;
    const char* Vb = Kb + 8192;
    i32x8 pf[2];
#pragma unroll
    for (int kb = 0; kb < 2; ++kb) {
      const int row = kb * 32 + l31, swk = (row >> 2) & 3;
      const i32x4 klo = *(const i32x4*)(Kb + row * 64 + (((2 * hh) ^ swk) << 4)), khi = *(const i32x4*)(Kb + row * 64 + (((2 * hh + 1) ^ swk) << 4));
      const i32x8 kf = {klo[0], klo[1], klo[2], klo[3], khi[0], khi[1], khi[2], khi[3]};
      f32x16 s[2];
#pragma unroll
      for (int qb = 0; qb < 2; ++qb) {
#pragma unroll
        for (int r = 0; r < 16; ++r) s[qb][r] = 0.f;
        s[qb] = __builtin_amdgcn_mfma_scale_f32_32x32x64_f8f6f4(kf, qf[qb], s[qb], 0, 0, 0, 0, 0, 0);
      }
#pragma unroll
      for (int qb = 0; qb < 2; ++qb) {
        float pv[16]; float ls = 0.f;
#pragma unroll
        for (int r = 0; r < 16; ++r) { pv[r] = __builtin_amdgcn_exp2f(s[qb][r]); ls += pv[r]; }
        lrun[qb] += ls;
#pragma unroll
        for (int e = 0; e < 4; ++e) {
          int w = __float_as_int(pv[4 * e]);
          w = __builtin_amdgcn_cvt_pk_bf8_f32(pv[4 * e], pv[4 * e + 1], w, false);
          w = __builtin_amdgcn_cvt_pk_bf8_f32(pv[4 * e + 2], pv[4 * e + 3], w, true);
          pf[qb][kb * 4 + e] = w;
        }
      }
    }
#pragma unroll
    for (int db = 0; db < 2; ++db) {
      const int row = db * 32 + l31, sw = (row >> 2) & 3;
      const i32x4 lo = *(const i32x4*)(Vb + row * 64 + (((2 * hh) ^ sw) << 4)), hi = *(const i32x4*)(Vb + row * 64 + (((2 * hh + 1) ^ sw) << 4));
      const i32x8 vf = {lo[0], lo[1], lo[2], lo[3], hi[0], hi[1], hi[2], hi[3]};
      o[0][db] = __builtin_amdgcn_mfma_scale_f32_32x32x64_f8f6f4(vf, pf[0], o[0][db], 0, 1, 0, 0, 0, 0);
      o[1][db] = __builtin_amdgcn_mfma_scale_f32_32x32x64_f8f6f4(vf, pf[1], o[1][db], 0, 1, 0, 0, 0, 0);
    }
  };
  __syncthreads();
  stage(kt0, 0);
  asm volatile("s_waitcnt vmcnt(0)" ::: "memory");
  __syncthreads();
  for (int t = 0; t < nkt; ++t) {
    if (t + 1 < nkt) stage(kt0 + t + 1, (t + 1) & 1);
    compute(t & 1);
    asm volatile("s_waitcnt vmcnt(0)" ::: "memory");
    __syncthreads();
  }
#pragma unroll
  for (int qb = 0; qb < 2; ++qb) {
    float l = lrun[qb] + __shfl_xor(lrun[qb], 32);
    float il = ATT_ALPHA / l;
    bf16_t* op = p.br + (size_t)(tok0 + qb * 32 + l31) * 1536 + head * 64;
#pragma unroll
    for (int db = 0; db < 2; ++db)
#pragma unroll
      for (int g = 0; g < 4; ++g) {
        u32x2 w; w.x = pack2(o[qb][db][4 * g] * il, o[qb][db][4 * g + 1] * il); w.y = pack2(o[qb][db][4 * g + 2] * il, o[qb][db][4 * g + 3] * il);
        *(u32x2*)(op + db * 32 + 8 * g + 4 * hh) = w;
      }
  }
}
__device__ __forceinline__ float attn_logit_bound(const Params& p, int layer) {
  const int lane = tidx() & 63;
  float aq = fabsf(p.att_qnorm[layer * 64 + lane]), ak = fabsf(p.att_knorm[layer * 64 + lane]);
  aq = wave_max(aq); ak = wave_max(ak);
  return 8.f * aq * ak * 1.02f * 1.44269504088896f * ATT_TAU;
}

__device__ __forceinline__ void phase_ssdprep(const Params& p, int layer) {
  const float* cw = p.ssd_conv_w + (size_t)layer * 5 * 768;
  const float* cb = p.ssd_conv_b + layer * 768;
  const int total = (MROWS / 16) * 96;
  for (int i = bidx() * NTHR + tidx(); i < total; i += gridDim.x * NTHR) {
    const int run = i / 96, c0 = (i - run * 96) * 8;
    const int row0 = run * 16;
    int t0, T;
    if (row0 < NLAT) { t0 = row0 & (SEQ - 1); T = SEQ; } else { t0 = (row0 - NLAT) & (CTXL - 1); T = CTXL; }
    float w[5][8], bias[8];
#pragma unroll
    for (int j = 0; j < 5; ++j) {
      f32x4 w0 = *(const f32x4*)(cw + j * 768 + c0), w1 = *(const f32x4*)(cw + j * 768 + c0 + 4);
#pragma unroll
      for (int e = 0; e < 4; ++e) { w[j][e] = w0[e]; w[j][4 + e] = w1[e]; }
    }
    {
      f32x4 b0 = *(const f32x4*)(cb + c0), b1 = *(const f32x4*)(cb + c0 + 4);
#pragma unroll
      for (int e = 0; e < 4; ++e) { bias[e] = b0[e]; bias[4 + e] = b1[e]; }
    }
    const bf16_t* src = p.proj + (size_t)row0 * 4096 + 1280 + c0;
    u32x4 win[5];
    const u32x4 zero4 = {0u, 0u, 0u, 0u};
    win[0] = zero4;
    { const u32x4 l1 = *(const u32x4*)(src - (t0 >= 2 ? 2 : 0) * 4096), l2 = *(const u32x4*)(src - (t0 >= 1 ? 1 : 0) * 4096);
      win[1] = t0 >= 2 ? l1 : zero4; win[2] = t0 >= 1 ? l2 : zero4; }
    win[3] = *(const u32x4*)(src);
    win[4] = *(const u32x4*)(src + 4096);
    u32x4 nxt[16];
#pragma unroll
    for (int r = 0; r < 16; ++r) {
      const bool ok = t0 + r + 2 < T;
      const u32x4 l = *(const u32x4*)(src + (size_t)(ok ? r + 2 : 0) * 4096);
      nxt[r] = ok ? l : zero4;
    }
#pragma unroll
    for (int r = 0; r < 16; ++r) {
      win[0] = win[1]; win[1] = win[2]; win[2] = win[3]; win[3] = win[4];
      win[4] = nxt[r];
      float a[8];
#pragma unroll
      for (int e = 0; e < 8; ++e) a[e] = bias[e];
#pragma unroll
      for (int j = 0; j < 5; ++j)
#pragma unroll
        for (int e = 0; e < 4; ++e) {
          a[2 * e] += w[j][2 * e] * __uint_as_float(win[j][e] << 16);
          a[2 * e + 1] += w[j][2 * e + 1] * __uint_as_float(win[j][e] & 0xffff0000u);
        }
      u32x4 o;
#pragma unroll
      for (int e = 0; e < 4; ++e) o[e] = pack2(siluf_(a[2 * e]), siluf_(a[2 * e + 1]));
      *(u32x4*)(p.xbc + (size_t)(row0 + r) * 768 + c0) = o;
    }
  }
  const int total2 = MROWS * 16;
  for (int i = bidx() * NTHR + tidx(); i < total2; i += gridDim.x * NTHR) {
    int row = i >> 4, j = i & 15;
    p.dtb[i] = softplusf_(p.small[(size_t)row * 32 + j] + p.ssd_dt_bias[layer * 16 + j]);
  }
}

__device__ __forceinline__ int chunk_row0(int b, int c) { return c < 64 ? b * SEQ + c * 128 : NLAT + b * CTXL + (c - 64) * 128; }
__device__ __forceinline__ float wave_incl_scan(float v, int lane) {
#pragma unroll
  for (int o = 1; o < 64; o <<= 1) { float t = __shfl_up(v, o); if (lane >= o) v += t; }
  return v;
}
__device__ __forceinline__ void ssd_scans(const Params& p, int layer, int row0, int h, float* fl) {
  const int tid = tidx(), lane = tid & 63, wv = tid >> 6;
  const bool fwd = tid < 128;
  const int s = fwd ? tid : 127 - (tid - 128);
  const float A = -__expf(p.ssd_a_log[layer * 16 + (fwd ? 0 : 8) + h]);
  const float dt = p.dtb[(size_t)(row0 + s) * 16 + (fwd ? 0 : 8) + h];
  float v = wave_incl_scan(dt * A, lane);
  if (lane == 63) fl[512 + wv] = v;
  __syncthreads();
  if (wv & 1) v += fl[512 + wv - 1];
  fl[(fwd ? 0 : 128) + s] = v;
  fl[(fwd ? 256 : 384) + s] = dt;
  __syncthreads();
}

#define SSD_TSTR 272
__device__ __forceinline__ void ssdA_item(const Params& p, int layer, int item) {
  const int tid = tidx(), wid = tid >> 6, lane = tid & 63, l31 = lane & 31, hh = lane >> 5;
  const int b = item / 528, c = (item / 8) % 66, h = item & 7, g = h >> 2;
  const int row0 = chunk_row0(b, c);
  float* fl = (float*)smem;
  char* BT = smem + 4096;
  char* XF = BT + 64 * SSD_TSTR;
  char* XB = XF + 64 * SSD_TSTR;
  __syncthreads();
  ssd_scans(p, layer, row0, h, fl);
  const float cfl = fl[127], cbl = fl[128];
  {
    const int s = tid >> 1, half = tid & 1;
    const float wf = __expf(cfl - fl[s]) * fl[256 + s], wb = __expf(cbl - fl[128 + s]) * fl[384 + s];
    const bf16_t* xr = p.xbc + (size_t)(row0 + s) * 768;
#pragma unroll
    for (int i = 0; i < 4; ++i) {
      u32x4 xv = *(const u32x4*)(xr + h * 64 + half * 32 + i * 8);
      u32x4 bv = *(const u32x4*)(xr + 512 + g * 64 + half * 32 + i * 8);
#pragma unroll
      for (int e = 0; e < 4; ++e) {
        int pp = half * 32 + i * 8 + 2 * e;
        float x0 = __uint_as_float(xv[e] << 16), x1 = __uint_as_float(xv[e] & 0xffff0000u);
        *(bf16_t*)(XF + pp * SSD_TSTR + s * 2) = f2bf(x0 * wf);
        *(bf16_t*)(XF + (pp + 1) * SSD_TSTR + s * 2) = f2bf(x1 * wf);
        *(bf16_t*)(XB + pp * SSD_TSTR + s * 2) = f2bf(x0 * wb);
        *(bf16_t*)(XB + (pp + 1) * SSD_TSTR + s * 2) = f2bf(x1 * wb);
        *(bf16_t*)(BT + pp * SSD_TSTR + s * 2) = (bf16_t)(bv[e] & 0xffffu);
        *(bf16_t*)(BT + (pp + 1) * SSD_TSTR + s * 2) = (bf16_t)(bv[e] >> 16);
      }
    }
  }
  __syncthreads();
  const int nb = wid >> 1, pb = wid & 1;
#pragma unroll
  for (int dir = 0; dir < 2; ++dir) {
    const char* XT = dir == 0 ? XF : XB;
    f32x16 acc;
#pragma unroll
    for (int r = 0; r < 16; ++r) acc[r] = 0.f;
#pragma unroll
    for (int ks = 0; ks < 8; ++ks) {
      bf16x8 a = *(const bf16x8*)(BT + (nb * 32 + l31) * SSD_TSTR + (ks * 16 + hh * 8) * 2);
      bf16x8 bb = *(const bf16x8*)(XT + (pb * 32 + l31) * SSD_TSTR + (ks * 16 + hh * 8) * 2);
      acc = __builtin_amdgcn_mfma_f32_32x32x16_bf16(a, bb, acc, 0, 0, 0);
    }
    bf16_t* dst = p.ssl + ((size_t)(((dir * 2 + b) * 8 + h) * 66 + c) * 64 + pb * 32 + l31) * 64 + nb * 32 + 4 * hh;
#pragma unroll
    for (int q4 = 0; q4 < 4; ++q4) {
      u32x2 w; w.x = pack2(acc[4 * q4], acc[4 * q4 + 1]); w.y = pack2(acc[4 * q4 + 2], acc[4 * q4 + 3]);
      *(u32x2*)(dst + 8 * q4) = w;
    }
  }
  if (tid == 0) {
    p.sdec[((0 * 2 + b) * 8 + h) * 66 + c] = __expf(cfl);
    p.sdec[((1 * 2 + b) * 8 + h) * 66 + c] = __expf(cbl);
  }
}

__device__ __forceinline__ void phase_ssdcarry(const Params& p) {
  const int total = 32 * 1024;
  for (int i = bidx() * NTHR + tidx(); i < total; i += gridDim.x * NTHR) {
    const int seq = i >> 10, el = (i & 1023) * 4;
    const int dir = seq >> 4;
    bf16_t* base = p.ssl + (size_t)seq * 66 * 4096 + el;
    const float* dec = p.sdec + seq * 66;
    float st[4] = {0.f, 0.f, 0.f, 0.f};
#pragma unroll 1
    for (int k0 = 0; k0 < 66; k0 += 22) {
      u32x2 v[22]; float d[22];
#pragma unroll
      for (int u = 0; u < 22; ++u) {
        const int k = k0 + u, c = dir == 0 ? (k < 2 ? 64 + k : k - 2) : (65 - k);
        v[u] = *(const u32x2*)(base + (size_t)c * 4096);
        d[u] = dec[c];
      }
#pragma unroll
      for (int u = 0; u < 22; ++u) {
        const int k = k0 + u, c = dir == 0 ? (k < 2 ? 64 + k : k - 2) : (65 - k);
        u32x2 w; w.x = pack2(st[0], st[1]); w.y = pack2(st[2], st[3]);
        *(u32x2*)(base + (size_t)c * 4096) = w;
        st[0] = d[u] * st[0] + __uint_as_float(v[u].x << 16); st[1] = d[u] * st[1] + __uint_as_float(v[u].x & 0xffff0000u);
        st[2] = d[u] * st[2] + __uint_as_float(v[u].y << 16); st[3] = d[u] * st[3] + __uint_as_float(v[u].y & 0xffff0000u);
      }
    }
  }
}

__device__ __forceinline__ void ssdC_item(const Params& p, int layer, int item) {
  const int tid = tidx(), wid = tid >> 6, lane = tid & 63, l31 = lane & 31, hh = lane >> 5;
  const int b = item / 528, c = (item / 8) % 66, h = item & 7, g = h >> 2;
  const int row0 = chunk_row0(b, c);
  float* fl = (float*)smem;
  char* Bt = smem + 4096;
  char* XT = Bt + 128 * 144;
  __syncthreads();
  ssd_scans(p, layer, row0, h, fl);
  {
#pragma unroll
    for (int i = 0; i < 4; ++i) {
      int id = tid + 256 * i, r = id >> 3, c16 = id & 7;
      *(u32x4*)(Bt + r * 144 + c16 * 16) = *(const u32x4*)(p.xbc + (size_t)(row0 + r) * 768 + 512 + g * 64 + c16 * 8);
    }
    const int s = tid >> 1, half = tid & 1;
    const bf16_t* xr = p.xbc + (size_t)(row0 + s) * 768 + h * 64 + half * 32;
#pragma unroll
    for (int i = 0; i < 4; ++i) {
      u32x4 xv = *(const u32x4*)(xr + i * 8);
#pragma unroll
      for (int e = 0; e < 4; ++e) {
        int pp = half * 32 + i * 8 + 2 * e;
        *(bf16_t*)(XT + pp * SSD_TSTR + s * 2) = (bf16_t)(xv[e] & 0xffffu);
        *(bf16_t*)(XT + (pp + 1) * SSD_TSTR + s * 2) = (bf16_t)(xv[e] >> 16);
      }
    }
  }
  __syncthreads();
  const int s = wid * 32 + l31;
  const float cfs = fl[s], cbs = fl[128 + s];
  bf16x8 cf[4];
#pragma unroll
  for (int ks = 0; ks < 4; ++ks) cf[ks] = *(const bf16x8*)(p.xbc + (size_t)(row0 + s) * 768 + 640 + g * 64 + ks * 16 + hh * 8);
  f32x16 Y[2];
  {
    f32x16 aF[2], aB[2];
#pragma unroll
    for (int pb = 0; pb < 2; ++pb)
#pragma unroll
      for (int r = 0; r < 16; ++r) { aF[pb][r] = 0.f; aB[pb][r] = 0.f; }
    const bf16_t* spf = p.ssl + (size_t)(((0 * 2 + b) * 8 + h) * 66 + c) * 4096;
    const bf16_t* spb = p.ssl + (size_t)(((1 * 2 + b) * 8 + h) * 66 + c) * 4096;
#pragma unroll
    for (int pb = 0; pb < 2; ++pb)
#pragma unroll
      for (int ks = 0; ks < 4; ++ks) {
        bf16x8 a0 = *(const bf16x8*)(spf + (pb * 32 + l31) * 64 + ks * 16 + hh * 8);
        bf16x8 a1 = *(const bf16x8*)(spb + (pb * 32 + l31) * 64 + ks * 16 + hh * 8);
        aF[pb] = __builtin_amdgcn_mfma_f32_32x32x16_bf16(a0, cf[ks], aF[pb], 0, 0, 0);
        aB[pb] = __builtin_amdgcn_mfma_f32_32x32x16_bf16(a1, cf[ks], aB[pb], 0, 0, 0);
      }
    const float ef = __expf(cfs), eb = __expf(cbs);
#pragma unroll
    for (int pb = 0; pb < 2; ++pb)
#pragma unroll
      for (int r = 0; r < 16; ++r) Y[pb][r] = aF[pb][r] * ef + aB[pb][r] * eb;
  }
  for (int rb = 0; rb < 4; ++rb) {
    f32x16 gt;
#pragma unroll
    for (int r = 0; r < 16; ++r) gt[r] = 0.f;
#pragma unroll
    for (int ks = 0; ks < 4; ++ks) {
      bf16x8 a = *(const bf16x8*)(Bt + (rb * 32 + l31) * 144 + (ks * 16 + hh * 8) * 2);
      gt = __builtin_amdgcn_mfma_f32_32x32x16_bf16(a, cf[ks], gt, 0, 0, 0);
    }
#pragma unroll
    for (int dir = 0; dir < 2; ++dir) {
      if (dir == 0 ? (rb > wid) : (rb < wid)) continue;
      const float* cum = fl + (dir == 0 ? 0 : 128);
      const float* dta = fl + (dir == 0 ? 256 : 384);
      const float cs = dir == 0 ? cfs : cbs;
      float val[16];
#pragma unroll
      for (int q4 = 0; q4 < 4; ++q4) {
        int r0 = rb * 32 + 8 * q4 + 4 * hh;
        f32x4 cr = *(const f32x4*)(cum + r0), dr = *(const f32x4*)(dta + r0);
#pragma unroll
        for (int e = 0; e < 4; ++e) {
          int r = r0 + e;
          bool keep = dir == 0 ? (r <= s) : (r >= s);
          float arg = fminf(cs - cr[e], 0.f);
          val[4 * q4 + e] = keep ? gt[4 * q4 + e] * __expf(arg) * dr[e] : 0.f;
        }
      }
#pragma unroll
      for (int sp = 0; sp < 2; ++sp) {
        u32x4 w;
#pragma unroll
        for (int e = 0; e < 4; ++e) w[e] = pack2(val[8 * sp + 2 * e], val[8 * sp + 2 * e + 1]);
        bf16x8 pf = *(bf16x8*)&w;
#pragma unroll
        for (int pb = 0; pb < 2; ++pb) {
          const char* xa = XT + (pb * 32 + l31) * SSD_TSTR + (rb * 32 + 16 * sp + 4 * hh) * 2;
          u32x2 v0 = *(const u32x2*)xa, v1 = *(const u32x2*)(xa + 16);
          u32x4 vw = {v0[0], v0[1], v1[0], v1[1]};
          Y[pb] = __builtin_amdgcn_mfma_f32_32x32x16_bf16(*(bf16x8*)&vw, pf, Y[pb], 0, 0, 0);
        }
      }
    }
  }
  bf16_t* op = p.yf + (size_t)(row0 + s) * 512 + h * 64;
#pragma unroll
  for (int pb = 0; pb < 2; ++pb)
#pragma unroll
    for (int q4 = 0; q4 < 4; ++q4) {
      u32x2 w; w.x = pack2(Y[pb][4 * q4], Y[pb][4 * q4 + 1]); w.y = pack2(Y[pb][4 * q4 + 2], Y[pb][4 * q4 + 3]);
      *(u32x2*)(op + pb * 32 + 8 * q4 + 4 * hh) = w;
    }
}

__device__ __forceinline__ void phase_ssdout(const Params& p, int layer, int nrows) {
  const int lane = tidx() & 63, wv = tidx() >> 6;
  const int c0 = lane * 8, h = c0 >> 6;
  const float Dk = p.ssd_d[layer * 8 + h];
  float ng[8];
  { const f32x4 n0 = *(const f32x4*)(p.ssd_norm + layer * 512 + c0), n1 = *(const f32x4*)(p.ssd_norm + layer * 512 + c0 + 4);
#pragma unroll
    for (int e = 0; e < 4; ++e) { ng[e] = n0[e]; ng[4 + e] = n1[e]; } }
  for (int row = bidx() * 4 + wv; row < nrows; row += gridDim.x * 4) {
    u32x4 a = *(const u32x4*)(p.yf + (size_t)row * 512 + c0);
    u32x4 xs = *(const u32x4*)(p.xbc + (size_t)row * 768 + c0), z = *(const u32x4*)(p.proj + (size_t)row * 4096 + 768 + c0);
    float y[8]; float ss = 0.f;
#pragma unroll
    for (int e = 0; e < 4; ++e) {
      float y0 = __uint_as_float(a[e] << 16) + __uint_as_float(xs[e] << 16) * Dk;
      float y1 = __uint_as_float(a[e] & 0xffff0000u) + __uint_as_float(xs[e] & 0xffff0000u) * Dk;
      y0 *= siluf_(__uint_as_float(z[e] << 16)); y1 *= siluf_(__uint_as_float(z[e] & 0xffff0000u));
      y[2 * e] = y0; y[2 * e + 1] = y1; ss += y0 * y0 + y1 * y1;
    }
    ss = wave_sum(ss);
    float rs = rsqrtf(ss * (1.f / 512.f) + 1e-6f);
    u32x4 w;
#pragma unroll
    for (int e = 0; e < 4; ++e) w[e] = pack2(y[2 * e] * rs * ng[2 * e], y[2 * e + 1] * rs * ng[2 * e + 1]);
    *(u32x4*)(p.br + (size_t)row * 1536 + 512 + c0) = w;
  }
}

__device__ __forceinline__ float wave_incl_maxscan(float v, int lane) {
#pragma unroll
  for (int o = 1; o < 64; o <<= 1) { float t = __shfl_up(v, o); if (lane >= o) v = fmaxf(v, t); }
  return v;
}
__device__ __forceinline__ void ml_scans(const Params& p, int layer, int row0, int h, float* fl) {
  const int tid = tidx(), lane = tid & 63, wv = tid >> 6;
  const int dir = tid >> 7;
  const int s = dir == 0 ? tid : 127 - (tid - 128);
  const float ip = p.small[(size_t)(row0 + s) * 32 + 16 + dir * 8 + h] + p.ml_gate_bias[layer * 16 + dir * 8 + h];
  const float fp = p.small[(size_t)(row0 + s) * 32 + 16 + dir * 8 + 4 + h] + p.ml_gate_bias[layer * 16 + dir * 8 + 4 + h];
  float bc = wave_incl_scan(logsigmoidf_(fp), lane);
  if (lane == 63) fl[768 + wv] = bc;
  __syncthreads();
  if (wv & 1) bc += fl[768 + wv - 1];
  const float u = ip - bc;
  float pm = wave_incl_maxscan(u, lane);
  if (lane == 63) fl[776 + wv] = pm;
  __syncthreads();
  if (wv & 1) pm = fmaxf(pm, fl[776 + wv - 1]);
  fl[dir * 128 + s] = bc; fl[256 + dir * 128 + s] = u; fl[512 + dir * 128 + s] = pm;
  __syncthreads();
}

#define ML_TSTR 272
__device__ __forceinline__ void mlA_item(const Params& p, int layer, int item) {
  const int tid = tidx(), wid = tid >> 6, lane = tid & 63, l31 = lane & 31, hh = lane >> 5;
  const int b = item / 264, c = (item / 4) % 66, h = item & 3;
  const int row0 = chunk_row0(b, c);
  float* fl = (float*)smem;
  char* KT = smem + 8192;
  char* VW = KT + 128 * ML_TSTR;
  __syncthreads();
  ml_scans(p, layer, row0, h, fl);
  const int r_ = tid >> 1, half = tid & 1;
  {
    const bf16_t* kr = p.proj + (size_t)(row0 + r_) * 4096 + 2560 + h * 128 + half * 64;
#pragma unroll
    for (int i = 0; i < 8; ++i) {
      u32x4 kv = *(const u32x4*)(kr + i * 8);
#pragma unroll
      for (int e = 0; e < 4; ++e) {
        int ee = half * 64 + i * 8 + 2 * e;
        *(bf16_t*)(KT + ee * ML_TSTR + r_ * 2) = (bf16_t)(kv[e] & 0xffffu);
        *(bf16_t*)(KT + (ee + 1) * ML_TSTR + r_ * 2) = (bf16_t)(kv[e] >> 16);
      }
    }
  }
  for (int dir = 0; dir < 2; ++dir) {
    const int seq = (dir * 2 + b) * 4 + h;
    const float blast = fl[dir * 128 + (dir == 0 ? 127 : 0)];
    const float umax = fl[512 + dir * 128 + (dir == 0 ? 127 : 0)];
    {
      const float wgt = __expf(fl[256 + dir * 128 + r_] - umax) * 0.08838834764831845f;
      if (half == 0) fl[1024 + r_] = wgt;
      const bf16_t* vr = p.proj + (size_t)(row0 + r_) * 4096 + 3072 + h * 128 + half * 64;
#pragma unroll
      for (int i = 0; i < 8; ++i) {
        u32x4 vv = *(const u32x4*)(vr + i * 8);
#pragma unroll
        for (int e = 0; e < 4; ++e) {
          int dd = half * 64 + i * 8 + 2 * e;
          *(bf16_t*)(VW + dd * ML_TSTR + r_ * 2) = f2bf(__uint_as_float(vv[e] << 16) * wgt);
          *(bf16_t*)(VW + (dd + 1) * ML_TSTR + r_ * 2) = f2bf(__uint_as_float(vv[e] & 0xffff0000u) * wgt);
        }
      }
    }
    __syncthreads();
    {
      const int e_ = tid & 127, hf = tid >> 7;
      float a = 0.f;
#pragma unroll
      for (int i = 0; i < 8; ++i) {
        u32x4 kv = *(const u32x4*)(KT + e_ * ML_TSTR + (hf * 64 + i * 8) * 2);
        const float* wp = fl + 1024 + hf * 64 + i * 8;
#pragma unroll
        for (int e = 0; e < 4; ++e) a += __uint_as_float(kv[e] << 16) * wp[2 * e] + __uint_as_float(kv[e] & 0xffff0000u) * wp[2 * e + 1];
      }
      if (hf == 1) fl[1280 + e_] = a;
      __syncthreads();
      if (hf == 0) p.mnl[((size_t)seq * 66 + c) * 128 + e_] = a + fl[1280 + e_];
    }
    f32x16 acc[4];
#pragma unroll
    for (int eb = 0; eb < 4; ++eb)
#pragma unroll
      for (int r = 0; r < 16; ++r) acc[eb][r] = 0.f;
#pragma unroll
    for (int ks = 0; ks < 8; ++ks) {
      bf16x8 bv = *(const bf16x8*)(VW + (wid * 32 + l31) * ML_TSTR + (ks * 16 + hh * 8) * 2);
#pragma unroll
      for (int eb = 0; eb < 4; ++eb) {
        bf16x8 av = *(const bf16x8*)(KT + (eb * 32 + l31) * ML_TSTR + (ks * 16 + hh * 8) * 2);
        acc[eb] = __builtin_amdgcn_mfma_f32_32x32x16_bf16(av, bv, acc[eb], 0, 0, 0);
      }
    }
    bf16_t* dst = p.mcl + (((size_t)seq * 66 + c) * 128 + wid * 32 + l31) * 128 + 4 * hh;
#pragma unroll
    for (int eb = 0; eb < 4; ++eb)
#pragma unroll
      for (int q4 = 0; q4 < 4; ++q4) {
        u32x2 w; w.x = pack2(acc[eb][4 * q4], acc[eb][4 * q4 + 1]); w.y = pack2(acc[eb][4 * q4 + 2], acc[eb][4 * q4 + 3]);
        *(u32x2*)(dst + eb * 32 + 8 * q4) = w;
      }
    if (tid == 0) { p.mml[seq * 66 + c] = blast + umax; p.mbl[seq * 66 + c] = blast; }
    __syncthreads();
  }
}

__device__ __forceinline__ void phase_mlcarry(const Params& p) {
  const int per = 4096 + 32;
  const int total = 16 * per;
  for (int i = ((int)gridDim.x - 1 - bidx()) * NTHR + tidx(); i < total; i += gridDim.x * NTHR) {
    const int seq = i / per, j = i % per;
    const int dir = seq >> 3;
    const float* ml = p.mml + seq * 66; const float* bl = p.mbl + seq * 66;
    float m = 0.f;
    float st[4] = {0.f, 0.f, 0.f, 0.f};
    const bool isC = j < 4096;
    bf16_t* cb = p.mcl + (size_t)seq * 66 * 16384 + (isC ? j * 4 : 0);
    float* nb = p.mnl + (size_t)seq * 66 * 128 + (isC ? 0 : (j - 4096) * 4);
#pragma unroll 1
    for (int k0 = 0; k0 < 66; k0 += 22) {
      float mlv[22], blv[22];
#pragma unroll
      for (int u = 0; u < 22; ++u) {
        const int k = k0 + u, c = dir == 0 ? (k < 2 ? 64 + k : k - 2) : (65 - k);
        mlv[u] = ml[c]; blv[u] = bl[c];
      }
      if (isC) {
        u32x2 v[22];
#pragma unroll
        for (int u = 0; u < 22; ++u) {
          const int k = k0 + u, c = dir == 0 ? (k < 2 ? 64 + k : k - 2) : (65 - k);
          v[u] = *(const u32x2*)(cb + (size_t)c * 16384);
        }
#pragma unroll
        for (int u = 0; u < 22; ++u) {
          const int k = k0 + u, c = dir == 0 ? (k < 2 ? 64 + k : k - 2) : (65 - k);
          const float mnew = fmaxf(blv[u] + m, mlv[u]);
          const float ap = __expf(blv[u] + m - mnew), al = __expf(mlv[u] - mnew);
          u32x2 w; w.x = pack2(st[0], st[1]); w.y = pack2(st[2], st[3]);
          *(u32x2*)(cb + (size_t)c * 16384) = w;
          st[0] = ap * st[0] + al * __uint_as_float(v[u].x << 16); st[1] = ap * st[1] + al * __uint_as_float(v[u].x & 0xffff0000u);
          st[2] = ap * st[2] + al * __uint_as_float(v[u].y << 16); st[3] = ap * st[3] + al * __uint_as_float(v[u].y & 0xffff0000u);
          if (j == 0) p.mmp[seq * 66 + c] = m;
          m = mnew;
        }
      } else {
        f32x4 v[22];
#pragma unroll
        for (int u = 0; u < 22; ++u) {
          const int k = k0 + u, c = dir == 0 ? (k < 2 ? 64 + k : k - 2) : (65 - k);
          v[u] = *(const f32x4*)(nb + (size_t)c * 128);
        }
#pragma unroll
        for (int u = 0; u < 22; ++u) {
          const int k = k0 + u, c = dir == 0 ? (k < 2 ? 64 + k : k - 2) : (65 - k);
          const float mnew = fmaxf(blv[u] + m, mlv[u]);
          const float ap = __expf(blv[u] + m - mnew), al = __expf(mlv[u] - mnew);
          f32x4 w = {st[0], st[1], st[2], st[3]};
          *(f32x4*)(nb + (size_t)c * 128) = w;
          st[0] = ap * st[0] + al * v[u][0]; st[1] = ap * st[1] + al * v[u][1]; st[2] = ap * st[2] + al * v[u][2]; st[3] = ap * st[3] + al * v[u][3];
          m = mnew;
        }
      }
    }
  }
}

__device__ __forceinline__ void mlC_item(const Params& p, int layer, int item) {
  const int tid = tidx(), wid = tid >> 6, lane = tid & 63, l31 = lane & 31, hh = lane >> 5;
  const int b = item / 264, c = (item / 4) % 66, h = item & 3;
  const int row0 = chunk_row0(b, c);
  float* fl = (float*)smem;
  char* Kt = smem + 8192;
  char* VT = Kt + 128 * ML_TSTR;
  __syncthreads();
  ml_scans(p, layer, row0, h, fl);
  {
#pragma unroll
    for (int i = 0; i < 8; ++i) {
      int id = tid + 256 * i, r = id >> 4, c16 = id & 15;
      *(u32x4*)(Kt + r * ML_TSTR + c16 * 16) = *(const u32x4*)(p.proj + (size_t)(row0 + r) * 4096 + 2560 + h * 128 + c16 * 8);
    }
    const int r_ = tid >> 1, half = tid & 1;
    const bf16_t* vr = p.proj + (size_t)(row0 + r_) * 4096 + 3072 + h * 128 + half * 64;
#pragma unroll
    for (int i = 0; i < 8; ++i) {
      u32x4 vv = *(const u32x4*)(vr + i * 8);
#pragma unroll
      for (int e = 0; e < 4; ++e) {
        int dd = half * 64 + i * 8 + 2 * e;
        *(bf16_t*)(VT + dd * ML_TSTR + r_ * 2) = (bf16_t)(vv[e] & 0xffffu);
        *(bf16_t*)(VT + (dd + 1) * ML_TSTR + r_ * 2) = (bf16_t)(vv[e] >> 16);
      }
    }
    {
      const int dir = tid >> 7, e_ = tid & 127;
      const int seq = (dir * 2 + b) * 4 + h;
      fl[1024 + dir * 128 + e_] = p.mnl[((size_t)seq * 66 + c) * 128 + e_];
    }
  }
  __syncthreads();
  const int s = wid * 32 + l31;
  bf16x8 qf[8];
#pragma unroll
  for (int ks = 0; ks < 8; ++ks) qf[ks] = *(const bf16x8*)(p.proj + (size_t)(row0 + s) * 4096 + 2048 + h * 128 + ks * 16 + hh * 8);
  f32x16 hacc[4];
#pragma unroll
  for (int db = 0; db < 4; ++db)
#pragma unroll
    for (int r = 0; r < 16; ++r) hacc[db][r] = 0.f;
  for (int dir = 0; dir < 2; ++dir) {
    const int seq = (dir * 2 + b) * 4 + h;
    const float mprev = p.mmp[seq * 66 + c];
    const float bcs = fl[dir * 128 + s], pms = fl[512 + dir * 128 + s];
    const float msel = fmaxf(mprev, pms);
    const float ms = bcs + msel;
    const float winter = __expf(mprev - msel);
    const float* uu = fl + 256 + dir * 128;
    float qn = 0.f;
    {
      const float* np = fl + 1024 + dir * 128;
#pragma unroll
      for (int ks = 0; ks < 8; ++ks) {
        u32x4 w = *(u32x4*)&qf[ks];
        const float* npp = np + ks * 16 + hh * 8;
#pragma unroll
        for (int e = 0; e < 4; ++e) qn += __uint_as_float(w[e] << 16) * npp[2 * e] + __uint_as_float(w[e] & 0xffff0000u) * npp[2 * e + 1];
      }
      qn += __shfl_xor(qn, 32);
    }
    float den = 0.f;
    for (int rb = 0; rb < 4; ++rb) {
      if (dir == 0 ? (rb > wid) : (rb < wid)) continue;
      f32x16 st;
#pragma unroll
      for (int r = 0; r < 16; ++r) st[r] = 0.f;
#pragma unroll
      for (int ks = 0; ks < 8; ++ks) {
        bf16x8 a = *(const bf16x8*)(Kt + (rb * 32 + l31) * ML_TSTR + (ks * 16 + hh * 8) * 2);
        st = __builtin_amdgcn_mfma_f32_32x32x16_bf16(a, qf[ks], st, 0, 0, 0);
      }
#pragma unroll
      for (int q4 = 0; q4 < 4; ++q4) {
        int r0 = rb * 32 + 8 * q4 + 4 * hh;
        f32x4 ur = *(const f32x4*)(uu + r0);
#pragma unroll
        for (int e = 0; e < 4; ++e) {
          int r = r0 + e;
          bool keep = dir == 0 ? (r <= s) : (r >= s);
          float arg = fminf(ur[e] - msel, 0.f);
          den += keep ? st[4 * q4 + e] * 0.08838834764831845f * __expf(arg) : 0.f;
        }
      }
    }
    den += __shfl_xor(den, 32);
    den += winter * qn;
    const float inv = 1.f / fmaxf(fabsf(den), __expf(-ms));
    {
      const float qs = winter * inv;
      const bf16_t* cp = p.mcl + ((size_t)seq * 66 + c) * 16384;
#pragma unroll
      for (int ks = 0; ks < 8; ++ks) {
        u32x4 w = *(u32x4*)&qf[ks];
        u32x4 ws;
#pragma unroll
        for (int e = 0; e < 4; ++e) ws[e] = pack2(__uint_as_float(w[e] << 16) * qs, __uint_as_float(w[e] & 0xffff0000u) * qs);
        bf16x8 qsf = *(bf16x8*)&ws;
#pragma unroll
        for (int db = 0; db < 4; ++db) {
          bf16x8 a = *(const bf16x8*)(cp + (db * 32 + l31) * 128 + ks * 16 + hh * 8);
          hacc[db] = __builtin_amdgcn_mfma_f32_32x32x16_bf16(a, qsf, hacc[db], 0, 0, 0);
        }
      }
    }
    for (int rb = 0; rb < 4; ++rb) {
      if (dir == 0 ? (rb > wid) : (rb < wid)) continue;
      f32x16 st;
#pragma unroll
      for (int r = 0; r < 16; ++r) st[r] = 0.f;
#pragma unroll
      for (int ks = 0; ks < 8; ++ks) {
        bf16x8 a = *(const bf16x8*)(Kt + (rb * 32 + l31) * ML_TSTR + (ks * 16 + hh * 8) * 2);
        st = __builtin_amdgcn_mfma_f32_32x32x16_bf16(a, qf[ks], st, 0, 0, 0);
      }
      const float sc = 0.08838834764831845f * inv;
#pragma unroll
      for (int sp = 0; sp < 2; ++sp) {
        u32x4 w;
#pragma unroll
        for (int q2 = 0; q2 < 2; ++q2) {
          int q4 = 2 * sp + q2;
          int r0 = rb * 32 + 8 * q4 + 4 * hh;
          f32x4 ur = *(const f32x4*)(uu + r0);
          float v[4];
#pragma unroll
          for (int e = 0; e < 4; ++e) {
            int r = r0 + e;
            bool keep = dir == 0 ? (r <= s) : (r >= s);
            float arg = fminf(ur[e] - msel, 0.f);
            v[e] = keep ? st[4 * q4 + e] * sc * __expf(arg) : 0.f;
          }
          w[2 * q2] = pack2(v[0], v[1]); w[2 * q2 + 1] = pack2(v[2], v[3]);
        }
        bf16x8 pf = *(bf16x8*)&w;
#pragma unroll
        for (int db = 0; db < 4; ++db) {
          const char* va = VT + (db * 32 + l31) * ML_TSTR + (rb * 32 + 16 * sp + 4 * hh) * 2;
          u32x2 v0 = *(const u32x2*)va, v1 = *(const u32x2*)(va + 16);
          u32x4 vw = {v0[0], v0[1], v1[0], v1[1]};
          hacc[db] = __builtin_amdgcn_mfma_f32_32x32x16_bf16(*(bf16x8*)&vw, pf, hacc[db], 0, 0, 0);
        }
      }
    }
  }
  bf16_t* op = p.hf + (size_t)(row0 + s) * 512 + h * 128;
#pragma unroll
  for (int db = 0; db < 4; ++db)
#pragma unroll
    for (int q4 = 0; q4 < 4; ++q4) {
      u32x2 w; w.x = pack2(hacc[db][4 * q4], hacc[db][4 * q4 + 1]); w.y = pack2(hacc[db][4 * q4 + 2], hacc[db][4 * q4 + 3]);
      *(u32x2*)(op + db * 32 + 8 * q4 + 4 * hh) = w;
    }
}

__device__ __forceinline__ void phase_mlout(const Params& p, int layer, int nrows) {
  const int lane = tidx() & 63, wv = tidx() >> 6;
  const int c0 = lane * 8;
  float ng[8];
  { const f32x4 n0 = *(const f32x4*)(p.ml_norm + layer * 512 + c0), n1 = *(const f32x4*)(p.ml_norm + layer * 512 + c0 + 4);
#pragma unroll
    for (int e = 0; e < 4; ++e) { ng[e] = n0[e]; ng[4 + e] = n1[e]; } }
  for (int row = bidx() * 4 + wv; row < nrows; row += gridDim.x * 4) {
    u32x4 a = *(const u32x4*)(p.hf + (size_t)row * 512 + c0);
    u32x4 o = *(const u32x4*)(p.proj + (size_t)row * 4096 + 3584 + c0);
    float y[8]; float ss = 0.f;
#pragma unroll
    for (int e = 0; e < 4; ++e) {
      float y0 = __uint_as_float(a[e] << 16);
      float y1 = __uint_as_float(a[e] & 0xffff0000u);
      y[2 * e] = y0; y[2 * e + 1] = y1; ss += y0 * y0 + y1 * y1;
    }
    ss += wr_dpp<0xB1>(ss); ss += wr_dpp<0x4E>(ss); ss += wr_dpp<0x141>(ss); ss += wr_dpp<0x140>(ss);
    float rs = rsqrtf(ss * (1.f / 128.f) + 1e-6f);
    u32x4 w;
#pragma unroll
    for (int e = 0; e < 4; ++e) {
      float o0 = sigmoidf_(__uint_as_float(o[e] << 16)), o1 = sigmoidf_(__uint_as_float(o[e] & 0xffff0000u));
      w[e] = pack2(y[2 * e] * rs * ng[2 * e] * o0, y[2 * e + 1] * rs * ng[2 * e + 1] * o1);
    }
    *(u32x4*)(p.br + (size_t)row * 1536 + 1024 + c0) = w;
  }
}

__device__ __forceinline__ void phase_uvconv(const Params& p, int layer) {
  const size_t n4 = (size_t)16384 * 1024 / 4;
  const f32x4* su = (const f32x4*)(p.peer_u + (size_t)layer * 16384 * 1024);
  const f32x4* sv = (const f32x4*)(p.peer_v + (size_t)layer * 16384 * 1024);
  u32x2* du = (u32x2*)p.uv; u32x2* dv = (u32x2*)(p.uv + (size_t)16384 * 1024);
  for (size_t i = (size_t)bidx() * NTHR + tidx(); i < n4; i += (size_t)gridDim.x * NTHR) {
    f32x4 a = su[i], b = sv[i];
    u32x2 w; w.x = pack2(a[0], a[1]); w.y = pack2(a[2], a[3]); du[i] = w;
    u32x2 w2; w2.x = pack2(b[0], b[1]); w2.y = pack2(b[2], b[3]); dv[i] = w2;
  }
}

__device__ __forceinline__ void phase_topk(const Params& p, int layer, int nrows) {
#if DIAG_HP
  float* sks = (float*)smem;
  float* qs = (float*)(smem + 2 * 128 * 129 * 4);
#else
  bf16_t* sks = (bf16_t*)smem;
  float* qs = (float*)(smem + 2 * 128 * 130 * 2);
#endif
  const int tid = tidx(), lane = tid & 63, wv = tid >> 6;
  const int nchunks = nrows / 64;
  int cur_h = -1;
  for (int item = bidx(); item < nchunks * 8; item += gridDim.x) {
    int h = item % 8, chunk = item / 8;
    if (h != cur_h) {
      __syncthreads();
#if DIAG_HP
      const float* src = p.peer_subkeys + ((size_t)layer * 8 + h) * 2 * 128 * 128;
      for (int i = tid; i < 2 * 128 * 128; i += NTHR) { int pk = i >> 7, d = i & 127; sks[pk * 129 + d] = src[i]; }
#else
      const bf16_t* src = p.sk + ((size_t)layer * 8 + h) * 2 * 128 * 128;
      for (int i = tid; i < 2 * 128 * 128; i += NTHR) { int pk = i >> 7, d = i & 127; sks[pk * 130 + d] = src[i]; }
#endif
      __syncthreads();
      cur_h = h;
    }
    float* myq = qs + wv * 256;
    for (int ti = 0; ti < 16; ++ti) {
      int row = chunk * 64 + wv * 16 + ti;
#if DIAG_HP
      const float* qp = p.qf + (size_t)row * 2048 + h * 256;
      myq[lane] = qp[lane]; myq[lane + 64] = qp[lane + 64]; myq[lane + 128] = qp[lane + 128]; myq[lane + 192] = qp[lane + 192];
#else
      const bf16_t* qp = p.q + (size_t)row * 2048 + h * 256;
      myq[lane] = bf2f(qp[lane]); myq[lane + 64] = bf2f(qp[lane + 64]); myq[lane + 128] = bf2f(qp[lane + 128]); myq[lane + 192] = bf2f(qp[lane + 192]);
#endif
      __builtin_amdgcn_wave_barrier();
      float s1v = 0.f, s2v = 0.f; int i1v = 0, i2v = 0;
      for (int pp = 0; pp < 2; ++pp) {
        const float* qq = myq + pp * 128;
        float a0 = 0.f, a1 = 0.f;
#if DIAG_HP
        const float* k0 = sks + (pp * 128 + lane) * 129;
        const float* k1 = sks + (pp * 128 + lane + 64) * 129;
#pragma unroll 8
        for (int d = 0; d < 128; ++d) { a0 += qq[d] * k0[d]; a1 += qq[d] * k1[d]; }
#else
        const bf16_t* k0 = sks + (pp * 128 + lane) * 130;
        const bf16_t* k1 = sks + (pp * 128 + lane + 64) * 130;
#pragma unroll 8
        for (int d = 0; d < 128; d += 2) {
          unsigned w0 = *(const unsigned*)(k0 + d), w1 = *(const unsigned*)(k1 + d);
          float q0 = qq[d], q1 = qq[d + 1];
          a0 += q0 * __uint_as_float(w0 << 16) + q1 * __uint_as_float(w0 & 0xffff0000u);
          a1 += q0 * __uint_as_float(w1 << 16) + q1 * __uint_as_float(w1 & 0xffff0000u);
        }
#endif
        float sv = 0.f; int iv = 0;
        for (int r = 0; r < 16; ++r) {
          float mx = wave_max(fmaxf(a0, a1));
          unsigned long long bal = __ballot(a0 == mx || a1 == mx);
          int wl = __ffsll((long long)bal) - 1;
          int key = 0;
          if (lane == wl) { if (a0 == mx) { key = lane; a0 = -3e38f; } else { key = lane + 64; a1 = -3e38f; } }
          key = __shfl(key, wl);
          if (lane == r) { sv = mx; iv = key; }
        }
        if (pp == 0) { s1v = sv; i1v = iv; } else { s2v = sv; i2v = iv; }
      }
      float cs[4]; int ci[4];
      float s1i = __shfl(s1v, lane >> 2); int i1i = __shfl(i1v, lane >> 2);
#pragma unroll
      for (int r = 0; r < 4; ++r) {
        int j = (lane & 3) * 4 + r;
        float s2j = __shfl(s2v, j); int i2j = __shfl(i2v, j);
        cs[r] = s1i + s2j; ci[r] = i1i * 128 + i2j;
      }
      float selv = 0.f; int seli = 0;
      for (int r = 0; r < 16; ++r) {
        float lm = fmaxf(fmaxf(cs[0], cs[1]), fmaxf(cs[2], cs[3]));
        float mx = wave_max(lm);
        unsigned long long bal = __ballot(lm == mx);
        int wl = __ffsll((long long)bal) - 1;
        int id = 0;
        if (lane == wl) {
          if (cs[0] == mx) { id = ci[0]; cs[0] = -3e38f; }
          else if (cs[1] == mx) { id = ci[1]; cs[1] = -3e38f; }
          else if (cs[2] == mx) { id = ci[2]; cs[2] = -3e38f; }
          else { id = ci[3]; cs[3] = -3e38f; }
        }
        id = __shfl(id, wl);
        if (lane == r) { selv = mx; seli = id; }
      }
      float top = __shfl(selv, 0);
      float e = lane < 16 ? __expf(selv - top) : 0.f;
      float sum = wave_sum(e);
      if (lane < 16) {
        p.idx[(size_t)row * 128 + h * 16 + lane] = seli;
        p.gw[(size_t)row * 128 + h * 16 + lane] = e / sum;
      }
      __builtin_amdgcn_wave_barrier();
    }
  }
}

__device__ __forceinline__ void phase_uvconv8(const Params& p, int layer) {
  const int lane = tidx() & 63, wv = tidx() >> 6;
  for (int row = bidx() * 4 + wv; row < 32768; row += gridDim.x * 4) {
    const float* src = (row < 16384 ? p.peer_u + ((size_t)layer * 16384 + row) * 1024 : p.peer_v + ((size_t)layer * 16384 + (row - 16384)) * 1024) + lane * 16;
    f32x4 a[4]; float amax = 0.f;
#pragma unroll
    for (int i = 0; i < 4; ++i) {
      a[i] = *(const f32x4*)(src + 4 * i);
#pragma unroll
      for (int e = 0; e < 4; ++e) amax = fmaxf(amax, fabsf(a[i][e]));
    }
    amax = wave_max(amax);
    const float scale = amax > 0.f ? amax * (1.f / 127.f) : 1.f;
    const float inv = 1.f / scale;
    u32x4 w;
#pragma unroll
    for (int i = 0; i < 4; ++i) {
      unsigned q = 0;
#pragma unroll
      for (int e = 0; e < 4; ++e) {
        int v = (int)rintf(a[i][e] * inv);
        v = v < -127 ? -127 : (v > 127 ? 127 : v);
        q |= (unsigned)(v & 0xff) << (8 * e);
      }
      w[i] = q;
    }
    if (row < 16384) *(u32x4*)(p.uvq + (size_t)row * 1024 + lane * 16) = w;
    else *(u32x4*)(p.uvq + (size_t)16384 * 1024 + ((size_t)(lane >> 3) * 16384 + (row - 16384)) * 128 + (lane & 7) * 16) = w;
    if (lane == 0) p.uvs[row] = scale;
  }
}


typedef short s16x2 __attribute__((ext_vector_type(2)));
__device__ __forceinline__ int swap32_add(int a, int b) { auto s = __builtin_amdgcn_permlane32_swap((unsigned)a, (unsigned)b, false, false); return (int)s[0] + (int)s[1]; }
__device__ __forceinline__ int swap16_add(int a, int b) { auto s = __builtin_amdgcn_permlane16_swap((unsigned)a, (unsigned)b, false, false); return (int)s[0] + (int)s[1]; }
template <int CTRL> __device__ __forceinline__ int dpp_i(int v) { return __builtin_amdgcn_update_dpp(0, v, CTRL, 0xf, 0xf, true); }
template <int CTRL> __device__ __forceinline__ float dpp_f(float v) { return __int_as_float(__builtin_amdgcn_update_dpp(0, __float_as_int(v), CTRL, 0xf, 0xf, true)); }

struct UBatch { u32x4 uq[8]; int ent[8]; int entk; float sul, svl, gl, sxk; };
__device__ __forceinline__ void gu_issue(const Params& p, UBatch& B, const int* list, int b, int r0, int lane) {
  const signed char* U8 = (const signed char*)p.uvq;
  const i32x4 e0 = *(const i32x4*)(list + b), e1 = *(const i32x4*)(list + b + 4);
#pragma unroll
  for (int j = 0; j < 8; ++j) {
    B.ent[j] = __builtin_amdgcn_readfirstlane(j < 4 ? e0[j & 3] : e1[j & 3]);
    B.uq[j] = *(const u32x4*)(U8 + (unsigned)(((B.ent[j] & 16383) << 10) + lane * 16));
  }
  B.entk = list[b + (lane >> 3)];
  const int el = B.entk & 16383;
  B.sul = p.uvs[el]; B.svl = p.uvs[16384 + el];
  B.gl = p.gw[(size_t)(r0 + (B.entk >> 23)) * 128 + ((B.entk >> 16) & 127)];
  B.sxk = p.sxq[r0 + (B.entk >> 23)];
}
__device__ __forceinline__ void gu_compute(const Params& p, const UBatch& B, const char* xl, int b, int cnt, int r0, int lane) {
  u32x4 xs[8];
#pragma unroll
  for (int j = 0; j < 8; ++j) xs[j] = *(const u32x4*)(xl + ((B.ent[j] >> 23) << 10));
  int d[8];
#pragma unroll
  for (int j = 0; j < 8; ++j) {
    int a = 0;
#pragma unroll
    for (int c = 0; c < 4; ++c) a = __builtin_amdgcn_sdot4((int)xs[j][c], (int)B.uq[j][c], a, false);
    d[j] = a;
  }
  int r4[4], r2[2];
#pragma unroll
  for (int j = 0; j < 4; ++j) r4[j] = swap32_add(d[j], d[j + 4]);
#pragma unroll
  for (int j = 0; j < 2; ++j) r2[j] = swap16_add(r4[j], r4[j + 2]);
#pragma unroll
  for (int j = 0; j < 2; ++j) { r2[j] += dpp_i<0x128>(r2[j]); r2[j] += dpp_i<0x124>(r2[j]); r2[j] += dpp_i<0x122>(r2[j]); r2[j] += dpp_i<0x121>(r2[j]); }
  const int t = (lane & 8) ? r2[1] : r2[0];
  const int tk = B.entk >> 23;
  const float dot = B.sul * B.sxk * (float)t;
  const float wl = PEER_ALPHA * B.gl * gelu_tanh(dot) * B.svl;
  if ((lane & 7) == 0 && b + (lane >> 3) < cnt) p.wbuf[(size_t)(r0 + tk) * 128 + ((B.entk >> 16) & 127)] = wl;
}
__device__ __forceinline__ void phase_gatherU(const Params& p, int layer, int nrows) {
  const int lane = tidx() & 63, wv = __builtin_amdgcn_readfirstlane(tidx() >> 6);
  const int part = bidx() & 7, vb = bidx() >> 3, nvb = (gridDim.x - part + 7) >> 3;
  int* list = (int*)(smem + wv * 6400);
  char* xlw = smem + wv * 6400 + 2304;
  const char* xl = xlw + lane * 16;
  for (int r0 = (vb * 4 + wv) * 4; r0 < nrows; r0 += nvb * 16) {
    int iv[8];
#pragma unroll
    for (int q = 0; q < 8; ++q) iv[q] = p.idx[(size_t)(r0 + (q >> 1)) * 128 + (q & 1) * 64 + lane];
    u32x4 x4[4];
#pragma unroll
    for (int t = 0; t < 4; ++t) x4[t] = *(const u32x4*)(p.xq + (size_t)(r0 + t) * DM + lane * 16);
    int cnt = 0;
    __builtin_amdgcn_wave_barrier();
#pragma unroll
    for (int q = 0; q < 8; ++q) {
      const bool in = (iv[q] >> 11) == part;
      const unsigned long long m = __ballot(in);
      const int rk = cnt + __builtin_amdgcn_mbcnt_hi((unsigned)(m >> 32), __builtin_amdgcn_mbcnt_lo((unsigned)m, 0));
      if (in) list[rk] = ((q >> 1) << 23) | (((q & 1) * 64 + lane) << 16) | iv[q];
      cnt += __popcll(m);
    }
    if (lane < 8) list[cnt + lane] = part << 11;
#pragma unroll
    for (int t = 0; t < 4; ++t) *(u32x4*)(xlw + t * 1024 + lane * 16) = x4[t];
    __builtin_amdgcn_wave_barrier();
    if (cnt == 0) continue;
    UBatch A, Bb;
    const int lastb = (cnt - 1) & ~7;
    gu_issue(p, A, list, 0, r0, lane);
    for (int b = 0; b < cnt; b += 16) {
      gu_issue(p, Bb, list, b + 8 < lastb ? b + 8 : lastb, r0, lane);
      gu_compute(p, A, xl, b, cnt, r0, lane);
      gu_issue(p, A, list, b + 16 < lastb ? b + 16 : lastb, r0, lane);
      if (b + 8 < cnt) gu_compute(p, Bb, xl, b + 8, cnt, r0, lane);
    }
  }
}

struct VMeta { i32x4 ie[4]; f32x4 we[4]; };
struct VRows { u32x4 vq[16]; int wq4[4]; float sw; f32x2 x0, ga; };
__device__ __forceinline__ void gv_meta(const Params& p, VMeta& M, int row, int goff) {
  const int* ip = p.idx + (size_t)row * 128; const float* wp = p.wbuf + (size_t)row * 128;
#pragma unroll
  for (int i = 0; i < 4; ++i) {
    M.ie[i] = *(const i32x4*)((const char*)ip + (unsigned)(goff + 16 * i));
    M.we[i] = *(const f32x4*)((const char*)wp + (unsigned)(goff + 16 * i));
  }
}
__device__ __forceinline__ void gv_rows(const Params& p, VRows& R, const VMeta& M, const signed char* V8, int loff, int row, int layer, int coff) {
#pragma unroll
  for (int j = 0; j < 16; ++j) R.vq[j] = *(const u32x4*)(V8 + (unsigned)((M.ie[j >> 2][j & 3] << 7) + loff));
  R.x0 = *(const f32x2*)((const char*)xrow(p, row) + (unsigned)coff);
  R.ga = *(const f32x2*)((const char*)(p.mod + (size_t)(layer * 3 + modrow(row)) * 6144 + 5 * DM) + (unsigned)coff);
  float mx = fmaxf(fmaxf(fabsf(M.we[0][0]), fabsf(M.we[0][1])), fmaxf(fabsf(M.we[0][2]), fabsf(M.we[0][3])));
#pragma unroll
  for (int i = 1; i < 4; ++i) mx = fmaxf(fmaxf(fmaxf(mx, fabsf(M.we[i][0])), fmaxf(fabsf(M.we[i][1]), fabsf(M.we[i][2]))), fabsf(M.we[i][3]));
  mx = fmaxf(mx, dpp_f<0x128>(mx));
  { auto s = __builtin_amdgcn_permlane16_swap(__float_as_uint(mx), __float_as_uint(mx), false, false); mx = fmaxf(__uint_as_float(s[0]), __uint_as_float(s[1])); }
  { auto s = __builtin_amdgcn_permlane32_swap(__float_as_uint(mx), __float_as_uint(mx), false, false); mx = fmaxf(__uint_as_float(s[0]), __uint_as_float(s[1])); }
  R.sw = mx > 0.f ? mx * (1.f / 127.f) : 1.f;
  const float k = (mx > 0.f ? 127.f / mx : 1.f) * (256.f / 32767.f);
#pragma unroll
  for (int i = 0; i < 4; ++i) {
    auto c0 = __builtin_amdgcn_cvt_pknorm_i16(M.we[i][0] * k, M.we[i][1] * k), c1 = __builtin_amdgcn_cvt_pknorm_i16(M.we[i][2] * k, M.we[i][3] * k);
    s16x2 a = {c0[0], c0[1]}, bq = {c1[0], c1[1]};
    a = a + (s16x2){128, 128}; bq = bq + (s16x2){128, 128};
    const unsigned ua = ((unsigned)(unsigned short)a[1] << 16) | (unsigned short)a[0], ub = ((unsigned)(unsigned short)bq[1] << 16) | (unsigned short)bq[0];
    R.wq4[i] = (int)__builtin_amdgcn_perm(ub, ua, 0x07050301u);
  }
}
__device__ __forceinline__ void gv_compute(const Params& p, const VRows& R, int row, int coff, int lane, float oscale, bool valid = true) {
  int acc[16];
#pragma unroll
  for (int grp = 0; grp < 4; ++grp) {
#pragma unroll
    for (int dw = 0; dw < 4; ++dw) {
      if (grp == 0) { acc[4 * dw] = 0; acc[4 * dw + 1] = 0; acc[4 * dw + 2] = 0; acc[4 * dw + 3] = 0; }
      const unsigned D0 = R.vq[4 * grp][dw], D1 = R.vq[4 * grp + 1][dw], D2 = R.vq[4 * grp + 2][dw], D3 = R.vq[4 * grp + 3][dw];
      const unsigned P0 = __builtin_amdgcn_perm(D1, D0, 0x05010400u), P1 = __builtin_amdgcn_perm(D1, D0, 0x07030602u);
      const unsigned Q0 = __builtin_amdgcn_perm(D3, D2, 0x05010400u), Q1 = __builtin_amdgcn_perm(D3, D2, 0x07030602u);
      const unsigned T0 = __builtin_amdgcn_perm(Q0, P0, 0x05040100u), T1 = __builtin_amdgcn_perm(Q0, P0, 0x07060302u);
      const unsigned T2 = __builtin_amdgcn_perm(Q1, P1, 0x05040100u), T3 = __builtin_amdgcn_perm(Q1, P1, 0x07060302u);
      acc[4 * dw] = __builtin_amdgcn_sdot4((int)T0, R.wq4[grp], acc[4 * dw], false);
      acc[4 * dw + 1] = __builtin_amdgcn_sdot4((int)T1, R.wq4[grp], acc[4 * dw + 1], false);
      acc[4 * dw + 2] = __builtin_amdgcn_sdot4((int)T2, R.wq4[grp], acc[4 * dw + 2], false);
      acc[4 * dw + 3] = __builtin_amdgcn_sdot4((int)T3, R.wq4[grp], acc[4 * dw + 3], false);
    }
  }
  int r8[8], r4[4], r2[2];
#pragma unroll
  for (int j = 0; j < 8; ++j) r8[j] = swap32_add(acc[j], acc[j + 8]);
#pragma unroll
  for (int j = 0; j < 4; ++j) r4[j] = swap16_add(r8[j], r8[j + 4]);
#pragma unroll
  for (int j = 0; j < 4; ++j) r4[j] += dpp_i<0x128>(r4[j]);
  const bool b3 = lane & 8;
  r2[0] = b3 ? r4[2] : r4[0]; r2[1] = b3 ? r4[3] : r4[1];
  f32x2 x0 = R.x0;
  x0[0] += oscale * R.ga[0] * R.sw * (float)r2[0]; x0[1] += oscale * R.ga[1] * R.sw * (float)r2[1];
  if (valid) *(f32x2*)((char*)xrow(p, row) + (unsigned)coff) = x0;
}
__device__ __forceinline__ void phase_gatherV(const Params& p, int layer, int nrows, float oscale = 1.f) {
  const int lane = tidx() & 63, wv = __builtin_amdgcn_readfirstlane(tidx() >> 6);
  const int part = bidx() & 7, vb = bidx() >> 3, nvb = (gridDim.x - part + 7) >> 3;
  const signed char* V8 = (const signed char*)p.uvq + (size_t)16384 * 1024 + (size_t)part * 16384 * 128;
  const int loff = (lane & 7) * 16, goff = (lane >> 3) * 64;
  const int coff = 4 * (part * 128 + (lane & 7) * 16 + ((lane >> 5) & 1) * 8 + ((lane >> 4) & 1) * 4 + ((lane >> 3) & 1) * 2);
  const int rs = nvb * 4, rfirst = vb * 4 + wv;
  if (rfirst >= nrows) return;
  const int n = (nrows - rfirst + rs - 1) / rs;
  VMeta M; VRows RA, RB;
#define ROWK(k) (rfirst + ((k) < n - 1 ? (k) : n - 1) * rs)
  gv_meta(p, M, ROWK(0), goff);
  gv_rows(p, RA, M, V8, loff, ROWK(0), layer, coff);
  gv_meta(p, M, ROWK(1), goff);
  for (int k = 0; k < n; k += 2) {
    gv_rows(p, RB, M, V8, loff, ROWK(k + 1), layer, coff);
    gv_meta(p, M, ROWK(k + 2), goff);
    gv_compute(p, RA, ROWK(k), coff, lane, oscale);
    gv_rows(p, RA, M, V8, loff, ROWK(k + 2), layer, coff);
    gv_meta(p, M, ROWK(k + 3), goff);
    gv_compute(p, RB, ROWK(k + 1), coff, lane, oscale, k + 1 < n);
  }
#undef ROWK
}

__device__ __forceinline__ unsigned f2key(float f) { unsigned u = __float_as_uint(f); return (u & 0x80000000u) ? ~u : (u | 0x80000000u); }
__device__ __forceinline__ float key2f(unsigned k) { unsigned u = (k & 0x80000000u) ? (k ^ 0x80000000u) : ~k; return __uint_as_float(u); }
#define INS16(L, vv) { unsigned v_ = (vv); _Pragma("unroll") for (int j_ = 0; j_ < 16; ++j_) { unsigned hi_ = max(L[j_], v_); v_ = min(L[j_], v_); L[j_] = hi_; } }
__device__ __forceinline__ unsigned sel16(const unsigned (&a)[16], unsigned i) {
  unsigned t[8], u[4], v[2];
#pragma unroll
  for (int k = 0; k < 8; ++k) t[k] = (i & 1u) ? a[2 * k + 1] : a[2 * k];
#pragma unroll
  for (int k = 0; k < 4; ++k) u[k] = (i & 2u) ? t[2 * k + 1] : t[2 * k];
#pragma unroll
  for (int k = 0; k < 2; ++k) v[k] = (i & 4u) ? u[2 * k + 1] : u[2 * k];
  return (i & 8u) ? v[1] : v[0];
}

__device__ __forceinline__ void sort16_desc(unsigned (&a)[16]) {
#pragma unroll
  for (int k = 2; k <= 16; k <<= 1)
#pragma unroll
    for (int j = k >> 1; j > 0; j >>= 1)
#pragma unroll
      for (int i = 0; i < 16; ++i) {
        const int l = i ^ j;
        if (l > i) {
          const unsigned hi = max(a[i], a[l]), lo = min(a[i], a[l]);
          if ((i & k) == 0) { a[i] = hi; a[l] = lo; } else { a[i] = lo; a[l] = hi; }
        }
      }
}
__device__ __forceinline__ void merge16_desc(unsigned (&L)[16], const unsigned (&g)[16]) {
#pragma unroll
  for (int i = 0; i < 16; ++i) L[i] = max(L[i], g[15 - i]);
#pragma unroll
  for (int j = 8; j > 0; j >>= 1)
#pragma unroll
    for (int i = 0; i < 16; ++i) {
      const int l = i ^ j;
      if (l > i) { const unsigned hi = max(L[i], L[l]), lo = min(L[i], L[l]); L[i] = hi; L[l] = lo; }
    }
}
__device__ __forceinline__ void phase_topk2(const Params& p, int layer, int nrows) {
  char* SK = smem;
  const int tid = tidx(), wid = tid >> 6, lane = tid & 63, l31 = lane & 31, hh = lane >> 5;
  const int ntiles = nrows / 128;
  int cur_h = -1;
  for (int item = bidx(); item < ntiles * 8; item += gridDim.x) {
    const int h = item & 7, tile = item >> 3;
    if (h != cur_h) {
      __syncthreads();
      const bf16_t* src = p.sk + ((size_t)layer * 8 + h) * 2 * 128 * 128;
#pragma unroll
      for (int i = 0; i < 16; ++i) {
        int id = tid + 256 * i, row = id >> 4, c16 = id & 15;
        *(u32x4*)(SK + row * 272 + c16 * 16) = *(const u32x4*)(src + (size_t)row * 128 + c16 * 8);
      }
      __syncthreads();
      cur_h = h;
    }
    const int row = tile * 128 + wid * 32 + l31;
    f32x16 sc[2][4];
#pragma unroll
    for (int pp = 0; pp < 2; ++pp) {
      bf16x8 qf[8];
#pragma unroll
      for (int ks = 0; ks < 8; ++ks) qf[ks] = *(const bf16x8*)(p.q + (size_t)row * 2048 + h * 256 + pp * 128 + ks * 16 + hh * 8);
#pragma unroll
      for (int kb = 0; kb < 4; ++kb) {
#pragma unroll
        for (int r = 0; r < 16; ++r) sc[pp][kb][r] = 0.f;
#pragma unroll
        for (int ks = 0; ks < 8; ++ks) {
          bf16x8 a = *(const bf16x8*)(SK + (pp * 128 + kb * 32 + l31) * 272 + (ks * 16 + hh * 8) * 2);
          sc[pp][kb] = __builtin_amdgcn_mfma_f32_32x32x16_bf16(a, qf[ks], sc[pp][kb], 0, 0, 0);
        }
      }
    }
    unsigned L1[16];
#pragma unroll
    for (int j = 0; j < 16; ++j) L1[j] = 0u;
#pragma unroll
    for (int kb = 0; kb < 4; ++kb)
#pragma unroll
      for (int rh = 0; rh < 2; ++rh) {
        unsigned g[16];
#pragma unroll
        for (int rr = 0; rr < 8; ++rr) {
          const int r = rh * 8 + rr;
          auto sw = __builtin_amdgcn_permlane32_swap(__float_as_uint(sc[0][kb][r]), __float_as_uint(sc[1][kb][r]), false, false);
          const unsigned kidx = kb * 32 + (r & 3) + 8 * (r >> 2);
          g[2 * rr] = (f2key(__uint_as_float(sw[0])) & ~127u) | kidx;
          g[2 * rr + 1] = (f2key(__uint_as_float(sw[1])) & ~127u) | (kidx + 4);
        }
        sort16_desc(g);
        merge16_desc(L1, g);
      }
    float As[16], Bs[16]; unsigned Ai[16], Bi[16];
#pragma unroll
    for (int j = 0; j < 16; ++j) {
      auto sw = __builtin_amdgcn_permlane32_swap(L1[j], L1[j], false, false);
      unsigned other = hh ? sw[0] : sw[1];
      unsigned ka = hh ? other : L1[j], kb_ = hh ? L1[j] : other;
      As[j] = key2f(ka & ~127u); Ai[j] = ka & 127u;
      Bs[j] = key2f(kb_ & ~127u); Bi[j] = kb_ & 127u;
    }
    unsigned L2[16];
#pragma unroll
    for (int j = 0; j < 16; ++j) L2[j] = 0u;
    const float smax = As[0] + Bs[0];
#define CKEY(i, j) (((262143u - min((unsigned)((smax - (As[i] + Bs[j])) * 16384.f), 262143u)) << 14) | (Ai[i] * 128u + Bi[j]))
    {
      unsigned g[16];
      g[0] = CKEY(0, 0);
      g[1] = CKEY(0, 1);
      g[2] = CKEY(0, 2);
      g[3] = CKEY(0, 3);
      g[4] = CKEY(0, 4);
      g[5] = CKEY(0, 5);
      g[6] = CKEY(0, 6);
      g[7] = CKEY(0, 7);
      g[8] = CKEY(0, 8);
      g[9] = CKEY(0, 9);
      g[10] = CKEY(0, 10);
      g[11] = CKEY(0, 11);
      g[12] = CKEY(0, 12);
      g[13] = CKEY(0, 13);
      g[14] = CKEY(0, 14);
      g[15] = CKEY(0, 15);
      sort16_desc(g);
      merge16_desc(L2, g);
    }
    {
      unsigned g[16];
      g[0] = CKEY(1, 0);
      g[1] = CKEY(1, 1);
      g[2] = CKEY(1, 2);
      g[3] = CKEY(1, 3);
      g[4] = CKEY(1, 4);
      g[5] = CKEY(1, 5);
      g[6] = CKEY(1, 6);
      g[7] = CKEY(1, 7);
      g[8] = CKEY(2, 0);
      g[9] = CKEY(2, 1);
      g[10] = CKEY(2, 2);
      g[11] = CKEY(2, 3);
      g[12] = CKEY(2, 4);
      g[13] = CKEY(3, 0);
      g[14] = CKEY(3, 1);
      g[15] = CKEY(3, 2);
      sort16_desc(g);
      merge16_desc(L2, g);
    }
    {
      unsigned g[16];
      g[0] = CKEY(3, 3);
      g[1] = CKEY(4, 0);
      g[2] = CKEY(4, 1);
      g[3] = CKEY(4, 2);
      g[4] = CKEY(5, 0);
      g[5] = CKEY(5, 1);
      g[6] = CKEY(6, 0);
      g[7] = CKEY(6, 1);
      g[8] = CKEY(7, 0);
      g[9] = CKEY(7, 1);
      g[10] = CKEY(8, 0);
      g[11] = CKEY(9, 0);
      g[12] = CKEY(10, 0);
      g[13] = CKEY(11, 0);
      g[14] = CKEY(12, 0);
      g[15] = CKEY(13, 0);
      sort16_desc(g);
      merge16_desc(L2, g);
    }
    {
      unsigned g[16];
      g[0] = CKEY(14, 0);
      g[1] = CKEY(15, 0);
      g[2] = 0u;
      g[3] = 0u;
      g[4] = 0u;
      g[5] = 0u;
      g[6] = 0u;
      g[7] = 0u;
      g[8] = 0u;
      g[9] = 0u;
      g[10] = 0u;
      g[11] = 0u;
      g[12] = 0u;
      g[13] = 0u;
      g[14] = 0u;
      g[15] = 0u;
      sort16_desc(g);
      merge16_desc(L2, g);
    }
#undef CKEY
    float ex[16]; unsigned ev[16]; float sum = 0.f;
#pragma unroll
    for (int t = 0; t < 16; ++t) {
      ev[t] = L2[t] & 16383u;
      float d = (float)(262143u - (L2[t] >> 14)) * (1.f / 16384.f);
      ex[t] = __expf(-d); sum += ex[t];
    }
    const float isum = 1.f / sum;
    if (hh == 0) {
      int* ip = p.idx + (size_t)row * 128 + h * 16;
      float* gp = p.gw + (size_t)row * 128 + h * 16;
#pragma unroll
      for (int t4 = 0; t4 < 4; ++t4) {
        u32x4 e0 = {ev[4 * t4], ev[4 * t4 + 1], ev[4 * t4 + 2], ev[4 * t4 + 3]};
        f32x4 g0 = {ex[4 * t4] * isum, ex[4 * t4 + 1] * isum, ex[4 * t4 + 2] * isum, ex[4 * t4 + 3] * isum};
        *(u32x4*)(ip + 4 * t4) = e0;
        *(f32x4*)(gp + 4 * t4) = g0;
      }
    }
  }
}

__device__ __forceinline__ void phase_gather(const Params& p, int layer, int nrows, float oscale) {
  const int lane = tidx() & 63, wv = tidx() >> 6;
  const bf16_t* U = p.uv; const bf16_t* V = p.uv + (size_t)16384 * 1024;
  for (int row = bidx() * 4 + wv; row < nrows; row += gridDim.x * 4) {
    float xv[16], acc[16];
    {
      u32x4 a = *(const u32x4*)(p.h + (size_t)row * DM + lane * 8), b = *(const u32x4*)(p.h + (size_t)row * DM + 512 + lane * 8);
#pragma unroll
      for (int e = 0; e < 4; ++e) {
        xv[2 * e] = __uint_as_float(a[e] << 16); xv[2 * e + 1] = __uint_as_float(a[e] & 0xffff0000u);
        xv[8 + 2 * e] = __uint_as_float(b[e] << 16); xv[8 + 2 * e + 1] = __uint_as_float(b[e] & 0xffff0000u);
      }
    }
#pragma unroll
    for (int i = 0; i < 16; ++i) acc[i] = 0.f;
    int myidx0 = p.idx[(size_t)row * 128 + lane], myidx1 = p.idx[(size_t)row * 128 + 64 + lane];
    float myg0 = p.gw[(size_t)row * 128 + lane], myg1 = p.gw[(size_t)row * 128 + 64 + lane];
    for (int k = 0; k < 128; ++k) {
      int e_ = k < 64 ? __shfl(myidx0, k) : __shfl(myidx1, k - 64);
      float g_ = k < 64 ? __shfl(myg0, k) : __shfl(myg1, k - 64);
      e_ = __builtin_amdgcn_readfirstlane(e_);
#if DIAG_HP
      const float* ur = p.peer_u + ((size_t)layer * 16384 + e_) * DM; const float* vr = p.peer_v + ((size_t)layer * 16384 + e_) * DM;
      f32x4 u0 = *(const f32x4*)(ur + lane * 8), u1 = *(const f32x4*)(ur + lane * 8 + 4), u2 = *(const f32x4*)(ur + 512 + lane * 8), u3 = *(const f32x4*)(ur + 512 + lane * 8 + 4);
      f32x4 v0 = *(const f32x4*)(vr + lane * 8), v1 = *(const f32x4*)(vr + lane * 8 + 4), v2 = *(const f32x4*)(vr + 512 + lane * 8), v3 = *(const f32x4*)(vr + 512 + lane * 8 + 4);
      float dot = 0.f;
#pragma unroll
      for (int e = 0; e < 4; ++e) dot += xv[e] * u0[e] + xv[4 + e] * u1[e] + xv[8 + e] * u2[e] + xv[12 + e] * u3[e];
      dot = wave_sum(dot);
      float w = g_ * gelu_tanh(dot);
#pragma unroll
      for (int e = 0; e < 4; ++e) { acc[e] += w * v0[e]; acc[4 + e] += w * v1[e]; acc[8 + e] += w * v2[e]; acc[12 + e] += w * v3[e]; }
#else
      const bf16_t* ur = U + (size_t)e_ * DM; const bf16_t* vr = V + (size_t)e_ * DM;
      u32x4 ua = *(const u32x4*)(ur + lane * 8), ub = *(const u32x4*)(ur + 512 + lane * 8);
      u32x4 va = *(const u32x4*)(vr + lane * 8), vb = *(const u32x4*)(vr + 512 + lane * 8);
      float dot = 0.f;
#pragma unroll
      for (int e = 0; e < 4; ++e) {
        dot += xv[2 * e] * __uint_as_float(ua[e] << 16) + xv[2 * e + 1] * __uint_as_float(ua[e] & 0xffff0000u);
        dot += xv[8 + 2 * e] * __uint_as_float(ub[e] << 16) + xv[8 + 2 * e + 1] * __uint_as_float(ub[e] & 0xffff0000u);
      }
      dot = wave_sum(dot);
      float w = PEER_ALPHA * oscale * g_ * gelu_tanh(dot);
#pragma unroll
      for (int e = 0; e < 4; ++e) {
        acc[2 * e] += w * __uint_as_float(va[e] << 16); acc[2 * e + 1] += w * __uint_as_float(va[e] & 0xffff0000u);
        acc[8 + 2 * e] += w * __uint_as_float(vb[e] << 16); acc[8 + 2 * e + 1] += w * __uint_as_float(vb[e] & 0xffff0000u);
      }
#endif
    }
    float* xr = xrow(p, row);
    const float* g2 = p.mod + (size_t)(layer * 3 + modrow(row)) * 6144 + 5 * DM;
#pragma unroll
    for (int hh = 0; hh < 2; ++hh) {
      int c0 = hh * 512 + lane * 8;
      f32x4 x0 = *(const f32x4*)(xr + c0), x1 = *(const f32x4*)(xr + c0 + 4);
      f32x4 ga = *(const f32x4*)(g2 + c0), gb = *(const f32x4*)(g2 + c0 + 4);
#pragma unroll
      for (int e = 0; e < 4; ++e) { x0[e] += ga[e] * acc[hh * 8 + e]; x1[e] += gb[e] * acc[hh * 8 + 4 + e]; }
      *(f32x4*)(xr + c0) = x0; *(f32x4*)(xr + c0 + 4) = x1;
    }
  }
}


__device__ __forceinline__ void phase_mix1(const Params& p, int layer, int with_ctx_queries) {
  const bool fast = attn_logit_bound(p, layer) <= 15.5f;
  const int natt = fast ? 512 + (with_ctx_queries ? 16 : 0) : 1024 + (with_ctx_queries ? 32 : 0);
  const int G = gridDim.x, b_ = bidx();
  for (int item = b_; item < natt; item += G) { for (int r = 0; r < REP_ATT; ++r) { if (fast) attn_item64(p, layer, item); else attn_item(p, layer, item); } }
  int b1 = b_ - natt % G; if (b1 < 0) b1 += G;
  for (int it = b1; it < 528; it += G) { for (int r = 0; r < REP_MLA; ++r) mlA_item(p, layer, it); }
  const int nextra = 528 % G;
  const int first = (nextra * 2 < G) ? nextra : 0, span = G - first;
  if (b1 >= first)
    for (int it = b1 - first; it < 1056; it += span) { for (int r = 0; r < REP_SSDA; ++r) ssdA_item(p, layer, it); }
}
__device__ __forceinline__ void phase_mix3(const Params& p, int layer, int last) {
  const int nc = last ? 64 : 66, G = gridDim.x, b_ = bidx();
  const int nml = 2 * nc * 4, nssd = 2 * nc * 8;
  for (int it = b_; it < nml; it += G) {
    const int b = it / (nc * 4), c = (it / 4) % nc, h = it & 3;
    for (int r = 0; r < REP_MLC; ++r) mlC_item(p, layer, (b * 66 + c) * 4 + h);
  }
  const int nextra = nml % G;
  const int first = (nextra * 2 < G) ? nextra : 0, span = G - first;
  if (b_ >= first)
    for (int it = b_ - first; it < nssd; it += span) {
      const int b = it / (nc * 8), c = (it / 8) % nc, h = it & 7;
      for (int r = 0; r < REP_SSDC; ++r) ssdC_item(p, layer, (b * 66 + c) * 8 + h);
    }
}


#define XB_TMO      128
#define XB_XCNT(j)  (256  + 64 * (j))
#define XB_XSUB(j)  (1280 + 64 * (j))
#define XB_XGEN(j)  (2304 + 64 * (j))
#define XB_TOP      3328
#define XB_TOPGEN   3392
#define XCD_BAR_WORDS 3456
#define XB_SPIN_CAP (1u << 18)
#define LAS __attribute__((address_space(3)))
__device__ __forceinline__ unsigned xb_ld(unsigned* p)              { return __hip_atomic_load(p, __ATOMIC_RELAXED, __HIP_MEMORY_SCOPE_AGENT); }
__device__ __forceinline__ unsigned xb_add(unsigned* p, unsigned v) { return __hip_atomic_fetch_add(p, v, __ATOMIC_RELAXED, __HIP_MEMORY_SCOPE_AGENT); }
__device__ __forceinline__ unsigned xb_xcc_id() { return (unsigned)__builtin_amdgcn_s_getreg((3 << 11) | 20) & 0xFu; }
#define XB_SPIN(cond, bar) do { unsigned _sp = 0; while (cond) { __builtin_amdgcn_s_sleep(1); \
    if ((++_sp & 255u) == 0u) { if (xb_ld(&(bar)[XB_TMO])) break; if (_sp > XB_SPIN_CAP) { atomicAdd(&(bar)[XB_TMO], 1u); break; } } } } while (0)
struct XcdBarrier { unsigned* bar; unsigned x; volatile LAS unsigned* st; };
__device__ __forceinline__ XcdBarrier xcd_barrier_post(unsigned* bar, volatile LAS unsigned* st) {
    XcdBarrier b; b.bar = bar; b.x = xb_xcc_id(); b.st = st;
    if (threadIdx.x == 0) (void)xb_add(&bar[XB_XCNT(b.x)], 1u);
    return b;
}
__device__ __forceinline__ void xcd_barrier_complete(unsigned* bar, unsigned x, unsigned& nloc, unsigned& nx) {
    const unsigned G = gridDim.x * gridDim.y * gridDim.z;
    unsigned sum, cnt, mine, sp = 0u;
    for (;;) {
        sum = 0u; cnt = 0u; mine = 0u;
#pragma unroll
        for (unsigned j = 0; j < 16; ++j) { const unsigned c = xb_ld(&bar[XB_XCNT(j)]); sum += c; cnt += (c > 0u) ? 1u : 0u; mine = (j == x) ? c : mine; }
        if (sum == G) break;
        __builtin_amdgcn_s_sleep(1);
        if ((++sp & 255u) == 0u) { if (xb_ld(&bar[XB_TMO])) break; if (sp > XB_SPIN_CAP) { atomicAdd(&bar[XB_TMO], 1u); break; } }
    }
    nloc = mine > 0u ? mine : 1u; nx = cnt > 0u ? cnt : 1u;
}
__device__ __forceinline__ void xcd_barrier(const XcdBarrier& b) {
    asm volatile("s_waitcnt vmcnt(0)" ::: "memory");
    __syncthreads();
    if (threadIdx.x == 0) {
        unsigned* bar = b.bar;
        __builtin_amdgcn_s_waitcnt(0);
        unsigned nloc = b.st[0], nx = b.st[1];
        if (nloc == 0u) { xcd_barrier_complete(bar, b.x, nloc, nx); b.st[0] = nloc; b.st[1] = nx; }
        const unsigned old = xb_add(&bar[XB_XSUB(b.x)], 1u);
        const unsigned gen = old / nloc;
        if (old + 1u == (gen + 1u) * nloc) {
            __builtin_amdgcn_fence(__ATOMIC_RELEASE, "agent");
            asm volatile("s_waitcnt vmcnt(0)" ::: "memory");
            const unsigned og = xb_add(&bar[XB_TOP], 1u);
            const unsigned tg = og / nx;
            if (og + 1u == (tg + 1u) * nx) xb_add(&bar[XB_TOPGEN], 1u);
            else XB_SPIN(xb_ld(&bar[XB_TOPGEN]) == tg, bar);
            __builtin_amdgcn_fence(__ATOMIC_ACQUIRE, "agent");
            xb_add(&bar[XB_XGEN(b.x)], 1u);
            asm volatile("s_waitcnt vmcnt(0)" ::: "memory");
        } else {
            XB_SPIN(xb_ld(&bar[XB_XGEN(b.x)]) == gen, bar);
            __builtin_amdgcn_fence(__ATOMIC_ACQUIRE, "agent");
            asm volatile("s_waitcnt vmcnt(0)" ::: "memory");
        }
    }
    __syncthreads();
}

#ifndef REP_GEMM
#define REP_GEMM 1
#endif

#ifndef REP_MIX
#define REP_MIX 1
#endif
#ifndef REP_PV
#define REP_PV 1
#endif
#ifndef REP_PEER
#define REP_PEER 1
#endif
#ifndef REP_ELEM
#define REP_ELEM 1
#endif
#ifndef REP_SYNC
#define REP_SYNC 1
#endif
#ifndef REP_TOPK
#define REP_TOPK 1
#endif
#define GSYNC() do { for (int r_ = 0; r_ < REP_SYNC; ++r_) xcd_barrier(xb); } while (0)
__global__ void __launch_bounds__(256, 2) k_mega(Params p) {
  cg::grid_group grid = cg::this_grid();
  volatile LAS unsigned* xst = (volatile LAS unsigned*)(smem + LDS_BYTES - 16);
  if (threadIdx.x == 0) { xst[0] = 0u; xst[1] = 0u; }
  __syncthreads();
  XcdBarrier xb = xcd_barrier_post(p.bar, xst);
  for (int r = 0; r < REP_INIT; ++r) phase_init(p);
  if (p.bar == nullptr) grid.sync();
  GSYNC();
  for (int layer = 0; layer < 2; ++layer) {
    const int last = layer == 1;
    const int nrows2 = last ? NLAT : MROWS;
    if (layer == 0 || DIAG_HP) { for (int r = 0; r < REP_NORM; ++r) phase_norm(p, layer, 1, MROWS, layer == 0); GSYNC(); }
    for (int r = 0; r < REP_GEMM * REP_G_IN; ++r) phase_inproj(p, layer, MROWS, DIAG_HP ? 0 : 2);
    GSYNC();
    for (int r = 0; r < REP_SPREP; ++r) { phase_ssdprep(p, layer); phase_vtrans(p); }
    GSYNC();
    for (int r = 0; r < REP_MIX; ++r) phase_mix1(p, layer, !last);
    GSYNC();
    phase_ssdcarry(p); phase_mlcarry(p); GSYNC();
    for (int r = 0; r < REP_MIX; ++r) phase_mix3(p, layer, last);
    GSYNC();
    for (int r = 0; r < REP_SOUT; ++r) { phase_ssdout(p, layer, nrows2); phase_mlout(p, layer, nrows2); }
    GSYNC();
#if DIAG_HP
    for (int r = 0; r < REP_GEMM * REP_G_GATE; ++r) phase_inproj(p, layer, nrows2, 1);
    GSYNC();
#endif
    for (int r = 0; r < REP_GEMM * REP_G_MERGE; ++r) phase_merge(p, layer, nrows2);
    GSYNC();
    for (int r = 0; r < REP_GEMM * REP_G_OUT; ++r) phase_outproj(p, layer, nrows2, r == 0 ? 1.f : 0.f, (layer == 0 && r == 0) ? 1 : 0);
    GSYNC();
    for (int r = 0; r < REP_NORM; ++r) phase_norm(p, layer, 2, nrows2, 0);
    GSYNC();
    for (int r = 0; r < REP_GEMM * REP_G_WQ; ++r) phase_wq(p, layer, nrows2);
#if !DIAG_HP
    for (int r = 0; r < REP_UVC; ++r) phase_uvconv8(p, layer);
#endif
    GSYNC();
    for (int r = 0; r < REP_TOPK; ++r) { if (DIAG_HP) phase_topk(p, layer, nrows2); else phase_topk2(p, layer, nrows2); }
    GSYNC();
#if DIAG_HP
    phase_gather(p, layer, nrows2, 1.f);
    if (!last) { GSYNC(); phase_norm(p, layer + 1, 1, nrows2, 0); GSYNC(); }
#else
    for (int r = 0; r < REP_PEER; ++r) phase_gatherU(p, layer, nrows2);
    GSYNC();
    for (int r = 0; r < REP_PV; ++r) phase_gatherV(p, layer, nrows2, r == 0 ? 1.f : 0.f);
    if (!last) { GSYNC(); phase_norm(p, layer + 1, 1, nrows2, 0); GSYNC(); }
#endif
  }
}

extern "C" void kernel_launch(void* const* d_in, const int* in_sizes, int n_in, void* d_out, int out_size, void* d_ws, size_t ws_size,
                              hipStream_t stream) {
  Params p{};
  const float* const* in = (const float* const*)d_in;
  p.x = in[0]; p.c = in[1]; p.ctx = in[2]; p.c_ctx = in[3]; p.norm1_g = in[4]; p.norm2_g = in[5]; p.w_mod = in[6]; p.b_mod = in[7];
  p.w_in = in[8]; p.att_qnorm = in[9]; p.att_knorm = in[10]; p.ssd_conv_w = in[11]; p.ssd_conv_b = in[12]; p.ssd_dt_bias = in[13];
  p.ssd_a_log = in[14]; p.ssd_d = in[15]; p.ssd_norm = in[16]; p.ml_gate_bias = in[17]; p.ml_norm = in[18]; p.w_branch = in[19];
  p.w_out = in[20]; p.peer_wq = in[21]; p.peer_subkeys = in[22]; p.peer_u = in[23]; p.peer_v = in[24];
  p.out = (float*)d_out;
  char* w = (char*)d_ws; size_t off = 65536;
  p.bar = (unsigned*)d_ws;
  auto take = [&](size_t bytes) { char* r = w + off; off += (bytes + 255) & ~(size_t)255; return r; };
  p.mod = (float*)take((size_t)2 * 3 * 6144 * 4);
  p.xc = (float*)take((size_t)NCTX * DM * 4);
  p.small = (float*)take((size_t)MROWS * 32 * 4);
  p.dtb = (float*)take((size_t)MROWS * 16 * 4);
  p.wt_in = (bf16_t*)take((size_t)2 * INCP * DM * 2);
  p.wt_br = (bf16_t*)take((size_t)2 * 3 * DM * 512 * 2);
  p.wt_out = (bf16_t*)take((size_t)2 * DM * DM * 2);
  p.wt_q = (bf16_t*)take((size_t)2 * 2048 * DM * 2);
  p.sk = (bf16_t*)take((size_t)2 * 8 * 2 * 128 * 128 * 2);
  p.wt_q_lo = (bf16_t*)take(DIAG_HP ? (size_t)2 * 2048 * DM * 2 : 256);
  p.vt = (bf16_t*)take((size_t)4 * 64 * 8448 * 2 + (size_t)2 * 4 * 132 * 4096);
  p.ropec = (float*)take((size_t)8192 * 32 * 4);
  p.ropes = (float*)take((size_t)8192 * 32 * 4);
  p.ssl = (bf16_t*)take((size_t)32 * 66 * 4096 * 2);
  p.sdec = (float*)take((size_t)32 * 66 * 4);
  p.mcl = (bf16_t*)take((size_t)16 * 66 * 16384 * 2);
  p.mnl = (float*)take((size_t)16 * 66 * 128 * 4);
  p.mml = (float*)take((size_t)16 * 66 * 4);
  p.mbl = (float*)take((size_t)16 * 66 * 4);
  p.mmp = (float*)take((size_t)16 * 66 * 4);
  p.h = (bf16_t*)take((size_t)MROWS * DM * 2);
  p.br = (bf16_t*)take((size_t)MROWS * 1536 * 2);
  p.xbc = (bf16_t*)take((size_t)MROWS * 768 * 2);
  p.idx = (int*)p.xbc; p.gw = (float*)((char*)p.xbc + (size_t)MROWS * 128 * 4);
  p.yf = (bf16_t*)take((size_t)MROWS * 512 * 2);
  p.yb = (bf16_t*)take((size_t)MROWS * 512 * 2);
  p.hf = (bf16_t*)take((size_t)MROWS * 512 * 2);
  p.hb = p.hf;
  p.gp8 = (unsigned char*)take((size_t)MROWS * 3072);
  p.mix = p.yf;
  p.proj = (bf16_t*)take((size_t)MROWS * 4096 * 2);
  p.uvs = (float*)take((size_t)2 * 16384 * 4);
  p.gp = p.proj; p.q = p.proj; p.qf = (float*)p.proj; p.h2lo = p.br; p.uv = (bf16_t*)((char*)p.proj + (size_t)MROWS * 2048 * 2); p.uvq = (unsigned char*)p.uv;
  p.xq = (signed char*)p.br; p.sxq = (float*)((char*)p.br + (size_t)MROWS * DM); p.wbuf = (float*)((char*)p.br + (size_t)MROWS * DM + (size_t)MROWS * 4);
  if (off > ws_size) return;

  const int LDS = LDS_BYTES;
  static int grid_blocks = 0;
  if (!grid_blocks) {
    (void)hipFuncSetAttribute((const void*)k_mega, hipFuncAttributeMaxDynamicSharedMemorySize, LDS);
    int dev = 0, cus = 0, per_cu = 0;
    (void)hipGetDevice(&dev);
    (void)hipDeviceGetAttribute(&cus, hipDeviceAttributeMultiprocessorCount, dev);
    (void)hipOccupancyMaxActiveBlocksPerMultiprocessor(&per_cu, (const void*)k_mega, 256, LDS);
    if (per_cu < 1) per_cu = 1;
    if (per_cu > 2) per_cu = 2;
    grid_blocks = cus * per_cu;
  }
  (void)hipMemsetAsync(d_ws, 0, XCD_BAR_WORDS * 4, stream);
  void* args[] = {&p};
  hipError_t e = hipLaunchCooperativeKernel((const void*)k_mega, dim3(grid_blocks), dim3(256), args, LDS, stream);
  if (e != hipSuccess) fprintf(stderr, "cooperative launch failed: %s (grid %d)\n", hipGetErrorString(e), grid_blocks);
}
```
